# Optimizing an MI355X kernel written in HIP

```python
import jax, jax.numpy as jnp
from jax import lax
import numpy as np

D_MODEL = 2048
BATCH = 4
SEQ = 2048
DEPTH = 1

HEAD_DIM = 64
N_ATTN_HEADS = 16
ATTN_WIDTH = N_ATTN_HEADS * HEAD_DIM
LRU_WIDTH = D_MODEL - ATTN_WIDTH
N_LRU_BLOCKS = 16
LRU_BLOCK = LRU_WIDTH // N_LRU_BLOCKS
CONV_WIDTH = 4
LRU_C = 8.0
IN_COLS = 3 * ATTN_WIDTH + 2 * LRU_WIDTH
DILATED_BRANCHES = ((128, 1), (512, 4), (2048, 16))
ATTN_BLOCK = 128
N_EXPERTS = 32
TOP_K = 4
D_FF = D_MODEL
SWIGLU_LIMIT = 7.0
SWIGLU_ALPHA = 1.702
MOE_BLOCK = 128
EPS = 1e-6

kernel_name = 'hybrid_dilated_attn_rglru_moe_layer'


def rms_norm(x, g):
    xf = x.astype(jnp.float32)
    y = xf * lax.rsqrt(jnp.mean(xf * xf, axis=-1, keepdims=True) + EPS)
    return (y * g.astype(jnp.float32)).astype(x.dtype)


def alibi_slopes(n_heads):
    return jnp.asarray(2.0 ** (-8.0 * np.arange(1, n_heads + 1) / n_heads), jnp.float32)


def dilated_branch(q, k, v, slopes, window, dilation):
    B, S, H, Dh = q.shape
    n_back = window // dilation
    assert n_back <= ATTN_BLOCK
    span = dilation * ATTN_BLOCK
    S_pad = -(-S // span) * span
    L = S_pad // dilation
    nb = L // ATTN_BLOCK

    def to_blocks(t):
        t = jnp.pad(t, ((0, 0), (0, S_pad - S), (0, 0), (0, 0)))
        t = t.reshape(B, L, dilation, H, Dh).transpose(0, 2, 3, 1, 4)
        return t.reshape(B, dilation, H, nb, ATTN_BLOCK, Dh)

    def with_prev(t):
        prev = jnp.pad(t[:, :, :, :-1], ((0, 0), (0, 0), (0, 0), (1, 0), (0, 0), (0, 0)))
        return jnp.concatenate([prev, t], axis=4)

    qb = to_blocks(q)
    kk = with_prev(to_blocks(k))
    vv = with_prev(to_blocks(v))
    scores = jnp.einsum('bdhnqe,bdhnke->bdhnqk', qb, kk).astype(jnp.float32) * (Dh ** -0.5)
    qi = jnp.arange(ATTN_BLOCK)[:, None] + ATTN_BLOCK
    ki = jnp.arange(2 * ATTN_BLOCK)[None, :]
    rel = qi - ki
    key_pos = jnp.arange(nb)[:, None, None] * ATTN_BLOCK + ki[None] - ATTN_BLOCK
    mask = (rel >= 0)[None] & (rel <= n_back)[None] & (key_pos >= 0)
    bias = -slopes[:, None, None] * (rel * dilation).astype(jnp.float32)[None]
    scores = jnp.where(mask[None, None, None], scores + bias[None, None, :, None], -jnp.inf)
    m = jnp.max(scores, axis=-1, keepdims=True)
    p = jnp.exp(scores - m)
    s = jnp.sum(p, axis=-1, keepdims=True)
    o = jnp.einsum('bdhnqk,bdhnke->bdhnqe', p, vv.astype(jnp.float32)) / s
    lse = (m + jnp.log(s))[..., 0]
    o = o.reshape(B, dilation, H, L, Dh).transpose(0, 3, 1, 2, 4).reshape(B, S_pad, H, Dh)[:, :S]
    lse = lse.reshape(B, dilation, H, L).transpose(0, 3, 1, 2).reshape(B, S_pad, H)[:, :S]
    return o, lse


def dilated_mixture_attention(q, k, v):
    slopes = alibi_slopes(q.shape[2])
    outs, lses = [], []
    for window, dilation in DILATED_BRANCHES:
        o, lse = dilated_branch(q, k, v, slopes, window, dilation)
        outs.append(o)
        lses.append(lse)
    w = jax.nn.softmax(jnp.stack(lses, axis=0), axis=0)
    o = jnp.einsum('nbsh,nbshe->bshe', w, jnp.stack(outs, axis=0))
    return o.astype(q.dtype)


def causal_depthwise_conv(x, w, b):
    S = x.shape[1]
    xp = jnp.pad(x, ((0, 0), (CONV_WIDTH - 1, 0), (0, 0)))
    out = xp[:, 0:S] * w[0]
    for i in range(1, CONV_WIDTH):
        out = out + xp[:, i:i + S] * w[i]
    return out + b


def block_diag_linear(x, w, b):
    B, S, _ = x.shape
    xb = x.reshape(B, S, N_LRU_BLOCKS, LRU_BLOCK)
    y = jnp.einsum('bsnc,ncd->bsnd', xb, w.astype(jnp.float32)).reshape(B, S, LRU_WIDTH)
    return y + b.astype(jnp.float32)


def rg_lru(x, w_a, b_a, w_x, b_x, lam):
    xf = x.astype(jnp.float32)
    r = jax.nn.sigmoid(block_diag_linear(xf, w_a, b_a))
    i = jax.nn.sigmoid(block_diag_linear(xf, w_x, b_x))
    log_a = -LRU_C * r * jax.nn.softplus(-lam.astype(jnp.float32))
    a = jnp.exp(log_a)
    b = jnp.sqrt(-jnp.expm1(2.0 * log_a)) * (i * xf)

    def combine(c1, c2):
        a1, b1 = c1
        a2, b2 = c2
        return a1 * a2, a2 * b1 + b2

    _, h = lax.associative_scan(combine, (a, b), axis=1)
    return h.astype(x.dtype)


def moe_ffn(h, w_router, b_router, w_gate_up, b_gate_up, w_down, b_down):
    B, S, D = h.shape
    N = B * S
    NK = N * TOP_K
    xt = h.reshape(N, D)
    logits = xt.astype(jnp.float32) @ w_router.astype(jnp.float32) + b_router.astype(jnp.float32)
    top_val, top_idx = lax.top_k(logits, TOP_K)
    gates = jax.nn.softmax(top_val, axis=-1)
    e_flat = top_idx.reshape(NK)
    tok_flat = jnp.repeat(jnp.arange(N, dtype=jnp.int32), TOP_K)
    order = jnp.argsort(e_flat)
    e_sorted = e_flat[order]
    counts = jnp.bincount(e_flat, length=N_EXPERTS)
    start = jnp.cumsum(counts) - counts
    padded = (counts + MOE_BLOCK - 1) // MOE_BLOCK * MOE_BLOCK
    pend = jnp.cumsum(padded)
    pstart = pend - padded
    dest_sorted = (pstart[e_sorted] + jnp.arange(NK) - start[e_sorted]).astype(jnp.int32)
    P = NK + N_EXPERTS * MOE_BLOCK
    n_blocks = P // MOE_BLOCK
    tok_buf = jnp.full((P,), N, jnp.int32).at[dest_sorted].set(tok_flat[order])
    block_expert = jnp.minimum(
        jnp.searchsorted(pend, jnp.arange(n_blocks) * MOE_BLOCK, side='right'), N_EXPERTS - 1)
    x_pad = jnp.concatenate([xt, jnp.zeros((1, D), xt.dtype)], axis=0)

    def run_block(args):
        tok, e = args
        xb = x_pad[tok]
        gu = xb @ w_gate_up[e] + b_gate_up[e]
        gate = jnp.minimum(gu[:, 0::2], SWIGLU_LIMIT)
        up = jnp.clip(gu[:, 1::2], -SWIGLU_LIMIT, SWIGLU_LIMIT)
        act = gate * jax.nn.sigmoid(SWIGLU_ALPHA * gate) * (up + 1.0)
        return act @ w_down[e] + b_down[e]

    y_buf = lax.map(run_block, (tok_buf.reshape(n_blocks, MOE_BLOCK), block_expert))
    y_buf = y_buf.reshape(P, D)
    dest = jnp.zeros((NK,), jnp.int32).at[order].set(dest_sorted)
    y = y_buf[dest].reshape(N, TOP_K, D)
    out = jnp.einsum('nk,nkd->nd', gates.astype(y.dtype), y)
    return out.reshape(B, S, D)


def setup_inputs(seed: int = 0) -> dict:
    key = jax.random.key(seed)
    ks = jax.random.split(key, 22)
    f32 = jnp.float32

    def nrm(k, shape, scale):
        return jax.random.normal(k, shape, f32) * scale

    def gain(k, n):
        return 1.0 + 0.02 * jax.random.normal(k, (n,), f32)

    a_c = jax.random.uniform(ks[9], (LRU_WIDTH,), f32, 0.9, 0.999)
    a0 = a_c ** (1.0 / LRU_C)
    lru_lambda = jnp.log(a0) - jnp.log1p(-a0)
    return {
        'x': jax.random.normal(ks[0], (BATCH, SEQ, D_MODEL), f32),
        'norm_mix': gain(ks[1], D_MODEL),
        'w_in': nrm(ks[2], (D_MODEL, IN_COLS), D_MODEL ** -0.5),
        'conv_w': nrm(ks[3], (CONV_WIDTH, LRU_WIDTH), CONV_WIDTH ** -0.5),
        'conv_b': nrm(ks[4], (LRU_WIDTH,), 0.02),
        'w_a': nrm(ks[5], (N_LRU_BLOCKS, LRU_BLOCK, LRU_BLOCK), LRU_BLOCK ** -0.5),
        'b_a': nrm(ks[6], (LRU_WIDTH,), 0.02),
        'w_x': nrm(ks[7], (N_LRU_BLOCKS, LRU_BLOCK, LRU_BLOCK), LRU_BLOCK ** -0.5),
        'b_x': nrm(ks[8], (LRU_WIDTH,), 0.02),
        'lru_lambda': lru_lambda,
        'attn_out_norm': gain(ks[10], ATTN_WIDTH),
        'lru_out_norm': gain(ks[11], LRU_WIDTH),
        'w_out': nrm(ks[12], (D_MODEL, D_MODEL), D_MODEL ** -0.5),
        'norm_ffn': gain(ks[13], D_MODEL),
        'w_router': nrm(ks[14], (D_MODEL, N_EXPERTS), D_MODEL ** -0.5),
        'b_router': nrm(ks[15], (N_EXPERTS,), 0.01),
        'w_gate_up': nrm(ks[16], (N_EXPERTS, D_MODEL, 2 * D_FF), D_MODEL ** -0.5),
        'b_gate_up': nrm(ks[17], (N_EXPERTS, 2 * D_FF), 0.02),
        'w_down': nrm(ks[18], (N_EXPERTS, D_FF, D_MODEL), D_FF ** -0.5),
        'b_down': nrm(ks[19], (N_EXPERTS, D_MODEL), 0.02),
        'norm_final': gain(ks[20], D_MODEL),
    }


def reference(x, norm_mix, w_in, conv_w, conv_b, w_a, b_a, w_x, b_x, lru_lambda,
              attn_out_norm, lru_out_norm, w_out, norm_ffn, w_router, b_router,
              w_gate_up, b_gate_up, w_down, b_down, norm_final):
    B, S, _ = x.shape
    for _layer in range(DEPTH):
        h = rms_norm(x, norm_mix)
        proj = h @ w_in
        q, k, v, xr, gr = jnp.split(
            proj, [ATTN_WIDTH, 2 * ATTN_WIDTH, 3 * ATTN_WIDTH, 3 * ATTN_WIDTH + LRU_WIDTH], axis=-1)
        q = q.reshape(B, S, N_ATTN_HEADS, HEAD_DIM)
        k = k.reshape(B, S, N_ATTN_HEADS, HEAD_DIM)
        v = v.reshape(B, S, N_ATTN_HEADS, HEAD_DIM)
        attn = dilated_mixture_attention(q, k, v).reshape(B, S, ATTN_WIDTH)
        xr = causal_depthwise_conv(xr, conv_w, conv_b)
        rec = rg_lru(xr, w_a, b_a, w_x, b_x, lru_lambda) * jax.nn.gelu(gr)
        mixed = jnp.concatenate([rms_norm(attn, attn_out_norm), rms_norm(rec, lru_out_norm)], axis=-1)
        x = x + mixed @ w_out
        x = x + moe_ffn(rms_norm(x, norm_ffn), w_router, b_router, w_gate_up, b_gate_up, w_down, b_down)
    return rms_norm(x, norm_final)
```

```cpp
#include <hip/hip_runtime.h>
#include <stdint.h>

constexpr int D_MODEL = 2048, BATCH = 4, SEQ = 2048, NTOK = BATCH * SEQ;
constexpr int HEAD_DIM = 64, N_HEADS = 16, ATTN_W = 1024, LRU_W = 1024, LRU_BLK = 64;
constexpr int IN_COLS = 3 * ATTN_W + 2 * LRU_W;
constexpr int N_EXP = 32, TOP_K = 4, D_FF = 2048, NSLOT = NTOK * TOP_K;
constexpr float EPS = 1e-6f;

__device__ __forceinline__ float block_sum_256(float v, float* red) {
    for (int o = 32; o > 0; o >>= 1) v += __shfl_xor(v, o);
    const int w = threadIdx.x >> 6;
    __syncthreads();
    if ((threadIdx.x & 63) == 0) red[w] = v;
    __syncthreads();
    return (red[0] + red[1]) + (red[2] + red[3]);
}

__global__ void __launch_bounds__(256) k_rmsnorm(const float* __restrict__ x, const float* __restrict__ g, float* __restrict__ out, int D, int ldx, int ldo) {
    __shared__ float red[4];
    const float* xr = x + (size_t)blockIdx.x * ldx;
    float s = 0.f;
    for (int c = threadIdx.x; c < D; c += 256) { const float v = xr[c]; s += v * v; }
    const float tot = block_sum_256(s, red);
    const float rs = rsqrtf(tot / (float)D + EPS);
    float* o = out + (size_t)blockIdx.x * ldo;
    for (int c = threadIdx.x; c < D; c += 256) o[c] = xr[c] * rs * g[c];
}

struct GemmP {
    const float* A; int lda; const int* gather;
    const float* B; int ldb;
    float* C; int ldc;
    const float* bias; const float* res; int ldres;
    const int* mcount;
    const int* moff;
    int M, N, K;
    long strideBz; long strideBiasz; int gatherStride;
};
template <int MODE>
__global__ void __launch_bounds__(256) k_gemm(GemmP p) {
    __shared__ float As[8][128 + 4];
    __shared__ float Bs[8][128 + 4];
    const int z = blockIdx.z;
    const int M = p.mcount ? p.mcount[z] : p.M;
    const int m0 = blockIdx.y * 128, n0 = blockIdx.x * 128;
    if (m0 >= M) return;
    const float* B = p.B + (size_t)z * p.strideBz;
    const float* bias = p.bias ? p.bias + (size_t)z * p.strideBiasz : nullptr;
    const int* gather = p.gather ? p.gather + (size_t)z * p.gatherStride : nullptr;
    const int orow0 = p.moff ? p.moff[z] : 0;
    const int tid = threadIdx.x, ty = tid >> 4, tx = tid & 15;
    const int ar = tid >> 1, ak = (tid & 1) * 4;
    int arow = m0 + ar; if (arow >= M) arow = M - 1;
    long asrc;
    if (gather) asrc = (long)gather[arow] * p.lda; else asrc = (long)(orow0 * (MODE == 2 ? 1 : 0) + arow) * p.lda;
    const float* Ap = p.A + asrc + ak;
    const int bk = tid >> 5, bn = (tid & 31) * 4;
    const float* Bp = B + (size_t)bk * p.ldb + n0 + bn;
    float acc[8][8];
#pragma unroll
    for (int i = 0; i < 8; ++i)
#pragma unroll
        for (int j = 0; j < 8; ++j) acc[i][j] = 0.f;
    for (int k0 = 0; k0 < p.K; k0 += 8) {
        const float4 av = *(const float4*)(Ap + k0);
        const float4 bv = *(const float4*)(Bp + (size_t)k0 * p.ldb);
        __syncthreads();
        As[ak + 0][ar] = av.x; As[ak + 1][ar] = av.y; As[ak + 2][ar] = av.z; As[ak + 3][ar] = av.w;
        *(float4*)&Bs[bk][bn] = bv;
        __syncthreads();
#pragma unroll
        for (int k = 0; k < 8; ++k) {
            float a[8], b[8];
#pragma unroll
            for (int i = 0; i < 8; ++i) a[i] = As[k][ty * 8 + i];
#pragma unroll
            for (int j = 0; j < 8; ++j) b[j] = Bs[k][tx * 8 + j];
#pragma unroll
            for (int i = 0; i < 8; ++i)
#pragma unroll
                for (int j = 0; j < 8; ++j) acc[i][j] = fmaf(a[i], b[j], acc[i][j]);
        }
    }
#pragma unroll
    for (int i = 0; i < 8; ++i) {
        const int m = m0 + ty * 8 + i;
        if (m >= M) continue;
        const int n = n0 + tx * 8;
        if (MODE == 0) {
            float* c = p.C + (size_t)m * p.ldc + n;
            const float* r = p.res ? p.res + (size_t)m * p.ldres + n : nullptr;
#pragma unroll
            for (int j = 0; j < 8; ++j) c[j] = acc[i][j] + (r ? r[j] : 0.f);
        } else if (MODE == 1) {
            float* c = p.C + (size_t)(orow0 + m) * p.ldc + n / 2;
#pragma unroll
            for (int j = 0; j < 4; ++j) {
                float g = acc[i][2 * j] + bias[n + 2 * j], u = acc[i][2 * j + 1] + bias[n + 2 * j + 1];
                g = fminf(g, 7.0f); u = fminf(fmaxf(u, -7.0f), 7.0f);
                const float sg = 1.0f / (1.0f + expf(-1.702f * g));
                c[j] = g * sg * (u + 1.0f);
            }
        } else {
            float* c = p.C + (size_t)(orow0 + m) * p.ldc + n;
#pragma unroll
            for (int j = 0; j < 8; ++j) c[j] = acc[i][j] + bias[n + j];
        }
    }
}

__device__ __forceinline__ void attn_branch(const float* __restrict__ proj, int b, int t, int h, int lane, float q, float slope, int dil, float& o_out, float& lse_out) {
    float m = -INFINITY, s = 0.f, o = 0.f;
    for (int j = 0; j <= 128; ++j) {
        const int pos = t - j * dil; if (pos < 0) break;
        const float* kp = proj + (size_t)(b * SEQ + pos) * IN_COLS + ATTN_W + h * 64;
        float prod = q * kp[lane];
        for (int off = 32; off > 0; off >>= 1) prod += __shfl_xor(prod, off);
        const float sc = prod * 0.125f - slope * (float)(j * dil);
        const float mn = fmaxf(m, sc);
        const float alpha = expf(m - mn), pp = expf(sc - mn);
        s = s * alpha + pp; o = o * alpha + pp * kp[ATTN_W + lane]; m = mn;
    }
    o_out = o / s; lse_out = m + logf(s);
}
__global__ void __launch_bounds__(64) k_attn(const float* __restrict__ proj, float* __restrict__ attn) {
    const int bt = blockIdx.x, h = blockIdx.y, lane = threadIdx.x;
    const int b = bt / SEQ, t = bt % SEQ;
    const float q = proj[(size_t)bt * IN_COLS + h * 64 + lane];
    const float slope = exp2f(-8.0f * (float)(h + 1) / 16.0f);
    float ob0, ob1, ob2, l0, l1, l2;
    attn_branch(proj, b, t, h, lane, q, slope, 1, ob0, l0);
    attn_branch(proj, b, t, h, lane, q, slope, 4, ob1, l1);
    attn_branch(proj, b, t, h, lane, q, slope, 16, ob2, l2);
    const float M = fmaxf(l0, fmaxf(l1, l2));
    const float w0 = expf(l0 - M), w1 = expf(l1 - M), w2 = expf(l2 - M);
    attn[(size_t)bt * ATTN_W + h * 64 + lane] = (w0 * ob0 + w1 * ob1 + w2 * ob2) / (w0 + w1 + w2);
}

__global__ void __launch_bounds__(256) k_conv(const float* __restrict__ proj, const float* __restrict__ cw, const float* __restrict__ cb, float* __restrict__ xc) {
    const int bt = blockIdx.x, t = bt % SEQ;
    for (int c = threadIdx.x; c < LRU_W; c += 256) {
        float acc = cb[c];
#pragma unroll
        for (int i = 0; i < 4; ++i) { const int tt = t - 3 + i; if (tt >= 0) acc += cw[i * LRU_W + c] * proj[(size_t)(bt - 3 + i) * IN_COLS + 3 * ATTN_W + c]; }
        xc[(size_t)bt * LRU_W + c] = acc;
    }
}
__global__ void __launch_bounds__(256) k_gates(const float* __restrict__ xc, const float* __restrict__ wa, const float* __restrict__ ba, const float* __restrict__ wx, const float* __restrict__ bx,
                                                const float* __restrict__ lam, float* __restrict__ ga, float* __restrict__ gb) {
    const int bt = blockIdx.x;
    __shared__ float xs[LRU_W];
    for (int c = threadIdx.x; c < LRU_W; c += 256) xs[c] = xc[(size_t)bt * LRU_W + c];
    __syncthreads();
    for (int d = threadIdx.x; d < LRU_W; d += 256) {
        const int blk = d >> 6, dd = d & 63;
        float r = ba[d], ii = bx[d];
        for (int c = 0; c < 64; ++c) { const float xv = xs[blk * 64 + c]; r = fmaf(xv, wa[(blk * 64 + c) * 64 + dd], r); ii = fmaf(xv, wx[(blk * 64 + c) * 64 + dd], ii); }
        r = 1.0f / (1.0f + expf(-r)); ii = 1.0f / (1.0f + expf(-ii));
        const float sp = log1pf(expf(-lam[d]));
        const float log_a = -8.0f * r * sp;
        ga[(size_t)bt * LRU_W + d] = expf(log_a);
        gb[(size_t)bt * LRU_W + d] = sqrtf(-expm1f(2.0f * log_a)) * (ii * xs[d]);
    }
}
__device__ __forceinline__ float gelu_tanh(float x) { return 0.5f * x * (1.0f + tanhf(0.7978845608028654f * (x + 0.044715f * x * x * x))); }
__global__ void __launch_bounds__(64) k_scan(const float* __restrict__ ga, const float* __restrict__ gb, const float* __restrict__ proj, float* __restrict__ rec) {
    const int c = blockIdx.x * 64 + threadIdx.x, b = blockIdx.y;
    float h = 0.f;
    for (int t = 0; t < SEQ; ++t) {
        const size_t r = (size_t)(b * SEQ + t);
        h = ga[r * LRU_W + c] * h + gb[r * LRU_W + c];
        rec[r * LRU_W + c] = h * gelu_tanh(proj[r * IN_COLS + 3 * ATTN_W + LRU_W + c]);
    }
}

__global__ void __launch_bounds__(256) k_router(const float* __restrict__ x1, const float* __restrict__ g, const float* __restrict__ wr, const float* __restrict__ br,
                                                 float* __restrict__ hn2, int* __restrict__ cnt, int* __restrict__ lists, int* __restrict__ sel_e, int* __restrict__ sel_pos, float* __restrict__ sel_g) {
    __shared__ float red[4];
    __shared__ float hs[D_MODEL];
    __shared__ float part[8][32];
    const int t = blockIdx.x, tid = threadIdx.x;
    const float* xr = x1 + (size_t)t * D_MODEL;
    float s = 0.f;
    for (int c = tid; c < D_MODEL; c += 256) { const float v = xr[c]; s += v * v; }
    const float rs = rsqrtf(block_sum_256(s, red) / (float)D_MODEL + EPS);
    for (int c = tid; c < D_MODEL; c += 256) { const float v = xr[c] * rs * g[c]; hs[c] = v; hn2[(size_t)t * D_MODEL + c] = v; }
    __syncthreads();
    const int e = tid & 31, pr = tid >> 5;
    float acc = 0.f;
    for (int c = pr * 256; c < pr * 256 + 256; ++c) acc = fmaf(hs[c], wr[c * N_EXP + e], acc);
    part[pr][e] = acc;
    __syncthreads();
    if (tid < 64) {
        float lg = -INFINITY;
        if (tid < N_EXP) { float a = br[tid]; for (int q = 0; q < 8; ++q) a += part[q][tid]; lg = a; }
        int idx0 = 0, idx1 = 0, idx2 = 0, idx3 = 0; float v0 = 0.f, v1 = 0.f, v2 = 0.f, v3 = 0.f;
        float cur = lg;
#pragma unroll
        for (int k = 0; k < 4; ++k) {
            float mx = cur;
            for (int off = 32; off > 0; off >>= 1) mx = fmaxf(mx, __shfl_xor(mx, off));
            const unsigned long long bal = __ballot(cur == mx);
            const int bi = __ffsll((long long)bal) - 1;
            if (k == 0) { idx0 = bi; v0 = mx; } else if (k == 1) { idx1 = bi; v1 = mx; } else if (k == 2) { idx2 = bi; v2 = mx; } else { idx3 = bi; v3 = mx; }
            if (tid == bi) cur = -INFINITY;
        }
        if (tid == 0) {
            const float e0 = 1.0f, e1 = expf(v1 - v0), e2 = expf(v2 - v0), e3 = expf(v3 - v0);
            const float inv = 1.0f / (e0 + e1 + e2 + e3);
            int pos;
            pos = atomicAdd(&cnt[idx0], 1); lists[idx0 * NTOK + pos] = t; sel_e[t * 4 + 0] = idx0; sel_pos[t * 4 + 0] = pos; sel_g[t * 4 + 0] = e0 * inv;
            pos = atomicAdd(&cnt[idx1], 1); lists[idx1 * NTOK + pos] = t; sel_e[t * 4 + 1] = idx1; sel_pos[t * 4 + 1] = pos; sel_g[t * 4 + 1] = e1 * inv;
            pos = atomicAdd(&cnt[idx2], 1); lists[idx2 * NTOK + pos] = t; sel_e[t * 4 + 2] = idx2; sel_pos[t * 4 + 2] = pos; sel_g[t * 4 + 2] = e2 * inv;
            pos = atomicAdd(&cnt[idx3], 1); lists[idx3 * NTOK + pos] = t; sel_e[t * 4 + 3] = idx3; sel_pos[t * 4 + 3] = pos; sel_g[t * 4 + 3] = e3 * inv;
        }
    }
}
__global__ void k_offsets(const int* __restrict__ cnt, int* __restrict__ off) {
    if (threadIdx.x == 0) { int a = 0; for (int e = 0; e < N_EXP; ++e) { off[e] = a; a += cnt[e]; } }
}
__global__ void __launch_bounds__(256) k_final(const float* __restrict__ x1, const float* __restrict__ Y, const int* __restrict__ off, const int* __restrict__ sel_e, const int* __restrict__ sel_pos,
                                                const float* __restrict__ sel_g, const float* __restrict__ g, float* __restrict__ out) {
    __shared__ float red[4];
    const int t = blockIdx.x, tid = threadIdx.x;
    float v[8]; float s = 0.f;
    size_t rows[4]; float gg[4];
#pragma unroll
    for (int k = 0; k < 4; ++k) { rows[k] = (size_t)(off[sel_e[t * 4 + k]] + sel_pos[t * 4 + k]); gg[k] = sel_g[t * 4 + k]; }
#pragma unroll
    for (int i = 0; i < 8; ++i) {
        const int c = tid + i * 256;
        float a = x1[(size_t)t * D_MODEL + c];
        float m = 0.f;
#pragma unroll
        for (int k = 0; k < 4; ++k) m += gg[k] * Y[rows[k] * D_MODEL + c];
        a += m; v[i] = a; s += a * a;
    }
    const float rs = rsqrtf(block_sum_256(s, red) / (float)D_MODEL + EPS);
#pragma unroll
    for (int i = 0; i < 8; ++i) { const int c = tid + i * 256; out[(size_t)t * D_MODEL + c] = v[i] * rs * g[c]; }
}

extern "C" void kernel_launch(void* const* d_in, const int* in_sizes, int n_in, void* d_out, int out_size, void* d_ws, size_t ws_size, hipStream_t stream) {
    const float* x = (const float*)d_in[0];      const float* norm_mix = (const float*)d_in[1]; const float* w_in = (const float*)d_in[2];
    const float* conv_w = (const float*)d_in[3]; const float* conv_b = (const float*)d_in[4];
    const float* w_a = (const float*)d_in[5];    const float* b_a = (const float*)d_in[6];      const float* w_x = (const float*)d_in[7]; const float* b_x = (const float*)d_in[8];
    const float* lam = (const float*)d_in[9];    const float* attn_norm = (const float*)d_in[10]; const float* lru_norm = (const float*)d_in[11];
    const float* w_out = (const float*)d_in[12]; const float* norm_ffn = (const float*)d_in[13]; const float* w_router = (const float*)d_in[14]; const float* b_router = (const float*)d_in[15];
    const float* w_gu = (const float*)d_in[16];  const float* b_gu = (const float*)d_in[17];    const float* w_dn = (const float*)d_in[18]; const float* b_dn = (const float*)d_in[19];
    const float* norm_final = (const float*)d_in[20];
    float* out = (float*)d_out;
    char* ws = (char*)d_ws; size_t o = 0;
    auto take = [&](size_t bytes) { char* p = ws + o; o += (bytes + 255) & ~(size_t)255; return p; };
    int* cnt = (int*)take(256); int* off = (int*)take(256);
    float* h = (float*)take((size_t)NTOK * D_MODEL * 4);
    float* proj = (float*)take((size_t)NTOK * IN_COLS * 4);
    float* attn = (float*)take((size_t)NTOK * ATTN_W * 4);
    float* xc = (float*)take((size_t)NTOK * LRU_W * 4);
    float* ga = (float*)take((size_t)NTOK * LRU_W * 4);
    float* gb = (float*)take((size_t)NTOK * LRU_W * 4);
    float* rec = (float*)take((size_t)NTOK * LRU_W * 4);
    float* mixed = (float*)take((size_t)NTOK * D_MODEL * 4);
    float* x1 = (float*)take((size_t)NTOK * D_MODEL * 4);
    float* hn2 = (float*)take((size_t)NTOK * D_MODEL * 4);
    int* lists = (int*)take((size_t)N_EXP * NTOK * 4);
    int* sel_e = (int*)take((size_t)NSLOT * 4); int* sel_pos = (int*)take((size_t)NSLOT * 4); float* sel_g = (float*)take((size_t)NSLOT * 4);
    float* act = (float*)take((size_t)NSLOT * D_FF * 4);
    float* Y = (float*)take((size_t)NSLOT * D_MODEL * 4);

    hipMemsetAsync(cnt, 0, 256, stream);
    k_rmsnorm<<<NTOK, 256, 0, stream>>>(x, norm_mix, h, D_MODEL, D_MODEL, D_MODEL);
    { GemmP p{}; p.A = h; p.lda = D_MODEL; p.B = w_in; p.ldb = IN_COLS; p.C = proj; p.ldc = IN_COLS; p.M = NTOK; p.N = IN_COLS; p.K = D_MODEL;
      k_gemm<0><<<dim3(IN_COLS / 128, NTOK / 128, 1), 256, 0, stream>>>(p); }
    k_attn<<<dim3(NTOK, N_HEADS), 64, 0, stream>>>(proj, attn);
    k_conv<<<NTOK, 256, 0, stream>>>(proj, conv_w, conv_b, xc);
    k_gates<<<NTOK, 256, 0, stream>>>(xc, w_a, b_a, w_x, b_x, lam, ga, gb);
    k_scan<<<dim3(LRU_W / 64, BATCH), 64, 0, stream>>>(ga, gb, proj, rec);
    k_rmsnorm<<<NTOK, 256, 0, stream>>>(attn, attn_norm, mixed, ATTN_W, ATTN_W, D_MODEL);
    k_rmsnorm<<<NTOK, 256, 0, stream>>>(rec, lru_norm, mixed + ATTN_W, LRU_W, LRU_W, D_MODEL);
    { GemmP p{}; p.A = mixed; p.lda = D_MODEL; p.B = w_out; p.ldb = D_MODEL; p.C = x1; p.ldc = D_MODEL; p.res = x; p.ldres = D_MODEL; p.M = NTOK; p.N = D_MODEL; p.K = D_MODEL;
      k_gemm<0><<<dim3(D_MODEL / 128, NTOK / 128, 1), 256, 0, stream>>>(p); }
    k_router<<<NTOK, 256, 0, stream>>>(x1, norm_ffn, w_router, b_router, hn2, cnt, lists, sel_e, sel_pos, sel_g);
    k_offsets<<<1, 64, 0, stream>>>(cnt, off);
    { GemmP p{}; p.A = hn2; p.lda = D_MODEL; p.gather = lists; p.gatherStride = NTOK; p.B = w_gu; p.ldb = 2 * D_FF; p.strideBz = (long)D_MODEL * 2 * D_FF; p.C = act; p.ldc = D_FF;
      p.bias = b_gu; p.strideBiasz = 2 * D_FF; p.mcount = cnt; p.moff = off; p.M = NTOK; p.N = 2 * D_FF; p.K = D_MODEL;
      k_gemm<1><<<dim3(2 * D_FF / 128, NTOK / 128, N_EXP), 256, 0, stream>>>(p); }
    { GemmP p{}; p.A = act; p.lda = D_FF; p.B = w_dn; p.ldb = D_MODEL; p.strideBz = (long)D_FF * D_MODEL; p.C = Y; p.ldc = D_MODEL;
      p.bias = b_dn; p.strideBiasz = D_MODEL; p.mcount = cnt; p.moff = off; p.M = NTOK; p.N = D_MODEL; p.K = D_FF;
      k_gemm<2><<<dim3(D_MODEL / 128, NTOK / 128, N_EXP), 256, 0, stream>>>(p); }
    k_final<<<NTOK, 256, 0, stream>>>(x1, Y, off, sel_e, sel_pos, sel_g, norm_final, out);
}
```

```cpp
#include <hip/hip_runtime.h>
#include <stdint.h>
#include <stdio.h>

#ifndef MK_N_LAUNCHES
#define MK_N_LAUNCHES 1
#endif

#define LAS __attribute__((address_space(3)))
#define GAS __attribute__((address_space(1)))
typedef unsigned short bf16_t;
typedef short bf16x8 __attribute__((ext_vector_type(8)));
typedef float f32x4 __attribute__((ext_vector_type(4)));
typedef float f32x2 __attribute__((ext_vector_type(2)));
typedef unsigned u32x4 __attribute__((ext_vector_type(4)));
typedef unsigned u32x2 __attribute__((ext_vector_type(2)));

constexpr int D_MODEL = 2048, BATCH = 4, SEQ = 2048, NTOK = BATCH * SEQ;
constexpr int N_HEADS = 16, ATTN_W = 1024, LRU_W = 1024;
constexpr int IN_COLS = 5120;
constexpr int N_EXP = 32, D_FF = 2048, NSLOT = NTOK * 4;
constexpr int KDIM = 2048;
constexpr float EPS = 1e-6f;
constexpr int NWAVES = 8, NTHR = 512;
constexpr int PADROWS = NSLOT + N_EXP * 256;

constexpr size_t MiB = 1u << 20;
constexpr size_t WS_CTL = 0, WS_LISTS = 1 * MiB, CTL_ZERO_BYTES = 2 * MiB;
constexpr size_t WS_SEL = 2 * MiB;
constexpr size_t WS_LRUE = 3 * MiB;
constexpr size_t WS_WIN = 4 * MiB, WS_WOUT = 24 * MiB, WS_HN = 32 * MiB, WS_PROJ = 64 * MiB, WS_ATT = 144 * MiB, WS_HL = 176 * MiB, WS_PC = 208 * MiB;
constexpr size_t WS_MIXED = 240 * MiB, WS_X1 = 272 * MiB, WS_ACT = 336 * MiB, WS_Y = 496 * MiB, WS_WGU = 656 * MiB, WS_WDN = 1168 * MiB, WS_END = 1424 * MiB;
static_assert((size_t)PADROWS * 2048 * 2 <= 160 * MiB, "ACT/Y size");
constexpr int CW_BAR = 4096, CW_CNT = 8192;

constexpr int RING_BYTES = 131072;
constexpr int LDSCTL_OFF = 139264;
constexpr int LDS_BYTES = 147456;
constexpr int L_MISC = LDSCTL_OFF;
constexpr int L_TPRE = LDSCTL_OFF + 256;
constexpr int L_CNT = LDSCTL_OFF + 512;

__device__ __forceinline__ unsigned f2bf(float f) { unsigned u = __builtin_bit_cast(unsigned, f); return (u + 0x7fffu + ((u >> 16) & 1u)) >> 16; }
__device__ __forceinline__ unsigned pk2(float lo, float hi) { return f2bf(lo) | (f2bf(hi) << 16); }
__device__ __forceinline__ float bf2f(unsigned short b) { return __builtin_bit_cast(float, (unsigned)b << 16); }
__device__ __forceinline__ float bflo(unsigned w) { return __builtin_bit_cast(float, w << 16); }
__device__ __forceinline__ float bfhi(unsigned w) { return __builtin_bit_cast(float, w & 0xffff0000u); }
__device__ __forceinline__ float wave_sum(float v) {
#pragma unroll
    for (int o = 1; o < 64; o <<= 1) v += __shfl_xor(v, o);
    return v;
}
__device__ __forceinline__ float wave_max(float v) {
#pragma unroll
    for (int o = 1; o < 64; o <<= 1) v = fmaxf(v, __shfl_xor(v, o));
    return v;
}
#define LDS_WAIT() asm volatile("s_waitcnt lgkmcnt(0)" ::: "memory")
#define VM_WAIT() asm volatile("s_waitcnt vmcnt(0)" ::: "memory")

#define XB_TMO      128
#define XB_XCNT(j)  (256  + 64 * (j))
#define XB_XSUB(j)  (1280 + 64 * (j))
#define XB_XGEN(j)  (2304 + 64 * (j))
#define XB_TOP      3328
#define XB_TOPGEN   3392
#define XCD_BAR_WORDS 3456
#define XB_SPIN_CAP (1u << 20)
__device__ __forceinline__ unsigned xb_ld(unsigned* p)              { return __hip_atomic_load(p, __ATOMIC_RELAXED, __HIP_MEMORY_SCOPE_AGENT); }
__device__ __forceinline__ unsigned xb_add(unsigned* p, unsigned v) { return __hip_atomic_fetch_add(p, v, __ATOMIC_RELAXED, __HIP_MEMORY_SCOPE_AGENT); }
__device__ __forceinline__ unsigned xb_xcc_id() { return (unsigned)__builtin_amdgcn_s_getreg((3 << 11) | 20) & 0xFu; }
#define XB_SPIN(cond, bar) do { unsigned _sp = 0; while (cond) { __builtin_amdgcn_s_sleep(1); \
    if ((++_sp & 255u) == 0u) { if (xb_ld(&(bar)[XB_TMO])) break; if (_sp > XB_SPIN_CAP) { atomicAdd(&(bar)[XB_TMO], 1u); break; } } } } while (0)
struct XcdBarrier { unsigned* bar; unsigned x; volatile LAS unsigned* st; };
__device__ __forceinline__ XcdBarrier xcd_barrier_post(unsigned* bar, volatile LAS unsigned* st) {
    XcdBarrier b; b.bar = bar; b.x = xb_xcc_id(); b.st = st;
    if (threadIdx.x == 0) (void)xb_add(&bar[XB_XCNT(b.x)], 1u);
    return b;
}
__device__ __forceinline__ void xcd_barrier_complete(unsigned* bar, unsigned x, unsigned& nloc, unsigned& nx) {
    const unsigned G = gridDim.x * gridDim.y * gridDim.z;
    unsigned sum, cnt, mine, sp = 0u;
    for (;;) {
        sum = 0u; cnt = 0u; mine = 0u;
#pragma unroll
        for (unsigned j = 0; j < 16; ++j) { const unsigned c = xb_ld(&bar[XB_XCNT(j)]); sum += c; cnt += (c > 0u) ? 1u : 0u; mine = (j == x) ? c : mine; }
        if (sum == G) break;
        __builtin_amdgcn_s_sleep(1);
        if ((++sp & 255u) == 0u) { if (xb_ld(&bar[XB_TMO])) break; if (sp > XB_SPIN_CAP) { atomicAdd(&bar[XB_TMO], 1u); break; } }
    }
    nloc = mine > 0u ? mine : 1u; nx = cnt > 0u ? cnt : 1u;
}
__device__ __forceinline__ void xcd_barrier(const XcdBarrier& b) {
    asm volatile("s_waitcnt vmcnt(0)" ::: "memory");
    __syncthreads();
    if (threadIdx.x == 0) {
        unsigned* bar = b.bar;
        __builtin_amdgcn_s_waitcnt(0);
        unsigned nloc = b.st[0], nx = b.st[1];
        if (nloc == 0u) { xcd_barrier_complete(bar, b.x, nloc, nx); b.st[0] = nloc; b.st[1] = nx; }
        const unsigned old = xb_add(&bar[XB_XSUB(b.x)], 1u);
        const unsigned gen = old / nloc;
        if (old + 1u == (gen + 1u) * nloc) {
            __builtin_amdgcn_fence(__ATOMIC_RELEASE, "agent");
            asm volatile("s_waitcnt vmcnt(0)" ::: "memory");
            const unsigned og = xb_add(&bar[XB_TOP], 1u);
            const unsigned tg = og / nx;
            if (og + 1u == (tg + 1u) * nx) xb_add(&bar[XB_TOPGEN], 1u);
            else XB_SPIN(xb_ld(&bar[XB_TOPGEN]) == tg, bar);
            __builtin_amdgcn_fence(__ATOMIC_ACQUIRE, "agent");
            xb_add(&bar[XB_XGEN(b.x)], 1u);
            asm volatile("s_waitcnt vmcnt(0)" ::: "memory");
        } else {
            XB_SPIN(xb_ld(&bar[XB_XGEN(b.x)]) == gen, bar);
            __builtin_amdgcn_fence(__ATOMIC_ACQUIRE, "agent");
            asm volatile("s_waitcnt vmcnt(0)" ::: "memory");
        }
    }
    __syncthreads();
}

namespace g8 {
constexpr int BM = 256, BK = 64, HALF = 128, HTB = HALF * BK * 2, STAGE_BYTES = 8 * HTB, NXCD = 8, WGM = 8;
__host__ __device__ __forceinline__ int lds_byte(int r, int c) { const int st = (r >> 4) * 2 + (c >> 5), rr = r & 15, cc = c & 31, ob = rr * 64 + cc * 2; return st * 1024 + (ob ^ (((ob >> 9) & 1) << 5)); }
__host__ __device__ __forceinline__ void stage_rc(int b, int& R, int& C) { const int st = b / 1024, sb = b % 1024, swz = sb ^ (((sb >> 9) & 1) << 5); R = (st >> 1) * 16 + swz / 64; C = (st & 1) * 32 + (swz % 64) / 2; }
__host__ __device__ __forceinline__ int perm32(int rho) { const int n = rho >> 4, i = rho & 15; return 8 * (i >> 2) + 4 * n + (i & 3); }

struct Unit { const char* a; const char* b; int crow, ccol, e, gi; };

struct DenseOrder {
    const char* A; const char* Bt; int nM, nN, nwg, G, c;
    __device__ __forceinline__ bool next(int i, Unit& u) const {
        const long L = (long)i * G + c; if (L >= nwg) return false;
        int wgid = (int)L; { const int q = nwg / NXCD, r = nwg % NXCD, xcd = wgid % NXCD, off = wgid / NXCD; wgid = (xcd < r ? xcd * (q + 1) : r * (q + 1) + (xcd - r) * q) + off; }
        const int nig = WGM * nN, gid = wgid / nig, fm = gid * WGM, gsz = (nM - fm) < WGM ? (nM - fm) : WGM;
        const int pm = fm + ((wgid % nig) % gsz), pn = (wgid % nig) / gsz;
        u.a = A + (size_t)pm * BM * KDIM * 2; u.b = Bt + (size_t)pn * BM * KDIM * 2; u.crow = pm * BM; u.ccol = pn * BM; u.e = 0; u.gi = 0; return true;
    }
};
struct GroupedOrder {
    const char* A; const char* Bt; const LAS int* tpre; int nN, G, c; size_t bstride;
    bool gather; const char* Asrc;
    __device__ __forceinline__ bool next(int i, Unit& u) const {
        const int total = tpre[N_EXP] * nN; const long L = (long)i * G + c; if (L >= total) return false;
        const int mtile = (int)L / nN, nt = (int)L % nN;
        int e = 0; while (mtile >= tpre[e + 1]) ++e;
        const int mt = mtile - tpre[e];
        u.a = gather ? Asrc : A + (size_t)mtile * BM * KDIM * 2;
        u.b = Bt + (size_t)e * bstride + (size_t)nt * BM * KDIM * 2; u.crow = mtile * BM; u.ccol = nt * BM; u.e = e; u.gi = e * NTOK + mt * BM; return true;
    }
};

__device__ __forceinline__ unsigned cvt_pk_bf16(float lo, float hi) { unsigned r; asm volatile("v_cvt_pk_bf16_f32 %0, %1, %2" : "=v"(r) : "v"(lo), "v"(hi)); return r; }

struct EpiBf16 {
    static constexpr bool PERM = true;
    bf16_t* O; int ldc; const float* bias; int bias_stride;
    __device__ __forceinline__ void operator()(const f32x4 (&acc)[2][2][4][2], const Unit& u, int wr, int wc, int fr, int fq) const {
        const int row0 = u.crow + wr * 64 + fr, col0 = u.ccol + wc * 32 + 8 * fq;
        f32x4 bv[2][2];
#pragma unroll
        for (int bj = 0; bj < 2; ++bj)
#pragma unroll
            for (int n = 0; n < 2; ++n) bv[bj][n] = bias ? *(const f32x4*)(bias + (size_t)u.e * bias_stride + col0 + bj * HALF + 4 * n) : (f32x4){0.f, 0.f, 0.f, 0.f};
#pragma unroll
        for (int ai = 0; ai < 2; ++ai)
#pragma unroll
            for (int m = 0; m < 4; ++m) { bf16_t* rowp = O + (size_t)(row0 + ai * HALF + m * 16) * ldc + col0;
#pragma unroll
                for (int bj = 0; bj < 2; ++bj) { const f32x4 v0 = acc[ai][bj][m][0] + bv[bj][0], v1 = acc[ai][bj][m][1] + bv[bj][1];
                    u32x4 w; w.x = cvt_pk_bf16(v0[0], v0[1]); w.y = cvt_pk_bf16(v0[2], v0[3]); w.z = cvt_pk_bf16(v1[0], v1[1]); w.w = cvt_pk_bf16(v1[2], v1[3]);
                    *(u32x4*)(rowp + bj * HALF) = w; } }
    }
};
struct EpiResF32 {
    static constexpr bool PERM = false;
    float* C; const float* res; int ldc;
    __device__ __forceinline__ void operator()(const f32x4 (&acc)[2][2][4][2], const Unit& u, int wr, int wc, int fr, int fq) const {
        const int row0 = u.crow + wr * 64 + fr, col0 = u.ccol + wc * 32 + 4 * fq;
#pragma unroll
        for (int ai = 0; ai < 2; ++ai)
#pragma unroll
            for (int m = 0; m < 4; ++m) { const size_t off = (size_t)(row0 + ai * HALF + m * 16) * ldc + col0;
#pragma unroll
                for (int bj = 0; bj < 2; ++bj)
#pragma unroll
                    for (int n = 0; n < 2; ++n) { const f32x4 r = *(const f32x4*)(res + off + bj * HALF + n * 16); *(f32x4*)(C + off + bj * HALF + n * 16) = acc[ai][bj][m][n] + r; } }
    }
};
struct EpiSwiglu {
    static constexpr bool PERM = true;
    bf16_t* O; const float* bias;
    __device__ __forceinline__ float act(float g, float up) const {
        g = fminf(g, 7.0f); up = fminf(fmaxf(up, -7.0f), 7.0f);
        const float sg = 1.0f / (1.0f + __expf(-1.702f * g));
        return g * sg * (up + 1.0f);
    }
    __device__ __forceinline__ void operator()(const f32x4 (&acc)[2][2][4][2], const Unit& u, int wr, int wc, int fr, int fq) const {
        const int row0 = u.crow + wr * 64 + fr, col0 = u.ccol + wc * 32 + 8 * fq;
        f32x4 bv[2][2];
#pragma unroll
        for (int bj = 0; bj < 2; ++bj)
#pragma unroll
            for (int n = 0; n < 2; ++n) bv[bj][n] = *(const f32x4*)(bias + (size_t)u.e * (2 * D_FF) + col0 + bj * HALF + 4 * n);
#pragma unroll
        for (int ai = 0; ai < 2; ++ai)
#pragma unroll
            for (int m = 0; m < 4; ++m) { bf16_t* rowp = O + (size_t)(row0 + ai * HALF + m * 16) * D_FF + (col0 >> 1);
#pragma unroll
                for (int bj = 0; bj < 2; ++bj) { const f32x4 v0 = acc[ai][bj][m][0] + bv[bj][0], v1 = acc[ai][bj][m][1] + bv[bj][1];
                    u32x2 w; w.x = cvt_pk_bf16(act(v0[0], v0[1]), act(v0[2], v0[3])); w.y = cvt_pk_bf16(act(v1[0], v1[1]), act(v1[2], v1[3]));
                    *(u32x2*)(rowp + bj * (HALF / 2)) = w; } }
    }
};

template <class Epi, class Sched, bool GATHER>
__device__ __forceinline__ void gemm_phase(LAS unsigned char* lds, const Sched& S, const Epi& E, const int* __restrict__ lists) {
    const int tid = threadIdx.x, wid = __builtin_amdgcn_readfirstlane(tid >> 6), lane = tid & 63, wr = wid >> 2, wc = wid & 3, fr = lane & 15, fq = lane >> 4;
    constexpr int K = KDIM, nt = K / BK;
    unsigned voffA[2], voffB[2]; int gR[2], gC[2];
#pragma unroll
    for (int i = 0; i < 2; ++i) { int R, C; stage_rc(tid * 16 + i * 8192, R, C); const int Rb = Epi::PERM ? ((R & ~31) + perm32(R & 31)) : R;
        voffA[i] = (unsigned)(R * K + C) * 2u; voffB[i] = (unsigned)(Rb * K + C) * 2u; gR[i] = R; gC[i] = C; }
    constexpr size_t kstep = (size_t)(BK * 2);
    constexpr size_t hstep = (size_t)HALF * K * 2;
    const unsigned ldsw = (unsigned)wid * 1024u;
    const int aoff = lds_byte(wr * 64 + fr, fq * 8), boff = lds_byte(wc * 32 + fr, fq * 8);
#define G8_SA(b, h) (((b) * 2 + (h)) * HTB)
#define G8_SB(b, h) ((4 + (b) * 2 + (h)) * HTB)
#define G8_STAGE(bufoff, gbase, v0, v1) do { \
        __builtin_amdgcn_global_load_lds((const unsigned*)((const char*)(gbase) + (v0)), (LAS unsigned*)(lds + (bufoff) + ldsw), 16, 0, 0); \
        __builtin_amdgcn_global_load_lds((const unsigned*)((const char*)(gbase) + (v1)), (LAS unsigned*)(lds + (bufoff) + ldsw + 8192), 16, 0, 0); } while (0)
#define G8_STAGE_B(bufoff, gbase) G8_STAGE(bufoff, gbase, voffB[0], voffB[1])
#define G8_STAGE_A(bufoff, gbase, h, ga0, ga1) do { if (GATHER) G8_STAGE(bufoff, gbase, ga0, ga1); else G8_STAGE(bufoff, (gbase) + (h) * hstep, voffA[0], voffA[1]); } while (0)
#define G8_LDA(dst, b, h) do { _Pragma("unroll") for (int m = 0; m < 4; ++m) _Pragma("unroll") for (int k = 0; k < 2; ++k) dst[m][k] = *(const LAS bf16x8*)(lds + G8_SA(b, h) + aoff + m * 2048 + k * 1024); } while (0)
#define G8_LDB(dst, b, h) do { _Pragma("unroll") for (int n = 0; n < 2; ++n) _Pragma("unroll") for (int k = 0; k < 2; ++k) dst[n][k] = *(const LAS bf16x8*)(lds + G8_SB(b, h) + boff + n * 2048 + k * 1024); } while (0)
#define G8_MMA(ai, bj, At, Bt) do { __builtin_amdgcn_s_setprio(1); _Pragma("unroll") for (int m = 0; m < 4; ++m) _Pragma("unroll") for (int n = 0; n < 2; ++n) _Pragma("unroll") for (int k = 0; k < 2; ++k) \
        acc[ai][bj][m][n] = __builtin_amdgcn_mfma_f32_16x16x32_bf16(Bt[n][k], At[m][k], acc[ai][bj][m][n], 0, 0, 0); __builtin_amdgcn_s_setprio(0); } while (0)
#define G8_WAIT_V(n) asm volatile("s_waitcnt vmcnt(" #n ")" ::: "memory")
#define G8_WAIT_L(n) asm volatile("s_waitcnt lgkmcnt(" #n ")" ::: "memory")
#define G8_BAR __builtin_amdgcn_s_barrier()
#define G8_SCHED __builtin_amdgcn_sched_barrier(0)
    Unit cur, nxt; int ui = 0;
    if (!S.next(0, cur)) return;
    f32x4 acc[2][2][4][2];
#pragma unroll
    for (int a = 0; a < 2; ++a)
#pragma unroll
        for (int b = 0; b < 2; ++b)
#pragma unroll
            for (int m = 0; m < 4; ++m)
#pragma unroll
                for (int n = 0; n < 2; ++n) acc[a][b][m][n] = (f32x4){0.f, 0.f, 0.f, 0.f};
    bf16x8 At[4][2], B0[2][2], B1[2][2];
    unsigned c00 = 0, c01 = 0, c10 = 0, c11 = 0, n00 = 0, n01 = 0, n10 = 0, n11 = 0;
    if (GATHER) {
        c00 = (unsigned)(lists[cur.gi + gR[0]] * K + gC[0]) * 2u; c01 = (unsigned)(lists[cur.gi + gR[1]] * K + gC[1]) * 2u;
        c10 = (unsigned)(lists[cur.gi + HALF + gR[0]] * K + gC[0]) * 2u; c11 = (unsigned)(lists[cur.gi + HALF + gR[1]] * K + gC[1]) * 2u;
    }
    const char* cA = cur.a; const char* cB = cur.b;
    G8_STAGE_B(G8_SB(0, 0), cB); G8_STAGE_A(G8_SA(0, 0), cA, 0, c00, c01); G8_STAGE_B(G8_SB(0, 1), cB + hstep); G8_STAGE_A(G8_SA(0, 1), cA, 1, c10, c11);
    if (wr == 1) G8_BAR;
    G8_WAIT_V(4); G8_BAR;
    G8_STAGE_B(G8_SB(1, 0), cB + kstep); G8_STAGE_A(G8_SA(1, 0), cA + kstep, 0, c00, c01); G8_STAGE_B(G8_SB(1, 1), cB + hstep + kstep);
    G8_WAIT_V(6); G8_BAR;
    for (;;) {
        const bool has_next = S.next(ui + 1, nxt);
        const char* nA = has_next ? nxt.a : cA; const char* nB = has_next ? nxt.b : cB;
        for (int t = 0; t < nt; t += 2) {
            const bool last = (t == nt - 2);
            if (GATHER) {
                if (last) {
                    if (has_next) {
                        n00 = (unsigned)(lists[nxt.gi + gR[0]] * K + gC[0]) * 2u; n01 = (unsigned)(lists[nxt.gi + gR[1]] * K + gC[1]) * 2u;
                        n10 = (unsigned)(lists[nxt.gi + HALF + gR[0]] * K + gC[0]) * 2u; n11 = (unsigned)(lists[nxt.gi + HALF + gR[1]] * K + gC[1]) * 2u;
                    } else { n00 = c00; n01 = c01; n10 = c10; n11 = c11; }
                }
            }
            const char* a1 = cA + (size_t)(t + 1) * kstep;
            const char* a2 = last ? nA : cA + (size_t)(t + 2) * kstep; const char* b2 = last ? nB : cB + (size_t)(t + 2) * kstep;
            const char* a3 = a2 + kstep; const char* b3 = b2 + kstep;
            const unsigned x00 = last ? n00 : c00, x01 = last ? n01 : c01, x10 = last ? n10 : c10, x11 = last ? n11 : c11;
            G8_LDB(B0, 0, 0); G8_SCHED; G8_LDA(At, 0, 0); G8_STAGE_A(G8_SA(1, 1), a1, 1, c10, c11);
            G8_WAIT_L(8); G8_BAR; G8_WAIT_L(0); G8_MMA(0, 0, At, B0); G8_BAR; G8_SCHED;
            G8_LDB(B1, 0, 1); G8_STAGE_B(G8_SB(0, 0), b2);
            G8_BAR; G8_WAIT_L(0); G8_MMA(0, 1, At, B1); G8_BAR;
            G8_LDA(At, 0, 1); G8_STAGE_A(G8_SA(0, 0), a2, 0, x00, x01);
            G8_BAR; G8_WAIT_L(0); G8_MMA(1, 0, At, B0); G8_BAR; G8_SCHED;
            G8_STAGE_B(G8_SB(0, 1), b2 + hstep);
            G8_WAIT_V(6); G8_BAR; G8_MMA(1, 1, At, B1); G8_BAR;
            G8_LDB(B0, 1, 0); G8_SCHED; G8_LDA(At, 1, 0); G8_STAGE_A(G8_SA(0, 1), a2, 1, x10, x11);
            G8_WAIT_L(8); G8_BAR; G8_WAIT_L(0); G8_MMA(0, 0, At, B0); G8_BAR; G8_SCHED;
            G8_LDB(B1, 1, 1); G8_STAGE_B(G8_SB(1, 0), b3);
            G8_BAR; G8_WAIT_L(0); G8_MMA(0, 1, At, B1); G8_BAR;
            G8_LDA(At, 1, 1); G8_STAGE_A(G8_SA(1, 0), a3, 0, x00, x01);
            G8_BAR; G8_WAIT_L(0); G8_MMA(1, 0, At, B0); G8_BAR; G8_SCHED;
            G8_STAGE_B(G8_SB(1, 1), b3 + hstep);
            G8_WAIT_V(6); G8_BAR; G8_MMA(1, 1, At, B1); G8_BAR;
        }
        E(acc, cur, wr, wc, fr, fq);
        if (!has_next) break;
#pragma unroll
        for (int a = 0; a < 2; ++a)
#pragma unroll
            for (int b = 0; b < 2; ++b)
#pragma unroll
                for (int m = 0; m < 4; ++m)
#pragma unroll
                    for (int n = 0; n < 2; ++n) acc[a][b][m][n] = (f32x4){0.f, 0.f, 0.f, 0.f};
        cur = nxt; cA = nA; cB = nB; ++ui;
        if (GATHER) { c00 = n00; c01 = n01; c10 = n10; c11 = n11; }
    }
    G8_WAIT_V(0);
    if (wr == 0) G8_BAR;
    G8_BAR;
#undef G8_SA
#undef G8_SB
#undef G8_STAGE
#undef G8_STAGE_A
#undef G8_STAGE_B
#undef G8_LDA
#undef G8_LDB
#undef G8_MMA
#undef G8_WAIT_V
#undef G8_WAIT_L
#undef G8_BAR
#undef G8_SCHED
}
}

struct Frame {
    LAS unsigned char* lds;
    unsigned* ctl;
    int tid, lane, wave, vcu, G, gw, NGW;
};
struct Args { const float* in[21]; float* out; unsigned char* ws; int ph_lo, ph_hi; };

__device__ __forceinline__ void conv_decode(const Args& a, int it, const float*& W, int& N, bf16_t*& WT, int& kb, int& nb) {
    constexpr int I_IN = 32 * 80, I_OUT = 32 * 32, I_GU = 32 * 64, I_DN = 32 * 32;
    unsigned char* ws = a.ws;
    if (it < I_IN) { W = a.in[2]; N = IN_COLS; WT = (bf16_t*)(ws + WS_WIN); }
    else if ((it -= I_IN) < I_OUT) { W = a.in[12]; N = D_MODEL; WT = (bf16_t*)(ws + WS_WOUT); }
    else if ((it -= I_OUT) < N_EXP * I_GU) { const int e = it / I_GU; it -= e * I_GU; W = a.in[16] + (size_t)e * KDIM * 4096; N = 4096; WT = (bf16_t*)(ws + WS_WGU) + (size_t)e * 4096 * KDIM; }
    else { it -= N_EXP * I_GU; const int e = it / I_DN; it -= e * I_DN; W = a.in[18] + (size_t)e * KDIM * D_MODEL; N = D_MODEL; WT = (bf16_t*)(ws + WS_WDN) + (size_t)e * D_MODEL * KDIM; }
    const int nblk = N / 64; kb = it / nblk; nb = it % nblk;
}
constexpr int CONV_ITEMS = 32 * 80 + 32 * 32 + N_EXP * 32 * 64 + N_EXP * 32 * 32;
__device__ __forceinline__ void conv_load(f32x4 (&v)[16], const float* W, int N, int kb, int nb, int lane) {
    const float* p = W + (size_t)(kb * 64 + (lane >> 4)) * N + nb * 64 + (lane & 15) * 4;
#pragma unroll
    for (int i = 0; i < 16; ++i) v[i] = *(const f32x4*)(p + (size_t)(4 * i) * N);
}
__device__ __forceinline__ void conv_store(const f32x4 (&v)[16], bf16_t* WT, int kb, int nb, LAS float* scr, int lane) {
#pragma unroll
    for (int i = 0; i < 16; ++i) { LAS float* s = scr + (4 * i + (lane >> 4)) * 65 + (lane & 15) * 4; s[0] = v[i][0]; s[1] = v[i][1]; s[2] = v[i][2]; s[3] = v[i][3]; }
    LDS_WAIT();
    const int c = lane & 7;
#pragma unroll
    for (int j = 0; j < 8; ++j) { const int n = (lane >> 3) + 8 * j; const LAS float* s = scr + (8 * c) * 65 + n;
        u32x4 o; o.x = pk2(s[0], s[65]); o.y = pk2(s[2 * 65], s[3 * 65]); o.z = pk2(s[4 * 65], s[5 * 65]); o.w = pk2(s[6 * 65], s[7 * 65]);
        *(u32x4*)(WT + (size_t)(nb * 64 + n) * KDIM + kb * 64 + 8 * c) = o; }
    LDS_WAIT();
}
__device__ __forceinline__ void rms_row_bf16(const float* xrow, const float* g, bf16_t* orow, int lane) {
    const f32x4* xr = (const f32x4*)xrow + lane; const f32x4* gr = (const f32x4*)g + lane;
    f32x4 v[8]; float s = 0.f;
#pragma unroll
    for (int j = 0; j < 8; ++j) { v[j] = xr[64 * j]; s += (v[j][0] * v[j][0] + v[j][1] * v[j][1]) + (v[j][2] * v[j][2] + v[j][3] * v[j][3]); }
    const float rs = rsqrtf(wave_sum(s) * (1.0f / 2048.0f) + EPS);
    u32x2* o = (u32x2*)orow + lane;
#pragma unroll
    for (int j = 0; j < 8; ++j) { const f32x4 gg = gr[64 * j]; u32x2 w; w.x = pk2(v[j][0] * rs * gg[0], v[j][1] * rs * gg[1]); w.y = pk2(v[j][2] * rs * gg[2], v[j][3] * rs * gg[3]); o[64 * j] = w; }
}
__device__ __forceinline__ void p0_prologue(const Frame& F, const Args& a) {
    LAS float* scr = (LAS float*)(F.lds + F.wave * 16896);
    f32x4 va[16], vb[16];
    int it = F.gw;
    const float* W; int N, kb, nb; bf16_t* WT;
    if (it < CONV_ITEMS) { conv_decode(a, it, W, N, WT, kb, nb); conv_load(va, W, N, kb, nb, F.lane); }
    while (it < CONV_ITEMS) {
        int it2 = it + F.NGW; const float* W2 = nullptr; int N2 = 0, kb2 = 0, nb2 = 0; bf16_t* WT2 = nullptr;
        if (it2 < CONV_ITEMS) { conv_decode(a, it2, W2, N2, WT2, kb2, nb2); conv_load(vb, W2, N2, kb2, nb2, F.lane); }
        conv_store(va, WT, kb, nb, scr, F.lane);
        it = it2; if (it >= CONV_ITEMS) break;
        it2 = it + F.NGW;
        if (it2 < CONV_ITEMS) { conv_decode(a, it2, W, N, WT, kb, nb); conv_load(va, W, N, kb, nb, F.lane); }
        conv_store(vb, WT2, kb2, nb2, scr, F.lane);
        it = it2;
    }
    bf16_t* HN = (bf16_t*)(a.ws + WS_HN);
    for (int m = F.gw; m < NTOK; m += F.NGW) rms_row_bf16(a.in[0] + (size_t)m * D_MODEL, a.in[1], HN + (size_t)m * D_MODEL, F.lane);
}

__device__ __forceinline__ float gelu_tanh(float x) { return 0.5f * x * (1.0f + tanhf(0.7978845608028654f * (x + 0.044715f * x * x * x))); }
__device__ __forceinline__ float sigmoidf_(float x) { return 1.0f / (1.0f + __expf(-x)); }
__device__ __forceinline__ void lru_unit(const Frame& F, const Args& a, int unit) {
    const int lane = F.lane;
    const int b = unit >> 9, k = (unit >> 4) & 31, blk = unit & 15;
    const bf16_t* proj = (const bf16_t*)(a.ws + WS_PROJ);
    LAS float* xs = (LAS float*)(F.lds + F.wave * 16384);
    const int ch = blk * 64 + lane;
    const float cw0 = a.in[3][0 * LRU_W + ch], cw1 = a.in[3][1 * LRU_W + ch], cw2 = a.in[3][2 * LRU_W + ch], cw3 = a.in[3][3 * LRU_W + ch], cb = a.in[4][ch];
    const int t0 = k * 64; const size_t row0 = (size_t)b * SEQ + t0;
    const bf16_t* xp = proj + row0 * IN_COLS + 3 * ATTN_W + ch;
    float x0 = (t0 >= 3) ? bf2f(xp[-3 * IN_COLS]) : 0.f, x1 = (t0 >= 2) ? bf2f(xp[-2 * IN_COLS]) : 0.f, x2 = (t0 >= 1) ? bf2f(xp[-1 * IN_COLS]) : 0.f;
    for (int t = 0; t < 64; ++t) {
        const float x3 = bf2f(xp[(size_t)t * IN_COLS]);
        xs[t * 64 + lane] = cb + cw0 * x0 + cw1 * x1 + cw2 * x2 + cw3 * x3;
        x0 = x1; x1 = x2; x2 = x3;
    }
    float wa[64], wx[64];
    const float* wap = a.in[5] + (size_t)blk * 4096 + lane; const float* wxp = a.in[7] + (size_t)blk * 4096 + lane;
#pragma unroll
    for (int c = 0; c < 64; ++c) { wa[c] = wap[c * 64]; wx[c] = wxp[c * 64]; }
    const float ba = a.in[6][ch], bx = a.in[8][ch];
    const float sp = log1pf(__expf(-a.in[9][ch]));
    float* hl = (float*)(a.ws + WS_HL) + row0 * LRU_W + ch; float* pc = (float*)(a.ws + WS_PC) + row0 * LRU_W + ch;
    LDS_WAIT();
    float h = 0.f, P = 1.f;
    for (int t = 0; t < 64; ++t) {
        float r = ba, ii = bx;
        const LAS f32x4* xr = (const LAS f32x4*)(xs + t * 64);
#pragma unroll
        for (int c4 = 0; c4 < 16; ++c4) { const f32x4 xv = xr[c4];
            r = fmaf(xv[0], wa[4 * c4], r); r = fmaf(xv[1], wa[4 * c4 + 1], r); r = fmaf(xv[2], wa[4 * c4 + 2], r); r = fmaf(xv[3], wa[4 * c4 + 3], r);
            ii = fmaf(xv[0], wx[4 * c4], ii); ii = fmaf(xv[1], wx[4 * c4 + 1], ii); ii = fmaf(xv[2], wx[4 * c4 + 2], ii); ii = fmaf(xv[3], wx[4 * c4 + 3], ii); }
        r = sigmoidf_(r); ii = sigmoidf_(ii);
        const float log_a = -8.0f * r * sp;
        const float av = __expf(log_a);
        const float bv = sqrtf(-expm1f(2.0f * log_a)) * (ii * xs[t * 64 + lane]);
        h = av * h + bv; P *= av;
        hl[(size_t)t * LRU_W] = h; pc[(size_t)t * LRU_W] = P;
    }
    float* ae = (float*)(a.ws + WS_LRUE); float* he = ae + 4 * 32 * 1024;
    ae[(size_t)(b * 32 + k) * 1024 + ch] = P; he[(size_t)(b * 32 + k) * 1024 + ch] = h;
    LDS_WAIT();
}
__device__ __forceinline__ void attn_branch_naive(const bf16_t* __restrict__ proj, int b, int t, int h, int lane, float q, float slope, int dil, float& o_out, float& lse_out) {
    float m = -INFINITY, s = 0.f, o = 0.f;
    for (int j = 0; j <= 128; ++j) {
        const int pos = t - j * dil; if (pos < 0) break;
        const bf16_t* kp = proj + (size_t)(b * SEQ + pos) * IN_COLS + ATTN_W + h * 64;
        const float prod = wave_sum(q * bf2f(kp[lane]));
        const float sc = prod * 0.125f - slope * (float)(j * dil);
        const float mn = fmaxf(m, sc);
        const float alpha = __expf(m - mn), pp = __expf(sc - mn);
        s = s * alpha + pp; o = o * alpha + pp * bf2f(kp[ATTN_W + lane]); m = mn;
    }
    o_out = o / s; lse_out = m + __logf(s);
}
__device__ __forceinline__ void p2_mixers(const Frame& F, const Args& a) {
    for (int u = F.gw; u < 2048; u += F.NGW) lru_unit(F, a, u);
    const bf16_t* proj = (const bf16_t*)(a.ws + WS_PROJ); float* att = (float*)(a.ws + WS_ATT);
    for (int u = F.gw; u < NTOK * N_HEADS; u += F.NGW) {
        const int bt = u >> 4, h = u & 15, b = bt / SEQ, t = bt % SEQ;
        const float q = bf2f(proj[(size_t)bt * IN_COLS + h * 64 + F.lane]);
        const float slope = exp2f(-8.0f * (float)(h + 1) / 16.0f);
        float o0, o1, o2, l0, l1, l2;
        attn_branch_naive(proj, b, t, h, F.lane, q, slope, 1, o0, l0);
        attn_branch_naive(proj, b, t, h, F.lane, q, slope, 4, o1, l1);
        attn_branch_naive(proj, b, t, h, F.lane, q, slope, 16, o2, l2);
        const float M = fmaxf(l0, fmaxf(l1, l2));
        const float w0 = __expf(l0 - M), w1 = __expf(l1 - M), w2 = __expf(l2 - M);
        att[(size_t)bt * ATTN_W + h * 64 + F.lane] = (w0 * o0 + w1 * o1 + w2 * o2) / (w0 + w1 + w2);
    }
}

__device__ __forceinline__ void p3_mix(const Frame& F, const Args& a) {
    LAS float* Hin = (LAS float*)F.lds;
    const float* ae = (const float*)(a.ws + WS_LRUE); const float* he = ae + 4 * 32 * 1024;
    const bf16_t* proj = (const bf16_t*)(a.ws + WS_PROJ);
    bf16_t* mixed = (bf16_t*)(a.ws + WS_MIXED);
    for (int grp = F.vcu; grp < NTOK / 32; grp += F.G) {
        const int tok0 = grp * 32, b = tok0 / SEQ, k = (tok0 % SEQ) / 64;
        __syncthreads();
        for (int d = F.tid; d < LRU_W; d += NTHR) { float H = 0.f; for (int j = 0; j < k; ++j) H = ae[(size_t)(b * 32 + j) * 1024 + d] * H + he[(size_t)(b * 32 + j) * 1024 + d]; Hin[d] = H; }
        __syncthreads();
        for (int tt = F.wave; tt < 32; tt += NWAVES) {
            const size_t tok = (size_t)tok0 + tt;
            { const f32x4* ar = (const f32x4*)((const float*)(a.ws + WS_ATT) + tok * ATTN_W) + F.lane; const f32x4* gr = (const f32x4*)a.in[10] + F.lane;
              f32x4 v[4]; float s = 0.f;
#pragma unroll
              for (int j = 0; j < 4; ++j) { v[j] = ar[64 * j]; s += (v[j][0] * v[j][0] + v[j][1] * v[j][1]) + (v[j][2] * v[j][2] + v[j][3] * v[j][3]); }
              const float rs = rsqrtf(wave_sum(s) * (1.0f / 1024.0f) + EPS);
              u32x2* o = (u32x2*)(mixed + tok * D_MODEL) + F.lane;
#pragma unroll
              for (int j = 0; j < 4; ++j) { const f32x4 g = gr[64 * j]; u32x2 w; w.x = pk2(v[j][0] * rs * g[0], v[j][1] * rs * g[1]); w.y = pk2(v[j][2] * rs * g[2], v[j][3] * rs * g[3]); o[64 * j] = w; } }
            { const f32x4* hr = (const f32x4*)((const float*)(a.ws + WS_HL) + tok * LRU_W) + F.lane; const f32x4* pr = (const f32x4*)((const float*)(a.ws + WS_PC) + tok * LRU_W) + F.lane;
              const u32x2* gp = (const u32x2*)(proj + tok * IN_COLS + 3 * ATTN_W + LRU_W) + F.lane; const f32x4* gr = (const f32x4*)a.in[11] + F.lane;
              f32x4 v[4]; float s = 0.f;
#pragma unroll
              for (int j = 0; j < 4; ++j) { const f32x4 hv = hr[64 * j], pv = pr[64 * j]; const u32x2 gw = gp[64 * j]; const f32x4 hi = *(const LAS f32x4*)(Hin + (F.lane + 64 * j) * 4);
                  v[j][0] = (hv[0] + pv[0] * hi[0]) * gelu_tanh(bflo(gw.x)); v[j][1] = (hv[1] + pv[1] * hi[1]) * gelu_tanh(bfhi(gw.x));
                  v[j][2] = (hv[2] + pv[2] * hi[2]) * gelu_tanh(bflo(gw.y)); v[j][3] = (hv[3] + pv[3] * hi[3]) * gelu_tanh(bfhi(gw.y));
                  s += (v[j][0] * v[j][0] + v[j][1] * v[j][1]) + (v[j][2] * v[j][2] + v[j][3] * v[j][3]); }
              const float rs = rsqrtf(wave_sum(s) * (1.0f / 1024.0f) + EPS);
              u32x2* o = (u32x2*)(mixed + tok * D_MODEL + ATTN_W) + F.lane;
#pragma unroll
              for (int j = 0; j < 4; ++j) { const f32x4 g = gr[64 * j]; u32x2 w; w.x = pk2(v[j][0] * rs * g[0], v[j][1] * rs * g[1]); w.y = pk2(v[j][2] * rs * g[2], v[j][3] * rs * g[3]); o[64 * j] = w; } }
        }
    }
    __syncthreads();
}

__device__ __forceinline__ void p5_router(const Frame& F, const Args& a) {
    const float* x1 = (const float*)(a.ws + WS_X1); bf16_t* hn2 = (bf16_t*)(a.ws + WS_HN);
    const float* g = a.in[13]; const float* wr = a.in[14]; const float* br = a.in[15];
    int* cnt = (int*)(F.ctl + CW_CNT); int* lists = (int*)(a.ws + WS_LISTS);
    int* sel_e = (int*)(a.ws + WS_SEL); int* sel_pos = sel_e + NSLOT; float* sel_g = (float*)(sel_pos + NSLOT);
    LAS float* HS = (LAS float*)F.lds;
    LAS float* WSm = HS + 32 * 257;
    LAS float* RS = WSm + 256 * 32;
    LAS float* LG = RS + 32;
    LAS int* lcnt = (LAS int*)(LG + 1024);
    LAS int* gbase = lcnt + 32;
    LAS int* ent_e = gbase + 32;
    LAS int* ent_r = ent_e + 128;
    LAS float* ent_g = (LAS float*)(ent_r + 128);
    for (int grp = F.vcu; grp < NTOK / 32; grp += F.G) {
        const int tok0 = grp * 32;
        __syncthreads();
        if (F.tid < 32) lcnt[F.tid] = 0;
        for (int tt = F.wave; tt < 32; tt += NWAVES) {
            const f32x4* xr = (const f32x4*)(x1 + (size_t)(tok0 + tt) * D_MODEL) + F.lane; float s = 0.f;
#pragma unroll
            for (int j = 0; j < 8; ++j) { const f32x4 v = xr[64 * j]; s += (v[0] * v[0] + v[1] * v[1]) + (v[2] * v[2] + v[3] * v[3]); }
            const float rs = rsqrtf(wave_sum(s) * (1.0f / 2048.0f) + EPS);
            if (F.lane == 0) RS[tt] = rs;
        }
        __syncthreads();
        const int tt = F.tid >> 4, eg = F.tid & 15;
        float acc0 = 0.f, acc1 = 0.f;
        for (int kc = 0; kc < 8; ++kc) {
#pragma unroll
            for (int i = 0; i < 4; ++i) { const int idx = F.tid + i * NTHR; const int r = idx >> 6, c4 = (idx & 63) * 4;
                const f32x4 v = *(const f32x4*)(x1 + (size_t)(tok0 + r) * D_MODEL + kc * 256 + c4); const f32x4 gg = *(const f32x4*)(g + kc * 256 + c4); const float rs = RS[r];
                const float h0 = v[0] * rs * gg[0], h1 = v[1] * rs * gg[1], h2 = v[2] * rs * gg[2], h3 = v[3] * rs * gg[3];
                LAS float* hp = HS + r * 257 + c4; hp[0] = h0; hp[1] = h1; hp[2] = h2; hp[3] = h3;
                u32x2 w; w.x = pk2(h0, h1); w.y = pk2(h2, h3); *(u32x2*)(hn2 + (size_t)(tok0 + r) * D_MODEL + kc * 256 + c4) = w; }
#pragma unroll
            for (int i = 0; i < 4; ++i) { const int idx = F.tid + i * NTHR; *(LAS f32x4*)(WSm + idx * 4) = *(const f32x4*)(wr + (size_t)kc * 256 * 32 + idx * 4); }
            __syncthreads();
            const LAS float* hp = HS + tt * 257; const LAS float* wp = WSm + 2 * eg;
#pragma unroll 8
            for (int c = 0; c < 256; ++c) { const float hv = hp[c]; const f32x2 w2 = *(const LAS f32x2*)(wp + c * 32); acc0 = fmaf(hv, w2[0], acc0); acc1 = fmaf(hv, w2[1], acc1); }
            __syncthreads();
        }
        LG[tt * 32 + 2 * eg] = acc0 + br[2 * eg]; LG[tt * 32 + 2 * eg + 1] = acc1 + br[2 * eg + 1];
        __syncthreads();
        for (int t4 = 0; t4 < 4; ++t4) {
            const int tk = F.wave * 4 + t4;
            float cur = (F.lane < 32) ? LG[tk * 32 + F.lane] : -INFINITY;
            int i0 = 0, i1 = 0, i2 = 0, i3 = 0; float v0 = 0.f, v1 = 0.f, v2 = 0.f, v3 = 0.f;
#pragma unroll
            for (int k = 0; k < 4; ++k) {
                const float mx = wave_max(cur);
                const unsigned long long bal = __ballot(cur == mx);
                const int bi = __ffsll((long long)bal) - 1;
                if (k == 0) { i0 = bi; v0 = mx; } else if (k == 1) { i1 = bi; v1 = mx; } else if (k == 2) { i2 = bi; v2 = mx; } else { i3 = bi; v3 = mx; }
                if (F.lane == bi) cur = -INFINITY;
            }
            if (F.lane == 0) {
                const float e1 = __expf(v1 - v0), e2 = __expf(v2 - v0), e3 = __expf(v3 - v0); const float inv = 1.0f / (1.0f + e1 + e2 + e3);
                const int base = tk * 4;
                ent_e[base + 0] = i0; ent_r[base + 0] = __hip_atomic_fetch_add(&lcnt[i0], 1, __ATOMIC_RELAXED, __HIP_MEMORY_SCOPE_WORKGROUP); ent_g[base + 0] = inv;
                ent_e[base + 1] = i1; ent_r[base + 1] = __hip_atomic_fetch_add(&lcnt[i1], 1, __ATOMIC_RELAXED, __HIP_MEMORY_SCOPE_WORKGROUP); ent_g[base + 1] = e1 * inv;
                ent_e[base + 2] = i2; ent_r[base + 2] = __hip_atomic_fetch_add(&lcnt[i2], 1, __ATOMIC_RELAXED, __HIP_MEMORY_SCOPE_WORKGROUP); ent_g[base + 2] = e2 * inv;
                ent_e[base + 3] = i3; ent_r[base + 3] = __hip_atomic_fetch_add(&lcnt[i3], 1, __ATOMIC_RELAXED, __HIP_MEMORY_SCOPE_WORKGROUP); ent_g[base + 3] = e3 * inv;
            }
        }
        __syncthreads();
        if (F.tid < 32) { const int n = lcnt[F.tid]; gbase[F.tid] = n > 0 ? atomicAdd(&cnt[F.tid], n) : 0; }
        __syncthreads();
        if (F.tid < 128) { const int e = ent_e[F.tid], pos = gbase[e] + ent_r[F.tid], tok = tok0 + (F.tid >> 2);
            lists[e * NTOK + pos] = tok; sel_e[tok * 4 + (F.tid & 3)] = e; sel_pos[tok * 4 + (F.tid & 3)] = pos; sel_g[tok * 4 + (F.tid & 3)] = ent_g[F.tid]; }
    }
    __syncthreads();
}

__device__ __forceinline__ void build_tpre(const Frame& F) {
    LAS int* tpre = (LAS int*)(F.lds + L_TPRE);
    __syncthreads();
    if (F.tid == 0) { const int* cnt = (const int*)(F.ctl + CW_CNT); int acc = 0; for (int e = 0; e < N_EXP; ++e) { tpre[e] = acc; acc += (cnt[e] + 255) >> 8; } tpre[N_EXP] = acc; }
    __syncthreads();
}

__device__ __forceinline__ void p8_final(const Frame& F, const Args& a) {
    const LAS int* tpre = (const LAS int*)(F.lds + L_TPRE);
    const float* x1 = (const float*)(a.ws + WS_X1); const bf16_t* Y = (const bf16_t*)(a.ws + WS_Y);
    const int* sel_e = (const int*)(a.ws + WS_SEL); const int* sel_pos = sel_e + NSLOT; const float* sel_g = (const float*)(sel_pos + NSLOT);
    const f32x4* gr = (const f32x4*)a.in[20] + F.lane;
    for (int tok = F.gw; tok < NTOK; tok += F.NGW) {
        const f32x4* xr = (const f32x4*)(x1 + (size_t)tok * D_MODEL) + F.lane;
        f32x4 v[8];
#pragma unroll
        for (int j = 0; j < 8; ++j) v[j] = xr[64 * j];
#pragma unroll
        for (int k = 0; k < 4; ++k) {
            const int e = sel_e[tok * 4 + k]; const size_t row = (size_t)tpre[e] * 256 + sel_pos[tok * 4 + k]; const float gk = sel_g[tok * 4 + k];
            const u32x2* yp = (const u32x2*)(Y + row * D_MODEL) + F.lane;
#pragma unroll
            for (int j = 0; j < 8; ++j) { const u32x2 w = yp[64 * j]; v[j][0] += gk * bflo(w.x); v[j][1] += gk * bfhi(w.x); v[j][2] += gk * bflo(w.y); v[j][3] += gk * bfhi(w.y); }
        }
        float s = 0.f;
#pragma unroll
        for (int j = 0; j < 8; ++j) s += (v[j][0] * v[j][0] + v[j][1] * v[j][1]) + (v[j][2] * v[j][2] + v[j][3] * v[j][3]);
        const float rs = rsqrtf(wave_sum(s) * (1.0f / 2048.0f) + EPS);
        f32x4* o = (f32x4*)(a.out + (size_t)tok * D_MODEL) + F.lane;
#pragma unroll
        for (int j = 0; j < 8; ++j) { const f32x4 g = gr[64 * j]; o[64 * j] = (f32x4){v[j][0] * rs * g[0], v[j][1] * rs * g[1], v[j][2] * rs * g[2], v[j][3] * rs * g[3]}; }
    }
}

constexpr int N_PHASES = 9;
__global__ void __launch_bounds__(NTHR, 2) mk_fwd(Args args) {
    extern __shared__ __attribute__((aligned(16))) unsigned char lds_raw[];
    Frame F;
    F.lds = (LAS unsigned char*)lds_raw;
    F.tid = threadIdx.x; F.lane = F.tid & 63; F.wave = __builtin_amdgcn_readfirstlane(F.tid >> 6);
    F.G = gridDim.x; { const int bx = blockIdx.x; F.vcu = (F.G % 8 == 0) ? (bx % 8) * (F.G / 8) + bx / 8 : bx; }
    F.gw = F.vcu * NWAVES + F.wave; F.NGW = F.G * NWAVES;
    F.ctl = (unsigned*)(args.ws + WS_CTL);
    for (int u = F.tid; u < (LDS_BYTES - LDSCTL_OFF) / 4; u += NTHR) ((LAS unsigned*)(F.lds + LDSCTL_OFF))[u] = 0u;
    __syncthreads();
    const int lo = args.ph_lo, hi = args.ph_hi;
    XcdBarrier bar; bar.bar = F.ctl + CW_BAR; bar.x = 0; bar.st = nullptr;
    if (hi - lo > 1) bar = xcd_barrier_post(F.ctl + CW_BAR, (volatile LAS unsigned*)(F.lds + L_MISC) + 8);
#define IN(k) (lo <= (k) && (k) < hi)
#define SEAM(k) do { if (IN(k) && IN((k) + 1)) xcd_barrier(bar); } while (0)
    unsigned char* ws = args.ws;

    if (IN(0)) { p0_prologue(F, args); } SEAM(0);

    if (IN(1)) {
        g8::DenseOrder S{(const char*)(ws + WS_HN), (const char*)(ws + WS_WIN), NTOK / 256, IN_COLS / 256, (NTOK / 256) * (IN_COLS / 256), F.G, (int)blockIdx.x};
        g8::EpiBf16 E{(bf16_t*)(ws + WS_PROJ), IN_COLS, nullptr, 0};
        g8::gemm_phase<g8::EpiBf16, g8::DenseOrder, false>(F.lds, S, E, nullptr);
    } SEAM(1);

    if (IN(2)) { p2_mixers(F, args); } SEAM(2);
    if (IN(3)) { p3_mix(F, args); } SEAM(3);

    if (IN(4)) {
        g8::DenseOrder S{(const char*)(ws + WS_MIXED), (const char*)(ws + WS_WOUT), NTOK / 256, D_MODEL / 256, (NTOK / 256) * (D_MODEL / 256), F.G, (int)blockIdx.x};
        g8::EpiResF32 E{(float*)(ws + WS_X1), args.in[0], D_MODEL};
        g8::gemm_phase<g8::EpiResF32, g8::DenseOrder, false>(F.lds, S, E, nullptr);
    } SEAM(4);

    if (IN(5)) { p5_router(F, args); } SEAM(5);

    if (IN(6)) {
        build_tpre(F);
        g8::GroupedOrder S{nullptr, (const char*)(ws + WS_WGU), (const LAS int*)(F.lds + L_TPRE), 4096 / 256, F.G, (int)blockIdx.x, (size_t)4096 * KDIM * 2, true, (const char*)(ws + WS_HN)};
        g8::EpiSwiglu E{(bf16_t*)(ws + WS_ACT), args.in[17]};
        g8::gemm_phase<g8::EpiSwiglu, g8::GroupedOrder, true>(F.lds, S, E, (const int*)(ws + WS_LISTS));
    } SEAM(6);

    if (IN(7)) {
        build_tpre(F);
        g8::GroupedOrder S{(const char*)(ws + WS_ACT), (const char*)(ws + WS_WDN), (const LAS int*)(F.lds + L_TPRE), D_MODEL / 256, F.G, (int)blockIdx.x, (size_t)D_MODEL * KDIM * 2, false, nullptr};
        g8::EpiBf16 E{(bf16_t*)(ws + WS_Y), D_MODEL, args.in[19], D_MODEL};
        g8::gemm_phase<g8::EpiBf16, g8::GroupedOrder, false>(F.lds, S, E, nullptr);
    } SEAM(7);

    if (IN(8)) { build_tpre(F); p8_final(F, args); }
#undef IN
#undef SEAM
}

extern "C" void kernel_launch(void* const* d_in, const int* in_sizes, int n_in, void* d_out, int out_size, void* d_ws, size_t ws_size, hipStream_t stream) {
    static int grid = 0;
    if (grid == 0) {
        if (n_in != 21 || out_size != NTOK * D_MODEL || ws_size < WS_END) { fprintf(stderr, "kernel_launch: unexpected problem (n_in %d out %d ws %zu)\n", n_in, out_size, ws_size); grid = -1; return; }
        int dev = 0, cus = 0, per_cu = 0;
        if (hipGetDevice(&dev) != hipSuccess || hipDeviceGetAttribute(&cus, hipDeviceAttributeMultiprocessorCount, dev) != hipSuccess) { grid = -1; return; }
        if (hipFuncSetAttribute((const void*)mk_fwd, hipFuncAttributeMaxDynamicSharedMemorySize, LDS_BYTES) != hipSuccess) { fprintf(stderr, "kernel_launch: hipFuncSetAttribute failed\n"); grid = -1; return; }
        if (hipOccupancyMaxActiveBlocksPerMultiprocessor(&per_cu, (const void*)mk_fwd, NTHR, LDS_BYTES) != hipSuccess || per_cu < 1) { fprintf(stderr, "kernel_launch: occupancy query says %d\n", per_cu); }
        (void)hipGetLastError();
        grid = cus;
    }
    if (grid < 0) return;
    if (hipMemsetAsync((char*)d_ws + WS_CTL, 0, CTL_ZERO_BYTES, stream) != hipSuccess) return;
    Args a{};
    for (int i = 0; i < 21; ++i) a.in[i] = (const float*)d_in[i];
    a.out = (float*)d_out; a.ws = (unsigned char*)d_ws;
#if MK_N_LAUNCHES == 1
    a.ph_lo = 0; a.ph_hi = N_PHASES;
    hipLaunchKernelGGL(mk_fwd, dim3(grid), dim3(NTHR), LDS_BYTES, stream, a);
#else
    for (int p = 0; p < N_PHASES; ++p) { a.ph_lo = p; a.ph_hi = p + 1; hipLaunchKernelGGL(mk_fwd, dim3(grid), dim3(NTHR), LDS_BYTES, stream, a); }
#endif
}
```

```cpp
#include <hip/hip_runtime.h>
#include <stdint.h>
#include <stdio.h>

#ifndef MK_N_LAUNCHES
#define MK_N_LAUNCHES 1
#endif

#define LAS __attribute__((address_space(3)))
#define GAS __attribute__((address_space(1)))
typedef unsigned short bf16_t;
typedef short bf16x8 __attribute__((ext_vector_type(8)));
typedef float f32x4 __attribute__((ext_vector_type(4)));
typedef float f32x2 __attribute__((ext_vector_type(2)));
typedef unsigned u32x4 __attribute__((ext_vector_type(4)));
typedef unsigned u32x2 __attribute__((ext_vector_type(2)));

constexpr int D_MODEL = 2048, BATCH = 4, SEQ = 2048, NTOK = BATCH * SEQ;
constexpr int N_HEADS = 16, ATTN_W = 1024, LRU_W = 1024;
constexpr int IN_COLS = 5120;
constexpr int N_EXP = 32, D_FF = 2048, NSLOT = NTOK * 4;
constexpr int KDIM = 2048;
constexpr float EPS = 1e-6f;
constexpr int NWAVES = 8, NTHR = 512;
constexpr int PADROWS = NSLOT + N_EXP * 256;

constexpr size_t MiB = 1u << 20;
constexpr size_t WS_CTL = 0, WS_LISTS = 1 * MiB, CTL_ZERO_BYTES = 2 * MiB;
constexpr size_t WS_SEL = 2 * MiB;
constexpr size_t WS_LRUE = 3 * MiB;
constexpr size_t WS_WIN = 4 * MiB, WS_WOUT = 24 * MiB, WS_HN = 32 * MiB, WS_PROJ = 64 * MiB, WS_ATT = 144 * MiB  , WS_HL = 192 * MiB, WS_PC = 224 * MiB;
constexpr size_t WS_MIXED = 256 * MiB, WS_X1 = 288 * MiB, WS_ACT = 352 * MiB, WS_Y = 512 * MiB, WS_WGU = 672 * MiB, WS_WDN = 1184 * MiB, WS_LSE = 1440 * MiB  , WS_END = 1442 * MiB;
static_assert((size_t)PADROWS * 2048 * 2 <= 160 * MiB, "ACT/Y size");
constexpr int CW_BAR = 4096, CW_CNT = 8192;

constexpr int RING_BYTES = 131072;
constexpr int LDSCTL_OFF = 139264;
constexpr int LDS_BYTES = 147456;
constexpr int L_MISC = LDSCTL_OFF;
constexpr int L_TPRE = LDSCTL_OFF + 256;
constexpr int L_CNT = LDSCTL_OFF + 512;

__device__ __forceinline__ unsigned f2bf(float f) { unsigned u = __builtin_bit_cast(unsigned, f); return (u + 0x7fffu + ((u >> 16) & 1u)) >> 16; }
__device__ __forceinline__ unsigned pk2(float lo, float hi) { return f2bf(lo) | (f2bf(hi) << 16); }
__device__ __forceinline__ float bf2f(unsigned short b) { return __builtin_bit_cast(float, (unsigned)b << 16); }
__device__ __forceinline__ float bflo(unsigned w) { return __builtin_bit_cast(float, w << 16); }
__device__ __forceinline__ float bfhi(unsigned w) { return __builtin_bit_cast(float, w & 0xffff0000u); }
__device__ __forceinline__ float wave_sum(float v) {
#pragma unroll
    for (int o = 1; o < 64; o <<= 1) v += __shfl_xor(v, o);
    return v;
}
__device__ __forceinline__ float wave_max(float v) {
#pragma unroll
    for (int o = 1; o < 64; o <<= 1) v = fmaxf(v, __shfl_xor(v, o));
    return v;
}
#define LDS_WAIT() asm volatile("s_waitcnt lgkmcnt(0)" ::: "memory")
#define VM_WAIT() asm volatile("s_waitcnt vmcnt(0)" ::: "memory")

#define XB_TMO      128
#define XB_XCNT(j)  (256  + 64 * (j))
#define XB_XSUB(j)  (1280 + 64 * (j))
#define XB_XGEN(j)  (2304 + 64 * (j))
#define XB_TOP      3328
#define XB_TOPGEN   3392
#define XCD_BAR_WORDS 3456
#define XB_SPIN_CAP (1u << 20)
__device__ __forceinline__ unsigned xb_ld(unsigned* p)              { return __hip_atomic_load(p, __ATOMIC_RELAXED, __HIP_MEMORY_SCOPE_AGENT); }
__device__ __forceinline__ unsigned xb_add(unsigned* p, unsigned v) { return __hip_atomic_fetch_add(p, v, __ATOMIC_RELAXED, __HIP_MEMORY_SCOPE_AGENT); }
__device__ __forceinline__ unsigned xb_xcc_id() { return (unsigned)__builtin_amdgcn_s_getreg((3 << 11) | 20) & 0xFu; }
#define XB_SPIN(cond, bar) do { unsigned _sp = 0; while (cond) { __builtin_amdgcn_s_sleep(1); \
    if ((++_sp & 255u) == 0u) { if (xb_ld(&(bar)[XB_TMO])) break; if (_sp > XB_SPIN_CAP) { atomicAdd(&(bar)[XB_TMO], 1u); break; } } } } while (0)
struct XcdBarrier { unsigned* bar; unsigned x; volatile LAS unsigned* st; };
__device__ __forceinline__ XcdBarrier xcd_barrier_post(unsigned* bar, volatile LAS unsigned* st) {
    XcdBarrier b; b.bar = bar; b.x = xb_xcc_id(); b.st = st;
    if (threadIdx.x == 0) (void)xb_add(&bar[XB_XCNT(b.x)], 1u);
    return b;
}
__device__ __forceinline__ void xcd_barrier_complete(unsigned* bar, unsigned x, unsigned& nloc, unsigned& nx) {
    const unsigned G = gridDim.x * gridDim.y * gridDim.z;
    unsigned sum, cnt, mine, sp = 0u;
    for (;;) {
        sum = 0u; cnt = 0u; mine = 0u;
#pragma unroll
        for (unsigned j = 0; j < 16; ++j) { const unsigned c = xb_ld(&bar[XB_XCNT(j)]); sum += c; cnt += (c > 0u) ? 1u : 0u; mine = (j == x) ? c : mine; }
        if (sum == G) break;
        __builtin_amdgcn_s_sleep(1);
        if ((++sp & 255u) == 0u) { if (xb_ld(&bar[XB_TMO])) break; if (sp > XB_SPIN_CAP) { atomicAdd(&bar[XB_TMO], 1u); break; } }
    }
    nloc = mine > 0u ? mine : 1u; nx = cnt > 0u ? cnt : 1u;
}
__device__ __forceinline__ void xcd_barrier(const XcdBarrier& b) {
    asm volatile("s_waitcnt vmcnt(0)" ::: "memory");
    __syncthreads();
    if (threadIdx.x == 0) {
        unsigned* bar = b.bar;
        __builtin_amdgcn_s_waitcnt(0);
        unsigned nloc = b.st[0], nx = b.st[1];
        if (nloc == 0u) { xcd_barrier_complete(bar, b.x, nloc, nx); b.st[0] = nloc; b.st[1] = nx; }
        const unsigned old = xb_add(&bar[XB_XSUB(b.x)], 1u);
        const unsigned gen = old / nloc;
        if (old + 1u == (gen + 1u) * nloc) {
            __builtin_amdgcn_fence(__ATOMIC_RELEASE, "agent");
            asm volatile("s_waitcnt vmcnt(0)" ::: "memory");
            const unsigned og = xb_add(&bar[XB_TOP], 1u);
            const unsigned tg = og / nx;
            if (og + 1u == (tg + 1u) * nx) xb_add(&bar[XB_TOPGEN], 1u);
            else XB_SPIN(xb_ld(&bar[XB_TOPGEN]) == tg, bar);
            __builtin_amdgcn_fence(__ATOMIC_ACQUIRE, "agent");
            xb_add(&bar[XB_XGEN(b.x)], 1u);
            asm volatile("s_waitcnt vmcnt(0)" ::: "memory");
        } else {
            XB_SPIN(xb_ld(&bar[XB_XGEN(b.x)]) == gen, bar);
            __builtin_amdgcn_fence(__ATOMIC_ACQUIRE, "agent");
            asm volatile("s_waitcnt vmcnt(0)" ::: "memory");
        }
    }
    __syncthreads();
}

namespace g8 {
constexpr int BM = 256, BK = 64, HALF = 128, HTB = HALF * BK * 2, STAGE_BYTES = 8 * HTB, NXCD = 8, WGM = 8;
__host__ __device__ __forceinline__ int lds_byte(int r, int c) { const int st = (r >> 4) * 2 + (c >> 5), rr = r & 15, cc = c & 31, ob = rr * 64 + cc * 2; return st * 1024 + (ob ^ (((ob >> 9) & 1) << 5)); }
__host__ __device__ __forceinline__ void stage_rc(int b, int& R, int& C) { const int st = b / 1024, sb = b % 1024, swz = sb ^ (((sb >> 9) & 1) << 5); R = (st >> 1) * 16 + swz / 64; C = (st & 1) * 32 + (swz % 64) / 2; }
__host__ __device__ __forceinline__ int perm32(int rho) { const int n = rho >> 4, i = rho & 15; return 8 * (i >> 2) + 4 * n + (i & 3); }

struct Unit { const char* a; const char* b; int crow, ccol, e, gi; };

struct DenseOrder {
    const char* A; const char* Bt; int nM, nN, nwg, G, c;
    __device__ __forceinline__ bool next(int i, Unit& u) const {
        const long L = (long)i * G + c; if (L >= nwg) return false;
        int wgid = (int)L; { const int q = nwg / NXCD, r = nwg % NXCD, xcd = wgid % NXCD, off = wgid / NXCD; wgid = (xcd < r ? xcd * (q + 1) : r * (q + 1) + (xcd - r) * q) + off; }
        const int nig = WGM * nN, gid = wgid / nig, fm = gid * WGM, gsz = (nM - fm) < WGM ? (nM - fm) : WGM;
        const int pm = fm + ((wgid % nig) % gsz), pn = (wgid % nig) / gsz;
        u.a = A + (size_t)pm * BM * KDIM * 2; u.b = Bt + (size_t)pn * BM * KDIM * 2; u.crow = pm * BM; u.ccol = pn * BM; u.e = 0; u.gi = 0; return true;
    }
};
struct GroupedOrder {
    const char* A; const char* Bt; const LAS int* tpre; int nN, G, c; size_t bstride;
    bool gather; const char* Asrc;
    __device__ __forceinline__ bool next(int i, Unit& u) const {
        const int total = tpre[N_EXP] * nN; const long L = (long)i * G + c; if (L >= total) return false;
        const int mtile = (int)L / nN, nt = (int)L % nN;
        int e = 0; while (mtile >= tpre[e + 1]) ++e;
        const int mt = mtile - tpre[e];
        u.a = gather ? Asrc : A + (size_t)mtile * BM * KDIM * 2;
        u.b = Bt + (size_t)e * bstride + (size_t)nt * BM * KDIM * 2; u.crow = mtile * BM; u.ccol = nt * BM; u.e = e; u.gi = e * NTOK + mt * BM; return true;
    }
};

__device__ __forceinline__ unsigned cvt_pk_bf16(float lo, float hi) { unsigned r; asm volatile("v_cvt_pk_bf16_f32 %0, %1, %2" : "=v"(r) : "v"(lo), "v"(hi)); return r; }

struct EpiBf16 {
    static constexpr bool PERM = true;
    bf16_t* O; int ldc; const float* bias; int bias_stride;
    __device__ __forceinline__ void operator()(const f32x4 (&acc)[2][2][4][2], const Unit& u, int wr, int wc, int fr, int fq) const {
        const int row0 = u.crow + wr * 64 + fr, col0 = u.ccol + wc * 32 + 8 * fq;
        f32x4 bv[2][2];
#pragma unroll
        for (int bj = 0; bj < 2; ++bj)
#pragma unroll
            for (int n = 0; n < 2; ++n) bv[bj][n] = bias ? *(const f32x4*)(bias + (size_t)u.e * bias_stride + col0 + bj * HALF + 4 * n) : (f32x4){0.f, 0.f, 0.f, 0.f};
#pragma unroll
        for (int ai = 0; ai < 2; ++ai)
#pragma unroll
            for (int m = 0; m < 4; ++m) { bf16_t* rowp = O + (size_t)(row0 + ai * HALF + m * 16) * ldc + col0;
#pragma unroll
                for (int bj = 0; bj < 2; ++bj) { const f32x4 v0 = acc[ai][bj][m][0] + bv[bj][0], v1 = acc[ai][bj][m][1] + bv[bj][1];
                    u32x4 w; w.x = cvt_pk_bf16(v0[0], v0[1]); w.y = cvt_pk_bf16(v0[2], v0[3]); w.z = cvt_pk_bf16(v1[0], v1[1]); w.w = cvt_pk_bf16(v1[2], v1[3]);
                    *(u32x4*)(rowp + bj * HALF) = w; } }
    }
};
struct EpiResF32 {
    static constexpr bool PERM = false;
    float* C; const float* res; int ldc;
    __device__ __forceinline__ void operator()(const f32x4 (&acc)[2][2][4][2], const Unit& u, int wr, int wc, int fr, int fq) const {
        const int row0 = u.crow + wr * 64 + fr, col0 = u.ccol + wc * 32 + 4 * fq;
#pragma unroll
        for (int ai = 0; ai < 2; ++ai)
#pragma unroll
            for (int m = 0; m < 4; ++m) { const size_t off = (size_t)(row0 + ai * HALF + m * 16) * ldc + col0;
#pragma unroll
                for (int bj = 0; bj < 2; ++bj)
#pragma unroll
                    for (int n = 0; n < 2; ++n) { const f32x4 r = *(const f32x4*)(res + off + bj * HALF + n * 16); *(f32x4*)(C + off + bj * HALF + n * 16) = acc[ai][bj][m][n] + r; } }
    }
};
struct EpiSwiglu {
    static constexpr bool PERM = true;
    bf16_t* O; const float* bias;
    __device__ __forceinline__ float act(float g, float up) const {
        g = fminf(g, 7.0f); up = fminf(fmaxf(up, -7.0f), 7.0f);
        const float sg = 1.0f / (1.0f + __expf(-1.702f * g));
        return g * sg * (up + 1.0f);
    }
    __device__ __forceinline__ void operator()(const f32x4 (&acc)[2][2][4][2], const Unit& u, int wr, int wc, int fr, int fq) const {
        const int row0 = u.crow + wr * 64 + fr, col0 = u.ccol + wc * 32 + 8 * fq;
        f32x4 bv[2][2];
#pragma unroll
        for (int bj = 0; bj < 2; ++bj)
#pragma unroll
            for (int n = 0; n < 2; ++n) bv[bj][n] = *(const f32x4*)(bias + (size_t)u.e * (2 * D_FF) + col0 + bj * HALF + 4 * n);
#pragma unroll
        for (int ai = 0; ai < 2; ++ai)
#pragma unroll
            for (int m = 0; m < 4; ++m) { bf16_t* rowp = O + (size_t)(row0 + ai * HALF + m * 16) * D_FF + (col0 >> 1);
#pragma unroll
                for (int bj = 0; bj < 2; ++bj) { const f32x4 v0 = acc[ai][bj][m][0] + bv[bj][0], v1 = acc[ai][bj][m][1] + bv[bj][1];
                    u32x2 w; w.x = cvt_pk_bf16(act(v0[0], v0[1]), act(v0[2], v0[3])); w.y = cvt_pk_bf16(act(v1[0], v1[1]), act(v1[2], v1[3]));
                    *(u32x2*)(rowp + bj * (HALF / 2)) = w; } }
    }
};

template <class Epi, class Sched, bool GATHER>
__device__ __forceinline__ void gemm_phase(LAS unsigned char* lds, const Sched& S, const Epi& E, const int* __restrict__ lists) {
    const int tid = threadIdx.x, wid = __builtin_amdgcn_readfirstlane(tid >> 6), lane = tid & 63, wr = wid >> 2, wc = wid & 3, fr = lane & 15, fq = lane >> 4;
    constexpr int K = KDIM, nt = K / BK;
    unsigned voffA[2], voffB[2]; int gR[2], gC[2];
#pragma unroll
    for (int i = 0; i < 2; ++i) { int R, C; stage_rc(tid * 16 + i * 8192, R, C); const int Rb = Epi::PERM ? ((R & ~31) + perm32(R & 31)) : R;
        voffA[i] = (unsigned)(R * K + C) * 2u; voffB[i] = (unsigned)(Rb * K + C) * 2u; gR[i] = R; gC[i] = C; }
    constexpr size_t kstep = (size_t)(BK * 2);
    constexpr size_t hstep = (size_t)HALF * K * 2;
    const unsigned ldsw = (unsigned)wid * 1024u;
    const int aoff = lds_byte(wr * 64 + fr, fq * 8), boff = lds_byte(wc * 32 + fr, fq * 8);
#define G8_SA(b, h) (((b) * 2 + (h)) * HTB)
#define G8_SB(b, h) ((4 + (b) * 2 + (h)) * HTB)
#define G8_STAGE(bufoff, gbase, v0, v1) do { \
        __builtin_amdgcn_global_load_lds((const unsigned*)((const char*)(gbase) + (v0)), (LAS unsigned*)(lds + (bufoff) + ldsw), 16, 0, 0); \
        __builtin_amdgcn_global_load_lds((const unsigned*)((const char*)(gbase) + (v1)), (LAS unsigned*)(lds + (bufoff) + ldsw + 8192), 16, 0, 0); } while (0)
#define G8_STAGE_B(bufoff, gbase) G8_STAGE(bufoff, gbase, voffB[0], voffB[1])
#define G8_STAGE_A(bufoff, gbase, h, ga0, ga1) do { if (GATHER) G8_STAGE(bufoff, gbase, ga0, ga1); else G8_STAGE(bufoff, (gbase) + (h) * hstep, voffA[0], voffA[1]); } while (0)
#define G8_LDA(dst, b, h) do { _Pragma("unroll") for (int m = 0; m < 4; ++m) _Pragma("unroll") for (int k = 0; k < 2; ++k) dst[m][k] = *(const LAS bf16x8*)(lds + G8_SA(b, h) + aoff + m * 2048 + k * 1024); } while (0)
#define G8_LDB(dst, b, h) do { _Pragma("unroll") for (int n = 0; n < 2; ++n) _Pragma("unroll") for (int k = 0; k < 2; ++k) dst[n][k] = *(const LAS bf16x8*)(lds + G8_SB(b, h) + boff + n * 2048 + k * 1024); } while (0)
#define G8_MMA(ai, bj, At, Bt) do { __builtin_amdgcn_s_setprio(1); _Pragma("unroll") for (int m = 0; m < 4; ++m) _Pragma("unroll") for (int n = 0; n < 2; ++n) _Pragma("unroll") for (int k = 0; k < 2; ++k) \
        acc[ai][bj][m][n] = __builtin_amdgcn_mfma_f32_16x16x32_bf16(Bt[n][k], At[m][k], acc[ai][bj][m][n], 0, 0, 0); __builtin_amdgcn_s_setprio(0); } while (0)
#define G8_WAIT_V(n) asm volatile("s_waitcnt vmcnt(" #n ")" ::: "memory")
#define G8_WAIT_L(n) asm volatile("s_waitcnt lgkmcnt(" #n ")" ::: "memory")
#define G8_BAR __builtin_amdgcn_s_barrier()
#define G8_SCHED __builtin_amdgcn_sched_barrier(0)
    Unit cur, nxt; int ui = 0;
    if (!S.next(0, cur)) return;
    f32x4 acc[2][2][4][2];
#pragma unroll
    for (int a = 0; a < 2; ++a)
#pragma unroll
        for (int b = 0; b < 2; ++b)
#pragma unroll
            for (int m = 0; m < 4; ++m)
#pragma unroll
                for (int n = 0; n < 2; ++n) acc[a][b][m][n] = (f32x4){0.f, 0.f, 0.f, 0.f};
    bf16x8 At[4][2], B0[2][2], B1[2][2];
    unsigned c00 = 0, c01 = 0, c10 = 0, c11 = 0, n00 = 0, n01 = 0, n10 = 0, n11 = 0;
    if (GATHER) {
        c00 = (unsigned)(lists[cur.gi + gR[0]] * K + gC[0]) * 2u; c01 = (unsigned)(lists[cur.gi + gR[1]] * K + gC[1]) * 2u;
        c10 = (unsigned)(lists[cur.gi + HALF + gR[0]] * K + gC[0]) * 2u; c11 = (unsigned)(lists[cur.gi + HALF + gR[1]] * K + gC[1]) * 2u;
    }
    const char* cA = cur.a; const char* cB = cur.b;
    G8_STAGE_B(G8_SB(0, 0), cB); G8_STAGE_A(G8_SA(0, 0), cA, 0, c00, c01); G8_STAGE_B(G8_SB(0, 1), cB + hstep); G8_STAGE_A(G8_SA(0, 1), cA, 1, c10, c11);
    if (wr == 1) G8_BAR;
    G8_WAIT_V(4); G8_BAR;
    G8_STAGE_B(G8_SB(1, 0), cB + kstep); G8_STAGE_A(G8_SA(1, 0), cA + kstep, 0, c00, c01); G8_STAGE_B(G8_SB(1, 1), cB + hstep + kstep);
    G8_WAIT_V(6); G8_BAR;
    for (;;) {
        const bool has_next = S.next(ui + 1, nxt);
        const char* nA = has_next ? nxt.a : cA; const char* nB = has_next ? nxt.b : cB;
        for (int t = 0; t < nt; t += 2) {
            const bool last = (t == nt - 2);
            if (GATHER) {
                if (last) {
                    if (has_next) {
                        n00 = (unsigned)(lists[nxt.gi + gR[0]] * K + gC[0]) * 2u; n01 = (unsigned)(lists[nxt.gi + gR[1]] * K + gC[1]) * 2u;
                        n10 = (unsigned)(lists[nxt.gi + HALF + gR[0]] * K + gC[0]) * 2u; n11 = (unsigned)(lists[nxt.gi + HALF + gR[1]] * K + gC[1]) * 2u;
                    } else { n00 = c00; n01 = c01; n10 = c10; n11 = c11; }
                }
            }
            const char* a1 = cA + (size_t)(t + 1) * kstep;
            const char* a2 = last ? nA : cA + (size_t)(t + 2) * kstep; const char* b2 = last ? nB : cB + (size_t)(t + 2) * kstep;
            const char* a3 = a2 + kstep; const char* b3 = b2 + kstep;
            const unsigned x00 = last ? n00 : c00, x01 = last ? n01 : c01, x10 = last ? n10 : c10, x11 = last ? n11 : c11;
            G8_LDB(B0, 0, 0); G8_SCHED; G8_LDA(At, 0, 0); G8_STAGE_A(G8_SA(1, 1), a1, 1, c10, c11);
            G8_WAIT_L(8); G8_BAR; G8_WAIT_L(0); G8_MMA(0, 0, At, B0); G8_BAR; G8_SCHED;
            G8_LDB(B1, 0, 1); G8_STAGE_B(G8_SB(0, 0), b2);
            G8_BAR; G8_WAIT_L(0); G8_MMA(0, 1, At, B1); G8_BAR;
            G8_LDA(At, 0, 1); G8_STAGE_A(G8_SA(0, 0), a2, 0, x00, x01);
            G8_BAR; G8_WAIT_L(0); G8_MMA(1, 0, At, B0); G8_BAR; G8_SCHED;
            G8_STAGE_B(G8_SB(0, 1), b2 + hstep);
            G8_WAIT_V(6); G8_BAR; G8_MMA(1, 1, At, B1); G8_BAR;
            G8_LDB(B0, 1, 0); G8_SCHED; G8_LDA(At, 1, 0); G8_STAGE_A(G8_SA(0, 1), a2, 1, x10, x11);
            G8_WAIT_L(8); G8_BAR; G8_WAIT_L(0); G8_MMA(0, 0, At, B0); G8_BAR; G8_SCHED;
            G8_LDB(B1, 1, 1); G8_STAGE_B(G8_SB(1, 0), b3);
            G8_BAR; G8_WAIT_L(0); G8_MMA(0, 1, At, B1); G8_BAR;
            G8_LDA(At, 1, 1); G8_STAGE_A(G8_SA(1, 0), a3, 0, x00, x01);
            G8_BAR; G8_WAIT_L(0); G8_MMA(1, 0, At, B0); G8_BAR; G8_SCHED;
            G8_STAGE_B(G8_SB(1, 1), b3 + hstep);
            G8_WAIT_V(6); G8_BAR; G8_MMA(1, 1, At, B1); G8_BAR;
        }
        E(acc, cur, wr, wc, fr, fq);
        if (!has_next) break;
#pragma unroll
        for (int a = 0; a < 2; ++a)
#pragma unroll
            for (int b = 0; b < 2; ++b)
#pragma unroll
                for (int m = 0; m < 4; ++m)
#pragma unroll
                    for (int n = 0; n < 2; ++n) acc[a][b][m][n] = (f32x4){0.f, 0.f, 0.f, 0.f};
        cur = nxt; cA = nA; cB = nB; ++ui;
        if (GATHER) { c00 = n00; c01 = n01; c10 = n10; c11 = n11; }
    }
    G8_WAIT_V(0);
    if (wr == 0) G8_BAR;
    G8_BAR;
#undef G8_SA
#undef G8_SB
#undef G8_STAGE
#undef G8_STAGE_A
#undef G8_STAGE_B
#undef G8_LDA
#undef G8_LDB
#undef G8_MMA
#undef G8_WAIT_V
#undef G8_WAIT_L
#undef G8_BAR
#undef G8_SCHED
}
}

struct Frame {
    LAS unsigned char* lds;
    unsigned* ctl;
    int tid, lane, wave, vcu, G, gw, NGW;
};
struct Args { const float* in[21]; float* out; unsigned char* ws; int ph_lo, ph_hi; };

__device__ __forceinline__ void conv_decode(const Args& a, int it, const float*& W, int& N, bf16_t*& WT, int& kb, int& nb) {
    constexpr int I_IN = 32 * 80, I_OUT = 32 * 32, I_GU = 32 * 64, I_DN = 32 * 32;
    unsigned char* ws = a.ws;
    if (it < I_IN) { W = a.in[2]; N = IN_COLS; WT = (bf16_t*)(ws + WS_WIN); }
    else if ((it -= I_IN) < I_OUT) { W = a.in[12]; N = D_MODEL; WT = (bf16_t*)(ws + WS_WOUT); }
    else if ((it -= I_OUT) < N_EXP * I_GU) { const int e = it / I_GU; it -= e * I_GU; W = a.in[16] + (size_t)e * KDIM * 4096; N = 4096; WT = (bf16_t*)(ws + WS_WGU) + (size_t)e * 4096 * KDIM; }
    else { it -= N_EXP * I_GU; const int e = it / I_DN; it -= e * I_DN; W = a.in[18] + (size_t)e * KDIM * D_MODEL; N = D_MODEL; WT = (bf16_t*)(ws + WS_WDN) + (size_t)e * D_MODEL * KDIM; }
    const int nblk = N / 64; kb = it / nblk; nb = it % nblk;
}
constexpr int CONV_ITEMS = 32 * 80 + 32 * 32 + N_EXP * 32 * 64 + N_EXP * 32 * 32;
__device__ __forceinline__ void conv_load(f32x4 (&v)[16], const float* W, int N, int kb, int nb, int lane) {
    const float* p = W + (size_t)(kb * 64 + (lane >> 4)) * N + nb * 64 + (lane & 15) * 4;
#pragma unroll
    for (int i = 0; i < 16; ++i) v[i] = *(const f32x4*)(p + (size_t)(4 * i) * N);
}
__device__ __forceinline__ void conv_store(const f32x4 (&v)[16], bf16_t* WT, int kb, int nb, LAS float* scr, int lane) {
#pragma unroll
    for (int i = 0; i < 16; ++i) { LAS float* s = scr + (4 * i + (lane >> 4)) * 65 + (lane & 15) * 4; s[0] = v[i][0]; s[1] = v[i][1]; s[2] = v[i][2]; s[3] = v[i][3]; }
    LDS_WAIT();
    const int c = lane & 7;
#pragma unroll
    for (int j = 0; j < 8; ++j) { const int n = (lane >> 3) + 8 * j; const LAS float* s = scr + (8 * c) * 65 + n;
        u32x4 o; o.x = pk2(s[0], s[65]); o.y = pk2(s[2 * 65], s[3 * 65]); o.z = pk2(s[4 * 65], s[5 * 65]); o.w = pk2(s[6 * 65], s[7 * 65]);
        *(u32x4*)(WT + (size_t)(nb * 64 + n) * KDIM + kb * 64 + 8 * c) = o; }
    LDS_WAIT();
}
__device__ __forceinline__ void rms_row_bf16(const float* xrow, const float* g, bf16_t* orow, int lane) {
    const f32x4* xr = (const f32x4*)xrow + lane; const f32x4* gr = (const f32x4*)g + lane;
    f32x4 v[8]; float s = 0.f;
#pragma unroll
    for (int j = 0; j < 8; ++j) { v[j] = xr[64 * j]; s += (v[j][0] * v[j][0] + v[j][1] * v[j][1]) + (v[j][2] * v[j][2] + v[j][3] * v[j][3]); }
    const float rs = rsqrtf(wave_sum(s) * (1.0f / 2048.0f) + EPS);
    u32x2* o = (u32x2*)orow + lane;
#pragma unroll
    for (int j = 0; j < 8; ++j) { const f32x4 gg = gr[64 * j]; u32x2 w; w.x = pk2(v[j][0] * rs * gg[0], v[j][1] * rs * gg[1]); w.y = pk2(v[j][2] * rs * gg[2], v[j][3] * rs * gg[3]); o[64 * j] = w; }
}
__device__ __forceinline__ void p0_prologue(const Frame& F, const Args& a) {
    LAS float* scr = (LAS float*)(F.lds + F.wave * 16896);
    f32x4 va[16], vb[16];
    int it = F.gw;
    const float* W; int N, kb, nb; bf16_t* WT;
    if (it < CONV_ITEMS) { conv_decode(a, it, W, N, WT, kb, nb); conv_load(va, W, N, kb, nb, F.lane); }
    while (it < CONV_ITEMS) {
        int it2 = it + F.NGW; const float* W2 = nullptr; int N2 = 0, kb2 = 0, nb2 = 0; bf16_t* WT2 = nullptr;
        if (it2 < CONV_ITEMS) { conv_decode(a, it2, W2, N2, WT2, kb2, nb2); conv_load(vb, W2, N2, kb2, nb2, F.lane); }
        conv_store(va, WT, kb, nb, scr, F.lane);
        it = it2; if (it >= CONV_ITEMS) break;
        it2 = it + F.NGW;
        if (it2 < CONV_ITEMS) { conv_decode(a, it2, W, N, WT, kb, nb); conv_load(va, W, N, kb, nb, F.lane); }
        conv_store(vb, WT2, kb2, nb2, scr, F.lane);
        it = it2;
    }
    bf16_t* HN = (bf16_t*)(a.ws + WS_HN);
    for (int m = F.gw; m < NTOK; m += F.NGW) rms_row_bf16(a.in[0] + (size_t)m * D_MODEL, a.in[1], HN + (size_t)m * D_MODEL, F.lane);
}

__device__ __forceinline__ float gelu_tanh(float x) { return 0.5f * x * (1.0f + tanhf(0.7978845608028654f * (x + 0.044715f * x * x * x))); }
__device__ __forceinline__ float sigmoidf_(float x) { return 1.0f / (1.0f + __expf(-x)); }
__device__ __forceinline__ void lru_unit(const Frame& F, const Args& a, int unit) {
    const int lane = F.lane;
    const int b = unit >> 9, k = (unit >> 4) & 31, blk = unit & 15;
    const bf16_t* proj = (const bf16_t*)(a.ws + WS_PROJ);
    LAS float* xs = (LAS float*)(F.lds + F.wave * 16384);
    const int ch = blk * 64 + lane;
    const float cw0 = a.in[3][0 * LRU_W + ch], cw1 = a.in[3][1 * LRU_W + ch], cw2 = a.in[3][2 * LRU_W + ch], cw3 = a.in[3][3 * LRU_W + ch], cb = a.in[4][ch];
    const int t0 = k * 64; const size_t row0 = (size_t)b * SEQ + t0;
    const bf16_t* xp = proj + row0 * IN_COLS + 3 * ATTN_W + ch;
    float x0 = (t0 >= 3) ? bf2f(xp[-3 * IN_COLS]) : 0.f, x1 = (t0 >= 2) ? bf2f(xp[-2 * IN_COLS]) : 0.f, x2 = (t0 >= 1) ? bf2f(xp[-1 * IN_COLS]) : 0.f;
    for (int t = 0; t < 64; ++t) {
        const float x3 = bf2f(xp[(size_t)t * IN_COLS]);
        xs[t * 64 + lane] = cb + cw0 * x0 + cw1 * x1 + cw2 * x2 + cw3 * x3;
        x0 = x1; x1 = x2; x2 = x3;
    }
    float wa[64], wx[64];
    const float* wap = a.in[5] + (size_t)blk * 4096 + lane; const float* wxp = a.in[7] + (size_t)blk * 4096 + lane;
#pragma unroll
    for (int c = 0; c < 64; ++c) { wa[c] = wap[c * 64]; wx[c] = wxp[c * 64]; }
    const float ba = a.in[6][ch], bx = a.in[8][ch];
    const float sp = log1pf(__expf(-a.in[9][ch]));
    float* hl = (float*)(a.ws + WS_HL) + row0 * LRU_W + ch; float* pc = (float*)(a.ws + WS_PC) + row0 * LRU_W + ch;
    LDS_WAIT();
    float h = 0.f, P = 1.f;
    for (int t = 0; t < 64; ++t) {
        float r = ba, ii = bx;
        const LAS f32x4* xr = (const LAS f32x4*)(xs + t * 64);
#pragma unroll
        for (int c4 = 0; c4 < 16; ++c4) { const f32x4 xv = xr[c4];
            r = fmaf(xv[0], wa[4 * c4], r); r = fmaf(xv[1], wa[4 * c4 + 1], r); r = fmaf(xv[2], wa[4 * c4 + 2], r); r = fmaf(xv[3], wa[4 * c4 + 3], r);
            ii = fmaf(xv[0], wx[4 * c4], ii); ii = fmaf(xv[1], wx[4 * c4 + 1], ii); ii = fmaf(xv[2], wx[4 * c4 + 2], ii); ii = fmaf(xv[3], wx[4 * c4 + 3], ii); }
        r = sigmoidf_(r); ii = sigmoidf_(ii);
        const float log_a = -8.0f * r * sp;
        const float av = __expf(log_a);
        const float bv = sqrtf(-expm1f(2.0f * log_a)) * (ii * xs[t * 64 + lane]);
        h = av * h + bv; P *= av;
        hl[(size_t)t * LRU_W] = h; pc[(size_t)t * LRU_W] = P;
    }
    float* ae = (float*)(a.ws + WS_LRUE); float* he = ae + 4 * 32 * 1024;
    ae[(size_t)(b * 32 + k) * 1024 + ch] = P; he[(size_t)(b * 32 + k) * 1024 + ch] = h;
    LDS_WAIT();
}
typedef float f32x16 __attribute__((ext_vector_type(16)));
typedef short s16x4 __attribute__((ext_vector_type(4)));
typedef short v4i16_t __attribute__((ext_vector_type(4)));
__device__ __forceinline__ s16x4 vtr(const LAS unsigned char* p) { return __builtin_bit_cast(s16x4, __builtin_amdgcn_ds_read_tr16_b64_v4i16((LAS v4i16_t*)p)); }
constexpr int VP = 192;
__device__ __forceinline__ void attn_unit(const Frame& F, const Args& a, int u) {
    const int lane = F.lane, c = lane & 31, hh = lane >> 5;
    const int br = u >> 12, rem = u & 4095, bh = rem >> 6, qt = rem & 63;
    const int b = bh >> 4, h = bh & 15;
    const int dsh = br * 2, d = 1 << dsh;
    const int r = qt & (d - 1), ltile = qt >> dsh, l0 = ltile * 32;
    const bf16_t* proj = (const bf16_t*)(a.ws + WS_PROJ) + (size_t)b * SEQ * IN_COLS + h * 64;
    LAS unsigned char* vl = F.lds + F.wave * 16384;
    bf16x8 qf[4];
    { const bf16_t* qrow = proj + (size_t)((l0 + c) * d + r) * IN_COLS + 8 * hh;
#pragma unroll
      for (int s = 0; s < 4; ++s) qf[s] = *(const bf16x8*)(qrow + 16 * s); }
    constexpr float LOG2E = 1.4426950408889634f;
    const float slope2 = exp2f(-0.5f * (float)(h + 1)) * LOG2E * (float)d;
    const float sc2 = 0.125f * LOG2E;
    float m = -INFINITY, lsum = 0.f;
    f32x16 o0, o1;
#pragma unroll
    for (int i = 0; i < 16; ++i) { o0[i] = 0.f; o1[i] = 0.f; }
    const int jfirst = ltile >= 4 ? 0 : 4 - ltile;
    bf16x8 kf[4], kn[4]; u32x4 vr[4], vn[4];
    const int vrow = lane >> 3, vch = lane & 7;
    { const int lk0 = l0 - 128 + 32 * jfirst;
      const bf16_t* krow = proj + (size_t)((lk0 + c) * d + r) * IN_COLS + ATTN_W + 8 * hh;
#pragma unroll
      for (int s = 0; s < 4; ++s) kf[s] = *(const bf16x8*)(krow + 16 * s);
#pragma unroll
      for (int i = 0; i < 4; ++i) vr[i] = *(const u32x4*)(proj + (size_t)((lk0 + vrow + 8 * i) * d + r) * IN_COLS + 2 * ATTN_W + vch * 8); }
    const LAS unsigned char* vtr_base = vl + (4 * hh + ((lane & 15) >> 2)) * VP + (16 * ((lane >> 4) & 1) + 4 * (lane & 3)) * 2;
    for (int j = jfirst; j <= 4; ++j) {
        if (j < 4) { const int lk0 = l0 - 128 + 32 * (j + 1);
            const bf16_t* krow = proj + (size_t)((lk0 + c) * d + r) * IN_COLS + ATTN_W + 8 * hh;
#pragma unroll
            for (int s = 0; s < 4; ++s) kn[s] = *(const bf16x8*)(krow + 16 * s);
#pragma unroll
            for (int i = 0; i < 4; ++i) vn[i] = *(const u32x4*)(proj + (size_t)((lk0 + vrow + 8 * i) * d + r) * IN_COLS + 2 * ATTN_W + vch * 8); }
#pragma unroll
        for (int i = 0; i < 4; ++i) *(LAS u32x4*)(vl + (vrow + 8 * i) * VP + vch * 16) = vr[i];
        f32x16 sa;
#pragma unroll
        for (int i = 0; i < 16; ++i) sa[i] = 0.f;
#pragma unroll
        for (int s = 0; s < 4; ++s) sa = __builtin_amdgcn_mfma_f32_32x32x16_bf16(kf[s], qf[s], sa, 0, 0, 0);
        const float relbase = (float)(c + 128 - 32 * j);
        float mx = -INFINITY;
#pragma unroll
        for (int i = 0; i < 16; ++i) { const int ki = (i & 3) + 8 * (i >> 2) + 4 * hh;
            float v = sa[i] * sc2 - slope2 * (relbase - (float)ki);
            const bool valid = (j == 0) ? (ki >= c) : ((j == 4) ? (ki <= c) : true);
            v = valid ? v : -INFINITY; sa[i] = v; mx = fmaxf(mx, v); }
        mx = fmaxf(mx, __shfl_xor(mx, 32));
        const float mnew = fmaxf(m, mx);
        const float alpha = __builtin_amdgcn_exp2f(m - mnew);
        float ps = 0.f;
#pragma unroll
        for (int i = 0; i < 16; ++i) { const float p = __builtin_amdgcn_exp2f(sa[i] - mnew); sa[i] = p; ps += p; }
        ps += __shfl_xor(ps, 32);
        lsum = lsum * alpha + ps; m = mnew;
#pragma unroll
        for (int i = 0; i < 16; ++i) { o0[i] *= alpha; o1[i] *= alpha; }
        bf16x8 pf[2];
#pragma unroll
        for (int s = 0; s < 2; ++s) { u32x4 w; w.x = g8::cvt_pk_bf16(sa[8 * s + 0], sa[8 * s + 1]); w.y = g8::cvt_pk_bf16(sa[8 * s + 2], sa[8 * s + 3]); w.z = g8::cvt_pk_bf16(sa[8 * s + 4], sa[8 * s + 5]); w.w = g8::cvt_pk_bf16(sa[8 * s + 6], sa[8 * s + 7]);
            pf[s] = __builtin_bit_cast(bf16x8, w); }
#pragma unroll
        for (int s = 0; s < 2; ++s) {
#pragma unroll
            for (int nt = 0; nt < 2; ++nt) {
                const s16x4 lo = vtr(vtr_base + (16 * s) * VP + nt * 64), hi = vtr(vtr_base + (16 * s + 8) * VP + nt * 64);
                bf16x8 af; af[0] = lo[0]; af[1] = lo[1]; af[2] = lo[2]; af[3] = lo[3]; af[4] = hi[0]; af[5] = hi[1]; af[6] = hi[2]; af[7] = hi[3];
                if (nt == 0) o0 = __builtin_amdgcn_mfma_f32_32x32x16_bf16(af, pf[s], o0, 0, 0, 0); else o1 = __builtin_amdgcn_mfma_f32_32x32x16_bf16(af, pf[s], o1, 0, 0, 0);
            }
        }
#pragma unroll
        for (int s = 0; s < 4; ++s) { kf[s] = kn[s]; vr[s] = vn[s]; }
    }
    const float inv = 1.0f / lsum;
    const size_t tok = (size_t)b * SEQ + (size_t)((l0 + c) * d + r);
    bf16_t* orow = (bf16_t*)(a.ws + WS_ATT) + ((size_t)br * NTOK + tok) * ATTN_W + h * 64 + 4 * hh;
#pragma unroll
    for (int g = 0; g < 4; ++g) {
        u32x2 w0, w1;
        w0.x = g8::cvt_pk_bf16(o0[4 * g] * inv, o0[4 * g + 1] * inv); w0.y = g8::cvt_pk_bf16(o0[4 * g + 2] * inv, o0[4 * g + 3] * inv);
        w1.x = g8::cvt_pk_bf16(o1[4 * g] * inv, o1[4 * g + 1] * inv); w1.y = g8::cvt_pk_bf16(o1[4 * g + 2] * inv, o1[4 * g + 3] * inv);
        *(u32x2*)(orow + 8 * g) = w0; *(u32x2*)(orow + 32 + 8 * g) = w1;
    }
    if (hh == 0) ((float*)(a.ws + WS_LSE))[((size_t)br * NTOK + tok) * 16 + h] = 0.6931471805599453f * (m + __builtin_amdgcn_logf(lsum));
}
__device__ __forceinline__ void p2_mixers(const Frame& F, const Args& a) {
    for (int u = F.gw; u < 2048; u += F.NGW) lru_unit(F, a, u);
    for (int u = F.gw; u < 3 * 4096; u += F.NGW) attn_unit(F, a, u);
}

__device__ __forceinline__ void p3_mix(const Frame& F, const Args& a) {
    LAS float* Hin = (LAS float*)F.lds;
    const float* ae = (const float*)(a.ws + WS_LRUE); const float* he = ae + 4 * 32 * 1024;
    const bf16_t* proj = (const bf16_t*)(a.ws + WS_PROJ);
    bf16_t* mixed = (bf16_t*)(a.ws + WS_MIXED);
    for (int grp = F.vcu; grp < NTOK / 32; grp += F.G) {
        const int tok0 = grp * 32, b = tok0 / SEQ, k = (tok0 % SEQ) / 64;
        __syncthreads();
        for (int d = F.tid; d < LRU_W; d += NTHR) { float H = 0.f; for (int j = 0; j < k; ++j) H = ae[(size_t)(b * 32 + j) * 1024 + d] * H + he[(size_t)(b * 32 + j) * 1024 + d]; Hin[d] = H; }
        __syncthreads();
        for (int tt = F.wave; tt < 32; tt += NWAVES) {
            const size_t tok = (size_t)tok0 + tt;
            { const bf16_t* ao = (const bf16_t*)(a.ws + WS_ATT); const float* lse = (const float*)(a.ws + WS_LSE); const f32x4* gr = (const f32x4*)a.in[10] + F.lane;
              f32x4 v[4]; float s = 0.f;
#pragma unroll
              for (int j = 0; j < 4; ++j) { const int hd = (F.lane >> 4) + 4 * j;
                  const float l0 = lse[(0 * (size_t)NTOK + tok) * 16 + hd], l1 = lse[(1 * (size_t)NTOK + tok) * 16 + hd], l2 = lse[(2 * (size_t)NTOK + tok) * 16 + hd];
                  const float M = fmaxf(l0, fmaxf(l1, l2)); float w0 = __expf(l0 - M), w1 = __expf(l1 - M), w2 = __expf(l2 - M); const float iw = 1.0f / (w0 + w1 + w2); w0 *= iw; w1 *= iw; w2 *= iw;
                  const u32x2 a0 = *((const u32x2*)(ao + (0 * (size_t)NTOK + tok) * ATTN_W) + F.lane + 64 * j), a1 = *((const u32x2*)(ao + (1 * (size_t)NTOK + tok) * ATTN_W) + F.lane + 64 * j), a2 = *((const u32x2*)(ao + (2 * (size_t)NTOK + tok) * ATTN_W) + F.lane + 64 * j);
                  v[j][0] = w0 * bflo(a0.x) + w1 * bflo(a1.x) + w2 * bflo(a2.x); v[j][1] = w0 * bfhi(a0.x) + w1 * bfhi(a1.x) + w2 * bfhi(a2.x);
                  v[j][2] = w0 * bflo(a0.y) + w1 * bflo(a1.y) + w2 * bflo(a2.y); v[j][3] = w0 * bfhi(a0.y) + w1 * bfhi(a1.y) + w2 * bfhi(a2.y);
                  s += (v[j][0] * v[j][0] + v[j][1] * v[j][1]) + (v[j][2] * v[j][2] + v[j][3] * v[j][3]); }
              const float rs = rsqrtf(wave_sum(s) * (1.0f / 1024.0f) + EPS);
              u32x2* o = (u32x2*)(mixed + tok * D_MODEL) + F.lane;
#pragma unroll
              for (int j = 0; j < 4; ++j) { const f32x4 g = gr[64 * j]; u32x2 w; w.x = pk2(v[j][0] * rs * g[0], v[j][1] * rs * g[1]); w.y = pk2(v[j][2] * rs * g[2], v[j][3] * rs * g[3]); o[64 * j] = w; } }
            { const f32x4* hr = (const f32x4*)((const float*)(a.ws + WS_HL) + tok * LRU_W) + F.lane; const f32x4* pr = (const f32x4*)((const float*)(a.ws + WS_PC) + tok * LRU_W) + F.lane;
              const u32x2* gp = (const u32x2*)(proj + tok * IN_COLS + 3 * ATTN_W + LRU_W) + F.lane; const f32x4* gr = (const f32x4*)a.in[11] + F.lane;
              f32x4 v[4]; float s = 0.f;
#pragma unroll
              for (int j = 0; j < 4; ++j) { const f32x4 hv = hr[64 * j], pv = pr[64 * j]; const u32x2 gw = gp[64 * j]; const f32x4 hi = *(const LAS f32x4*)(Hin + (F.lane + 64 * j) * 4);
                  v[j][0] = (hv[0] + pv[0] * hi[0]) * gelu_tanh(bflo(gw.x)); v[j][1] = (hv[1] + pv[1] * hi[1]) * gelu_tanh(bfhi(gw.x));
                  v[j][2] = (hv[2] + pv[2] * hi[2]) * gelu_tanh(bflo(gw.y)); v[j][3] = (hv[3] + pv[3] * hi[3]) * gelu_tanh(bfhi(gw.y));
                  s += (v[j][0] * v[j][0] + v[j][1] * v[j][1]) + (v[j][2] * v[j][2] + v[j][3] * v[j][3]); }
              const float rs = rsqrtf(wave_sum(s) * (1.0f / 1024.0f) + EPS);
              u32x2* o = (u32x2*)(mixed + tok * D_MODEL + ATTN_W) + F.lane;
#pragma unroll
              for (int j = 0; j < 4; ++j) { const f32x4 g = gr[64 * j]; u32x2 w; w.x = pk2(v[j][0] * rs * g[0], v[j][1] * rs * g[1]); w.y = pk2(v[j][2] * rs * g[2], v[j][3] * rs * g[3]); o[64 * j] = w; } }
        }
    }
    __syncthreads();
}

__device__ __forceinline__ void p5_router(const Frame& F, const Args& a) {
    const float* x1 = (const float*)(a.ws + WS_X1); bf16_t* hn2 = (bf16_t*)(a.ws + WS_HN);
    const float* g = a.in[13]; const float* wr = a.in[14]; const float* br = a.in[15];
    int* cnt = (int*)(F.ctl + CW_CNT); int* lists = (int*)(a.ws + WS_LISTS);
    int* sel_e = (int*)(a.ws + WS_SEL); int* sel_pos = sel_e + NSLOT; float* sel_g = (float*)(sel_pos + NSLOT);
    LAS float* HS = (LAS float*)F.lds;
    LAS float* WSm = HS + 32 * 257;
    LAS float* RS = WSm + 256 * 32;
    LAS float* LG = RS + 32;
    LAS int* lcnt = (LAS int*)(LG + 1024);
    LAS int* gbase = lcnt + 32;
    LAS int* ent_e = gbase + 32;
    LAS int* ent_r = ent_e + 128;
    LAS float* ent_g = (LAS float*)(ent_r + 128);
    for (int grp = F.vcu; grp < NTOK / 32; grp += F.G) {
        const int tok0 = grp * 32;
        __syncthreads();
        if (F.tid < 32) lcnt[F.tid] = 0;
        for (int tt = F.wave; tt < 32; tt += NWAVES) {
            const f32x4* xr = (const f32x4*)(x1 + (size_t)(tok0 + tt) * D_MODEL) + F.lane; float s = 0.f;
#pragma unroll
            for (int j = 0; j < 8; ++j) { const f32x4 v = xr[64 * j]; s += (v[0] * v[0] + v[1] * v[1]) + (v[2] * v[2] + v[3] * v[3]); }
            const float rs = rsqrtf(wave_sum(s) * (1.0f / 2048.0f) + EPS);
            if (F.lane == 0) RS[tt] = rs;
        }
        __syncthreads();
        const int tt = F.tid >> 4, eg = F.tid & 15;
        float acc0 = 0.f, acc1 = 0.f;
        for (int kc = 0; kc < 8; ++kc) {
#pragma unroll
            for (int i = 0; i < 4; ++i) { const int idx = F.tid + i * NTHR; const int r = idx >> 6, c4 = (idx & 63) * 4;
                const f32x4 v = *(const f32x4*)(x1 + (size_t)(tok0 + r) * D_MODEL + kc * 256 + c4); const f32x4 gg = *(const f32x4*)(g + kc * 256 + c4); const float rs = RS[r];
                const float h0 = v[0] * rs * gg[0], h1 = v[1] * rs * gg[1], h2 = v[2] * rs * gg[2], h3 = v[3] * rs * gg[3];
                LAS float* hp = HS + r * 257 + c4; hp[0] = h0; hp[1] = h1; hp[2] = h2; hp[3] = h3;
                u32x2 w; w.x = pk2(h0, h1); w.y = pk2(h2, h3); *(u32x2*)(hn2 + (size_t)(tok0 + r) * D_MODEL + kc * 256 + c4) = w; }
#pragma unroll
            for (int i = 0; i < 4; ++i) { const int idx = F.tid + i * NTHR; *(LAS f32x4*)(WSm + idx * 4) = *(const f32x4*)(wr + (size_t)kc * 256 * 32 + idx * 4); }
            __syncthreads();
            const LAS float* hp = HS + tt * 257; const LAS float* wp = WSm + 2 * eg;
#pragma unroll 8
            for (int c = 0; c < 256; ++c) { const float hv = hp[c]; const f32x2 w2 = *(const LAS f32x2*)(wp + c * 32); acc0 = fmaf(hv, w2[0], acc0); acc1 = fmaf(hv, w2[1], acc1); }
            __syncthreads();
        }
        LG[tt * 32 + 2 * eg] = acc0 + br[2 * eg]; LG[tt * 32 + 2 * eg + 1] = acc1 + br[2 * eg + 1];
        __syncthreads();
        for (int t4 = 0; t4 < 4; ++t4) {
            const int tk = F.wave * 4 + t4;
            float cur = (F.lane < 32) ? LG[tk * 32 + F.lane] : -INFINITY;
            int i0 = 0, i1 = 0, i2 = 0, i3 = 0; float v0 = 0.f, v1 = 0.f, v2 = 0.f, v3 = 0.f;
#pragma unroll
            for (int k = 0; k < 4; ++k) {
                const float mx = wave_max(cur);
                const unsigned long long bal = __ballot(cur == mx);
                const int bi = __ffsll((long long)bal) - 1;
                if (k == 0) { i0 = bi; v0 = mx; } else if (k == 1) { i1 = bi; v1 = mx; } else if (k == 2) { i2 = bi; v2 = mx; } else { i3 = bi; v3 = mx; }
                if (F.lane == bi) cur = -INFINITY;
            }
            if (F.lane == 0) {
                const float e1 = __expf(v1 - v0), e2 = __expf(v2 - v0), e3 = __expf(v3 - v0); const float inv = 1.0f / (1.0f + e1 + e2 + e3);
                const int base = tk * 4;
                ent_e[base + 0] = i0; ent_r[base + 0] = __hip_atomic_fetch_add(&lcnt[i0], 1, __ATOMIC_RELAXED, __HIP_MEMORY_SCOPE_WORKGROUP); ent_g[base + 0] = inv;
                ent_e[base + 1] = i1; ent_r[base + 1] = __hip_atomic_fetch_add(&lcnt[i1], 1, __ATOMIC_RELAXED, __HIP_MEMORY_SCOPE_WORKGROUP); ent_g[base + 1] = e1 * inv;
                ent_e[base + 2] = i2; ent_r[base + 2] = __hip_atomic_fetch_add(&lcnt[i2], 1, __ATOMIC_RELAXED, __HIP_MEMORY_SCOPE_WORKGROUP); ent_g[base + 2] = e2 * inv;
                ent_e[base + 3] = i3; ent_r[base + 3] = __hip_atomic_fetch_add(&lcnt[i3], 1, __ATOMIC_RELAXED, __HIP_MEMORY_SCOPE_WORKGROUP); ent_g[base + 3] = e3 * inv;
            }
        }
        __syncthreads();
        if (F.tid < 32) { const int n = lcnt[F.tid]; gbase[F.tid] = n > 0 ? atomicAdd(&cnt[F.tid], n) : 0; }
        __syncthreads();
        if (F.tid < 128) { const int e = ent_e[F.tid], pos = gbase[e] + ent_r[F.tid], tok = tok0 + (F.tid >> 2);
            lists[e * NTOK + pos] = tok; sel_e[tok * 4 + (F.tid & 3)] = e; sel_pos[tok * 4 + (F.tid & 3)] = pos; sel_g[tok * 4 + (F.tid & 3)] = ent_g[F.tid]; }
    }
    __syncthreads();
}

__device__ __forceinline__ void build_tpre(const Frame& F) {
    LAS int* tpre = (LAS int*)(F.lds + L_TPRE);
    __syncthreads();
    if (F.tid == 0) { const int* cnt = (const int*)(F.ctl + CW_CNT); int acc = 0; for (int e = 0; e < N_EXP; ++e) { tpre[e] = acc; acc += (cnt[e] + 255) >> 8; } tpre[N_EXP] = acc; }
    __syncthreads();
}

__device__ __forceinline__ void p8_final(const Frame& F, const Args& a) {
    const LAS int* tpre = (const LAS int*)(F.lds + L_TPRE);
    const float* x1 = (const float*)(a.ws + WS_X1); const bf16_t* Y = (const bf16_t*)(a.ws + WS_Y);
    const int* sel_e = (const int*)(a.ws + WS_SEL); const int* sel_pos = sel_e + NSLOT; const float* sel_g = (const float*)(sel_pos + NSLOT);
    const f32x4* gr = (const f32x4*)a.in[20] + F.lane;
    for (int tok = F.gw; tok < NTOK; tok += F.NGW) {
        const f32x4* xr = (const f32x4*)(x1 + (size_t)tok * D_MODEL) + F.lane;
        f32x4 v[8];
#pragma unroll
        for (int j = 0; j < 8; ++j) v[j] = xr[64 * j];
#pragma unroll
        for (int k = 0; k < 4; ++k) {
            const int e = sel_e[tok * 4 + k]; const size_t row = (size_t)tpre[e] * 256 + sel_pos[tok * 4 + k]; const float gk = sel_g[tok * 4 + k];
            const u32x2* yp = (const u32x2*)(Y + row * D_MODEL) + F.lane;
#pragma unroll
            for (int j = 0; j < 8; ++j) { const u32x2 w = yp[64 * j]; v[j][0] += gk * bflo(w.x); v[j][1] += gk * bfhi(w.x); v[j][2] += gk * bflo(w.y); v[j][3] += gk * bfhi(w.y); }
        }
        float s = 0.f;
#pragma unroll
        for (int j = 0; j < 8; ++j) s += (v[j][0] * v[j][0] + v[j][1] * v[j][1]) + (v[j][2] * v[j][2] + v[j][3] * v[j][3]);
        const float rs = rsqrtf(wave_sum(s) * (1.0f / 2048.0f) + EPS);
        f32x4* o = (f32x4*)(a.out + (size_t)tok * D_MODEL) + F.lane;
#pragma unroll
        for (int j = 0; j < 8; ++j) { const f32x4 g = gr[64 * j]; o[64 * j] = (f32x4){v[j][0] * rs * g[0], v[j][1] * rs * g[1], v[j][2] * rs * g[2], v[j][3] * rs * g[3]}; }
    }
}

constexpr int N_PHASES = 9;
__global__ void __launch_bounds__(NTHR, 2) mk_fwd(Args args) {
    extern __shared__ __attribute__((aligned(16))) unsigned char lds_raw[];
    Frame F;
    F.lds = (LAS unsigned char*)lds_raw;
    F.tid = threadIdx.x; F.lane = F.tid & 63; F.wave = __builtin_amdgcn_readfirstlane(F.tid >> 6);
    F.G = gridDim.x; { const int bx = blockIdx.x; F.vcu = (F.G % 8 == 0) ? (bx % 8) * (F.G / 8) + bx / 8 : bx; }
    F.gw = F.vcu * NWAVES + F.wave; F.NGW = F.G * NWAVES;
    F.ctl = (unsigned*)(args.ws + WS_CTL);
    for (int u = F.tid; u < (LDS_BYTES - LDSCTL_OFF) / 4; u += NTHR) ((LAS unsigned*)(F.lds + LDSCTL_OFF))[u] = 0u;
    __syncthreads();
    const int lo = args.ph_lo, hi = args.ph_hi;
    XcdBarrier bar; bar.bar = F.ctl + CW_BAR; bar.x = 0; bar.st = nullptr;
    if (hi - lo > 1) bar = xcd_barrier_post(F.ctl + CW_BAR, (volatile LAS unsigned*)(F.lds + L_MISC) + 8);
#define IN(k) (lo <= (k) && (k) < hi)
#define SEAM(k) do { if (IN(k) && IN((k) + 1)) xcd_barrier(bar); } while (0)
    unsigned char* ws = args.ws;

    if (IN(0)) { p0_prologue(F, args); } SEAM(0);

    if (IN(1)) {
        g8::DenseOrder S{(const char*)(ws + WS_HN), (const char*)(ws + WS_WIN), NTOK / 256, IN_COLS / 256, (NTOK / 256) * (IN_COLS / 256), F.G, (int)blockIdx.x};
        g8::EpiBf16 E{(bf16_t*)(ws + WS_PROJ), IN_COLS, nullptr, 0};
        g8::gemm_phase<g8::EpiBf16, g8::DenseOrder, false>(F.lds, S, E, nullptr);
    } SEAM(1);

    if (IN(2)) { p2_mixers(F, args); } SEAM(2);
    if (IN(3)) { p3_mix(F, args); } SEAM(3);

    if (IN(4)) {
        g8::DenseOrder S{(const char*)(ws + WS_MIXED), (const char*)(ws + WS_WOUT), NTOK / 256, D_MODEL / 256, (NTOK / 256) * (D_MODEL / 256), F.G, (int)blockIdx.x};
        g8::EpiResF32 E{(float*)(ws + WS_X1), args.in[0], D_MODEL};
        g8::gemm_phase<g8::EpiResF32, g8::DenseOrder, false>(F.lds, S, E, nullptr);
    } SEAM(4);

    if (IN(5)) { p5_router(F, args); } SEAM(5);

    if (IN(6)) {
        build_tpre(F);
        g8::GroupedOrder S{nullptr, (const char*)(ws + WS_WGU), (const LAS int*)(F.lds + L_TPRE), 4096 / 256, F.G, (int)blockIdx.x, (size_t)4096 * KDIM * 2, true, (const char*)(ws + WS_HN)};
        g8::EpiSwiglu E{(bf16_t*)(ws + WS_ACT), args.in[17]};
        g8::gemm_phase<g8::EpiSwiglu, g8::GroupedOrder, true>(F.lds, S, E, (const int*)(ws + WS_LISTS));
    } SEAM(6);

    if (IN(7)) {
        build_tpre(F);
        g8::GroupedOrder S{(const char*)(ws + WS_ACT), (const char*)(ws + WS_WDN), (const LAS int*)(F.lds + L_TPRE), D_MODEL / 256, F.G, (int)blockIdx.x, (size_t)D_MODEL * KDIM * 2, false, nullptr};
        g8::EpiBf16 E{(bf16_t*)(ws + WS_Y), D_MODEL, args.in[19], D_MODEL};
        g8::gemm_phase<g8::EpiBf16, g8::GroupedOrder, false>(F.lds, S, E, nullptr);
    } SEAM(7);

    if (IN(8)) { build_tpre(F); p8_final(F, args); }
#undef IN
#undef SEAM
}

extern "C" void kernel_launch(void* const* d_in, const int* in_sizes, int n_in, void* d_out, int out_size, void* d_ws, size_t ws_size, hipStream_t stream) {
    static int grid = 0;
    if (grid == 0) {
        if (n_in != 21 || out_size != NTOK * D_MODEL || ws_size < WS_END) { fprintf(stderr, "kernel_launch: unexpected problem (n_in %d out %d ws %zu)\n", n_in, out_size, ws_size); grid = -1; return; }
        int dev = 0, cus = 0, per_cu = 0;
        if (hipGetDevice(&dev) != hipSuccess || hipDeviceGetAttribute(&cus, hipDeviceAttributeMultiprocessorCount, dev) != hipSuccess) { grid = -1; return; }
        if (hipFuncSetAttribute((const void*)mk_fwd, hipFuncAttributeMaxDynamicSharedMemorySize, LDS_BYTES) != hipSuccess) { fprintf(stderr, "kernel_launch: hipFuncSetAttribute failed\n"); grid = -1; return; }
        if (hipOccupancyMaxActiveBlocksPerMultiprocessor(&per_cu, (const void*)mk_fwd, NTHR, LDS_BYTES) != hipSuccess || per_cu < 1) { fprintf(stderr, "kernel_launch: occupancy query says %d\n", per_cu); }
        (void)hipGetLastError();
        grid = cus;
    }
    if (grid < 0) return;
    if (hipMemsetAsync((char*)d_ws + WS_CTL, 0, CTL_ZERO_BYTES, stream) != hipSuccess) return;
    Args a{};
    for (int i = 0; i < 21; ++i) a.in[i] = (const float*)d_in[i];
    a.out = (float*)d_out; a.ws = (unsigned char*)d_ws;
#if MK_N_LAUNCHES == 1
    a.ph_lo = 0; a.ph_hi = N_PHASES;
    hipLaunchKernelGGL(mk_fwd, dim3(grid), dim3(NTHR), LDS_BYTES, stream, a);
#else
    for (int p = 0; p < N_PHASES; ++p) { a.ph_lo = p; a.ph_hi = p + 1; hipLaunchKernelGGL(mk_fwd, dim3(grid), dim3(NTHR), LDS_BYTES, stream, a); }
#endif
}
```

```cpp
#include <hip/hip_runtime.h>
#include <stdint.h>
#include <stdio.h>

#ifndef MK_N_LAUNCHES
#define MK_N_LAUNCHES 1
#endif

#ifndef PROBE_MASK
#define PROBE_MASK 0
#endif
#define LAS __attribute__((address_space(3)))
#define GAS __attribute__((address_space(1)))
typedef unsigned short bf16_t;
typedef short bf16x8 __attribute__((ext_vector_type(8)));
typedef float f32x4 __attribute__((ext_vector_type(4)));
typedef float f32x2 __attribute__((ext_vector_type(2)));
typedef unsigned u32x4 __attribute__((ext_vector_type(4)));
typedef unsigned u32x2 __attribute__((ext_vector_type(2)));

constexpr int D_MODEL = 2048, BATCH = 4, SEQ = 2048, NTOK = BATCH * SEQ;
constexpr int N_HEADS = 16, ATTN_W = 1024, LRU_W = 1024;
constexpr int IN_COLS = 5120;
constexpr int N_EXP = 32, D_FF = 2048, NSLOT = NTOK * 4;
constexpr int KDIM = 2048;
constexpr float EPS = 1e-6f;
constexpr int NWAVES = 8, NTHR = 512;
constexpr int PADROWS = NSLOT + N_EXP * 256;

constexpr size_t MiB = 1u << 20;
constexpr size_t WS_CTL = 0, WS_LISTS = 1 * MiB, CTL_ZERO_BYTES = 2 * MiB;
constexpr size_t WS_SEL = 2 * MiB;
constexpr size_t WS_LRUE = 3 * MiB;
constexpr size_t WS_WIN = 4 * MiB, WS_WOUT = 24 * MiB, WS_HN = 32 * MiB, WS_PROJ = 64 * MiB, WS_ATT = 144 * MiB  , WS_HL = 192 * MiB, WS_PC = 224 * MiB;
constexpr size_t WS_MIXED = 256 * MiB, WS_X1 = 288 * MiB, WS_ACT = 352 * MiB, WS_Y = 512 * MiB, WS_WGU = 672 * MiB, WS_WDN = 1184 * MiB, WS_LSE = 1440 * MiB  , WS_END = 1442 * MiB;
static_assert((size_t)PADROWS * 2048 * 2 <= 160 * MiB, "ACT/Y size");
constexpr int CW_BAR = 4096, CW_CNT = 8192;

constexpr int RING_BYTES = 131072;
constexpr int LDSCTL_OFF = 139264;
constexpr int LDS_BYTES = 147456;
constexpr int L_MISC = LDSCTL_OFF;
constexpr int L_TPRE = LDSCTL_OFF + 256;
constexpr int L_CNT = LDSCTL_OFF + 512;

__device__ __forceinline__ unsigned f2bf(float f) { unsigned u = __builtin_bit_cast(unsigned, f); return (u + 0x7fffu + ((u >> 16) & 1u)) >> 16; }
__device__ __forceinline__ unsigned pk2(float lo, float hi) { return f2bf(lo) | (f2bf(hi) << 16); }
__device__ __forceinline__ float bf2f(unsigned short b) { return __builtin_bit_cast(float, (unsigned)b << 16); }
__device__ __forceinline__ float bflo(unsigned w) { return __builtin_bit_cast(float, w << 16); }
__device__ __forceinline__ float bfhi(unsigned w) { return __builtin_bit_cast(float, w & 0xffff0000u); }
__device__ __forceinline__ float wave_sum(float v) {
#pragma unroll
    for (int o = 1; o < 64; o <<= 1) v += __shfl_xor(v, o);
    return v;
}
__device__ __forceinline__ float wave_max(float v) {
#pragma unroll
    for (int o = 1; o < 64; o <<= 1) v = fmaxf(v, __shfl_xor(v, o));
    return v;
}
#define LDS_WAIT() asm volatile("s_waitcnt lgkmcnt(0)" ::: "memory")
#define VM_WAIT() asm volatile("s_waitcnt vmcnt(0)" ::: "memory")

#define XB_TMO      128
#define XB_XCNT(j)  (256  + 64 * (j))
#define XB_XSUB(j)  (1280 + 64 * (j))
#define XB_XGEN(j)  (2304 + 64 * (j))
#define XB_TOP      3328
#define XB_TOPGEN   3392
#define XCD_BAR_WORDS 3456
#define XB_SPIN_CAP (1u << 20)
__device__ __forceinline__ unsigned xb_ld(unsigned* p)              { return __hip_atomic_load(p, __ATOMIC_RELAXED, __HIP_MEMORY_SCOPE_AGENT); }
__device__ __forceinline__ unsigned xb_add(unsigned* p, unsigned v) { return __hip_atomic_fetch_add(p, v, __ATOMIC_RELAXED, __HIP_MEMORY_SCOPE_AGENT); }
__device__ __forceinline__ unsigned xb_xcc_id() { return (unsigned)__builtin_amdgcn_s_getreg((3 << 11) | 20) & 0xFu; }
#define XB_SPIN(cond, bar) do { unsigned _sp = 0; while (cond) { __builtin_amdgcn_s_sleep(1); \
    if ((++_sp & 255u) == 0u) { if (xb_ld(&(bar)[XB_TMO])) break; if (_sp > XB_SPIN_CAP) { atomicAdd(&(bar)[XB_TMO], 1u); break; } } } } while (0)
struct XcdBarrier { unsigned* bar; unsigned x; volatile LAS unsigned* st; };
__device__ __forceinline__ XcdBarrier xcd_barrier_post(unsigned* bar, volatile LAS unsigned* st) {
    XcdBarrier b; b.bar = bar; b.x = xb_xcc_id(); b.st = st;
    if (threadIdx.x == 0) (void)xb_add(&bar[XB_XCNT(b.x)], 1u);
    return b;
}
__device__ __forceinline__ void xcd_barrier_complete(unsigned* bar, unsigned x, unsigned& nloc, unsigned& nx) {
    const unsigned G = gridDim.x * gridDim.y * gridDim.z;
    unsigned sum, cnt, mine, sp = 0u;
    for (;;) {
        sum = 0u; cnt = 0u; mine = 0u;
#pragma unroll
        for (unsigned j = 0; j < 16; ++j) { const unsigned c = xb_ld(&bar[XB_XCNT(j)]); sum += c; cnt += (c > 0u) ? 1u : 0u; mine = (j == x) ? c : mine; }
        if (sum == G) break;
        __builtin_amdgcn_s_sleep(1);
        if ((++sp & 255u) == 0u) { if (xb_ld(&bar[XB_TMO])) break; if (sp > XB_SPIN_CAP) { atomicAdd(&bar[XB_TMO], 1u); break; } }
    }
    nloc = mine > 0u ? mine : 1u; nx = cnt > 0u ? cnt : 1u;
}
__device__ __forceinline__ void xcd_barrier(const XcdBarrier& b) {
    asm volatile("s_waitcnt vmcnt(0)" ::: "memory");
    __syncthreads();
    if (threadIdx.x == 0) {
        unsigned* bar = b.bar;
        __builtin_amdgcn_s_waitcnt(0);
        unsigned nloc = b.st[0], nx = b.st[1];
        if (nloc == 0u) { xcd_barrier_complete(bar, b.x, nloc, nx); b.st[0] = nloc; b.st[1] = nx; }
        const unsigned old = xb_add(&bar[XB_XSUB(b.x)], 1u);
        const unsigned gen = old / nloc;
        if (old + 1u == (gen + 1u) * nloc) {
            __builtin_amdgcn_fence(__ATOMIC_RELEASE, "agent");
            asm volatile("s_waitcnt vmcnt(0)" ::: "memory");
            const unsigned og = xb_add(&bar[XB_TOP], 1u);
            const unsigned tg = og / nx;
            if (og + 1u == (tg + 1u) * nx) xb_add(&bar[XB_TOPGEN], 1u);
            else XB_SPIN(xb_ld(&bar[XB_TOPGEN]) == tg, bar);
            __builtin_amdgcn_fence(__ATOMIC_ACQUIRE, "agent");
            xb_add(&bar[XB_XGEN(b.x)], 1u);
            asm volatile("s_waitcnt vmcnt(0)" ::: "memory");
        } else {
            XB_SPIN(xb_ld(&bar[XB_XGEN(b.x)]) == gen, bar);
            __builtin_amdgcn_fence(__ATOMIC_ACQUIRE, "agent");
            asm volatile("s_waitcnt vmcnt(0)" ::: "memory");
        }
    }
    __syncthreads();
}

typedef float f32x16 __attribute__((ext_vector_type(16)));
typedef short s16x4 __attribute__((ext_vector_type(4)));
typedef short v4i16_t __attribute__((ext_vector_type(4)));
__device__ __forceinline__ s16x4 vtr(const LAS unsigned char* p) { return __builtin_bit_cast(s16x4, __builtin_amdgcn_ds_read_tr16_b64_v4i16((LAS v4i16_t*)p)); }

namespace g8 {
constexpr int BM = 256, BK = 64, HALF = 128, HTB = HALF * BK * 2, STAGE_BYTES = 8 * HTB, NXCD = 8, WGM = 8;
__host__ __device__ __forceinline__ int lds_byte(int r, int c) { const int st = (r >> 4) * 2 + (c >> 5), rr = r & 15, cc = c & 31, ob = rr * 64 + cc * 2; return st * 1024 + (ob ^ (((ob >> 9) & 1) << 5)); }
__host__ __device__ __forceinline__ void stage_rc(int b, int& R, int& C) { const int st = b / 1024, sb = b % 1024, swz = sb ^ (((sb >> 9) & 1) << 5); R = (st >> 1) * 16 + swz / 64; C = (st & 1) * 32 + (swz % 64) / 2; }
__host__ __device__ __forceinline__ int perm32(int rho) { const int n = rho >> 4, i = rho & 15; return 8 * (i >> 2) + 4 * n + (i & 3); }

struct Unit { const char* a; const char* b; int crow, ccol, e, gi; };

struct DenseOrder {
    const char* A; const char* Bt; int nM, nN, nwg, G, c; int ldb;
    __device__ __forceinline__ bool next(int i, Unit& u) const {
        const long L = (long)i * G + c; if (L >= nwg) return false;
        int wgid = (int)L; { const int q = nwg / NXCD, r = nwg % NXCD, xcd = wgid % NXCD, off = wgid / NXCD; wgid = (xcd < r ? xcd * (q + 1) : r * (q + 1) + (xcd - r) * q) + off; }
        const int nig = WGM * nN, gid = wgid / nig, fm = gid * WGM, gsz = (nM - fm) < WGM ? (nM - fm) : WGM;
        const int pm = fm + ((wgid % nig) % gsz), pn = (wgid % nig) / gsz;
        u.a = A + (size_t)pm * BM * KDIM * 2; u.b = Bt + (size_t)pn * BM * 2; u.crow = pm * BM; u.ccol = pn * BM; u.e = 0; u.gi = 0; return true;
    }
};
struct GroupedOrder {
    const char* A; const char* Bt; const LAS int* tpre; int nN, G, c; size_t bstride;
    bool gather; const char* Asrc; int ldb;
    __device__ __forceinline__ bool next(int i, Unit& u) const {
        const int total = tpre[N_EXP] * nN; const long L = (long)i * G + c; if (L >= total) return false;
        const int mtile = (int)L / nN, nt = (int)L % nN;
        int e = 0; while (mtile >= tpre[e + 1]) ++e;
        const int mt = mtile - tpre[e];
        u.a = gather ? Asrc : A + (size_t)mtile * BM * KDIM * 2;
        u.b = Bt + (size_t)e * bstride + (size_t)nt * BM * 2; u.crow = mtile * BM; u.ccol = nt * BM; u.e = e; u.gi = e * NTOK + mt * BM; return true;
    }
};

__device__ __forceinline__ unsigned cvt_pk_bf16(float lo, float hi) { unsigned r; asm volatile("v_cvt_pk_bf16_f32 %0, %1, %2" : "=v"(r) : "v"(lo), "v"(hi)); return r; }

struct EpiBf16 {
    bf16_t* O; int ldc; const float* bias; int bias_stride;
    __device__ __forceinline__ void operator()(const f32x4 (&acc)[2][2][4][2], const Unit& u, int wr, int wc, int fr, int fq) const {
        const int row0 = u.crow + wr * 64 + fr, col0 = u.ccol + wc * 32 + 4 * fq;
        f32x4 bv[2][2];
#pragma unroll
        for (int bj = 0; bj < 2; ++bj)
#pragma unroll
            for (int n = 0; n < 2; ++n) bv[bj][n] = bias ? *(const f32x4*)(bias + (size_t)u.e * bias_stride + col0 + bj * HALF + 16 * n) : (f32x4){0.f, 0.f, 0.f, 0.f};
#pragma unroll
        for (int ai = 0; ai < 2; ++ai)
#pragma unroll
            for (int m = 0; m < 4; ++m) { bf16_t* rowp = O + (size_t)(row0 + ai * HALF + m * 16) * ldc + col0;
#pragma unroll
                for (int bj = 0; bj < 2; ++bj)
#pragma unroll
                    for (int n = 0; n < 2; ++n) { const f32x4 v = acc[ai][bj][m][n] + bv[bj][n];
                        u32x2 w; w.x = cvt_pk_bf16(v[0], v[1]); w.y = cvt_pk_bf16(v[2], v[3]);
                        *(u32x2*)(rowp + bj * HALF + 16 * n) = w; } }
    }
};
struct EpiResF32 {
    float* C; const float* res; int ldc;
    __device__ __forceinline__ void operator()(const f32x4 (&acc)[2][2][4][2], const Unit& u, int wr, int wc, int fr, int fq) const {
        const int row0 = u.crow + wr * 64 + fr, col0 = u.ccol + wc * 32 + 4 * fq;
#pragma unroll
        for (int ai = 0; ai < 2; ++ai)
#pragma unroll
            for (int m = 0; m < 4; ++m) { const size_t off = (size_t)(row0 + ai * HALF + m * 16) * ldc + col0;
#pragma unroll
                for (int bj = 0; bj < 2; ++bj)
#pragma unroll
                    for (int n = 0; n < 2; ++n) { const f32x4 r = *(const f32x4*)(res + off + bj * HALF + n * 16); *(f32x4*)(C + off + bj * HALF + n * 16) = acc[ai][bj][m][n] + r; } }
    }
};
struct EpiSwiglu {
    bf16_t* O; const float* bias;
    __device__ __forceinline__ float act(float g, float up) const {
        g = fminf(g, 7.0f); up = fminf(fmaxf(up, -7.0f), 7.0f);
        const float sg = 1.0f / (1.0f + __expf(-1.702f * g));
        return g * sg * (up + 1.0f);
    }
    __device__ __forceinline__ void operator()(const f32x4 (&acc)[2][2][4][2], const Unit& u, int wr, int wc, int fr, int fq) const {
        const int row0 = u.crow + wr * 64 + fr, col0 = u.ccol + wc * 32 + 4 * fq;
        f32x4 bv[2][2];
#pragma unroll
        for (int bj = 0; bj < 2; ++bj)
#pragma unroll
            for (int n = 0; n < 2; ++n) bv[bj][n] = *(const f32x4*)(bias + (size_t)u.e * (2 * D_FF) + col0 + bj * HALF + 16 * n);
#pragma unroll
        for (int ai = 0; ai < 2; ++ai)
#pragma unroll
            for (int m = 0; m < 4; ++m) { bf16_t* rowp = O + (size_t)(row0 + ai * HALF + m * 16) * D_FF + (col0 >> 1);
#pragma unroll
                for (int bj = 0; bj < 2; ++bj)
#pragma unroll
                    for (int n = 0; n < 2; ++n) { const f32x4 v = acc[ai][bj][m][n] + bv[bj][n];
                        *(unsigned*)(rowp + bj * (HALF / 2) + 8 * n) = cvt_pk_bf16(act(v[0], v[1]), act(v[2], v[3])); } }
    }
};

template <class Epi, class Sched, bool GATHER>
__device__ __forceinline__ void gemm_phase(LAS unsigned char* lds, const Sched& S, const Epi& E, const int* __restrict__ lists) {
    const int tid = threadIdx.x, wid = __builtin_amdgcn_readfirstlane(tid >> 6), lane = tid & 63, wr = wid >> 2, wc = wid & 3, fr = lane & 15, fq = lane >> 4;
    constexpr int K = KDIM, nt = K / BK;
    unsigned voffA[2], voffB[2]; int gR[2], gC[2];
    const int ldb = S.ldb;
#pragma unroll
    for (int i = 0; i < 2; ++i) { int R, C; stage_rc(tid * 16 + i * 8192, R, C);
        voffA[i] = (unsigned)(R * K + C) * 2u; gR[i] = R; gC[i] = C;
        const int P = tid + 512 * i, kk = P >> 4, pos = P & 15, ch = pos ^ (2 * ((kk & 3) + 4 * ((kk >> 3) & 1)));
        voffB[i] = (unsigned)(kk * ldb + ch * 8) * 2u; }
    constexpr size_t kstep = (size_t)(BK * 2);
    constexpr size_t hstep = (size_t)HALF * K * 2;
    const size_t kstepB = (size_t)BK * ldb * 2;
    constexpr size_t hstepB = 256;
    const unsigned ldsw = (unsigned)wid * 1024u;
    const int aoff = lds_byte(wr * 64 + fr, fq * 8);
    int bb[2];
    { const int q = (lane & 15) >> 2, p = lane & 3, f = 2 * (q + 4 * (fq & 1));
#pragma unroll
      for (int nf = 0; nf < 2; ++nf) { const int ch = 4 * wc + 2 * nf + (p >> 1); bb[nf] = (8 * fq + q) * 256 + ((ch ^ f) * 16) + (p & 1) * 8; } }
#define G8_SA(b, h) (((b) * 2 + (h)) * HTB)
#define G8_SB(b, h) ((4 + (b) * 2 + (h)) * HTB)
#define G8_STAGE(bufoff, gbase, v0, v1) do { \
        __builtin_amdgcn_global_load_lds((const unsigned*)((const char*)(gbase) + (v0)), (LAS unsigned*)(lds + (bufoff) + ldsw), 16, 0, 0); \
        __builtin_amdgcn_global_load_lds((const unsigned*)((const char*)(gbase) + (v1)), (LAS unsigned*)(lds + (bufoff) + ldsw + 8192), 16, 0, 0); } while (0)
#define G8_STAGE_B(bufoff, gbase) G8_STAGE(bufoff, gbase, voffB[0], voffB[1])
#define G8_STAGE_A(bufoff, gbase, h, ga0, ga1) do { if (GATHER) G8_STAGE(bufoff, gbase, ga0, ga1); else G8_STAGE(bufoff, (gbase) + (h) * hstep, voffA[0], voffA[1]); } while (0)
#define G8_LDA(dst, b, h) do { _Pragma("unroll") for (int m = 0; m < 4; ++m) _Pragma("unroll") for (int k = 0; k < 2; ++k) dst[m][k] = *(const LAS bf16x8*)(lds + G8_SA(b, h) + aoff + m * 2048 + k * 1024); } while (0)
#define G8_TR(dst, addr, off) asm volatile("ds_read_b64_tr_b16 %0, %1 offset:%2" : "=v"(dst) : "v"(addr), "i"(off) : "memory")
#define G8_LDB(lo, hi, b, h) do { _Pragma("unroll") for (int n = 0; n < 2; ++n) { const unsigned _ad = ldsbase + (unsigned)(G8_SB(b, h)) + (unsigned)bb[n]; \
        G8_TR(lo[n][0], _ad, 0); G8_TR(hi[n][0], _ad, 1024); G8_TR(lo[n][1], _ad, 8192); G8_TR(hi[n][1], _ad, 9216); } } while (0)
#define G8_BF(lo, hi, n, k) __builtin_shufflevector(lo[n][k], hi[n][k], 0, 1, 2, 3, 4, 5, 6, 7)
#define G8_MMA(ai, bj, At, Bl, Bh) do { __builtin_amdgcn_s_setprio(1); _Pragma("unroll") for (int m = 0; m < 4; ++m) _Pragma("unroll") for (int n = 0; n < 2; ++n) _Pragma("unroll") for (int k = 0; k < 2; ++k) \
        acc[ai][bj][m][n] = __builtin_amdgcn_mfma_f32_16x16x32_bf16(G8_BF(Bl, Bh, n, k), At[m][k], acc[ai][bj][m][n], 0, 0, 0); __builtin_amdgcn_s_setprio(0); } while (0)
#define G8_WAIT_V(n) asm volatile("s_waitcnt vmcnt(" #n ")" ::: "memory")
#define G8_WAIT_L(n) do { asm volatile("s_waitcnt lgkmcnt(" #n ")" ::: "memory"); __builtin_amdgcn_sched_barrier(0); } while (0)
#define G8_BAR __builtin_amdgcn_s_barrier()
#define G8_SCHED __builtin_amdgcn_sched_barrier(0)
    Unit cur, nxt; int ui = 0;
    if (!S.next(0, cur)) return;
    f32x4 acc[2][2][4][2];
#pragma unroll
    for (int a = 0; a < 2; ++a)
#pragma unroll
        for (int b = 0; b < 2; ++b)
#pragma unroll
            for (int m = 0; m < 4; ++m)
#pragma unroll
                for (int n = 0; n < 2; ++n) acc[a][b][m][n] = (f32x4){0.f, 0.f, 0.f, 0.f};
    bf16x8 At[4][2]; s16x4 B0l[2][2], B0h[2][2], B1l[2][2], B1h[2][2];
    const unsigned ldsbase = (unsigned)(size_t)lds;
    unsigned c00 = 0, c01 = 0, c10 = 0, c11 = 0, n00 = 0, n01 = 0, n10 = 0, n11 = 0;
    if (GATHER) {
        c00 = (unsigned)(lists[cur.gi + gR[0]] * K + gC[0]) * 2u; c01 = (unsigned)(lists[cur.gi + gR[1]] * K + gC[1]) * 2u;
        c10 = (unsigned)(lists[cur.gi + HALF + gR[0]] * K + gC[0]) * 2u; c11 = (unsigned)(lists[cur.gi + HALF + gR[1]] * K + gC[1]) * 2u;
    }
    const char* cA = cur.a; const char* cB = cur.b;
    G8_STAGE_B(G8_SB(0, 0), cB); G8_STAGE_A(G8_SA(0, 0), cA, 0, c00, c01); G8_STAGE_B(G8_SB(0, 1), cB + hstepB); G8_STAGE_A(G8_SA(0, 1), cA, 1, c10, c11);
    if (wr == 1) G8_BAR;
    G8_WAIT_V(4); G8_BAR;
    G8_STAGE_B(G8_SB(1, 0), cB + kstepB); G8_STAGE_A(G8_SA(1, 0), cA + kstep, 0, c00, c01); G8_STAGE_B(G8_SB(1, 1), cB + hstepB + kstepB);
    G8_WAIT_V(6); G8_BAR;
    for (;;) {
        const bool has_next = S.next(ui + 1, nxt);
        const char* nA = has_next ? nxt.a : cA; const char* nB = has_next ? nxt.b : cB;
        for (int t = 0; t < nt; t += 2) {
            const bool last = (t == nt - 2);
            if (GATHER) {
                if (last) {
                    if (has_next) {
                        n00 = (unsigned)(lists[nxt.gi + gR[0]] * K + gC[0]) * 2u; n01 = (unsigned)(lists[nxt.gi + gR[1]] * K + gC[1]) * 2u;
                        n10 = (unsigned)(lists[nxt.gi + HALF + gR[0]] * K + gC[0]) * 2u; n11 = (unsigned)(lists[nxt.gi + HALF + gR[1]] * K + gC[1]) * 2u;
                    } else { n00 = c00; n01 = c01; n10 = c10; n11 = c11; }
                }
            }
            const char* a1 = cA + (size_t)(t + 1) * kstep;
            const char* a2 = last ? nA : cA + (size_t)(t + 2) * kstep; const char* b2 = last ? nB : cB + (size_t)(t + 2) * kstepB;
            const char* a3 = a2 + kstep; const char* b3 = b2 + kstepB;
            const unsigned x00 = last ? n00 : c00, x01 = last ? n01 : c01, x10 = last ? n10 : c10, x11 = last ? n11 : c11;
            G8_LDB(B0l, B0h, 0, 0); G8_SCHED; G8_LDA(At, 0, 0); G8_STAGE_A(G8_SA(1, 1), a1, 1, c10, c11);
            G8_WAIT_L(8); G8_BAR; G8_WAIT_L(0); G8_MMA(0, 0, At, B0l, B0h); G8_BAR; G8_SCHED;
            G8_LDB(B1l, B1h, 0, 1); G8_STAGE_B(G8_SB(0, 0), b2);
            G8_BAR; G8_WAIT_L(0); G8_MMA(0, 1, At, B1l, B1h); G8_BAR;
            G8_LDA(At, 0, 1); G8_STAGE_A(G8_SA(0, 0), a2, 0, x00, x01);
            G8_BAR; G8_WAIT_L(0); G8_MMA(1, 0, At, B0l, B0h); G8_BAR; G8_SCHED;
            G8_STAGE_B(G8_SB(0, 1), b2 + hstepB);
            G8_WAIT_V(6); G8_BAR; G8_MMA(1, 1, At, B1l, B1h); G8_BAR;
            G8_LDB(B0l, B0h, 1, 0); G8_SCHED; G8_LDA(At, 1, 0); G8_STAGE_A(G8_SA(0, 1), a2, 1, x10, x11);
            G8_WAIT_L(8); G8_BAR; G8_WAIT_L(0); G8_MMA(0, 0, At, B0l, B0h); G8_BAR; G8_SCHED;
            G8_LDB(B1l, B1h, 1, 1); G8_STAGE_B(G8_SB(1, 0), b3);
            G8_BAR; G8_WAIT_L(0); G8_MMA(0, 1, At, B1l, B1h); G8_BAR;
            G8_LDA(At, 1, 1); G8_STAGE_A(G8_SA(1, 0), a3, 0, x00, x01);
            G8_BAR; G8_WAIT_L(0); G8_MMA(1, 0, At, B0l, B0h); G8_BAR; G8_SCHED;
            G8_STAGE_B(G8_SB(1, 1), b3 + hstepB);
            G8_WAIT_V(6); G8_BAR; G8_MMA(1, 1, At, B1l, B1h); G8_BAR;
        }
        E(acc, cur, wr, wc, fr, fq);
        if (!has_next) break;
#pragma unroll
        for (int a = 0; a < 2; ++a)
#pragma unroll
            for (int b = 0; b < 2; ++b)
#pragma unroll
                for (int m = 0; m < 4; ++m)
#pragma unroll
                    for (int n = 0; n < 2; ++n) acc[a][b][m][n] = (f32x4){0.f, 0.f, 0.f, 0.f};
        cur = nxt; cA = nA; cB = nB; ++ui;
        if (GATHER) { c00 = n00; c01 = n01; c10 = n10; c11 = n11; }
    }
    G8_WAIT_V(0);
    if (wr == 0) G8_BAR;
    G8_BAR;
#undef G8_SA
#undef G8_SB
#undef G8_STAGE
#undef G8_STAGE_A
#undef G8_STAGE_B
#undef G8_LDA
#undef G8_LDB
#undef G8_TR
#undef G8_BF
#undef G8_MMA
#undef G8_WAIT_V
#undef G8_WAIT_L
#undef G8_BAR
#undef G8_SCHED
}
}

struct Frame {
    LAS unsigned char* lds;
    unsigned* ctl;
    int tid, lane, wave, vcu, G, gw, NGW;
};
struct Args { const float* in[21]; float* out; unsigned char* ws; int ph_lo, ph_hi; };

constexpr long CV_IN = (long)KDIM * IN_COLS / 512, CV_OUT = (long)KDIM * D_MODEL / 512, CV_GU = (long)N_EXP * KDIM * 4096 / 512, CV_DN = (long)N_EXP * KDIM * D_MODEL / 512;
__device__ __forceinline__ void conv_chunks(const float* __restrict__ src, bf16_t* __restrict__ dst, long c0, long c1, int gw, int NGW, int lane) {
    long c = c0 + gw;
    for (; c + 3L * NGW < c1; c += 4L * NGW) {
        f32x4 a[4], b[4];
#pragma unroll
        for (int i = 0; i < 4; ++i) { const float* p = src + (c + (long)i * NGW) * 512 + lane * 8; a[i] = *(const f32x4*)p; b[i] = *(const f32x4*)(p + 4); }
#pragma unroll
        for (int i = 0; i < 4; ++i) { u32x4 w; w.x = pk2(a[i][0], a[i][1]); w.y = pk2(a[i][2], a[i][3]); w.z = pk2(b[i][0], b[i][1]); w.w = pk2(b[i][2], b[i][3]);
            *(u32x4*)(dst + (c + (long)i * NGW) * 512 + lane * 8) = w; }
    }
    for (; c < c1; c += NGW) { const float* p = src + c * 512 + lane * 8; const f32x4 a = *(const f32x4*)p, b = *(const f32x4*)(p + 4);
        u32x4 w; w.x = pk2(a[0], a[1]); w.y = pk2(a[2], a[3]); w.z = pk2(b[0], b[1]); w.w = pk2(b[2], b[3]); *(u32x4*)(dst + c * 512 + lane * 8) = w; }
}
__device__ __forceinline__ void rms_row_bf16(const float* xrow, const float* g, bf16_t* orow, int lane) {
    const f32x4* xr = (const f32x4*)xrow + lane; const f32x4* gr = (const f32x4*)g + lane;
    f32x4 v[8]; float s = 0.f;
#pragma unroll
    for (int j = 0; j < 8; ++j) { v[j] = xr[64 * j]; s += (v[j][0] * v[j][0] + v[j][1] * v[j][1]) + (v[j][2] * v[j][2] + v[j][3] * v[j][3]); }
    const float rs = rsqrtf(wave_sum(s) * (1.0f / 2048.0f) + EPS);
    u32x2* o = (u32x2*)orow + lane;
#pragma unroll
    for (int j = 0; j < 8; ++j) { const f32x4 gg = gr[64 * j]; u32x2 w; w.x = pk2(v[j][0] * rs * gg[0], v[j][1] * rs * gg[1]); w.y = pk2(v[j][2] * rs * gg[2], v[j][3] * rs * gg[3]); o[64 * j] = w; }
}
__device__ __forceinline__ void p0_prologue(const Frame& F, const Args& a) {
    conv_chunks(a.in[2], (bf16_t*)(a.ws + WS_WIN), 0, CV_IN, F.gw, F.NGW, F.lane);
    conv_chunks(a.in[12], (bf16_t*)(a.ws + WS_WOUT), 0, CV_OUT, F.gw, F.NGW, F.lane);
    conv_chunks(a.in[16], (bf16_t*)(a.ws + WS_WGU), 0, CV_GU, F.gw, F.NGW, F.lane);
    conv_chunks(a.in[18], (bf16_t*)(a.ws + WS_WDN), 0, CV_DN, F.gw, F.NGW, F.lane);
    bf16_t* HN = (bf16_t*)(a.ws + WS_HN);
    for (int m = F.gw; m < NTOK; m += F.NGW) rms_row_bf16(a.in[0] + (size_t)m * D_MODEL, a.in[1], HN + (size_t)m * D_MODEL, F.lane);
}

__device__ __forceinline__ float gelu_tanh(float x) { return 0.5f * x * (1.0f + tanhf(0.7978845608028654f * (x + 0.044715f * x * x * x))); }
__device__ __forceinline__ float sigmoidf_(float x) { return 1.0f / (1.0f + __expf(-x)); }
__device__ __forceinline__ void lru_unit(const Frame& F, const Args& a, int unit) {
    const int lane = F.lane;
    const int b = unit >> 9, k = (unit >> 4) & 31, blk = unit & 15;
    const bf16_t* proj = (const bf16_t*)(a.ws + WS_PROJ);
    LAS float* xs = (LAS float*)(F.lds + F.wave * 16384);
    const int ch = blk * 64 + lane;
    const float cw0 = a.in[3][0 * LRU_W + ch], cw1 = a.in[3][1 * LRU_W + ch], cw2 = a.in[3][2 * LRU_W + ch], cw3 = a.in[3][3 * LRU_W + ch], cb = a.in[4][ch];
    const int t0 = k * 64; const size_t row0 = (size_t)b * SEQ + t0;
    const bf16_t* xp = proj + row0 * IN_COLS + 3 * ATTN_W + ch;
    float x0 = (t0 >= 3) ? bf2f(xp[-3 * IN_COLS]) : 0.f, x1 = (t0 >= 2) ? bf2f(xp[-2 * IN_COLS]) : 0.f, x2 = (t0 >= 1) ? bf2f(xp[-1 * IN_COLS]) : 0.f;
    for (int t = 0; t < 64; ++t) {
        const float x3 = bf2f(xp[(size_t)t * IN_COLS]);
        xs[t * 64 + lane] = cb + cw0 * x0 + cw1 * x1 + cw2 * x2 + cw3 * x3;
        x0 = x1; x1 = x2; x2 = x3;
    }
    float wa[64], wx[64];
    const float* wap = a.in[5] + (size_t)blk * 4096 + lane; const float* wxp = a.in[7] + (size_t)blk * 4096 + lane;
#pragma unroll
    for (int c = 0; c < 64; ++c) { wa[c] = wap[c * 64]; wx[c] = wxp[c * 64]; }
    const float ba = a.in[6][ch], bx = a.in[8][ch];
    const float sp = log1pf(__expf(-a.in[9][ch]));
    float* hl = (float*)(a.ws + WS_HL) + row0 * LRU_W + ch; float* pc = (float*)(a.ws + WS_PC) + row0 * LRU_W + ch;
    LDS_WAIT();
    float h = 0.f, P = 1.f;
    for (int t = 0; t < 64; ++t) {
        float r = ba, ii = bx;
        const LAS f32x4* xr = (const LAS f32x4*)(xs + t * 64);
#pragma unroll
        for (int c4 = 0; c4 < 16; ++c4) { const f32x4 xv = xr[c4];
            r = fmaf(xv[0], wa[4 * c4], r); r = fmaf(xv[1], wa[4 * c4 + 1], r); r = fmaf(xv[2], wa[4 * c4 + 2], r); r = fmaf(xv[3], wa[4 * c4 + 3], r);
            ii = fmaf(xv[0], wx[4 * c4], ii); ii = fmaf(xv[1], wx[4 * c4 + 1], ii); ii = fmaf(xv[2], wx[4 * c4 + 2], ii); ii = fmaf(xv[3], wx[4 * c4 + 3], ii); }
        r = sigmoidf_(r); ii = sigmoidf_(ii);
        const float log_a = -8.0f * r * sp;
        const float av = __expf(log_a);
        const float bv = sqrtf(-expm1f(2.0f * log_a)) * (ii * xs[t * 64 + lane]);
        h = av * h + bv; P *= av;
        hl[(size_t)t * LRU_W] = h; pc[(size_t)t * LRU_W] = P;
    }
    float* ae = (float*)(a.ws + WS_LRUE); float* he = ae + 4 * 32 * 1024;
    ae[(size_t)(b * 32 + k) * 1024 + ch] = P; he[(size_t)(b * 32 + k) * 1024 + ch] = h;
    LDS_WAIT();
}
constexpr int VP = 192;
__device__ __forceinline__ void attn_unit(const Frame& F, const Args& a, int u) {
    const int lane = F.lane, c = lane & 31, hh = lane >> 5;
    const int br = u >> 12, rem = u & 4095, bh = rem >> 6, qt = rem & 63;
    const int b = bh >> 4, h = bh & 15;
    const int dsh = br * 2, d = 1 << dsh;
    const int r = qt & (d - 1), ltile = qt >> dsh, l0 = ltile * 32;
    const bf16_t* proj = (const bf16_t*)(a.ws + WS_PROJ) + (size_t)b * SEQ * IN_COLS + h * 64;
    LAS unsigned char* vl = F.lds + F.wave * 16384;
    bf16x8 qf[4];
    { const bf16_t* qrow = proj + (size_t)((l0 + c) * d + r) * IN_COLS + 8 * hh;
#pragma unroll
      for (int s = 0; s < 4; ++s) qf[s] = *(const bf16x8*)(qrow + 16 * s); }
    constexpr float LOG2E = 1.4426950408889634f;
    const float slope2 = exp2f(-0.5f * (float)(h + 1)) * LOG2E * (float)d;
    const float sc2 = 0.125f * LOG2E;
    float m = -INFINITY, lsum = 0.f;
    f32x16 o0, o1;
#pragma unroll
    for (int i = 0; i < 16; ++i) { o0[i] = 0.f; o1[i] = 0.f; }
    const int jfirst = ltile >= 4 ? 0 : 4 - ltile;
    bf16x8 kf[4], kn[4]; u32x4 vr[4], vn[4];
    const int vrow = lane >> 3, vch = lane & 7;
    { const int lk0 = l0 - 128 + 32 * jfirst;
      const bf16_t* krow = proj + (size_t)((lk0 + c) * d + r) * IN_COLS + ATTN_W + 8 * hh;
#pragma unroll
      for (int s = 0; s < 4; ++s) kf[s] = *(const bf16x8*)(krow + 16 * s);
#pragma unroll
      for (int i = 0; i < 4; ++i) vr[i] = *(const u32x4*)(proj + (size_t)((lk0 + vrow + 8 * i) * d + r) * IN_COLS + 2 * ATTN_W + vch * 8); }
    const LAS unsigned char* vtr_base = vl + (4 * hh + ((lane & 15) >> 2)) * VP + (16 * ((lane >> 4) & 1) + 4 * (lane & 3)) * 2;
    for (int j = jfirst; j <= 4; ++j) {
        if (j < 4) { const int lk0 = l0 - 128 + 32 * (j + 1);
            const bf16_t* krow = proj + (size_t)((lk0 + c) * d + r) * IN_COLS + ATTN_W + 8 * hh;
#pragma unroll
            for (int s = 0; s < 4; ++s) kn[s] = *(const bf16x8*)(krow + 16 * s);
#pragma unroll
            for (int i = 0; i < 4; ++i) vn[i] = *(const u32x4*)(proj + (size_t)((lk0 + vrow + 8 * i) * d + r) * IN_COLS + 2 * ATTN_W + vch * 8); }
#pragma unroll
        for (int i = 0; i < 4; ++i) *(LAS u32x4*)(vl + (vrow + 8 * i) * VP + vch * 16) = vr[i];
        f32x16 sa;
#pragma unroll
        for (int i = 0; i < 16; ++i) sa[i] = 0.f;
#pragma unroll
        for (int s = 0; s < 4; ++s) sa = __builtin_amdgcn_mfma_f32_32x32x16_bf16(kf[s], qf[s], sa, 0, 0, 0);
        const float relbase = (float)(c + 128 - 32 * j);
        float mx = -INFINITY;
#pragma unroll
        for (int i = 0; i < 16; ++i) { const int ki = (i & 3) + 8 * (i >> 2) + 4 * hh;
            float v = sa[i] * sc2 - slope2 * (relbase - (float)ki);
            const bool valid = (j == 0) ? (ki >= c) : ((j == 4) ? (ki <= c) : true);
            v = valid ? v : -INFINITY; sa[i] = v; mx = fmaxf(mx, v); }
        mx = fmaxf(mx, __shfl_xor(mx, 32));
        const float mnew = fmaxf(m, mx);
        const float alpha = __builtin_amdgcn_exp2f(m - mnew);
        float ps = 0.f;
#pragma unroll
        for (int i = 0; i < 16; ++i) { const float p = __builtin_amdgcn_exp2f(sa[i] - mnew); sa[i] = p; ps += p; }
        ps += __shfl_xor(ps, 32);
        lsum = lsum * alpha + ps; m = mnew;
#pragma unroll
        for (int i = 0; i < 16; ++i) { o0[i] *= alpha; o1[i] *= alpha; }
        bf16x8 pf[2];
#pragma unroll
        for (int s = 0; s < 2; ++s) { u32x4 w; w.x = g8::cvt_pk_bf16(sa[8 * s + 0], sa[8 * s + 1]); w.y = g8::cvt_pk_bf16(sa[8 * s + 2], sa[8 * s + 3]); w.z = g8::cvt_pk_bf16(sa[8 * s + 4], sa[8 * s + 5]); w.w = g8::cvt_pk_bf16(sa[8 * s + 6], sa[8 * s + 7]);
            pf[s] = __builtin_bit_cast(bf16x8, w); }
#pragma unroll
        for (int s = 0; s < 2; ++s) {
#pragma unroll
            for (int nt = 0; nt < 2; ++nt) {
                const s16x4 lo = vtr(vtr_base + (16 * s) * VP + nt * 64), hi = vtr(vtr_base + (16 * s + 8) * VP + nt * 64);
                bf16x8 af; af[0] = lo[0]; af[1] = lo[1]; af[2] = lo[2]; af[3] = lo[3]; af[4] = hi[0]; af[5] = hi[1]; af[6] = hi[2]; af[7] = hi[3];
                if (nt == 0) o0 = __builtin_amdgcn_mfma_f32_32x32x16_bf16(af, pf[s], o0, 0, 0, 0); else o1 = __builtin_amdgcn_mfma_f32_32x32x16_bf16(af, pf[s], o1, 0, 0, 0);
            }
        }
#pragma unroll
        for (int s = 0; s < 4; ++s) { kf[s] = kn[s]; vr[s] = vn[s]; }
    }
    const float inv = 1.0f / lsum;
    const size_t tok = (size_t)b * SEQ + (size_t)((l0 + c) * d + r);
    bf16_t* orow = (bf16_t*)(a.ws + WS_ATT) + ((size_t)br * NTOK + tok) * ATTN_W + h * 64 + 4 * hh;
#pragma unroll
    for (int g = 0; g < 4; ++g) {
        u32x2 w0, w1;
        w0.x = g8::cvt_pk_bf16(o0[4 * g] * inv, o0[4 * g + 1] * inv); w0.y = g8::cvt_pk_bf16(o0[4 * g + 2] * inv, o0[4 * g + 3] * inv);
        w1.x = g8::cvt_pk_bf16(o1[4 * g] * inv, o1[4 * g + 1] * inv); w1.y = g8::cvt_pk_bf16(o1[4 * g + 2] * inv, o1[4 * g + 3] * inv);
        *(u32x2*)(orow + 8 * g) = w0; *(u32x2*)(orow + 32 + 8 * g) = w1;
    }
    if (hh == 0) ((float*)(a.ws + WS_LSE))[((size_t)br * NTOK + tok) * 16 + h] = 0.6931471805599453f * (m + __builtin_amdgcn_logf(lsum));
}
__device__ __forceinline__ void p2_mixers(const Frame& F, const Args& a) {
    for (int u = F.gw; u < 2048; u += F.NGW) lru_unit(F, a, u);
    for (int u = F.gw; u < 3 * 4096; u += F.NGW) attn_unit(F, a, u);
}

__device__ __forceinline__ void p3_mix(const Frame& F, const Args& a) {
    LAS float* Hin = (LAS float*)F.lds;
    const float* ae = (const float*)(a.ws + WS_LRUE); const float* he = ae + 4 * 32 * 1024;
    const bf16_t* proj = (const bf16_t*)(a.ws + WS_PROJ);
    bf16_t* mixed = (bf16_t*)(a.ws + WS_MIXED);
    for (int grp = F.vcu; grp < NTOK / 32; grp += F.G) {
        const int tok0 = grp * 32, b = tok0 / SEQ, k = (tok0 % SEQ) / 64;
        __syncthreads();
        for (int d = F.tid; d < LRU_W; d += NTHR) { float H = 0.f;
            for (int j0 = 0; j0 < k; j0 += 8) { float av[8], hv[8];
#pragma unroll
                for (int jj = 0; jj < 8; ++jj) { const bool ok = (j0 + jj) < k; const size_t o = (size_t)(b * 32 + (ok ? j0 + jj : 0)) * 1024 + d; const float a1 = ae[o], h1 = he[o]; av[jj] = ok ? a1 : 1.0f; hv[jj] = ok ? h1 : 0.0f; }
#pragma unroll
                for (int jj = 0; jj < 8; ++jj) H = av[jj] * H + hv[jj]; }
            Hin[d] = H; }
        __syncthreads();
        for (int tt = F.wave; tt < 32; tt += NWAVES) {
            const size_t tok = (size_t)tok0 + tt;
            { const bf16_t* ao = (const bf16_t*)(a.ws + WS_ATT); const float* lse = (const float*)(a.ws + WS_LSE); const f32x4* gr = (const f32x4*)a.in[10] + F.lane;
              f32x4 v[4]; float s = 0.f;
#pragma unroll
              for (int j = 0; j < 4; ++j) { const int hd = (F.lane >> 4) + 4 * j;
                  const float l0 = lse[(0 * (size_t)NTOK + tok) * 16 + hd], l1 = lse[(1 * (size_t)NTOK + tok) * 16 + hd], l2 = lse[(2 * (size_t)NTOK + tok) * 16 + hd];
                  const float M = fmaxf(l0, fmaxf(l1, l2)); float w0 = __expf(l0 - M), w1 = __expf(l1 - M), w2 = __expf(l2 - M); const float iw = 1.0f / (w0 + w1 + w2); w0 *= iw; w1 *= iw; w2 *= iw;
                  const u32x2 a0 = *((const u32x2*)(ao + (0 * (size_t)NTOK + tok) * ATTN_W) + F.lane + 64 * j), a1 = *((const u32x2*)(ao + (1 * (size_t)NTOK + tok) * ATTN_W) + F.lane + 64 * j), a2 = *((const u32x2*)(ao + (2 * (size_t)NTOK + tok) * ATTN_W) + F.lane + 64 * j);
                  v[j][0] = w0 * bflo(a0.x) + w1 * bflo(a1.x) + w2 * bflo(a2.x); v[j][1] = w0 * bfhi(a0.x) + w1 * bfhi(a1.x) + w2 * bfhi(a2.x);
                  v[j][2] = w0 * bflo(a0.y) + w1 * bflo(a1.y) + w2 * bflo(a2.y); v[j][3] = w0 * bfhi(a0.y) + w1 * bfhi(a1.y) + w2 * bfhi(a2.y);
                  s += (v[j][0] * v[j][0] + v[j][1] * v[j][1]) + (v[j][2] * v[j][2] + v[j][3] * v[j][3]); }
              const float rs = rsqrtf(wave_sum(s) * (1.0f / 1024.0f) + EPS);
              u32x2* o = (u32x2*)(mixed + tok * D_MODEL) + F.lane;
#pragma unroll
              for (int j = 0; j < 4; ++j) { const f32x4 g = gr[64 * j]; u32x2 w; w.x = pk2(v[j][0] * rs * g[0], v[j][1] * rs * g[1]); w.y = pk2(v[j][2] * rs * g[2], v[j][3] * rs * g[3]); o[64 * j] = w; } }
            { const f32x4* hr = (const f32x4*)((const float*)(a.ws + WS_HL) + tok * LRU_W) + F.lane; const f32x4* pr = (const f32x4*)((const float*)(a.ws + WS_PC) + tok * LRU_W) + F.lane;
              const u32x2* gp = (const u32x2*)(proj + tok * IN_COLS + 3 * ATTN_W + LRU_W) + F.lane; const f32x4* gr = (const f32x4*)a.in[11] + F.lane;
              f32x4 v[4]; float s = 0.f;
#pragma unroll
              for (int j = 0; j < 4; ++j) { const f32x4 hv = hr[64 * j], pv = pr[64 * j]; const u32x2 gw = gp[64 * j]; const f32x4 hi = *(const LAS f32x4*)(Hin + (F.lane + 64 * j) * 4);
                  v[j][0] = (hv[0] + pv[0] * hi[0]) * gelu_tanh(bflo(gw.x)); v[j][1] = (hv[1] + pv[1] * hi[1]) * gelu_tanh(bfhi(gw.x));
                  v[j][2] = (hv[2] + pv[2] * hi[2]) * gelu_tanh(bflo(gw.y)); v[j][3] = (hv[3] + pv[3] * hi[3]) * gelu_tanh(bfhi(gw.y));
                  s += (v[j][0] * v[j][0] + v[j][1] * v[j][1]) + (v[j][2] * v[j][2] + v[j][3] * v[j][3]); }
              const float rs = rsqrtf(wave_sum(s) * (1.0f / 1024.0f) + EPS);
              u32x2* o = (u32x2*)(mixed + tok * D_MODEL + ATTN_W) + F.lane;
#pragma unroll
              for (int j = 0; j < 4; ++j) { const f32x4 g = gr[64 * j]; u32x2 w; w.x = pk2(v[j][0] * rs * g[0], v[j][1] * rs * g[1]); w.y = pk2(v[j][2] * rs * g[2], v[j][3] * rs * g[3]); o[64 * j] = w; } }
        }
    }
    __syncthreads();
}

__device__ __forceinline__ void p5_router(const Frame& F, const Args& a) {
    const float* x1 = (const float*)(a.ws + WS_X1); bf16_t* hn2 = (bf16_t*)(a.ws + WS_HN);
    const float* g = a.in[13]; const float* wr = a.in[14]; const float* br = a.in[15];
    int* cnt = (int*)(F.ctl + CW_CNT); int* lists = (int*)(a.ws + WS_LISTS);
    int* sel_e = (int*)(a.ws + WS_SEL); int* sel_pos = sel_e + NSLOT; float* sel_g = (float*)(sel_pos + NSLOT);
    LAS float* PART = (LAS float*)F.lds;
    LAS float* SSQ = PART + 8 * 1024;
    LAS float* RS = SSQ + 256;
    LAS float* LG = RS + 32;
    LAS int* lcnt = (LAS int*)(LG + 1024);
    LAS int* gbase = lcnt + 32;
    LAS int* ent_e = gbase + 32;
    LAS int* ent_r = ent_e + 128;
    LAS float* ent_g = (LAS float*)(ent_r + 128);
    const int lane = F.lane, r16 = lane & 15, kq = lane >> 4;
    for (int grp = F.vcu; grp < NTOK / 32; grp += F.G) {
        const int tok0 = grp * 32;
        __syncthreads();
        if (F.tid < 32) lcnt[F.tid] = 0;
        f32x4 acc00 = {0.f, 0.f, 0.f, 0.f}, acc01 = acc00, acc10 = acc00, acc11 = acc00; float ss0 = 0.f, ss1 = 0.f;
        const float* xa = x1 + (size_t)(tok0 + r16) * D_MODEL + F.wave * 256 + 4 * kq;
        const float* gp = g + F.wave * 256 + 4 * kq;
        const float* wp = wr + (size_t)(F.wave * 256 + 4 * kq) * N_EXP + r16;
#pragma unroll 4
        for (int S = 0; S < 16; ++S) {
            const f32x4 xv0 = *(const f32x4*)(xa + 16 * S), xv1 = *(const f32x4*)(xa + 16 * S + (size_t)16 * D_MODEL), gv = *(const f32x4*)(gp + 16 * S);
            float b0[4], b1[4];
#pragma unroll
            for (int q = 0; q < 4; ++q) { b0[q] = wp[(size_t)(16 * S + q) * N_EXP]; b1[q] = wp[(size_t)(16 * S + q) * N_EXP + 16]; }
            ss0 += (xv0[0] * xv0[0] + xv0[1] * xv0[1]) + (xv0[2] * xv0[2] + xv0[3] * xv0[3]);
            ss1 += (xv1[0] * xv1[0] + xv1[1] * xv1[1]) + (xv1[2] * xv1[2] + xv1[3] * xv1[3]);
#pragma unroll
            for (int q = 0; q < 4; ++q) { const float a0 = xv0[q] * gv[q], a1 = xv1[q] * gv[q];
                acc00 = __builtin_amdgcn_mfma_f32_16x16x4f32(a0, b0[q], acc00, 0, 0, 0); acc01 = __builtin_amdgcn_mfma_f32_16x16x4f32(a0, b1[q], acc01, 0, 0, 0);
                acc10 = __builtin_amdgcn_mfma_f32_16x16x4f32(a1, b0[q], acc10, 0, 0, 0); acc11 = __builtin_amdgcn_mfma_f32_16x16x4f32(a1, b1[q], acc11, 0, 0, 0); }
        }
        { LAS float* pw = PART + F.wave * 1024;
#pragma unroll
          for (int q = 0; q < 4; ++q) { const int tr = 4 * kq + q;
              pw[tr * 32 + r16] = acc00[q]; pw[tr * 32 + 16 + r16] = acc01[q]; pw[(16 + tr) * 32 + r16] = acc10[q]; pw[(16 + tr) * 32 + 16 + r16] = acc11[q]; }
          ss0 += __shfl_xor(ss0, 16); ss0 += __shfl_xor(ss0, 32); ss1 += __shfl_xor(ss1, 16); ss1 += __shfl_xor(ss1, 32);
          if (kq == 0) { SSQ[F.wave * 32 + r16] = ss0; SSQ[F.wave * 32 + 16 + r16] = ss1; } }
        __syncthreads();
        if (F.tid < 32) { float t = 0.f;
#pragma unroll
            for (int w = 0; w < 8; ++w) t += SSQ[w * 32 + F.tid];
            RS[F.tid] = rsqrtf(t * (1.0f / 2048.0f) + EPS); }
        __syncthreads();
        { const int tt = F.tid >> 4, eg = F.tid & 15; float s0 = 0.f, s1 = 0.f;
#pragma unroll
          for (int w = 0; w < 8; ++w) { const f32x2 v = *(const LAS f32x2*)(PART + w * 1024 + tt * 32 + 2 * eg); s0 += v[0]; s1 += v[1]; }
          const float rs = RS[tt];
          LG[tt * 32 + 2 * eg] = s0 * rs + br[2 * eg]; LG[tt * 32 + 2 * eg + 1] = s1 * rs + br[2 * eg + 1]; }
        __syncthreads();
        for (int t4 = 0; t4 < 4; ++t4) {
            const int tk = F.wave * 4 + t4;
            { const float rs = RS[tk]; const f32x4* xr = (const f32x4*)(x1 + (size_t)(tok0 + tk) * D_MODEL) + lane; const f32x4* gr = (const f32x4*)g + lane; u32x2* o = (u32x2*)(hn2 + (size_t)(tok0 + tk) * D_MODEL) + lane;
#pragma unroll
              for (int j = 0; j < 8; ++j) { const f32x4 v = xr[64 * j], gg = gr[64 * j]; u32x2 w; w.x = pk2(v[0] * rs * gg[0], v[1] * rs * gg[1]); w.y = pk2(v[2] * rs * gg[2], v[3] * rs * gg[3]); o[64 * j] = w; } }
            float cur = (lane < 32) ? LG[tk * 32 + lane] : -INFINITY;
            int i0 = 0, i1 = 0, i2 = 0, i3 = 0; float v0 = 0.f, v1 = 0.f, v2 = 0.f, v3 = 0.f;
#pragma unroll
            for (int k = 0; k < 4; ++k) {
                const float mx = wave_max(cur);
                const unsigned long long bal = __ballot(cur == mx);
                const int bi = __ffsll((long long)bal) - 1;
                if (k == 0) { i0 = bi; v0 = mx; } else if (k == 1) { i1 = bi; v1 = mx; } else if (k == 2) { i2 = bi; v2 = mx; } else { i3 = bi; v3 = mx; }
                if (lane == bi) cur = -INFINITY;
            }
            if (lane == 0) {
                const float e1 = __expf(v1 - v0), e2 = __expf(v2 - v0), e3 = __expf(v3 - v0); const float inv = 1.0f / (1.0f + e1 + e2 + e3);
                const int base = tk * 4;
                ent_e[base + 0] = i0; ent_r[base + 0] = __hip_atomic_fetch_add(&lcnt[i0], 1, __ATOMIC_RELAXED, __HIP_MEMORY_SCOPE_WORKGROUP); ent_g[base + 0] = inv;
                ent_e[base + 1] = i1; ent_r[base + 1] = __hip_atomic_fetch_add(&lcnt[i1], 1, __ATOMIC_RELAXED, __HIP_MEMORY_SCOPE_WORKGROUP); ent_g[base + 1] = e1 * inv;
                ent_e[base + 2] = i2; ent_r[base + 2] = __hip_atomic_fetch_add(&lcnt[i2], 1, __ATOMIC_RELAXED, __HIP_MEMORY_SCOPE_WORKGROUP); ent_g[base + 2] = e2 * inv;
                ent_e[base + 3] = i3; ent_r[base + 3] = __hip_atomic_fetch_add(&lcnt[i3], 1, __ATOMIC_RELAXED, __HIP_MEMORY_SCOPE_WORKGROUP); ent_g[base + 3] = e3 * inv;
            }
        }
        __syncthreads();
        if (F.tid < 32) { const int n = lcnt[F.tid]; gbase[F.tid] = n > 0 ? atomicAdd(&cnt[F.tid], n) : 0; }
        __syncthreads();
        if (F.tid < 128) { const int e = ent_e[F.tid], pos = gbase[e] + ent_r[F.tid], tok = tok0 + (F.tid >> 2);
            lists[e * NTOK + pos] = tok; sel_e[tok * 4 + (F.tid & 3)] = e; sel_pos[tok * 4 + (F.tid & 3)] = pos; sel_g[tok * 4 + (F.tid & 3)] = ent_g[F.tid]; }
    }
    __syncthreads();
}

__device__ __forceinline__ void build_tpre(const Frame& F) {
    LAS int* tpre = (LAS int*)(F.lds + L_TPRE);
    __syncthreads();
    if (F.tid == 0) { const int* cnt = (const int*)(F.ctl + CW_CNT); int acc = 0; for (int e = 0; e < N_EXP; ++e) { tpre[e] = acc; acc += (cnt[e] + 255) >> 8; } tpre[N_EXP] = acc; }
    __syncthreads();
}

__device__ __forceinline__ void p8_final(const Frame& F, const Args& a) {
    const LAS int* tpre = (const LAS int*)(F.lds + L_TPRE);
    const float* x1 = (const float*)(a.ws + WS_X1); const bf16_t* Y = (const bf16_t*)(a.ws + WS_Y);
    const int* sel_e = (const int*)(a.ws + WS_SEL); const int* sel_pos = sel_e + NSLOT; const float* sel_g = (const float*)(sel_pos + NSLOT);
    const f32x4* gr = (const f32x4*)a.in[20] + F.lane;
    for (int tok = F.gw; tok < NTOK; tok += F.NGW) {
        const f32x4* xr = (const f32x4*)(x1 + (size_t)tok * D_MODEL) + F.lane;
        f32x4 v[8];
#pragma unroll
        for (int j = 0; j < 8; ++j) v[j] = xr[64 * j];
#pragma unroll
        for (int k = 0; k < 4; ++k) {
            const int e = sel_e[tok * 4 + k]; const size_t row = (size_t)tpre[e] * 256 + sel_pos[tok * 4 + k]; const float gk = sel_g[tok * 4 + k];
            const u32x2* yp = (const u32x2*)(Y + row * D_MODEL) + F.lane;
#pragma unroll
            for (int j = 0; j < 8; ++j) { const u32x2 w = yp[64 * j]; v[j][0] += gk * bflo(w.x); v[j][1] += gk * bfhi(w.x); v[j][2] += gk * bflo(w.y); v[j][3] += gk * bfhi(w.y); }
        }
        float s = 0.f;
#pragma unroll
        for (int j = 0; j < 8; ++j) s += (v[j][0] * v[j][0] + v[j][1] * v[j][1]) + (v[j][2] * v[j][2] + v[j][3] * v[j][3]);
        const float rs = rsqrtf(wave_sum(s) * (1.0f / 2048.0f) + EPS);
        f32x4* o = (f32x4*)(a.out + (size_t)tok * D_MODEL) + F.lane;
#pragma unroll
        for (int j = 0; j < 8; ++j) { const f32x4 g = gr[64 * j]; o[64 * j] = (f32x4){v[j][0] * rs * g[0], v[j][1] * rs * g[1], v[j][2] * rs * g[2], v[j][3] * rs * g[3]}; }
    }
}

__device__ __forceinline__ void ph1_inproj(const Frame& F, const Args& args) {
    unsigned char* ws = args.ws;
    g8::DenseOrder S{(const char*)(ws + WS_HN), (const char*)(ws + WS_WIN), NTOK / 256, IN_COLS / 256, (NTOK / 256) * (IN_COLS / 256), F.G, (int)blockIdx.x, IN_COLS};
    g8::EpiBf16 E{(bf16_t*)(ws + WS_PROJ), IN_COLS, nullptr, 0};
    g8::gemm_phase<g8::EpiBf16, g8::DenseOrder, false>(F.lds, S, E, nullptr);
}
__device__ __forceinline__ void ph4_outproj(const Frame& F, const Args& args) {
    unsigned char* ws = args.ws;
    g8::DenseOrder S{(const char*)(ws + WS_MIXED), (const char*)(ws + WS_WOUT), NTOK / 256, D_MODEL / 256, (NTOK / 256) * (D_MODEL / 256), F.G, (int)blockIdx.x, D_MODEL};
    g8::EpiResF32 E{(float*)(ws + WS_X1), args.in[0], D_MODEL};
    g8::gemm_phase<g8::EpiResF32, g8::DenseOrder, false>(F.lds, S, E, nullptr);
}
__device__ __forceinline__ void ph6_gateup(const Frame& F, const Args& args) {
    unsigned char* ws = args.ws;
    build_tpre(F);
    g8::GroupedOrder S{nullptr, (const char*)(ws + WS_WGU), (const LAS int*)(F.lds + L_TPRE), 4096 / 256, F.G, (int)blockIdx.x, (size_t)4096 * KDIM * 2, true, (const char*)(ws + WS_HN), 4096};
    g8::EpiSwiglu E{(bf16_t*)(ws + WS_ACT), args.in[17]};
    g8::gemm_phase<g8::EpiSwiglu, g8::GroupedOrder, true>(F.lds, S, E, (const int*)(ws + WS_LISTS));
}
__device__ __forceinline__ void ph7_down(const Frame& F, const Args& args) {
    unsigned char* ws = args.ws;
    build_tpre(F);
    g8::GroupedOrder S{(const char*)(ws + WS_ACT), (const char*)(ws + WS_WDN), (const LAS int*)(F.lds + L_TPRE), D_MODEL / 256, F.G, (int)blockIdx.x, (size_t)D_MODEL * KDIM * 2, false, nullptr, D_MODEL};
    g8::EpiBf16 E{(bf16_t*)(ws + WS_Y), D_MODEL, args.in[19], D_MODEL};
    g8::gemm_phase<g8::EpiBf16, g8::GroupedOrder, false>(F.lds, S, E, nullptr);
}

constexpr int N_PHASES = 9;
__global__ void __launch_bounds__(NTHR, 2) mk_fwd(Args args) {
    extern __shared__ __attribute__((aligned(16))) unsigned char lds_raw[];
    Frame F;
    F.lds = (LAS unsigned char*)lds_raw;
    F.tid = threadIdx.x; F.lane = F.tid & 63; F.wave = __builtin_amdgcn_readfirstlane(F.tid >> 6);
    F.G = gridDim.x; { const int bx = blockIdx.x; F.vcu = (F.G % 8 == 0) ? (bx % 8) * (F.G / 8) + bx / 8 : bx; }
    F.gw = F.vcu * NWAVES + F.wave; F.NGW = F.G * NWAVES;
    F.ctl = (unsigned*)(args.ws + WS_CTL);
    for (int u = F.tid; u < (LDS_BYTES - LDSCTL_OFF) / 4; u += NTHR) ((LAS unsigned*)(F.lds + LDSCTL_OFF))[u] = 0u;
    __syncthreads();
    const int lo = args.ph_lo, hi = args.ph_hi;
    XcdBarrier bar; bar.bar = F.ctl + CW_BAR; bar.x = 0; bar.st = nullptr;
    if (hi - lo > 1) bar = xcd_barrier_post(F.ctl + CW_BAR, (volatile LAS unsigned*)(F.lds + L_MISC) + 8);
#define IN(k) (lo <= (k) && (k) < hi)
#define SEAM(k) do { if (IN(k) && IN((k) + 1)) xcd_barrier(bar); } while (0)

#define PHASE(k, call) do { if (IN(k)) { call; } if ((PROBE_MASK >> (k)) & 1) { xcd_barrier(bar); if (IN(k)) { call; } } } while (0)
    PHASE(0, p0_prologue(F, args)); SEAM(0);
    PHASE(1, ph1_inproj(F, args)); SEAM(1);
    PHASE(2, p2_mixers(F, args)); SEAM(2);
    PHASE(3, p3_mix(F, args)); SEAM(3);
    PHASE(4, ph4_outproj(F, args)); SEAM(4);
    if (IN(5)) { p5_router(F, args); } SEAM(5);
    PHASE(6, ph6_gateup(F, args)); SEAM(6);
    PHASE(7, ph7_down(F, args)); SEAM(7);
    if (IN(8)) { build_tpre(F); p8_final(F, args); }
#undef IN
#undef SEAM
}

extern "C" void kernel_launch(void* const* d_in, const int* in_sizes, int n_in, void* d_out, int out_size, void* d_ws, size_t ws_size, hipStream_t stream) {
    static int grid = 0;
    if (grid == 0) {
        if (n_in != 21 || out_size != NTOK * D_MODEL || ws_size < WS_END) { fprintf(stderr, "kernel_launch: unexpected problem (n_in %d out %d ws %zu)\n", n_in, out_size, ws_size); grid = -1; return; }
        int dev = 0, cus = 0, per_cu = 0;
        if (hipGetDevice(&dev) != hipSuccess || hipDeviceGetAttribute(&cus, hipDeviceAttributeMultiprocessorCount, dev) != hipSuccess) { grid = -1; return; }
        if (hipFuncSetAttribute((const void*)mk_fwd, hipFuncAttributeMaxDynamicSharedMemorySize, LDS_BYTES) != hipSuccess) { fprintf(stderr, "kernel_launch: hipFuncSetAttribute failed\n"); grid = -1; return; }
        if (hipOccupancyMaxActiveBlocksPerMultiprocessor(&per_cu, (const void*)mk_fwd, NTHR, LDS_BYTES) != hipSuccess || per_cu < 1) { fprintf(stderr, "kernel_launch: occupancy query says %d\n", per_cu); }
        (void)hipGetLastError();
        grid = cus;
    }
    if (grid < 0) return;
    if (hipMemsetAsync((char*)d_ws + WS_CTL, 0, CTL_ZERO_BYTES, stream) != hipSuccess) return;
    Args a{};
    for (int i = 0; i < 21; ++i) a.in[i] = (const float*)d_in[i];
    a.out = (float*)d_out; a.ws = (unsigned char*)d_ws;
#if MK_N_LAUNCHES == 1
    a.ph_lo = 0; a.ph_hi = N_PHASES;
    hipLaunchKernelGGL(mk_fwd, dim3(grid), dim3(NTHR), LDS_BYTES, stream, a);
#else
    for (int p = 0; p < N_PHASES; ++p) { a.ph_lo = p; a.ph_hi = p + 1; hipLaunchKernelGGL(mk_fwd, dim3(grid), dim3(NTHR), LDS_BYTES, stream, a); }
#endif
}
```

```cpp
#include <hip/hip_runtime.h>
#include <stdint.h>
#include <stdio.h>

#ifndef MK_N_LAUNCHES
#define MK_N_LAUNCHES 1
#endif

#ifndef PROBE_MASK
#define PROBE_MASK 0
#endif
#define LAS __attribute__((address_space(3)))
#define GAS __attribute__((address_space(1)))
typedef unsigned short bf16_t;
typedef short bf16x8 __attribute__((ext_vector_type(8)));
typedef float f32x4 __attribute__((ext_vector_type(4)));
typedef float f32x2 __attribute__((ext_vector_type(2)));
typedef unsigned u32x4 __attribute__((ext_vector_type(4)));
typedef unsigned u32x2 __attribute__((ext_vector_type(2)));

constexpr int D_MODEL = 2048, BATCH = 4, SEQ = 2048, NTOK = BATCH * SEQ;
constexpr int N_HEADS = 16, ATTN_W = 1024, LRU_W = 1024;
constexpr int IN_COLS = 5120;
constexpr int N_EXP = 32, D_FF = 2048, NSLOT = NTOK * 4;
constexpr int KDIM = 2048;
constexpr float EPS = 1e-6f;
constexpr int NWAVES = 8, NTHR = 512;
constexpr int PADROWS = NSLOT + N_EXP * 256;

constexpr size_t MiB = 1u << 20;
constexpr size_t WS_CTL = 0, WS_LISTS = 1 * MiB, CTL_ZERO_BYTES = 2 * MiB;
constexpr size_t WS_SEL = 2 * MiB;
constexpr size_t WS_LRUE = 3 * MiB;
constexpr size_t WS_WIN = 4 * MiB, WS_WOUT = 24 * MiB, WS_HN = 32 * MiB, WS_PROJ = 64 * MiB, WS_ATT = 144 * MiB  , WS_HL = 192 * MiB, WS_PC = 224 * MiB;
constexpr size_t WS_MIXED = 256 * MiB, WS_X1 = 288 * MiB, WS_ACT = 352 * MiB, WS_Y = 512 * MiB, WS_WGU = 672 * MiB, WS_WDN = 1184 * MiB, WS_LSE = 1440 * MiB  , WS_END = 1442 * MiB;
static_assert((size_t)PADROWS * 2048 * 2 <= 160 * MiB, "ACT/Y size");
constexpr int CW_BAR = 4096, CW_CNT = 8192;

constexpr int RING_BYTES = 131072;
constexpr int LDSCTL_OFF = 139264;
constexpr int LDS_BYTES = 147456;
constexpr int L_MISC = LDSCTL_OFF;
constexpr int L_TPRE = LDSCTL_OFF + 256;
constexpr int L_CNT = LDSCTL_OFF + 512;

__device__ __forceinline__ unsigned f2bf(float f) { unsigned u = __builtin_bit_cast(unsigned, f); return (u + 0x7fffu + ((u >> 16) & 1u)) >> 16; }
__device__ __forceinline__ unsigned pk2(float lo, float hi) { return f2bf(lo) | (f2bf(hi) << 16); }
__device__ __forceinline__ float bf2f(unsigned short b) { return __builtin_bit_cast(float, (unsigned)b << 16); }
__device__ __forceinline__ float bflo(unsigned w) { return __builtin_bit_cast(float, w << 16); }
__device__ __forceinline__ float bfhi(unsigned w) { return __builtin_bit_cast(float, w & 0xffff0000u); }
__device__ __forceinline__ float wave_sum(float v) {
#pragma unroll
    for (int o = 1; o < 64; o <<= 1) v += __shfl_xor(v, o);
    return v;
}
__device__ __forceinline__ float wave_max(float v) {
#pragma unroll
    for (int o = 1; o < 64; o <<= 1) v = fmaxf(v, __shfl_xor(v, o));
    return v;
}
#define LDS_WAIT() asm volatile("s_waitcnt lgkmcnt(0)" ::: "memory")
#define VM_WAIT() asm volatile("s_waitcnt vmcnt(0)" ::: "memory")

#define XB_TMO      128
#define XB_XCNT(j)  (256  + 64 * (j))
#define XB_XSUB(j)  (1280 + 64 * (j))
#define XB_XGEN(j)  (2304 + 64 * (j))
#define XB_TOP      3328
#define XB_TOPGEN   3392
#define XCD_BAR_WORDS 3456
#define XB_SPIN_CAP (1u << 20)
__device__ __forceinline__ unsigned xb_ld(unsigned* p)              { return __hip_atomic_load(p, __ATOMIC_RELAXED, __HIP_MEMORY_SCOPE_AGENT); }
__device__ __forceinline__ unsigned xb_add(unsigned* p, unsigned v) { return __hip_atomic_fetch_add(p, v, __ATOMIC_RELAXED, __HIP_MEMORY_SCOPE_AGENT); }
__device__ __forceinline__ unsigned xb_xcc_id() { return (unsigned)__builtin_amdgcn_s_getreg((3 << 11) | 20) & 0xFu; }
#define XB_SPIN(cond, bar) do { unsigned _sp = 0; while (cond) { __builtin_amdgcn_s_sleep(1); \
    if ((++_sp & 255u) == 0u) { if (xb_ld(&(bar)[XB_TMO])) break; if (_sp > XB_SPIN_CAP) { atomicAdd(&(bar)[XB_TMO], 1u); break; } } } } while (0)
struct XcdBarrier { unsigned* bar; unsigned x; volatile LAS unsigned* st; };
__device__ __forceinline__ XcdBarrier xcd_barrier_post(unsigned* bar, volatile LAS unsigned* st) {
    XcdBarrier b; b.bar = bar; b.x = xb_xcc_id(); b.st = st;
    if (threadIdx.x == 0) (void)xb_add(&bar[XB_XCNT(b.x)], 1u);
    return b;
}
__device__ __forceinline__ void xcd_barrier_complete(unsigned* bar, unsigned x, unsigned& nloc, unsigned& nx) {
    const unsigned G = gridDim.x * gridDim.y * gridDim.z;
    unsigned sum, cnt, mine, sp = 0u;
    for (;;) {
        sum = 0u; cnt = 0u; mine = 0u;
#pragma unroll
        for (unsigned j = 0; j < 16; ++j) { const unsigned c = xb_ld(&bar[XB_XCNT(j)]); sum += c; cnt += (c > 0u) ? 1u : 0u; mine = (j == x) ? c : mine; }
        if (sum == G) break;
        __builtin_amdgcn_s_sleep(1);
        if ((++sp & 255u) == 0u) { if (xb_ld(&bar[XB_TMO])) break; if (sp > XB_SPIN_CAP) { atomicAdd(&bar[XB_TMO], 1u); break; } }
    }
    nloc = mine > 0u ? mine : 1u; nx = cnt > 0u ? cnt : 1u;
}
__device__ __forceinline__ void xcd_barrier(const XcdBarrier& b) {
    asm volatile("s_waitcnt vmcnt(0)" ::: "memory");
    __syncthreads();
    if (threadIdx.x == 0) {
        unsigned* bar = b.bar;
        __builtin_amdgcn_s_waitcnt(0);
        unsigned nloc = b.st[0], nx = b.st[1];
        if (nloc == 0u) { xcd_barrier_complete(bar, b.x, nloc, nx); b.st[0] = nloc; b.st[1] = nx; }
        const unsigned old = xb_add(&bar[XB_XSUB(b.x)], 1u);
        const unsigned gen = old / nloc;
        if (old + 1u == (gen + 1u) * nloc) {
            __builtin_amdgcn_fence(__ATOMIC_RELEASE, "agent");
            asm volatile("s_waitcnt vmcnt(0)" ::: "memory");
            const unsigned og = xb_add(&bar[XB_TOP], 1u);
            const unsigned tg = og / nx;
            if (og + 1u == (tg + 1u) * nx) xb_add(&bar[XB_TOPGEN], 1u);
            else XB_SPIN(xb_ld(&bar[XB_TOPGEN]) == tg, bar);
            __builtin_amdgcn_fence(__ATOMIC_ACQUIRE, "agent");
            xb_add(&bar[XB_XGEN(b.x)], 1u);
            asm volatile("s_waitcnt vmcnt(0)" ::: "memory");
        } else {
            XB_SPIN(xb_ld(&bar[XB_XGEN(b.x)]) == gen, bar);
            __builtin_amdgcn_fence(__ATOMIC_ACQUIRE, "agent");
            asm volatile("s_waitcnt vmcnt(0)" ::: "memory");
        }
    }
    __syncthreads();
}

typedef float f32x16 __attribute__((ext_vector_type(16)));
typedef short s16x4 __attribute__((ext_vector_type(4)));
typedef short v4i16_t __attribute__((ext_vector_type(4)));
__device__ __forceinline__ s16x4 vtr(const LAS unsigned char* p) { return __builtin_bit_cast(s16x4, __builtin_amdgcn_ds_read_tr16_b64_v4i16((LAS v4i16_t*)p)); }

namespace g8 {
constexpr int BM = 256, BK = 64, HALF = 128, HTB = HALF * BK * 2, STAGE_BYTES = 8 * HTB, NXCD = 8, WGM = 8;
__host__ __device__ __forceinline__ int lds_byte(int r, int c) { const int st = (r >> 4) * 2 + (c >> 5), rr = r & 15, cc = c & 31, ob = rr * 64 + cc * 2; return st * 1024 + (ob ^ (((ob >> 9) & 1) << 5)); }
__host__ __device__ __forceinline__ void stage_rc(int b, int& R, int& C) { const int st = b / 1024, sb = b % 1024, swz = sb ^ (((sb >> 9) & 1) << 5); R = (st >> 1) * 16 + swz / 64; C = (st & 1) * 32 + (swz % 64) / 2; }
__host__ __device__ __forceinline__ int perm32(int rho) { const int n = rho >> 4, i = rho & 15; return 8 * (i >> 2) + 4 * n + (i & 3); }

struct Unit { const char* a; const char* b; int crow, ccol, e, gi; };

struct DenseOrder {
    const char* A; const char* Bt; int nM, nN, nwg, G, c; int ldb;
    __device__ __forceinline__ bool next(int i, Unit& u) const {
        const long L = (long)i * G + c; if (L >= nwg) return false;
        int wgid = (int)L; { const int q = nwg / NXCD, r = nwg % NXCD, xcd = wgid % NXCD, off = wgid / NXCD; wgid = (xcd < r ? xcd * (q + 1) : r * (q + 1) + (xcd - r) * q) + off; }
        const int nig = WGM * nN, gid = wgid / nig, fm = gid * WGM, gsz = (nM - fm) < WGM ? (nM - fm) : WGM;
        const int pm = fm + ((wgid % nig) % gsz), pn = (wgid % nig) / gsz;
        u.a = A + (size_t)pm * BM * KDIM * 2; u.b = Bt + (size_t)pn * BM * 2; u.crow = pm * BM; u.ccol = pn * BM; u.e = 0; u.gi = 0; return true;
    }
};
struct GroupedOrder {
    const char* A; const char* Bt; const LAS int* tpre; int nN, G, c; size_t bstride;
    bool gather; const char* Asrc; int ldb;
    __device__ __forceinline__ bool next(int i, Unit& u) const {
        const int total = tpre[N_EXP] * nN; const long L = (long)i * G + c; if (L >= total) return false;
        const int mtile = (int)L / nN, nt = (int)L % nN;
        int e = 0; while (mtile >= tpre[e + 1]) ++e;
        const int mt = mtile - tpre[e];
        u.a = gather ? Asrc : A + (size_t)mtile * BM * KDIM * 2;
        u.b = Bt + (size_t)e * bstride + (size_t)nt * BM * 2; u.crow = mtile * BM; u.ccol = nt * BM; u.e = e; u.gi = e * NTOK + mt * BM; return true;
    }
};

__device__ __forceinline__ unsigned cvt_pk_bf16(float lo, float hi) { unsigned r; asm volatile("v_cvt_pk_bf16_f32 %0, %1, %2" : "=v"(r) : "v"(lo), "v"(hi)); return r; }

struct EpiBf16 {
    bf16_t* O; int ldc; const float* bias; int bias_stride;
    __device__ __forceinline__ void operator()(const f32x4 (&acc)[2][2][4][2], const Unit& u, int wr, int wc, int fr, int fq) const {
        const int row0 = u.crow + wr * 64 + fr, col0 = u.ccol + wc * 32 + 4 * fq;
        f32x4 bv[2][2];
#pragma unroll
        for (int bj = 0; bj < 2; ++bj)
#pragma unroll
            for (int n = 0; n < 2; ++n) bv[bj][n] = bias ? *(const f32x4*)(bias + (size_t)u.e * bias_stride + col0 + bj * HALF + 16 * n) : (f32x4){0.f, 0.f, 0.f, 0.f};
#pragma unroll
        for (int ai = 0; ai < 2; ++ai)
#pragma unroll
            for (int m = 0; m < 4; ++m) { bf16_t* rowp = O + (size_t)(row0 + ai * HALF + m * 16) * ldc + col0;
#pragma unroll
                for (int bj = 0; bj < 2; ++bj)
#pragma unroll
                    for (int n = 0; n < 2; ++n) { const f32x4 v = acc[ai][bj][m][n] + bv[bj][n];
                        u32x2 w; w.x = cvt_pk_bf16(v[0], v[1]); w.y = cvt_pk_bf16(v[2], v[3]);
                        *(u32x2*)(rowp + bj * HALF + 16 * n) = w; } }
    }
};
struct EpiResF32 {
    float* C; const float* res; int ldc;
    __device__ __forceinline__ void operator()(const f32x4 (&acc)[2][2][4][2], const Unit& u, int wr, int wc, int fr, int fq) const {
        const int row0 = u.crow + wr * 64 + fr, col0 = u.ccol + wc * 32 + 4 * fq;
#pragma unroll
        for (int ai = 0; ai < 2; ++ai)
#pragma unroll
            for (int m = 0; m < 4; ++m) { const size_t off = (size_t)(row0 + ai * HALF + m * 16) * ldc + col0;
#pragma unroll
                for (int bj = 0; bj < 2; ++bj)
#pragma unroll
                    for (int n = 0; n < 2; ++n) { const f32x4 r = *(const f32x4*)(res + off + bj * HALF + n * 16); *(f32x4*)(C + off + bj * HALF + n * 16) = acc[ai][bj][m][n] + r; } }
    }
};
struct EpiSwiglu {
    bf16_t* O; const float* bias;
    __device__ __forceinline__ float act(float g, float up) const {
        g = fminf(g, 7.0f); up = fminf(fmaxf(up, -7.0f), 7.0f);
        const float sg = 1.0f / (1.0f + __expf(-1.702f * g));
        return g * sg * (up + 1.0f);
    }
    __device__ __forceinline__ void operator()(const f32x4 (&acc)[2][2][4][2], const Unit& u, int wr, int wc, int fr, int fq) const {
        const int row0 = u.crow + wr * 64 + fr, col0 = u.ccol + wc * 32 + 4 * fq;
        f32x4 bv[2][2];
#pragma unroll
        for (int bj = 0; bj < 2; ++bj)
#pragma unroll
            for (int n = 0; n < 2; ++n) bv[bj][n] = *(const f32x4*)(bias + (size_t)u.e * (2 * D_FF) + col0 + bj * HALF + 16 * n);
#pragma unroll
        for (int ai = 0; ai < 2; ++ai)
#pragma unroll
            for (int m = 0; m < 4; ++m) { bf16_t* rowp = O + (size_t)(row0 + ai * HALF + m * 16) * D_FF + (col0 >> 1);
#pragma unroll
                for (int bj = 0; bj < 2; ++bj)
#pragma unroll
                    for (int n = 0; n < 2; ++n) { const f32x4 v = acc[ai][bj][m][n] + bv[bj][n];
                        *(unsigned*)(rowp + bj * (HALF / 2) + 8 * n) = cvt_pk_bf16(act(v[0], v[1]), act(v[2], v[3])); } }
    }
};

template <class Epi, class Sched, bool GATHER>
__device__ __forceinline__ void gemm_phase(LAS unsigned char* lds, const Sched& S, const Epi& E, const int* __restrict__ lists) {
    const int tid = threadIdx.x, wid = __builtin_amdgcn_readfirstlane(tid >> 6), lane = tid & 63, wr = wid >> 2, wc = wid & 3, fr = lane & 15, fq = lane >> 4;
    constexpr int K = KDIM, nt = K / BK;
    unsigned voffA[2], voffB[2]; int gR[2], gC[2];
    const int ldb = S.ldb;
#pragma unroll
    for (int i = 0; i < 2; ++i) { int R, C; stage_rc(tid * 16 + i * 8192, R, C);
        voffA[i] = (unsigned)(R * K + C) * 2u; gR[i] = R; gC[i] = C;
        const int P = tid + 512 * i, kk = P >> 4, pos = P & 15, ch = pos ^ (2 * ((kk & 3) + 4 * ((kk >> 3) & 1)));
        voffB[i] = (unsigned)(kk * ldb + ch * 8) * 2u; }
    constexpr size_t kstep = (size_t)(BK * 2);
    constexpr size_t hstep = (size_t)HALF * K * 2;
    const size_t kstepB = (size_t)BK * ldb * 2;
    constexpr size_t hstepB = 256;
    const unsigned ldsw = (unsigned)wid * 1024u;
    const int aoff = lds_byte(wr * 64 + fr, fq * 8);
    int bb[2];
    { const int q = (lane & 15) >> 2, p = lane & 3, f = 2 * (q + 4 * (fq & 1));
#pragma unroll
      for (int nf = 0; nf < 2; ++nf) { const int ch = 4 * wc + 2 * nf + (p >> 1); bb[nf] = (8 * fq + q) * 256 + ((ch ^ f) * 16) + (p & 1) * 8; } }
#define G8_SA(b, h) (((b) * 2 + (h)) * HTB)
#define G8_SB(b, h) ((4 + (b) * 2 + (h)) * HTB)
#define G8_STAGE(bufoff, gbase, v0, v1) do { \
        __builtin_amdgcn_global_load_lds((const unsigned*)((const char*)(gbase) + (v0)), (LAS unsigned*)(lds + (bufoff) + ldsw), 16, 0, 0); \
        __builtin_amdgcn_global_load_lds((const unsigned*)((const char*)(gbase) + (v1)), (LAS unsigned*)(lds + (bufoff) + ldsw + 8192), 16, 0, 0); } while (0)
#define G8_STAGE_B(bufoff, gbase) G8_STAGE(bufoff, gbase, voffB[0], voffB[1])
#define G8_STAGE_A(bufoff, gbase, h, ga0, ga1) do { if (GATHER) G8_STAGE(bufoff, gbase, ga0, ga1); else G8_STAGE(bufoff, (gbase) + (h) * hstep, voffA[0], voffA[1]); } while (0)
#define G8_LDA(dst, b, h) do { _Pragma("unroll") for (int m = 0; m < 4; ++m) _Pragma("unroll") for (int k = 0; k < 2; ++k) dst[m][k] = *(const LAS bf16x8*)(lds + G8_SA(b, h) + aoff + m * 2048 + k * 1024); } while (0)
#define G8_TR(dst, addr, off) asm volatile("ds_read_b64_tr_b16 %0, %1 offset:%2" : "=v"(dst) : "v"(addr), "i"(off) : "memory")
#define G8_LDB(lo, hi, b, h) do { _Pragma("unroll") for (int n = 0; n < 2; ++n) { const unsigned _ad = ldsbase + (unsigned)(G8_SB(b, h)) + (unsigned)bb[n]; \
        G8_TR(lo[n][0], _ad, 0); G8_TR(hi[n][0], _ad, 1024); G8_TR(lo[n][1], _ad, 8192); G8_TR(hi[n][1], _ad, 9216); } } while (0)
#define G8_BF(lo, hi, n, k) __builtin_shufflevector(lo[n][k], hi[n][k], 0, 1, 2, 3, 4, 5, 6, 7)
#define G8_MMA(ai, bj, At, Bl, Bh) do { __builtin_amdgcn_s_setprio(1); _Pragma("unroll") for (int m = 0; m < 4; ++m) _Pragma("unroll") for (int n = 0; n < 2; ++n) _Pragma("unroll") for (int k = 0; k < 2; ++k) \
        acc[ai][bj][m][n] = __builtin_amdgcn_mfma_f32_16x16x32_bf16(G8_BF(Bl, Bh, n, k), At[m][k], acc[ai][bj][m][n], 0, 0, 0); __builtin_amdgcn_s_setprio(0); } while (0)
#define G8_WAIT_V(n) asm volatile("s_waitcnt vmcnt(" #n ")" ::: "memory")
#define G8_WAIT_L(n) do { asm volatile("s_waitcnt lgkmcnt(" #n ")" ::: "memory"); __builtin_amdgcn_sched_barrier(0); } while (0)
#define G8_BAR __builtin_amdgcn_s_barrier()
#define G8_SCHED __builtin_amdgcn_sched_barrier(0)
    Unit cur, nxt; int ui = 0;
    if (!S.next(0, cur)) return;
    f32x4 acc[2][2][4][2];
#pragma unroll
    for (int a = 0; a < 2; ++a)
#pragma unroll
        for (int b = 0; b < 2; ++b)
#pragma unroll
            for (int m = 0; m < 4; ++m)
#pragma unroll
                for (int n = 0; n < 2; ++n) acc[a][b][m][n] = (f32x4){0.f, 0.f, 0.f, 0.f};
    bf16x8 At[4][2]; s16x4 B0l[2][2], B0h[2][2], B1l[2][2], B1h[2][2];
    const unsigned ldsbase = (unsigned)(size_t)lds;
    unsigned c00 = 0, c01 = 0, c10 = 0, c11 = 0, n00 = 0, n01 = 0, n10 = 0, n11 = 0;
    if (GATHER) {
        c00 = (unsigned)(lists[cur.gi + gR[0]] * K + gC[0]) * 2u; c01 = (unsigned)(lists[cur.gi + gR[1]] * K + gC[1]) * 2u;
        c10 = (unsigned)(lists[cur.gi + HALF + gR[0]] * K + gC[0]) * 2u; c11 = (unsigned)(lists[cur.gi + HALF + gR[1]] * K + gC[1]) * 2u;
    }
    const char* cA = cur.a; const char* cB = cur.b;
    G8_STAGE_B(G8_SB(0, 0), cB); G8_STAGE_A(G8_SA(0, 0), cA, 0, c00, c01); G8_STAGE_B(G8_SB(0, 1), cB + hstepB); G8_STAGE_A(G8_SA(0, 1), cA, 1, c10, c11);
    if (wr == 1) G8_BAR;
    G8_WAIT_V(4); G8_BAR;
    G8_STAGE_B(G8_SB(1, 0), cB + kstepB); G8_STAGE_A(G8_SA(1, 0), cA + kstep, 0, c00, c01); G8_STAGE_B(G8_SB(1, 1), cB + hstepB + kstepB);
    G8_WAIT_V(6); G8_BAR;
    for (;;) {
        const bool has_next = S.next(ui + 1, nxt);
        const char* nA = has_next ? nxt.a : cA; const char* nB = has_next ? nxt.b : cB;
        for (int t = 0; t < nt; t += 2) {
            const bool last = (t == nt - 2);
            if (GATHER) {
                if (last) {
                    if (has_next) {
                        n00 = (unsigned)(lists[nxt.gi + gR[0]] * K + gC[0]) * 2u; n01 = (unsigned)(lists[nxt.gi + gR[1]] * K + gC[1]) * 2u;
                        n10 = (unsigned)(lists[nxt.gi + HALF + gR[0]] * K + gC[0]) * 2u; n11 = (unsigned)(lists[nxt.gi + HALF + gR[1]] * K + gC[1]) * 2u;
                    } else { n00 = c00; n01 = c01; n10 = c10; n11 = c11; }
                }
            }
            const char* a1 = cA + (size_t)(t + 1) * kstep;
            const char* a2 = last ? nA : cA + (size_t)(t + 2) * kstep; const char* b2 = last ? nB : cB + (size_t)(t + 2) * kstepB;
            const char* a3 = a2 + kstep; const char* b3 = b2 + kstepB;
            const unsigned x00 = last ? n00 : c00, x01 = last ? n01 : c01, x10 = last ? n10 : c10, x11 = last ? n11 : c11;
            G8_LDB(B0l, B0h, 0, 0); G8_SCHED; G8_LDA(At, 0, 0); G8_STAGE_A(G8_SA(1, 1), a1, 1, c10, c11);
            G8_WAIT_L(8); G8_BAR; G8_WAIT_L(0); G8_MMA(0, 0, At, B0l, B0h); G8_BAR; G8_SCHED;
            G8_LDB(B1l, B1h, 0, 1); G8_STAGE_B(G8_SB(0, 0), b2);
            G8_BAR; G8_WAIT_L(0); G8_MMA(0, 1, At, B1l, B1h); G8_BAR;
            G8_LDA(At, 0, 1); G8_STAGE_A(G8_SA(0, 0), a2, 0, x00, x01);
            G8_BAR; G8_WAIT_L(0); G8_MMA(1, 0, At, B0l, B0h); G8_BAR; G8_SCHED;
            G8_STAGE_B(G8_SB(0, 1), b2 + hstepB);
            G8_WAIT_V(6); G8_BAR; G8_MMA(1, 1, At, B1l, B1h); G8_BAR;
            G8_LDB(B0l, B0h, 1, 0); G8_SCHED; G8_LDA(At, 1, 0); G8_STAGE_A(G8_SA(0, 1), a2, 1, x10, x11);
            G8_WAIT_L(8); G8_BAR; G8_WAIT_L(0); G8_MMA(0, 0, At, B0l, B0h); G8_BAR; G8_SCHED;
            G8_LDB(B1l, B1h, 1, 1); G8_STAGE_B(G8_SB(1, 0), b3);
            G8_BAR; G8_WAIT_L(0); G8_MMA(0, 1, At, B1l, B1h); G8_BAR;
            G8_LDA(At, 1, 1); G8_STAGE_A(G8_SA(1, 0), a3, 0, x00, x01);
            G8_BAR; G8_WAIT_L(0); G8_MMA(1, 0, At, B0l, B0h); G8_BAR; G8_SCHED;
            G8_STAGE_B(G8_SB(1, 1), b3 + hstepB);
            G8_WAIT_V(6); G8_BAR; G8_MMA(1, 1, At, B1l, B1h); G8_BAR;
        }
        E(acc, cur, wr, wc, fr, fq);
        if (!has_next) break;
#pragma unroll
        for (int a = 0; a < 2; ++a)
#pragma unroll
            for (int b = 0; b < 2; ++b)
#pragma unroll
                for (int m = 0; m < 4; ++m)
#pragma unroll
                    for (int n = 0; n < 2; ++n) acc[a][b][m][n] = (f32x4){0.f, 0.f, 0.f, 0.f};
        cur = nxt; cA = nA; cB = nB; ++ui;
        if (GATHER) { c00 = n00; c01 = n01; c10 = n10; c11 = n11; }
    }
    G8_WAIT_V(0);
    if (wr == 0) G8_BAR;
    G8_BAR;
#undef G8_SA
#undef G8_SB
#undef G8_STAGE
#undef G8_STAGE_A
#undef G8_STAGE_B
#undef G8_LDA
#undef G8_LDB
#undef G8_TR
#undef G8_BF
#undef G8_MMA
#undef G8_WAIT_V
#undef G8_WAIT_L
#undef G8_BAR
#undef G8_SCHED
}
}

struct Frame {
    LAS unsigned char* lds;
    unsigned* ctl;
    int tid, lane, wave, vcu, G, gw, NGW;
};
struct Args { const float* in[21]; float* out; unsigned char* ws; int ph_lo, ph_hi; };

constexpr long CV_IN = (long)KDIM * IN_COLS / 512, CV_OUT = (long)KDIM * D_MODEL / 512, CV_GU = (long)N_EXP * KDIM * 4096 / 512, CV_DN = (long)N_EXP * KDIM * D_MODEL / 512;
__device__ __forceinline__ void conv_chunks(const float* __restrict__ src, bf16_t* __restrict__ dst, long c0, long c1, int gw, int NGW, int lane) {
    long c = c0 + gw;
    for (; c + 7L * NGW < c1; c += 8L * NGW) {
        f32x4 a[8], b[8];
#pragma unroll
        for (int i = 0; i < 8; ++i) { const f32x4* p = (const f32x4*)(src + (c + (long)i * NGW) * 512 + lane * 8); a[i] = __builtin_nontemporal_load(p); b[i] = __builtin_nontemporal_load(p + 1); }
#pragma unroll
        for (int i = 0; i < 8; ++i) { u32x4 w; w.x = pk2(a[i][0], a[i][1]); w.y = pk2(a[i][2], a[i][3]); w.z = pk2(b[i][0], b[i][1]); w.w = pk2(b[i][2], b[i][3]);
            __builtin_nontemporal_store(w, (u32x4*)(dst + (c + (long)i * NGW) * 512 + lane * 8)); }
    }
    for (; c < c1; c += NGW) { const f32x4* p = (const f32x4*)(src + c * 512 + lane * 8); const f32x4 a = __builtin_nontemporal_load(p), b = __builtin_nontemporal_load(p + 1);
        u32x4 w; w.x = pk2(a[0], a[1]); w.y = pk2(a[2], a[3]); w.z = pk2(b[0], b[1]); w.w = pk2(b[2], b[3]); __builtin_nontemporal_store(w, (u32x4*)(dst + c * 512 + lane * 8)); }
}
__device__ __forceinline__ void rms_row_bf16(const float* xrow, const float* g, bf16_t* orow, int lane) {
    const f32x4* xr = (const f32x4*)xrow + lane; const f32x4* gr = (const f32x4*)g + lane;
    f32x4 v[8]; float s = 0.f;
#pragma unroll
    for (int j = 0; j < 8; ++j) { v[j] = xr[64 * j]; s += (v[j][0] * v[j][0] + v[j][1] * v[j][1]) + (v[j][2] * v[j][2] + v[j][3] * v[j][3]); }
    const float rs = rsqrtf(wave_sum(s) * (1.0f / 2048.0f) + EPS);
    u32x2* o = (u32x2*)orow + lane;
#pragma unroll
    for (int j = 0; j < 8; ++j) { const f32x4 gg = gr[64 * j]; u32x2 w; w.x = pk2(v[j][0] * rs * gg[0], v[j][1] * rs * gg[1]); w.y = pk2(v[j][2] * rs * gg[2], v[j][3] * rs * gg[3]); o[64 * j] = w; }
}
__device__ __forceinline__ void p0_prologue(const Frame& F, const Args& a) {
    conv_chunks(a.in[2], (bf16_t*)(a.ws + WS_WIN), 0, CV_IN, F.gw, F.NGW, F.lane);
    conv_chunks(a.in[12], (bf16_t*)(a.ws + WS_WOUT), 0, CV_OUT, F.gw, F.NGW, F.lane);
    conv_chunks(a.in[16], (bf16_t*)(a.ws + WS_WGU), 0, CV_GU, F.gw, F.NGW, F.lane);
    conv_chunks(a.in[18], (bf16_t*)(a.ws + WS_WDN), 0, CV_DN, F.gw, F.NGW, F.lane);
    bf16_t* HN = (bf16_t*)(a.ws + WS_HN);
    for (int m = F.gw; m < NTOK; m += F.NGW) rms_row_bf16(a.in[0] + (size_t)m * D_MODEL, a.in[1], HN + (size_t)m * D_MODEL, F.lane);
}

__device__ __forceinline__ float gelu_tanh(float x) { return 0.5f * x * (1.0f + tanhf(0.7978845608028654f * (x + 0.044715f * x * x * x))); }
__device__ __forceinline__ float sigmoidf_(float x) { return 1.0f / (1.0f + __expf(-x)); }
__device__ __forceinline__ void lru_unit(const Frame& F, const Args& a, int unit) {
    const int lane = F.lane;
    const int b = unit >> 9, k = (unit >> 4) & 31, blk = unit & 15;
    const bf16_t* proj = (const bf16_t*)(a.ws + WS_PROJ);
    LAS float* xs = (LAS float*)(F.lds + F.wave * 16384);
    const int ch = blk * 64 + lane;
    const float cw0 = a.in[3][0 * LRU_W + ch], cw1 = a.in[3][1 * LRU_W + ch], cw2 = a.in[3][2 * LRU_W + ch], cw3 = a.in[3][3 * LRU_W + ch], cb = a.in[4][ch];
    const int t0 = k * 64; const size_t row0 = (size_t)b * SEQ + t0;
    const bf16_t* xp = proj + row0 * IN_COLS + 3 * ATTN_W + ch;
    float x0 = (t0 >= 3) ? bf2f(xp[-3 * IN_COLS]) : 0.f, x1 = (t0 >= 2) ? bf2f(xp[-2 * IN_COLS]) : 0.f, x2 = (t0 >= 1) ? bf2f(xp[-1 * IN_COLS]) : 0.f;
    for (int t = 0; t < 64; ++t) {
        const float x3 = bf2f(xp[(size_t)t * IN_COLS]);
        xs[t * 64 + lane] = cb + cw0 * x0 + cw1 * x1 + cw2 * x2 + cw3 * x3;
        x0 = x1; x1 = x2; x2 = x3;
    }
    float wa[64], wx[64];
    const float* wap = a.in[5] + (size_t)blk * 4096 + lane; const float* wxp = a.in[7] + (size_t)blk * 4096 + lane;
#pragma unroll
    for (int c = 0; c < 64; ++c) { wa[c] = wap[c * 64]; wx[c] = wxp[c * 64]; }
    const float ba = a.in[6][ch], bx = a.in[8][ch];
    const float sp = log1pf(__expf(-a.in[9][ch]));
    float* hl = (float*)(a.ws + WS_HL) + row0 * LRU_W + ch; float* pc = (float*)(a.ws + WS_PC) + row0 * LRU_W + ch;
    LDS_WAIT();
    float h = 0.f, P = 1.f;
    for (int t = 0; t < 64; ++t) {
        float r = ba, ii = bx;
        const LAS f32x4* xr = (const LAS f32x4*)(xs + t * 64);
#pragma unroll
        for (int c4 = 0; c4 < 16; ++c4) { const f32x4 xv = xr[c4];
            r = fmaf(xv[0], wa[4 * c4], r); r = fmaf(xv[1], wa[4 * c4 + 1], r); r = fmaf(xv[2], wa[4 * c4 + 2], r); r = fmaf(xv[3], wa[4 * c4 + 3], r);
            ii = fmaf(xv[0], wx[4 * c4], ii); ii = fmaf(xv[1], wx[4 * c4 + 1], ii); ii = fmaf(xv[2], wx[4 * c4 + 2], ii); ii = fmaf(xv[3], wx[4 * c4 + 3], ii); }
        r = sigmoidf_(r); ii = sigmoidf_(ii);
        const float log_a = -8.0f * r * sp;
        const float av = __expf(log_a);
        const float bv = sqrtf(-expm1f(2.0f * log_a)) * (ii * xs[t * 64 + lane]);
        h = av * h + bv; P *= av;
        hl[(size_t)t * LRU_W] = h; pc[(size_t)t * LRU_W] = P;
    }
    float* ae = (float*)(a.ws + WS_LRUE); float* he = ae + 4 * 32 * 1024;
    ae[(size_t)(b * 32 + k) * 1024 + ch] = P; he[(size_t)(b * 32 + k) * 1024 + ch] = h;
    LDS_WAIT();
}
constexpr int VP = 192;
__device__ __forceinline__ void attn_unit(const Frame& F, const Args& a, int u) {
    const int lane = F.lane, c = lane & 31, hh = lane >> 5;
    const int br = u >> 12, rem = u & 4095, bh = rem >> 6, qt = rem & 63;
    const int b = bh >> 4, h = bh & 15;
    const int dsh = br * 2, d = 1 << dsh;
    const int r = qt & (d - 1), ltile = qt >> dsh, l0 = ltile * 32;
    const bf16_t* proj = (const bf16_t*)(a.ws + WS_PROJ) + (size_t)b * SEQ * IN_COLS + h * 64;
    LAS unsigned char* vl = F.lds + F.wave * 16384;
    bf16x8 qf[4];
    { const bf16_t* qrow = proj + (size_t)((l0 + c) * d + r) * IN_COLS + 8 * hh;
#pragma unroll
      for (int s = 0; s < 4; ++s) qf[s] = *(const bf16x8*)(qrow + 16 * s); }
    constexpr float LOG2E = 1.4426950408889634f;
    const float slope2 = exp2f(-0.5f * (float)(h + 1)) * LOG2E * (float)d;
    const float sc2 = 0.125f * LOG2E;
    float m = -INFINITY, lsum = 0.f;
    f32x16 o0, o1;
#pragma unroll
    for (int i = 0; i < 16; ++i) { o0[i] = 0.f; o1[i] = 0.f; }
    const int jfirst = ltile >= 4 ? 0 : 4 - ltile;
    bf16x8 kf[4], kn[4]; u32x4 vr[4], vn[4];
    const int vrow = lane >> 3, vch = lane & 7;
    { const int lk0 = l0 - 128 + 32 * jfirst;
      const bf16_t* krow = proj + (size_t)((lk0 + c) * d + r) * IN_COLS + ATTN_W + 8 * hh;
#pragma unroll
      for (int s = 0; s < 4; ++s) kf[s] = *(const bf16x8*)(krow + 16 * s);
#pragma unroll
      for (int i = 0; i < 4; ++i) vr[i] = *(const u32x4*)(proj + (size_t)((lk0 + vrow + 8 * i) * d + r) * IN_COLS + 2 * ATTN_W + vch * 8); }
    const LAS unsigned char* vtr_base = vl + (4 * hh + ((lane & 15) >> 2)) * VP + (16 * ((lane >> 4) & 1) + 4 * (lane & 3)) * 2;
    for (int j = jfirst; j <= 4; ++j) {
        if (j < 4) { const int lk0 = l0 - 128 + 32 * (j + 1);
            const bf16_t* krow = proj + (size_t)((lk0 + c) * d + r) * IN_COLS + ATTN_W + 8 * hh;
#pragma unroll
            for (int s = 0; s < 4; ++s) kn[s] = *(const bf16x8*)(krow + 16 * s);
#pragma unroll
            for (int i = 0; i < 4; ++i) vn[i] = *(const u32x4*)(proj + (size_t)((lk0 + vrow + 8 * i) * d + r) * IN_COLS + 2 * ATTN_W + vch * 8); }
#pragma unroll
        for (int i = 0; i < 4; ++i) *(LAS u32x4*)(vl + (vrow + 8 * i) * VP + vch * 16) = vr[i];
        f32x16 sa;
#pragma unroll
        for (int i = 0; i < 16; ++i) sa[i] = 0.f;
#pragma unroll
        for (int s = 0; s < 4; ++s) sa = __builtin_amdgcn_mfma_f32_32x32x16_bf16(kf[s], qf[s], sa, 0, 0, 0);
        const float relbase = (float)(c + 128 - 32 * j);
        float mx = -INFINITY;
#pragma unroll
        for (int i = 0; i < 16; ++i) { const int ki = (i & 3) + 8 * (i >> 2) + 4 * hh;
            float v = sa[i] * sc2 - slope2 * (relbase - (float)ki);
            const bool valid = (j == 0) ? (ki >= c) : ((j == 4) ? (ki <= c) : true);
            v = valid ? v : -INFINITY; sa[i] = v; mx = fmaxf(mx, v); }
        mx = fmaxf(mx, __shfl_xor(mx, 32));
        const float mnew = fmaxf(m, mx);
        const float alpha = __builtin_amdgcn_exp2f(m - mnew);
        float ps = 0.f;
#pragma unroll
        for (int i = 0; i < 16; ++i) { const float p = __builtin_amdgcn_exp2f(sa[i] - mnew); sa[i] = p; ps += p; }
        ps += __shfl_xor(ps, 32);
        lsum = lsum * alpha + ps; m = mnew;
#pragma unroll
        for (int i = 0; i < 16; ++i) { o0[i] *= alpha; o1[i] *= alpha; }
        bf16x8 pf[2];
#pragma unroll
        for (int s = 0; s < 2; ++s) { u32x4 w; w.x = g8::cvt_pk_bf16(sa[8 * s + 0], sa[8 * s + 1]); w.y = g8::cvt_pk_bf16(sa[8 * s + 2], sa[8 * s + 3]); w.z = g8::cvt_pk_bf16(sa[8 * s + 4], sa[8 * s + 5]); w.w = g8::cvt_pk_bf16(sa[8 * s + 6], sa[8 * s + 7]);
            pf[s] = __builtin_bit_cast(bf16x8, w); }
#pragma unroll
        for (int s = 0; s < 2; ++s) {
#pragma unroll
            for (int nt = 0; nt < 2; ++nt) {
                const s16x4 lo = vtr(vtr_base + (16 * s) * VP + nt * 64), hi = vtr(vtr_base + (16 * s + 8) * VP + nt * 64);
                bf16x8 af; af[0] = lo[0]; af[1] = lo[1]; af[2] = lo[2]; af[3] = lo[3]; af[4] = hi[0]; af[5] = hi[1]; af[6] = hi[2]; af[7] = hi[3];
                if (nt == 0) o0 = __builtin_amdgcn_mfma_f32_32x32x16_bf16(af, pf[s], o0, 0, 0, 0); else o1 = __builtin_amdgcn_mfma_f32_32x32x16_bf16(af, pf[s], o1, 0, 0, 0);
            }
        }
#pragma unroll
        for (int s = 0; s < 4; ++s) { kf[s] = kn[s]; vr[s] = vn[s]; }
    }
    const float inv = 1.0f / lsum;
    const size_t tok = (size_t)b * SEQ + (size_t)((l0 + c) * d + r);
    bf16_t* orow = (bf16_t*)(a.ws + WS_ATT) + ((size_t)br * NTOK + tok) * ATTN_W + h * 64 + 4 * hh;
#pragma unroll
    for (int g = 0; g < 4; ++g) {
        u32x2 w0, w1;
        w0.x = g8::cvt_pk_bf16(o0[4 * g] * inv, o0[4 * g + 1] * inv); w0.y = g8::cvt_pk_bf16(o0[4 * g + 2] * inv, o0[4 * g + 3] * inv);
        w1.x = g8::cvt_pk_bf16(o1[4 * g] * inv, o1[4 * g + 1] * inv); w1.y = g8::cvt_pk_bf16(o1[4 * g + 2] * inv, o1[4 * g + 3] * inv);
        *(u32x2*)(orow + 8 * g) = w0; *(u32x2*)(orow + 32 + 8 * g) = w1;
    }
    if (hh == 0) ((float*)(a.ws + WS_LSE))[((size_t)br * NTOK + tok) * 16 + h] = 0.6931471805599453f * (m + __builtin_amdgcn_logf(lsum));
}
__device__ __forceinline__ void p2_mixers(const Frame& F, const Args& a) {
    for (int u = F.gw; u < 2048; u += F.NGW) lru_unit(F, a, u);
    for (int u = F.gw; u < 3 * 4096; u += F.NGW) attn_unit(F, a, u);
}

__device__ __forceinline__ void p3_mix(const Frame& F, const Args& a) {
    LAS float* Hin = (LAS float*)F.lds;
    const float* ae = (const float*)(a.ws + WS_LRUE); const float* he = ae + 4 * 32 * 1024;
    const bf16_t* proj = (const bf16_t*)(a.ws + WS_PROJ);
    bf16_t* mixed = (bf16_t*)(a.ws + WS_MIXED);
    for (int grp = F.vcu; grp < NTOK / 32; grp += F.G) {
        const int tok0 = grp * 32, b = tok0 / SEQ, k = (tok0 % SEQ) / 64;
        __syncthreads();
        for (int d = F.tid; d < LRU_W; d += NTHR) { float H = 0.f;
            for (int j0 = 0; j0 < k; j0 += 8) { float av[8], hv[8];
#pragma unroll
                for (int jj = 0; jj < 8; ++jj) { const bool ok = (j0 + jj) < k; const size_t o = (size_t)(b * 32 + (ok ? j0 + jj : 0)) * 1024 + d; const float a1 = ae[o], h1 = he[o]; av[jj] = ok ? a1 : 1.0f; hv[jj] = ok ? h1 : 0.0f; }
#pragma unroll
                for (int jj = 0; jj < 8; ++jj) H = av[jj] * H + hv[jj]; }
            Hin[d] = H; }
        __syncthreads();
        for (int tt = F.wave; tt < 32; tt += NWAVES) {
            const size_t tok = (size_t)tok0 + tt;
            { const bf16_t* ao = (const bf16_t*)(a.ws + WS_ATT); const float* lse = (const float*)(a.ws + WS_LSE); const f32x4* gr = (const f32x4*)a.in[10] + F.lane;
              f32x4 v[4]; float s = 0.f;
#pragma unroll
              for (int j = 0; j < 4; ++j) { const int hd = (F.lane >> 4) + 4 * j;
                  const float l0 = lse[(0 * (size_t)NTOK + tok) * 16 + hd], l1 = lse[(1 * (size_t)NTOK + tok) * 16 + hd], l2 = lse[(2 * (size_t)NTOK + tok) * 16 + hd];
                  const float M = fmaxf(l0, fmaxf(l1, l2)); float w0 = __expf(l0 - M), w1 = __expf(l1 - M), w2 = __expf(l2 - M); const float iw = 1.0f / (w0 + w1 + w2); w0 *= iw; w1 *= iw; w2 *= iw;
                  const u32x2 a0 = *((const u32x2*)(ao + (0 * (size_t)NTOK + tok) * ATTN_W) + F.lane + 64 * j), a1 = *((const u32x2*)(ao + (1 * (size_t)NTOK + tok) * ATTN_W) + F.lane + 64 * j), a2 = *((const u32x2*)(ao + (2 * (size_t)NTOK + tok) * ATTN_W) + F.lane + 64 * j);
                  v[j][0] = w0 * bflo(a0.x) + w1 * bflo(a1.x) + w2 * bflo(a2.x); v[j][1] = w0 * bfhi(a0.x) + w1 * bfhi(a1.x) + w2 * bfhi(a2.x);
                  v[j][2] = w0 * bflo(a0.y) + w1 * bflo(a1.y) + w2 * bflo(a2.y); v[j][3] = w0 * bfhi(a0.y) + w1 * bfhi(a1.y) + w2 * bfhi(a2.y);
                  s += (v[j][0] * v[j][0] + v[j][1] * v[j][1]) + (v[j][2] * v[j][2] + v[j][3] * v[j][3]); }
              const float rs = rsqrtf(wave_sum(s) * (1.0f / 1024.0f) + EPS);
              u32x2* o = (u32x2*)(mixed + tok * D_MODEL) + F.lane;
#pragma unroll
              for (int j = 0; j < 4; ++j) { const f32x4 g = gr[64 * j]; u32x2 w; w.x = pk2(v[j][0] * rs * g[0], v[j][1] * rs * g[1]); w.y = pk2(v[j][2] * rs * g[2], v[j][3] * rs * g[3]); o[64 * j] = w; } }
            { const f32x4* hr = (const f32x4*)((const float*)(a.ws + WS_HL) + tok * LRU_W) + F.lane; const f32x4* pr = (const f32x4*)((const float*)(a.ws + WS_PC) + tok * LRU_W) + F.lane;
              const u32x2* gp = (const u32x2*)(proj + tok * IN_COLS + 3 * ATTN_W + LRU_W) + F.lane; const f32x4* gr = (const f32x4*)a.in[11] + F.lane;
              f32x4 v[4]; float s = 0.f;
#pragma unroll
              for (int j = 0; j < 4; ++j) { const f32x4 hv = hr[64 * j], pv = pr[64 * j]; const u32x2 gw = gp[64 * j]; const f32x4 hi = *(const LAS f32x4*)(Hin + (F.lane + 64 * j) * 4);
                  v[j][0] = (hv[0] + pv[0] * hi[0]) * gelu_tanh(bflo(gw.x)); v[j][1] = (hv[1] + pv[1] * hi[1]) * gelu_tanh(bfhi(gw.x));
                  v[j][2] = (hv[2] + pv[2] * hi[2]) * gelu_tanh(bflo(gw.y)); v[j][3] = (hv[3] + pv[3] * hi[3]) * gelu_tanh(bfhi(gw.y));
                  s += (v[j][0] * v[j][0] + v[j][1] * v[j][1]) + (v[j][2] * v[j][2] + v[j][3] * v[j][3]); }
              const float rs = rsqrtf(wave_sum(s) * (1.0f / 1024.0f) + EPS);
              u32x2* o = (u32x2*)(mixed + tok * D_MODEL + ATTN_W) + F.lane;
#pragma unroll
              for (int j = 0; j < 4; ++j) { const f32x4 g = gr[64 * j]; u32x2 w; w.x = pk2(v[j][0] * rs * g[0], v[j][1] * rs * g[1]); w.y = pk2(v[j][2] * rs * g[2], v[j][3] * rs * g[3]); o[64 * j] = w; } }
        }
    }
    __syncthreads();
}

__device__ __forceinline__ void p5_router(const Frame& F, const Args& a) {
    const float* x1 = (const float*)(a.ws + WS_X1); bf16_t* hn2 = (bf16_t*)(a.ws + WS_HN);
    const float* g = a.in[13]; const float* wr = a.in[14]; const float* br = a.in[15];
    int* cnt = (int*)(F.ctl + CW_CNT); int* lists = (int*)(a.ws + WS_LISTS);
    int* sel_e = (int*)(a.ws + WS_SEL); int* sel_pos = sel_e + NSLOT; float* sel_g = (float*)(sel_pos + NSLOT);
    LAS float* PART = (LAS float*)F.lds;
    LAS float* SSQ = PART + 8 * 1024;
    LAS float* RS = SSQ + 256;
    LAS float* LG = RS + 32;
    LAS int* lcnt = (LAS int*)(LG + 1024);
    LAS int* gbase = lcnt + 32;
    LAS int* ent_e = gbase + 32;
    LAS int* ent_r = ent_e + 128;
    LAS float* ent_g = (LAS float*)(ent_r + 128);
    const int lane = F.lane, r16 = lane & 15, kq = lane >> 4;
    for (int grp = F.vcu; grp < NTOK / 32; grp += F.G) {
        const int tok0 = grp * 32;
        __syncthreads();
        if (F.tid < 32) lcnt[F.tid] = 0;
        f32x4 acc00 = {0.f, 0.f, 0.f, 0.f}, acc01 = acc00, acc10 = acc00, acc11 = acc00; float ss0 = 0.f, ss1 = 0.f;
        const float* xa = x1 + (size_t)(tok0 + r16) * D_MODEL + F.wave * 256 + 4 * kq;
        const float* gp = g + F.wave * 256 + 4 * kq;
        const float* wp = wr + (size_t)(F.wave * 256 + 4 * kq) * N_EXP + r16;
#pragma unroll 4
        for (int S = 0; S < 16; ++S) {
            const f32x4 xv0 = *(const f32x4*)(xa + 16 * S), xv1 = *(const f32x4*)(xa + 16 * S + (size_t)16 * D_MODEL), gv = *(const f32x4*)(gp + 16 * S);
            float b0[4], b1[4];
#pragma unroll
            for (int q = 0; q < 4; ++q) { b0[q] = wp[(size_t)(16 * S + q) * N_EXP]; b1[q] = wp[(size_t)(16 * S + q) * N_EXP + 16]; }
            ss0 += (xv0[0] * xv0[0] + xv0[1] * xv0[1]) + (xv0[2] * xv0[2] + xv0[3] * xv0[3]);
            ss1 += (xv1[0] * xv1[0] + xv1[1] * xv1[1]) + (xv1[2] * xv1[2] + xv1[3] * xv1[3]);
#pragma unroll
            for (int q = 0; q < 4; ++q) { const float a0 = xv0[q] * gv[q], a1 = xv1[q] * gv[q];
                acc00 = __builtin_amdgcn_mfma_f32_16x16x4f32(a0, b0[q], acc00, 0, 0, 0); acc01 = __builtin_amdgcn_mfma_f32_16x16x4f32(a0, b1[q], acc01, 0, 0, 0);
                acc10 = __builtin_amdgcn_mfma_f32_16x16x4f32(a1, b0[q], acc10, 0, 0, 0); acc11 = __builtin_amdgcn_mfma_f32_16x16x4f32(a1, b1[q], acc11, 0, 0, 0); }
        }
        { LAS float* pw = PART + F.wave * 1024;
#pragma unroll
          for (int q = 0; q < 4; ++q) { const int tr = 4 * kq + q;
              pw[tr * 32 + r16] = acc00[q]; pw[tr * 32 + 16 + r16] = acc01[q]; pw[(16 + tr) * 32 + r16] = acc10[q]; pw[(16 + tr) * 32 + 16 + r16] = acc11[q]; }
          ss0 += __shfl_xor(ss0, 16); ss0 += __shfl_xor(ss0, 32); ss1 += __shfl_xor(ss1, 16); ss1 += __shfl_xor(ss1, 32);
          if (kq == 0) { SSQ[F.wave * 32 + r16] = ss0; SSQ[F.wave * 32 + 16 + r16] = ss1; } }
        __syncthreads();
        if (F.tid < 32) { float t = 0.f;
#pragma unroll
            for (int w = 0; w < 8; ++w) t += SSQ[w * 32 + F.tid];
            RS[F.tid] = rsqrtf(t * (1.0f / 2048.0f) + EPS); }
        __syncthreads();
        { const int tt = F.tid >> 4, eg = F.tid & 15; float s0 = 0.f, s1 = 0.f;
#pragma unroll
          for (int w = 0; w < 8; ++w) { const f32x2 v = *(const LAS f32x2*)(PART + w * 1024 + tt * 32 + 2 * eg); s0 += v[0]; s1 += v[1]; }
          const float rs = RS[tt];
          LG[tt * 32 + 2 * eg] = s0 * rs + br[2 * eg]; LG[tt * 32 + 2 * eg + 1] = s1 * rs + br[2 * eg + 1]; }
        __syncthreads();
        for (int t4 = 0; t4 < 4; ++t4) {
            const int tk = F.wave * 4 + t4;
            { const float rs = RS[tk]; const f32x4* xr = (const f32x4*)(x1 + (size_t)(tok0 + tk) * D_MODEL) + lane; const f32x4* gr = (const f32x4*)g + lane; u32x2* o = (u32x2*)(hn2 + (size_t)(tok0 + tk) * D_MODEL) + lane;
#pragma unroll
              for (int j = 0; j < 8; ++j) { const f32x4 v = xr[64 * j], gg = gr[64 * j]; u32x2 w; w.x = pk2(v[0] * rs * gg[0], v[1] * rs * gg[1]); w.y = pk2(v[2] * rs * gg[2], v[3] * rs * gg[3]); o[64 * j] = w; } }
            float cur = (lane < 32) ? LG[tk * 32 + lane] : -INFINITY;
            int i0 = 0, i1 = 0, i2 = 0, i3 = 0; float v0 = 0.f, v1 = 0.f, v2 = 0.f, v3 = 0.f;
#pragma unroll
            for (int k = 0; k < 4; ++k) {
                const float mx = wave_max(cur);
                const unsigned long long bal = __ballot(cur == mx);
                const int bi = __ffsll((long long)bal) - 1;
                if (k == 0) { i0 = bi; v0 = mx; } else if (k == 1) { i1 = bi; v1 = mx; } else if (k == 2) { i2 = bi; v2 = mx; } else { i3 = bi; v3 = mx; }
                if (lane == bi) cur = -INFINITY;
            }
            if (lane == 0) {
                const float e1 = __expf(v1 - v0), e2 = __expf(v2 - v0), e3 = __expf(v3 - v0); const float inv = 1.0f / (1.0f + e1 + e2 + e3);
                const int base = tk * 4;
                ent_e[base + 0] = i0; ent_r[base + 0] = __hip_atomic_fetch_add(&lcnt[i0], 1, __ATOMIC_RELAXED, __HIP_MEMORY_SCOPE_WORKGROUP); ent_g[base + 0] = inv;
                ent_e[base + 1] = i1; ent_r[base + 1] = __hip_atomic_fetch_add(&lcnt[i1], 1, __ATOMIC_RELAXED, __HIP_MEMORY_SCOPE_WORKGROUP); ent_g[base + 1] = e1 * inv;
                ent_e[base + 2] = i2; ent_r[base + 2] = __hip_atomic_fetch_add(&lcnt[i2], 1, __ATOMIC_RELAXED, __HIP_MEMORY_SCOPE_WORKGROUP); ent_g[base + 2] = e2 * inv;
                ent_e[base + 3] = i3; ent_r[base + 3] = __hip_atomic_fetch_add(&lcnt[i3], 1, __ATOMIC_RELAXED, __HIP_MEMORY_SCOPE_WORKGROUP); ent_g[base + 3] = e3 * inv;
            }
        }
        __syncthreads();
        if (F.tid < 32) { const int n = lcnt[F.tid]; gbase[F.tid] = n > 0 ? atomicAdd(&cnt[F.tid], n) : 0; }
        __syncthreads();
        if (F.tid < 128) { const int e = ent_e[F.tid], pos = gbase[e] + ent_r[F.tid], tok = tok0 + (F.tid >> 2);
            lists[e * NTOK + pos] = tok; sel_e[tok * 4 + (F.tid & 3)] = e; sel_pos[tok * 4 + (F.tid & 3)] = pos; sel_g[tok * 4 + (F.tid & 3)] = ent_g[F.tid]; }
    }
    __syncthreads();
}

__device__ __forceinline__ void build_tpre(const Frame& F) {
    LAS int* tpre = (LAS int*)(F.lds + L_TPRE);
    __syncthreads();
    if (F.tid == 0) { const int* cnt = (const int*)(F.ctl + CW_CNT); int acc = 0; for (int e = 0; e < N_EXP; ++e) { tpre[e] = acc; acc += (cnt[e] + 255) >> 8; } tpre[N_EXP] = acc; }
    __syncthreads();
}

__device__ __forceinline__ void p8_final(const Frame& F, const Args& a) {
    const LAS int* tpre = (const LAS int*)(F.lds + L_TPRE);
    const float* x1 = (const float*)(a.ws + WS_X1); const bf16_t* Y = (const bf16_t*)(a.ws + WS_Y);
    const int* sel_e = (const int*)(a.ws + WS_SEL); const int* sel_pos = sel_e + NSLOT; const float* sel_g = (const float*)(sel_pos + NSLOT);
    const f32x4* gr = (const f32x4*)a.in[20] + F.lane;
    for (int tok = F.gw; tok < NTOK; tok += F.NGW) {
        const f32x4* xr = (const f32x4*)(x1 + (size_t)tok * D_MODEL) + F.lane;
        f32x4 v[8];
#pragma unroll
        for (int j = 0; j < 8; ++j) v[j] = xr[64 * j];
#pragma unroll
        for (int k = 0; k < 4; ++k) {
            const int e = sel_e[tok * 4 + k]; const size_t row = (size_t)tpre[e] * 256 + sel_pos[tok * 4 + k]; const float gk = sel_g[tok * 4 + k];
            const u32x2* yp = (const u32x2*)(Y + row * D_MODEL) + F.lane;
#pragma unroll
            for (int j = 0; j < 8; ++j) { const u32x2 w = yp[64 * j]; v[j][0] += gk * bflo(w.x); v[j][1] += gk * bfhi(w.x); v[j][2] += gk * bflo(w.y); v[j][3] += gk * bfhi(w.y); }
        }
        float s = 0.f;
#pragma unroll
        for (int j = 0; j < 8; ++j) s += (v[j][0] * v[j][0] + v[j][1] * v[j][1]) + (v[j][2] * v[j][2] + v[j][3] * v[j][3]);
        const float rs = rsqrtf(wave_sum(s) * (1.0f / 2048.0f) + EPS);
        f32x4* o = (f32x4*)(a.out + (size_t)tok * D_MODEL) + F.lane;
#pragma unroll
        for (int j = 0; j < 8; ++j) { const f32x4 g = gr[64 * j]; o[64 * j] = (f32x4){v[j][0] * rs * g[0], v[j][1] * rs * g[1], v[j][2] * rs * g[2], v[j][3] * rs * g[3]}; }
    }
}

__device__ __forceinline__ void ph1_inproj(const Frame& F, const Args& args) {
    unsigned char* ws = args.ws;
    g8::DenseOrder S{(const char*)(ws + WS_HN), (const char*)(ws + WS_WIN), NTOK / 256, IN_COLS / 256, (NTOK / 256) * (IN_COLS / 256), F.G, (int)blockIdx.x, IN_COLS};
    g8::EpiBf16 E{(bf16_t*)(ws + WS_PROJ), IN_COLS, nullptr, 0};
    g8::gemm_phase<g8::EpiBf16, g8::DenseOrder, false>(F.lds, S, E, nullptr);
}
__device__ __forceinline__ void ph4_outproj(const Frame& F, const Args& args) {
    unsigned char* ws = args.ws;
    g8::DenseOrder S{(const char*)(ws + WS_MIXED), (const char*)(ws + WS_WOUT), NTOK / 256, D_MODEL / 256, (NTOK / 256) * (D_MODEL / 256), F.G, (int)blockIdx.x, D_MODEL};
    g8::EpiResF32 E{(float*)(ws + WS_X1), args.in[0], D_MODEL};
    g8::gemm_phase<g8::EpiResF32, g8::DenseOrder, false>(F.lds, S, E, nullptr);
}
__device__ __forceinline__ void ph6_gateup(const Frame& F, const Args& args) {
    unsigned char* ws = args.ws;
    build_tpre(F);
    g8::GroupedOrder S{nullptr, (const char*)(ws + WS_WGU), (const LAS int*)(F.lds + L_TPRE), 4096 / 256, F.G, (int)blockIdx.x, (size_t)4096 * KDIM * 2, true, (const char*)(ws + WS_HN), 4096};
    g8::EpiSwiglu E{(bf16_t*)(ws + WS_ACT), args.in[17]};
    g8::gemm_phase<g8::EpiSwiglu, g8::GroupedOrder, true>(F.lds, S, E, (const int*)(ws + WS_LISTS));
}
__device__ __forceinline__ void ph7_down(const Frame& F, const Args& args) {
    unsigned char* ws = args.ws;
    build_tpre(F);
    g8::GroupedOrder S{(const char*)(ws + WS_ACT), (const char*)(ws + WS_WDN), (const LAS int*)(F.lds + L_TPRE), D_MODEL / 256, F.G, (int)blockIdx.x, (size_t)D_MODEL * KDIM * 2, false, nullptr, D_MODEL};
    g8::EpiBf16 E{(bf16_t*)(ws + WS_Y), D_MODEL, args.in[19], D_MODEL};
    g8::gemm_phase<g8::EpiBf16, g8::GroupedOrder, false>(F.lds, S, E, nullptr);
}

constexpr int N_PHASES = 9;
__global__ void __launch_bounds__(NTHR, 2) mk_fwd(Args args) {
    extern __shared__ __attribute__((aligned(16))) unsigned char lds_raw[];
    Frame F;
    F.lds = (LAS unsigned char*)lds_raw;
    F.tid = threadIdx.x; F.lane = F.tid & 63; F.wave = __builtin_amdgcn_readfirstlane(F.tid >> 6);
    F.G = gridDim.x; { const int bx = blockIdx.x; F.vcu = (F.G % 8 == 0) ? (bx % 8) * (F.G / 8) + bx / 8 : bx; }
    F.gw = F.vcu * NWAVES + F.wave; F.NGW = F.G * NWAVES;
    F.ctl = (unsigned*)(args.ws + WS_CTL);
    for (int u = F.tid; u < (LDS_BYTES - LDSCTL_OFF) / 4; u += NTHR) ((LAS unsigned*)(F.lds + LDSCTL_OFF))[u] = 0u;
    __syncthreads();
    const int lo = args.ph_lo, hi = args.ph_hi;
    XcdBarrier bar; bar.bar = F.ctl + CW_BAR; bar.x = 0; bar.st = nullptr;
    if (hi - lo > 1) bar = xcd_barrier_post(F.ctl + CW_BAR, (volatile LAS unsigned*)(F.lds + L_MISC) + 8);
#define IN(k) (lo <= (k) && (k) < hi)
#define SEAM(k) do { if (IN(k) && IN((k) + 1)) xcd_barrier(bar); } while (0)

#define PHASE(k, call) do { if (IN(k)) { call; } if ((PROBE_MASK >> (k)) & 1) { xcd_barrier(bar); if (IN(k)) { call; } } } while (0)
    PHASE(0, p0_prologue(F, args)); SEAM(0);
    PHASE(1, ph1_inproj(F, args)); SEAM(1);
    PHASE(2, p2_mixers(F, args)); SEAM(2);
    PHASE(3, p3_mix(F, args)); SEAM(3);
    PHASE(4, ph4_outproj(F, args)); SEAM(4);
    if (IN(5)) { p5_router(F, args); } SEAM(5);
    PHASE(6, ph6_gateup(F, args)); SEAM(6);
    PHASE(7, ph7_down(F, args)); SEAM(7);
    if (IN(8)) { build_tpre(F); p8_final(F, args); }
#undef IN
#undef SEAM
}

extern "C" void kernel_launch(void* const* d_in, const int* in_sizes, int n_in, void* d_out, int out_size, void* d_ws, size_t ws_size, hipStream_t stream) {
    static int grid = 0;
    if (grid == 0) {
        if (n_in != 21 || out_size != NTOK * D_MODEL || ws_size < WS_END) { fprintf(stderr, "kernel_launch: unexpected problem (n_in %d out %d ws %zu)\n", n_in, out_size, ws_size); grid = -1; return; }
        int dev = 0, cus = 0, per_cu = 0;
        if (hipGetDevice(&dev) != hipSuccess || hipDeviceGetAttribute(&cus, hipDeviceAttributeMultiprocessorCount, dev) != hipSuccess) { grid = -1; return; }
        if (hipFuncSetAttribute((const void*)mk_fwd, hipFuncAttributeMaxDynamicSharedMemorySize, LDS_BYTES) != hipSuccess) { fprintf(stderr, "kernel_launch: hipFuncSetAttribute failed\n"); grid = -1; return; }
        if (hipOccupancyMaxActiveBlocksPerMultiprocessor(&per_cu, (const void*)mk_fwd, NTHR, LDS_BYTES) != hipSuccess || per_cu < 1) { fprintf(stderr, "kernel_launch: occupancy query says %d\n", per_cu); }
        (void)hipGetLastError();
        grid = cus;
    }
    if (grid < 0) return;
    if (hipMemsetAsync((char*)d_ws + WS_CTL, 0, CTL_ZERO_BYTES, stream) != hipSuccess) return;
    Args a{};
    for (int i = 0; i < 21; ++i) a.in[i] = (const float*)d_in[i];
    a.out = (float*)d_out; a.ws = (unsigned char*)d_ws;
#if MK_N_LAUNCHES == 1
    a.ph_lo = 0; a.ph_hi = N_PHASES;
    hipLaunchKernelGGL(mk_fwd, dim3(grid), dim3(NTHR), LDS_BYTES, stream, a);
#else
    for (int p = 0; p < N_PHASES; ++p) { a.ph_lo = p; a.ph_hi = p + 1; hipLaunchKernelGGL(mk_fwd, dim3(grid), dim3(NTHR), LDS_BYTES, stream, a); }
#endif
}
```

```cpp
#include <hip/hip_runtime.h>
#include <stdint.h>
#include <stdio.h>

#ifndef MK_N_LAUNCHES
#define MK_N_LAUNCHES 1
#endif

#ifndef PROBE_MASK
#define PROBE_MASK 0
#endif
#define LAS __attribute__((address_space(3)))
#define GAS __attribute__((address_space(1)))
typedef unsigned short bf16_t;
typedef short bf16x8 __attribute__((ext_vector_type(8)));
typedef float f32x4 __attribute__((ext_vector_type(4)));
typedef float f32x2 __attribute__((ext_vector_type(2)));
typedef unsigned u32x4 __attribute__((ext_vector_type(4)));
typedef unsigned u32x2 __attribute__((ext_vector_type(2)));

constexpr int D_MODEL = 2048, BATCH = 4, SEQ = 2048, NTOK = BATCH * SEQ;
constexpr int N_HEADS = 16, ATTN_W = 1024, LRU_W = 1024;
constexpr int IN_COLS = 5120;
constexpr int N_EXP = 32, D_FF = 2048, NSLOT = NTOK * 4;
constexpr int KDIM = 2048;
constexpr float EPS = 1e-6f;
constexpr int NWAVES = 8, NTHR = 512;
constexpr int PADROWS = NSLOT + N_EXP * 256;

constexpr size_t MiB = 1u << 20;
constexpr size_t WS_CTL = 0, WS_LISTS = 1 * MiB, CTL_ZERO_BYTES = 2 * MiB;
constexpr size_t WS_SEL = 2 * MiB;
constexpr size_t WS_LRUE = 3 * MiB;
constexpr size_t WS_WIN = 4 * MiB, WS_WOUT = 24 * MiB, WS_HN = 32 * MiB, WS_PROJ = 64 * MiB, WS_ATT = 144 * MiB  , WS_HL = 192 * MiB, WS_PC = 224 * MiB;
constexpr size_t WS_MIXED = 256 * MiB, WS_X1 = 288 * MiB, WS_ACT = 352 * MiB, WS_Y = 512 * MiB, WS_WGU = 672 * MiB, WS_WDN = 1184 * MiB, WS_LSE = 1440 * MiB  , WS_HN2S = 1442 * MiB  , WS_END = 2466 * MiB;
static_assert((size_t)PADROWS * 2048 * 2 <= 160 * MiB, "ACT/Y size");
constexpr int CW_BAR = 4096, CW_CNT = 8192;

constexpr int RING_BYTES = 131072;
constexpr int LDSCTL_OFF = 139264;
constexpr int LDS_BYTES = 147456;
constexpr int L_MISC = LDSCTL_OFF;
constexpr int L_TPRE = LDSCTL_OFF + 256;
constexpr int L_CNT = LDSCTL_OFF + 512;

__device__ __forceinline__ unsigned f2bf(float f) { unsigned u = __builtin_bit_cast(unsigned, f); return (u + 0x7fffu + ((u >> 16) & 1u)) >> 16; }
__device__ __forceinline__ unsigned pk2(float lo, float hi) { return f2bf(lo) | (f2bf(hi) << 16); }
__device__ __forceinline__ float bf2f(unsigned short b) { return __builtin_bit_cast(float, (unsigned)b << 16); }
__device__ __forceinline__ float bflo(unsigned w) { return __builtin_bit_cast(float, w << 16); }
__device__ __forceinline__ float bfhi(unsigned w) { return __builtin_bit_cast(float, w & 0xffff0000u); }
__device__ __forceinline__ float wave_sum(float v) {
#pragma unroll
    for (int o = 1; o < 64; o <<= 1) v += __shfl_xor(v, o);
    return v;
}
__device__ __forceinline__ float wave_max(float v) {
#pragma unroll
    for (int o = 1; o < 64; o <<= 1) v = fmaxf(v, __shfl_xor(v, o));
    return v;
}
#define LDS_WAIT() asm volatile("s_waitcnt lgkmcnt(0)" ::: "memory")
#define VM_WAIT() asm volatile("s_waitcnt vmcnt(0)" ::: "memory")

#define XB_TMO      128
#define XB_XCNT(j)  (256  + 64 * (j))
#define XB_XSUB(j)  (1280 + 64 * (j))
#define XB_XGEN(j)  (2304 + 64 * (j))
#define XB_TOP      3328
#define XB_TOPGEN   3392
#define XCD_BAR_WORDS 3456
#define XB_SPIN_CAP (1u << 20)
__device__ __forceinline__ unsigned xb_ld(unsigned* p)              { return __hip_atomic_load(p, __ATOMIC_RELAXED, __HIP_MEMORY_SCOPE_AGENT); }
__device__ __forceinline__ unsigned xb_add(unsigned* p, unsigned v) { return __hip_atomic_fetch_add(p, v, __ATOMIC_RELAXED, __HIP_MEMORY_SCOPE_AGENT); }
__device__ __forceinline__ unsigned xb_xcc_id() { return (unsigned)__builtin_amdgcn_s_getreg((3 << 11) | 20) & 0xFu; }
#define XB_SPIN(cond, bar) do { unsigned _sp = 0; while (cond) { __builtin_amdgcn_s_sleep(1); \
    if ((++_sp & 255u) == 0u) { if (xb_ld(&(bar)[XB_TMO])) break; if (_sp > XB_SPIN_CAP) { atomicAdd(&(bar)[XB_TMO], 1u); break; } } } } while (0)
struct XcdBarrier { unsigned* bar; unsigned x; volatile LAS unsigned* st; };
__device__ __forceinline__ XcdBarrier xcd_barrier_post(unsigned* bar, volatile LAS unsigned* st) {
    XcdBarrier b; b.bar = bar; b.x = xb_xcc_id(); b.st = st;
    if (threadIdx.x == 0) (void)xb_add(&bar[XB_XCNT(b.x)], 1u);
    return b;
}
__device__ __forceinline__ void xcd_barrier_complete(unsigned* bar, unsigned x, unsigned& nloc, unsigned& nx) {
    const unsigned G = gridDim.x * gridDim.y * gridDim.z;
    unsigned sum, cnt, mine, sp = 0u;
    for (;;) {
        sum = 0u; cnt = 0u; mine = 0u;
#pragma unroll
        for (unsigned j = 0; j < 16; ++j) { const unsigned c = xb_ld(&bar[XB_XCNT(j)]); sum += c; cnt += (c > 0u) ? 1u : 0u; mine = (j == x) ? c : mine; }
        if (sum == G) break;
        __builtin_amdgcn_s_sleep(1);
        if ((++sp & 255u) == 0u) { if (xb_ld(&bar[XB_TMO])) break; if (sp > XB_SPIN_CAP) { atomicAdd(&bar[XB_TMO], 1u); break; } }
    }
    nloc = mine > 0u ? mine : 1u; nx = cnt > 0u ? cnt : 1u;
}
__device__ __forceinline__ void xcd_barrier(const XcdBarrier& b) {
    asm volatile("s_waitcnt vmcnt(0)" ::: "memory");
    __syncthreads();
    if (threadIdx.x == 0) {
        unsigned* bar = b.bar;
        __builtin_amdgcn_s_waitcnt(0);
        unsigned nloc = b.st[0], nx = b.st[1];
        if (nloc == 0u) { xcd_barrier_complete(bar, b.x, nloc, nx); b.st[0] = nloc; b.st[1] = nx; }
        const unsigned old = xb_add(&bar[XB_XSUB(b.x)], 1u);
        const unsigned gen = old / nloc;
        if (old + 1u == (gen + 1u) * nloc) {
            __builtin_amdgcn_fence(__ATOMIC_RELEASE, "agent");
            asm volatile("s_waitcnt vmcnt(0)" ::: "memory");
            const unsigned og = xb_add(&bar[XB_TOP], 1u);
            const unsigned tg = og / nx;
            if (og + 1u == (tg + 1u) * nx) xb_add(&bar[XB_TOPGEN], 1u);
            else XB_SPIN(xb_ld(&bar[XB_TOPGEN]) == tg, bar);
            __builtin_amdgcn_fence(__ATOMIC_ACQUIRE, "agent");
            xb_add(&bar[XB_XGEN(b.x)], 1u);
            asm volatile("s_waitcnt vmcnt(0)" ::: "memory");
        } else {
            XB_SPIN(xb_ld(&bar[XB_XGEN(b.x)]) == gen, bar);
            __builtin_amdgcn_fence(__ATOMIC_ACQUIRE, "agent");
            asm volatile("s_waitcnt vmcnt(0)" ::: "memory");
        }
    }
    __syncthreads();
}

typedef float f32x16 __attribute__((ext_vector_type(16)));
typedef short s16x4 __attribute__((ext_vector_type(4)));
typedef short v4i16_t __attribute__((ext_vector_type(4)));
__device__ __forceinline__ s16x4 vtr(const LAS unsigned char* p) { return __builtin_bit_cast(s16x4, __builtin_amdgcn_ds_read_tr16_b64_v4i16((LAS v4i16_t*)p)); }

namespace g8 {
constexpr int BM = 256, BK = 64, HALF = 128, HTB = HALF * BK * 2, STAGE_BYTES = 8 * HTB, NXCD = 8, WGM = 8;
__host__ __device__ __forceinline__ int lds_byte(int r, int c) { const int st = (r >> 4) * 2 + (c >> 5), rr = r & 15, cc = c & 31, ob = rr * 64 + cc * 2; return st * 1024 + (ob ^ (((ob >> 9) & 1) << 5)); }
__host__ __device__ __forceinline__ void stage_rc(int b, int& R, int& C) { const int st = b / 1024, sb = b % 1024, swz = sb ^ (((sb >> 9) & 1) << 5); R = (st >> 1) * 16 + swz / 64; C = (st & 1) * 32 + (swz % 64) / 2; }
__host__ __device__ __forceinline__ int perm32(int rho) { const int n = rho >> 4, i = rho & 15; return 8 * (i >> 2) + 4 * n + (i & 3); }

struct Unit { const char* a; const char* b; int crow, ccol, e, gi; };

struct DenseOrder {
    const char* A; const char* Bt; int nM, nN, nwg, G, c; int ldb;
    __device__ __forceinline__ bool next(int i, Unit& u) const {
        const long L = (long)i * G + c; if (L >= nwg) return false;
        int wgid = (int)L; { const int q = nwg / NXCD, r = nwg % NXCD, xcd = wgid % NXCD, off = wgid / NXCD; wgid = (xcd < r ? xcd * (q + 1) : r * (q + 1) + (xcd - r) * q) + off; }
        const int nig = WGM * nN, gid = wgid / nig, fm = gid * WGM, gsz = (nM - fm) < WGM ? (nM - fm) : WGM;
        const int pm = fm + ((wgid % nig) % gsz), pn = (wgid % nig) / gsz;
        u.a = A + (size_t)pm * BM * KDIM * 2; u.b = Bt + (size_t)pn * BM * 4; u.crow = pm * BM; u.ccol = pn * BM; u.e = 0; u.gi = 0; return true;
    }
};
struct GroupedOrder {
    const char* A; const char* Bt; const LAS int* tpre; int nN, G, c; size_t bstride;
    bool capA; int ldb;
    __device__ __forceinline__ bool next(int i, Unit& u) const {
        const int total = __builtin_amdgcn_readfirstlane(tpre[N_EXP]) * nN; const long L = (long)i * G + c; if (L >= total) return false;
        const int mtile = (int)L / nN, nt = (int)L % nN;
        int e = 0; while (mtile >= __builtin_amdgcn_readfirstlane(tpre[e + 1])) ++e;
        const int mt = mtile - __builtin_amdgcn_readfirstlane(tpre[e]);
        u.a = A + (capA ? ((size_t)e * NTOK + (size_t)mt * BM) : (size_t)mtile * BM) * KDIM * 2;
        u.b = Bt + (size_t)e * bstride + (size_t)nt * BM * 4; u.crow = mtile * BM; u.ccol = nt * BM; u.e = e; u.gi = 0; return true;
    }
};

__device__ __forceinline__ unsigned cvt_pk_bf16(float lo, float hi) { unsigned r; asm volatile("v_cvt_pk_bf16_f32 %0, %1, %2" : "=v"(r) : "v"(lo), "v"(hi)); return r; }

struct EpiBf16 {
    bf16_t* O; int ldc; const float* bias; int bias_stride;
    __device__ __forceinline__ void operator()(const f32x4 (&acc)[2][2][4][2], const Unit& u, int wr, int wc, int fr, int fq) const {
        const int row0 = u.crow + wr * 64 + fr, col0 = u.ccol + wc * 32 + 4 * fq;
        f32x4 bv[2][2];
#pragma unroll
        for (int bj = 0; bj < 2; ++bj)
#pragma unroll
            for (int n = 0; n < 2; ++n) bv[bj][n] = bias ? *(const f32x4*)(bias + (size_t)u.e * bias_stride + col0 + bj * HALF + 16 * n) : (f32x4){0.f, 0.f, 0.f, 0.f};
#pragma unroll
        for (int ai = 0; ai < 2; ++ai)
#pragma unroll
            for (int m = 0; m < 4; ++m) { bf16_t* rowp = O + (size_t)(row0 + ai * HALF + m * 16) * ldc + col0;
#pragma unroll
                for (int bj = 0; bj < 2; ++bj)
#pragma unroll
                    for (int n = 0; n < 2; ++n) { const f32x4 v = acc[ai][bj][m][n] + bv[bj][n];
                        u32x2 w; w.x = cvt_pk_bf16(v[0], v[1]); w.y = cvt_pk_bf16(v[2], v[3]);
                        *(u32x2*)(rowp + bj * HALF + 16 * n) = w; } }
    }
};
struct EpiResF32 {
    float* C; const float* res; int ldc;
    __device__ __forceinline__ void operator()(const f32x4 (&acc)[2][2][4][2], const Unit& u, int wr, int wc, int fr, int fq) const {
        const int row0 = u.crow + wr * 64 + fr, col0 = u.ccol + wc * 32 + 4 * fq;
#pragma unroll
        for (int ai = 0; ai < 2; ++ai)
#pragma unroll
            for (int m = 0; m < 4; ++m) { const size_t off = (size_t)(row0 + ai * HALF + m * 16) * ldc + col0;
#pragma unroll
                for (int bj = 0; bj < 2; ++bj)
#pragma unroll
                    for (int n = 0; n < 2; ++n) { const f32x4 r = *(const f32x4*)(res + off + bj * HALF + n * 16); *(f32x4*)(C + off + bj * HALF + n * 16) = acc[ai][bj][m][n] + r; } }
    }
};
struct EpiSwiglu {
    bf16_t* O; const float* bias;
    __device__ __forceinline__ float act(float g, float up) const {
        g = fminf(g, 7.0f); up = fminf(fmaxf(up, -7.0f), 7.0f);
        const float sg = 1.0f / (1.0f + __expf(-1.702f * g));
        return g * sg * (up + 1.0f);
    }
    __device__ __forceinline__ void operator()(const f32x4 (&acc)[2][2][4][2], const Unit& u, int wr, int wc, int fr, int fq) const {
        const int row0 = u.crow + wr * 64 + fr, col0 = u.ccol + wc * 32 + 4 * fq;
#pragma unroll
        for (int bj = 0; bj < 2; ++bj)
#pragma unroll
            for (int n = 0; n < 2; ++n) { const f32x4 bv = *(const f32x4*)(bias + (size_t)u.e * (2 * D_FF) + col0 + bj * HALF + 16 * n);
#pragma unroll
                for (int ai = 0; ai < 2; ++ai)
#pragma unroll
                    for (int m = 0; m < 4; ++m) { const f32x4 v = acc[ai][bj][m][n] + bv;
                        *(unsigned*)(O + (size_t)(row0 + ai * HALF + m * 16) * D_FF + (col0 >> 1) + bj * (HALF / 2) + 8 * n) = cvt_pk_bf16(act(v[0], v[1]), act(v[2], v[3])); } }
    }
};

template <class Epi, class Sched>
__device__ __forceinline__ void gemm_phase(LAS unsigned char* lds, const Sched& S, const Epi& E) {
    const int tid = threadIdx.x, wid = __builtin_amdgcn_readfirstlane(tid >> 6), lane = tid & 63, wr = wid >> 2, wc = wid & 3, fr = lane & 15, fq = lane >> 4;
    constexpr int K = KDIM, nt = K / BK;
    unsigned voffA[2];
#pragma unroll
    for (int i = 0; i < 2; ++i) { int R, C; stage_rc(tid * 16 + i * 8192, R, C); voffA[i] = (unsigned)(R * K + C) * 2u; }
    const int ldb = S.ldb;
    constexpr size_t kstep = (size_t)(BK * 2);
    constexpr size_t hstep = (size_t)HALF * K * 2;
    const size_t kstepB = (size_t)BK * ldb * 4;
    constexpr size_t hstepB = 512;
    const size_t jstepB = (size_t)16 * ldb * 4;
    const unsigned bvoff = (unsigned)((tid >> 5) * ldb * 4 + (tid & 31) * 16);
    const unsigned ldsbase = (unsigned)(size_t)lds;
    unsigned wbase;
    { const int k0 = tid >> 5, q = tid & 31, f = 2 * ((k0 & 3) + 4 * ((k0 >> 3) & 1)); wbase = ldsbase + (unsigned)(k0 * 256 + (((q >> 1) ^ f) * 16) + (q & 1) * 8); }
    const unsigned ldsw = (unsigned)wid * 1024u;
    const int aoff = lds_byte(wr * 64 + fr, fq * 8);
    int bb[2];
    { const int q = (lane & 15) >> 2, p = lane & 3, f = 2 * (q + 4 * (fq & 1));
#pragma unroll
      for (int nf = 0; nf < 2; ++nf) { const int ch = 4 * wc + 2 * nf + (p >> 1); bb[nf] = (8 * fq + q) * 256 + ((ch ^ f) * 16) + (p & 1) * 8; } }
#define G8_SA(b, h) (((b) * 2 + (h)) * HTB)
#define G8_SB(b, h) ((4 + (b) * 2 + (h)) * HTB)
#define G8_STAGE_A(bufoff, gbase) do { \
        __builtin_amdgcn_global_load_lds((const unsigned*)((const char*)(gbase) + voffA[0]), (LAS unsigned*)(lds + (bufoff) + ldsw), 16, 0, 0); \
        __builtin_amdgcn_global_load_lds((const unsigned*)((const char*)(gbase) + voffA[1]), (LAS unsigned*)(lds + (bufoff) + ldsw + 8192), 16, 0, 0); } while (0)
#define G8_LOADB(R, ptr) do { const char* _p = (const char*)(ptr); \
        asm volatile("s_nop 4\n\tglobal_load_dwordx4 %0, %1, %2" : "=&v"(R##0) : "v"(bvoff), "s"(_p) : "memory"); _p += jstepB; \
        asm volatile("global_load_dwordx4 %0, %1, %2" : "=&v"(R##1) : "v"(bvoff), "s"(_p) : "memory"); _p += jstepB; \
        asm volatile("global_load_dwordx4 %0, %1, %2" : "=&v"(R##2) : "v"(bvoff), "s"(_p) : "memory"); _p += jstepB; \
        asm volatile("global_load_dwordx4 %0, %1, %2" : "=&v"(R##3) : "v"(bvoff), "s"(_p) : "memory"); } while (0)
#define G8_CVT2(R) do { R[0] = __builtin_bit_cast(float, cvt_pk_bf16(R[0], R[1])); R[1] = __builtin_bit_cast(float, cvt_pk_bf16(R[2], R[3])); } while (0)
#define G8_LO2(R) __builtin_shufflevector(R, R, 0, 1)
#define G8_CVTW(R, bufoff, N) do { asm volatile("s_waitcnt vmcnt(" #N ")" : "+v"(R##0), "+v"(R##1), "+v"(R##2), "+v"(R##3) :: "memory"); __builtin_amdgcn_sched_barrier(0); \
        const unsigned _wa = wbase + (unsigned)(bufoff); G8_CVT2(R##0); G8_CVT2(R##1); G8_CVT2(R##2); G8_CVT2(R##3); \
        asm volatile("ds_write_b64 %0, %1\n\tds_write_b64 %0, %2 offset:4096\n\tds_write_b64 %0, %3 offset:8192\n\tds_write_b64 %0, %4 offset:12288" :: "v"(_wa), "v"(G8_LO2(R##0)), "v"(G8_LO2(R##1)), "v"(G8_LO2(R##2)), "v"(G8_LO2(R##3)) : "memory"); } while (0)
#define G8_LDA(dst, b, h) do { _Pragma("unroll") for (int m = 0; m < 4; ++m) _Pragma("unroll") for (int k = 0; k < 2; ++k) dst[m][k] = *(const LAS bf16x8*)(lds + G8_SA(b, h) + aoff + m * 2048 + k * 1024); } while (0)
#define G8_TR(dst, addr, off) asm volatile("ds_read_b64_tr_b16 %0, %1 offset:%2" : "=v"(dst) : "v"(addr), "i"(off) : "memory")
#define G8_LDB(lo, hi, b, h) do { _Pragma("unroll") for (int n = 0; n < 2; ++n) { const unsigned _ad = ldsbase + (unsigned)(G8_SB(b, h)) + (unsigned)bb[n]; \
        G8_TR(lo[n][0], _ad, 0); G8_TR(hi[n][0], _ad, 1024); G8_TR(lo[n][1], _ad, 8192); G8_TR(hi[n][1], _ad, 9216); } } while (0)
#define G8_BF(lo, hi, n, k) __builtin_shufflevector(lo[n][k], hi[n][k], 0, 1, 2, 3, 4, 5, 6, 7)
#define G8_MMA(ai, bj, At, Bl, Bh) do { __builtin_amdgcn_s_setprio(1); _Pragma("unroll") for (int m = 0; m < 4; ++m) _Pragma("unroll") for (int n = 0; n < 2; ++n) _Pragma("unroll") for (int k = 0; k < 2; ++k) \
        acc[ai][bj][m][n] = __builtin_amdgcn_mfma_f32_16x16x32_bf16(G8_BF(Bl, Bh, n, k), At[m][k], acc[ai][bj][m][n], 0, 0, 0); __builtin_amdgcn_s_setprio(0); } while (0)
#define G8_WAIT_V(n) asm volatile("s_waitcnt vmcnt(" #n ")" ::: "memory")
#define G8_WAIT_L(n) do { asm volatile("s_waitcnt lgkmcnt(" #n ")" ::: "memory"); __builtin_amdgcn_sched_barrier(0); } while (0)
#define G8_BAR __builtin_amdgcn_s_barrier()
#define G8_SCHED __builtin_amdgcn_sched_barrier(0)
    Unit cur, nxt; int ui = 0;
    if (!S.next(0, cur)) return;
    f32x4 acc[2][2][4][2];
#pragma unroll
    for (int a = 0; a < 2; ++a)
#pragma unroll
        for (int b = 0; b < 2; ++b)
#pragma unroll
            for (int m = 0; m < 4; ++m)
#pragma unroll
                for (int n = 0; n < 2; ++n) acc[a][b][m][n] = (f32x4){0.f, 0.f, 0.f, 0.f};
    bf16x8 At[4][2]; s16x4 Bl[2][2], Bh[2][2];
    f32x4 RA0, RA1, RA2, RA3, RB0, RB1, RB2, RB3;
    const char* cA = cur.a; const char* cB = cur.b;
    G8_STAGE_A(G8_SA(0, 0), cA); G8_STAGE_A(G8_SA(0, 1), cA + hstep);
    G8_LOADB(RA, cB); G8_LOADB(RB, cB + hstepB);
    G8_CVTW(RA, G8_SB(0, 0), 4); G8_LOADB(RA, cB + kstepB);
    G8_CVTW(RB, G8_SB(0, 1), 4);
    G8_CVTW(RA, G8_SB(1, 0), 0);
    G8_LOADB(RA, cB + kstepB + hstepB);
    G8_STAGE_A(G8_SA(1, 0), cA + kstep);
    G8_LOADB(RB, cB + 2 * kstepB);
    G8_WAIT_L(0);
    if (wr == 1) G8_BAR;
    G8_BAR;
    const char* aq = cA + kstep; const char* bq = cB + 2 * kstepB;
    for (;;) {
        const bool has_next = S.next(ui + 1, nxt);
        const char* nA = has_next ? nxt.a : cA; const char* nB = has_next ? nxt.b : cB;
        for (int t = 0; t < nt; t += 2) {
            G8_LDB(Bl, Bh, 0, 0); G8_SCHED; G8_LDA(At, 0, 0); G8_STAGE_A(G8_SA(1, 1), aq + hstep); aq = (t == nt - 2) ? nA : aq + kstep;
            G8_WAIT_L(8); G8_BAR; G8_WAIT_L(0); G8_MMA(0, 0, At, Bl, Bh); G8_BAR; G8_SCHED;
            G8_LDB(Bl, Bh, 0, 1); G8_CVTW(RA, G8_SB(1, 1), 8); G8_LOADB(RA, bq + hstepB); bq += kstepB;
            G8_BAR; G8_WAIT_L(0); G8_MMA(0, 1, At, Bl, Bh); G8_BAR; G8_SCHED;
            G8_LDB(Bl, Bh, 0, 0); G8_SCHED; G8_LDA(At, 0, 1); G8_STAGE_A(G8_SA(0, 0), aq);
            G8_WAIT_L(8); G8_BAR; G8_WAIT_L(0); G8_MMA(1, 0, At, Bl, Bh); G8_BAR; G8_SCHED;
            G8_LDB(Bl, Bh, 0, 1); G8_CVTW(RB, G8_SB(0, 0), 6); G8_LOADB(RB, bq);
            G8_BAR; G8_WAIT_L(0); G8_MMA(1, 1, At, Bl, Bh); G8_BAR; G8_SCHED;
            G8_LDB(Bl, Bh, 1, 0); G8_SCHED; G8_LDA(At, 1, 0); G8_STAGE_A(G8_SA(0, 1), aq + hstep); aq += kstep;
            G8_WAIT_L(8); G8_BAR; G8_WAIT_L(0); G8_MMA(0, 0, At, Bl, Bh); G8_BAR; G8_SCHED;
            G8_LDB(Bl, Bh, 1, 1); G8_CVTW(RA, G8_SB(0, 1), 8); G8_LOADB(RA, bq + hstepB); bq = (t == nt - 4) ? nB : bq + kstepB;
            G8_BAR; G8_WAIT_L(0); G8_MMA(0, 1, At, Bl, Bh); G8_BAR; G8_SCHED;
            G8_LDB(Bl, Bh, 1, 0); G8_SCHED; G8_LDA(At, 1, 1); G8_STAGE_A(G8_SA(1, 0), aq);
            G8_WAIT_L(8); G8_BAR; G8_WAIT_L(0); G8_MMA(1, 0, At, Bl, Bh); G8_BAR; G8_SCHED;
            G8_LDB(Bl, Bh, 1, 1); G8_CVTW(RB, G8_SB(1, 0), 6); G8_LOADB(RB, bq);
            G8_BAR; G8_WAIT_L(0); G8_MMA(1, 1, At, Bl, Bh); G8_BAR; G8_SCHED;
        }
        asm volatile("s_waitcnt vmcnt(0)" : "+v"(RA0), "+v"(RA1), "+v"(RA2), "+v"(RA3), "+v"(RB0), "+v"(RB1), "+v"(RB2), "+v"(RB3) :: "memory"); __builtin_amdgcn_sched_barrier(0);
        E(acc, cur, wr, wc, fr, fq);
        if (!has_next) break;
#pragma unroll
        for (int a = 0; a < 2; ++a)
#pragma unroll
            for (int b = 0; b < 2; ++b)
#pragma unroll
                for (int m = 0; m < 4; ++m)
#pragma unroll
                    for (int n = 0; n < 2; ++n) acc[a][b][m][n] = (f32x4){0.f, 0.f, 0.f, 0.f};
        cur = nxt; cA = nA; cB = nB; ++ui;
    }
    G8_WAIT_V(0);
    asm volatile("" :: "v"(RA0), "v"(RA1), "v"(RA2), "v"(RA3), "v"(RB0), "v"(RB1), "v"(RB2), "v"(RB3));
    if (wr == 0) G8_BAR;
    G8_BAR;
#undef G8_SA
#undef G8_SB
#undef G8_STAGE_A
#undef G8_LOADB
#undef G8_CVTW
#undef G8_CVT2
#undef G8_LO2
#undef G8_LDA
#undef G8_TR
#undef G8_LDB
#undef G8_BF
#undef G8_MMA
#undef G8_WAIT_V
#undef G8_WAIT_L
#undef G8_BAR
#undef G8_SCHED
}
}

struct Frame {
    LAS unsigned char* lds;
    unsigned* ctl; unsigned char* ws;
    int tid, lane, wave, vcu, G, gw, NGW;
};
struct Args { const float* in[21]; float* out; unsigned char* ws; int ph_lo, ph_hi; };
template <int OFF> __device__ __forceinline__ unsigned long long karg_u64() { const auto kp = __builtin_amdgcn_kernarg_segment_ptr(); unsigned long long v;
    asm volatile("s_load_dwordx2 %0, %1, %2\n\ts_waitcnt lgkmcnt(0)" : "=s"(v) : "s"(kp), "i"(OFF)); return v; }
template <int I> __device__ __forceinline__ const float* karg_in() { return (const float*)karg_u64<8 * I>(); }
__device__ __forceinline__ float* karg_out() { return (float*)karg_u64<8 * 21>(); }


constexpr long CV_IN = (long)KDIM * IN_COLS / 512, CV_OUT = (long)KDIM * D_MODEL / 512, CV_GU = (long)N_EXP * KDIM * 4096 / 512, CV_DN = (long)N_EXP * KDIM * D_MODEL / 512;
__device__ __forceinline__ void conv_chunks(const float* __restrict__ src, bf16_t* __restrict__ dst, long c0, long c1, int gw, int NGW, int lane) {
    long c = c0 + gw;
    for (; c + 7L * NGW < c1; c += 8L * NGW) {
        f32x4 a[8], b[8];
#pragma unroll
        for (int i = 0; i < 8; ++i) { const f32x4* p = (const f32x4*)(src + (c + (long)i * NGW) * 512 + lane * 8); a[i] = __builtin_nontemporal_load(p); b[i] = __builtin_nontemporal_load(p + 1); }
#pragma unroll
        for (int i = 0; i < 8; ++i) { u32x4 w; w.x = pk2(a[i][0], a[i][1]); w.y = pk2(a[i][2], a[i][3]); w.z = pk2(b[i][0], b[i][1]); w.w = pk2(b[i][2], b[i][3]);
            __builtin_nontemporal_store(w, (u32x4*)(dst + (c + (long)i * NGW) * 512 + lane * 8)); }
    }
    for (; c < c1; c += NGW) { const f32x4* p = (const f32x4*)(src + c * 512 + lane * 8); const f32x4 a = __builtin_nontemporal_load(p), b = __builtin_nontemporal_load(p + 1);
        u32x4 w; w.x = pk2(a[0], a[1]); w.y = pk2(a[2], a[3]); w.z = pk2(b[0], b[1]); w.w = pk2(b[2], b[3]); __builtin_nontemporal_store(w, (u32x4*)(dst + c * 512 + lane * 8)); }
}
__device__ __forceinline__ void rms_row_bf16(const float* xrow, const float* g, bf16_t* orow, int lane) {
    const f32x4* xr = (const f32x4*)xrow + lane; const f32x4* gr = (const f32x4*)g + lane;
    f32x4 v[8]; float s = 0.f;
#pragma unroll
    for (int j = 0; j < 8; ++j) { v[j] = xr[64 * j]; s += (v[j][0] * v[j][0] + v[j][1] * v[j][1]) + (v[j][2] * v[j][2] + v[j][3] * v[j][3]); }
    const float rs = rsqrtf(wave_sum(s) * (1.0f / 2048.0f) + EPS);
    u32x2* o = (u32x2*)orow + lane;
#pragma unroll
    for (int j = 0; j < 8; ++j) { const f32x4 gg = gr[64 * j]; u32x2 w; w.x = pk2(v[j][0] * rs * gg[0], v[j][1] * rs * gg[1]); w.y = pk2(v[j][2] * rs * gg[2], v[j][3] * rs * gg[3]); o[64 * j] = w; }
}
__device__ __forceinline__ void p0_prologue(const Frame& F, const Args& a) {
    bf16_t* HN = (bf16_t*)(F.ws + WS_HN);
    for (int m = F.gw; m < NTOK; m += F.NGW) rms_row_bf16(karg_in<0>() + (size_t)m * D_MODEL, karg_in<1>(), HN + (size_t)m * D_MODEL, F.lane);
}

__device__ __forceinline__ float gelu_tanh(float x) { return 0.5f * x * (1.0f + tanhf(0.7978845608028654f * (x + 0.044715f * x * x * x))); }
__device__ __forceinline__ float sigmoidf_(float x) { return 1.0f / (1.0f + __expf(-x)); }
__device__ __forceinline__ void lru_unit(const Frame& F, const Args& a, int unit) {
    const int lane = F.lane;
    const int b = unit >> 9, k = (unit >> 4) & 31, blk = unit & 15;
    const bf16_t* proj = (const bf16_t*)(F.ws + WS_PROJ);
    LAS float* xs = (LAS float*)(F.lds + F.wave * 16384);
    const int ch = blk * 64 + lane;
    const float cw0 = karg_in<3>()[0 * LRU_W + ch], cw1 = karg_in<3>()[1 * LRU_W + ch], cw2 = karg_in<3>()[2 * LRU_W + ch], cw3 = karg_in<3>()[3 * LRU_W + ch], cb = karg_in<4>()[ch];
    const int t0 = k * 64; const size_t row0 = (size_t)b * SEQ + t0;
    const bf16_t* xp = proj + row0 * IN_COLS + 3 * ATTN_W + ch;
    float x0 = (t0 >= 3) ? bf2f(xp[-3 * IN_COLS]) : 0.f, x1 = (t0 >= 2) ? bf2f(xp[-2 * IN_COLS]) : 0.f, x2 = (t0 >= 1) ? bf2f(xp[-1 * IN_COLS]) : 0.f;
    for (int t = 0; t < 64; ++t) {
        const float x3 = bf2f(xp[(size_t)t * IN_COLS]);
        xs[t * 64 + lane] = cb + cw0 * x0 + cw1 * x1 + cw2 * x2 + cw3 * x3;
        x0 = x1; x1 = x2; x2 = x3;
    }
    float wa[64], wx[64];
    const float* wap = karg_in<5>() + (size_t)blk * 4096 + lane; const float* wxp = karg_in<7>() + (size_t)blk * 4096 + lane;
#pragma unroll
    for (int c = 0; c < 64; ++c) { wa[c] = wap[c * 64]; wx[c] = wxp[c * 64]; }
    const float ba = karg_in<6>()[ch], bx = karg_in<8>()[ch];
    const float sp = log1pf(__expf(-karg_in<9>()[ch]));
    float* hl = (float*)(F.ws + WS_HL) + row0 * LRU_W + ch; float* pc = (float*)(F.ws + WS_PC) + row0 * LRU_W + ch;
    LDS_WAIT();
    float h = 0.f, P = 1.f;
    for (int t = 0; t < 64; ++t) {
        float r = ba, ii = bx;
        const LAS f32x4* xr = (const LAS f32x4*)(xs + t * 64);
#pragma unroll
        for (int c4 = 0; c4 < 16; ++c4) { const f32x4 xv = xr[c4];
            r = fmaf(xv[0], wa[4 * c4], r); r = fmaf(xv[1], wa[4 * c4 + 1], r); r = fmaf(xv[2], wa[4 * c4 + 2], r); r = fmaf(xv[3], wa[4 * c4 + 3], r);
            ii = fmaf(xv[0], wx[4 * c4], ii); ii = fmaf(xv[1], wx[4 * c4 + 1], ii); ii = fmaf(xv[2], wx[4 * c4 + 2], ii); ii = fmaf(xv[3], wx[4 * c4 + 3], ii); }
        r = sigmoidf_(r); ii = sigmoidf_(ii);
        const float log_a = -8.0f * r * sp;
        const float av = __expf(log_a);
        const float bv = sqrtf(-expm1f(2.0f * log_a)) * (ii * xs[t * 64 + lane]);
        h = av * h + bv; P *= av;
        hl[(size_t)t * LRU_W] = h; pc[(size_t)t * LRU_W] = P;
    }
    float* ae = (float*)(F.ws + WS_LRUE); float* he = ae + 4 * 32 * 1024;
    ae[(size_t)(b * 32 + k) * 1024 + ch] = P; he[(size_t)(b * 32 + k) * 1024 + ch] = h;
    LDS_WAIT();
}
constexpr int VP = 192;
__device__ __forceinline__ void attn_unit(const Frame& F, const Args& a, int u) {
    const int lane = F.lane, c = lane & 31, hh = lane >> 5;
    const int br = u >> 12, rem = u & 4095, bh = rem >> 6, qt = rem & 63;
    const int b = bh >> 4, h = bh & 15;
    const int dsh = br * 2, d = 1 << dsh;
    const int r = qt & (d - 1), ltile = qt >> dsh, l0 = ltile * 32;
    const bf16_t* proj = (const bf16_t*)(F.ws + WS_PROJ) + (size_t)b * SEQ * IN_COLS + h * 64;
    LAS unsigned char* vl = F.lds + F.wave * 16384;
    bf16x8 qf[4];
    { const bf16_t* qrow = proj + (size_t)((l0 + c) * d + r) * IN_COLS + 8 * hh;
#pragma unroll
      for (int s = 0; s < 4; ++s) qf[s] = *(const bf16x8*)(qrow + 16 * s); }
    constexpr float LOG2E = 1.4426950408889634f;
    const float slope2 = exp2f(-0.5f * (float)(h + 1)) * LOG2E * (float)d;
    const float sc2 = 0.125f * LOG2E;
    float m = -INFINITY, lsum = 0.f;
    f32x16 o0, o1;
#pragma unroll
    for (int i = 0; i < 16; ++i) { o0[i] = 0.f; o1[i] = 0.f; }
    const int jfirst = ltile >= 4 ? 0 : 4 - ltile;
    bf16x8 kf[4], kn[4]; u32x4 vr[4], vn[4];
    const int vrow = lane >> 3, vch = lane & 7;
    { const int lk0 = l0 - 128 + 32 * jfirst;
      const bf16_t* krow = proj + (size_t)((lk0 + c) * d + r) * IN_COLS + ATTN_W + 8 * hh;
#pragma unroll
      for (int s = 0; s < 4; ++s) kf[s] = *(const bf16x8*)(krow + 16 * s);
#pragma unroll
      for (int i = 0; i < 4; ++i) vr[i] = *(const u32x4*)(proj + (size_t)((lk0 + vrow + 8 * i) * d + r) * IN_COLS + 2 * ATTN_W + vch * 8); }
    const LAS unsigned char* vtr_base = vl + (4 * hh + ((lane & 15) >> 2)) * VP + (16 * ((lane >> 4) & 1) + 4 * (lane & 3)) * 2;
    for (int j = jfirst; j <= 4; ++j) {
        if (j < 4) { const int lk0 = l0 - 128 + 32 * (j + 1);
            const bf16_t* krow = proj + (size_t)((lk0 + c) * d + r) * IN_COLS + ATTN_W + 8 * hh;
#pragma unroll
            for (int s = 0; s < 4; ++s) kn[s] = *(const bf16x8*)(krow + 16 * s);
#pragma unroll
            for (int i = 0; i < 4; ++i) vn[i] = *(const u32x4*)(proj + (size_t)((lk0 + vrow + 8 * i) * d + r) * IN_COLS + 2 * ATTN_W + vch * 8); }
#pragma unroll
        for (int i = 0; i < 4; ++i) *(LAS u32x4*)(vl + (vrow + 8 * i) * VP + vch * 16) = vr[i];
        f32x16 sa;
#pragma unroll
        for (int i = 0; i < 16; ++i) sa[i] = 0.f;
#pragma unroll
        for (int s = 0; s < 4; ++s) sa = __builtin_amdgcn_mfma_f32_32x32x16_bf16(kf[s], qf[s], sa, 0, 0, 0);
        const float relbase = (float)(c + 128 - 32 * j);
        float mx = -INFINITY;
#pragma unroll
        for (int i = 0; i < 16; ++i) { const int ki = (i & 3) + 8 * (i >> 2) + 4 * hh;
            float v = sa[i] * sc2 - slope2 * (relbase - (float)ki);
            const bool valid = (j == 0) ? (ki >= c) : ((j == 4) ? (ki <= c) : true);
            v = valid ? v : -INFINITY; sa[i] = v; mx = fmaxf(mx, v); }
        mx = fmaxf(mx, __shfl_xor(mx, 32));
        const float mnew = fmaxf(m, mx);
        const float alpha = __builtin_amdgcn_exp2f(m - mnew);
        float ps = 0.f;
#pragma unroll
        for (int i = 0; i < 16; ++i) { const float p = __builtin_amdgcn_exp2f(sa[i] - mnew); sa[i] = p; ps += p; }
        ps += __shfl_xor(ps, 32);
        lsum = lsum * alpha + ps; m = mnew;
#pragma unroll
        for (int i = 0; i < 16; ++i) { o0[i] *= alpha; o1[i] *= alpha; }
        bf16x8 pf[2];
#pragma unroll
        for (int s = 0; s < 2; ++s) { u32x4 w; w.x = g8::cvt_pk_bf16(sa[8 * s + 0], sa[8 * s + 1]); w.y = g8::cvt_pk_bf16(sa[8 * s + 2], sa[8 * s + 3]); w.z = g8::cvt_pk_bf16(sa[8 * s + 4], sa[8 * s + 5]); w.w = g8::cvt_pk_bf16(sa[8 * s + 6], sa[8 * s + 7]);
            pf[s] = __builtin_bit_cast(bf16x8, w); }
#pragma unroll
        for (int s = 0; s < 2; ++s) {
#pragma unroll
            for (int nt = 0; nt < 2; ++nt) {
                const s16x4 lo = vtr(vtr_base + (16 * s) * VP + nt * 64), hi = vtr(vtr_base + (16 * s + 8) * VP + nt * 64);
                bf16x8 af; af[0] = lo[0]; af[1] = lo[1]; af[2] = lo[2]; af[3] = lo[3]; af[4] = hi[0]; af[5] = hi[1]; af[6] = hi[2]; af[7] = hi[3];
                if (nt == 0) o0 = __builtin_amdgcn_mfma_f32_32x32x16_bf16(af, pf[s], o0, 0, 0, 0); else o1 = __builtin_amdgcn_mfma_f32_32x32x16_bf16(af, pf[s], o1, 0, 0, 0);
            }
        }
#pragma unroll
        for (int s = 0; s < 4; ++s) { kf[s] = kn[s]; vr[s] = vn[s]; }
    }
    const float inv = 1.0f / lsum;
    const size_t tok = (size_t)b * SEQ + (size_t)((l0 + c) * d + r);
    bf16_t* orow = (bf16_t*)(F.ws + WS_ATT) + ((size_t)br * NTOK + tok) * ATTN_W + h * 64 + 4 * hh;
#pragma unroll
    for (int g = 0; g < 4; ++g) {
        u32x2 w0, w1;
        w0.x = g8::cvt_pk_bf16(o0[4 * g] * inv, o0[4 * g + 1] * inv); w0.y = g8::cvt_pk_bf16(o0[4 * g + 2] * inv, o0[4 * g + 3] * inv);
        w1.x = g8::cvt_pk_bf16(o1[4 * g] * inv, o1[4 * g + 1] * inv); w1.y = g8::cvt_pk_bf16(o1[4 * g + 2] * inv, o1[4 * g + 3] * inv);
        *(u32x2*)(orow + 8 * g) = w0; *(u32x2*)(orow + 32 + 8 * g) = w1;
    }
    if (hh == 0) ((float*)(F.ws + WS_LSE))[((size_t)br * NTOK + tok) * 16 + h] = 0.6931471805599453f * (m + __builtin_amdgcn_logf(lsum));
}
__device__ __forceinline__ void p2_mixers(const Frame& F, const Args& a) {
    for (int u = F.gw; u < 2048; u += F.NGW) lru_unit(F, a, u);
    for (int u = F.gw; u < 3 * 4096; u += F.NGW) attn_unit(F, a, u);
}

__device__ __forceinline__ void p3_mix(const Frame& F, const Args& a) {
    LAS float* Hin = (LAS float*)F.lds;
    const float* ae = (const float*)(F.ws + WS_LRUE); const float* he = ae + 4 * 32 * 1024;
    const bf16_t* proj = (const bf16_t*)(F.ws + WS_PROJ);
    bf16_t* mixed = (bf16_t*)(F.ws + WS_MIXED);
    for (int grp = F.vcu; grp < NTOK / 32; grp += F.G) {
        const int tok0 = grp * 32, b = tok0 / SEQ, k = (tok0 % SEQ) / 64;
        __syncthreads();
        for (int d = F.tid; d < LRU_W; d += NTHR) { float H = 0.f;
            for (int j0 = 0; j0 < k; j0 += 8) { float av[8], hv[8];
#pragma unroll
                for (int jj = 0; jj < 8; ++jj) { const bool ok = (j0 + jj) < k; const size_t o = (size_t)(b * 32 + (ok ? j0 + jj : 0)) * 1024 + d; const float a1 = ae[o], h1 = he[o]; av[jj] = ok ? a1 : 1.0f; hv[jj] = ok ? h1 : 0.0f; }
#pragma unroll
                for (int jj = 0; jj < 8; ++jj) H = av[jj] * H + hv[jj]; }
            Hin[d] = H; }
        __syncthreads();
        for (int tt = F.wave; tt < 32; tt += NWAVES) {
            const size_t tok = (size_t)tok0 + tt;
            { const bf16_t* ao = (const bf16_t*)(F.ws + WS_ATT); const float* lse = (const float*)(F.ws + WS_LSE); const f32x4* gr = (const f32x4*)karg_in<10>() + F.lane;
              f32x4 v[4]; float s = 0.f;
#pragma unroll
              for (int j = 0; j < 4; ++j) { const int hd = (F.lane >> 4) + 4 * j;
                  const float l0 = lse[(0 * (size_t)NTOK + tok) * 16 + hd], l1 = lse[(1 * (size_t)NTOK + tok) * 16 + hd], l2 = lse[(2 * (size_t)NTOK + tok) * 16 + hd];
                  const float M = fmaxf(l0, fmaxf(l1, l2)); float w0 = __expf(l0 - M), w1 = __expf(l1 - M), w2 = __expf(l2 - M); const float iw = 1.0f / (w0 + w1 + w2); w0 *= iw; w1 *= iw; w2 *= iw;
                  const u32x2 a0 = *((const u32x2*)(ao + (0 * (size_t)NTOK + tok) * ATTN_W) + F.lane + 64 * j), a1 = *((const u32x2*)(ao + (1 * (size_t)NTOK + tok) * ATTN_W) + F.lane + 64 * j), a2 = *((const u32x2*)(ao + (2 * (size_t)NTOK + tok) * ATTN_W) + F.lane + 64 * j);
                  v[j][0] = w0 * bflo(a0.x) + w1 * bflo(a1.x) + w2 * bflo(a2.x); v[j][1] = w0 * bfhi(a0.x) + w1 * bfhi(a1.x) + w2 * bfhi(a2.x);
                  v[j][2] = w0 * bflo(a0.y) + w1 * bflo(a1.y) + w2 * bflo(a2.y); v[j][3] = w0 * bfhi(a0.y) + w1 * bfhi(a1.y) + w2 * bfhi(a2.y);
                  s += (v[j][0] * v[j][0] + v[j][1] * v[j][1]) + (v[j][2] * v[j][2] + v[j][3] * v[j][3]); }
              const float rs = rsqrtf(wave_sum(s) * (1.0f / 1024.0f) + EPS);
              u32x2* o = (u32x2*)(mixed + tok * D_MODEL) + F.lane;
#pragma unroll
              for (int j = 0; j < 4; ++j) { const f32x4 g = gr[64 * j]; u32x2 w; w.x = pk2(v[j][0] * rs * g[0], v[j][1] * rs * g[1]); w.y = pk2(v[j][2] * rs * g[2], v[j][3] * rs * g[3]); o[64 * j] = w; } }
            { const f32x4* hr = (const f32x4*)((const float*)(F.ws + WS_HL) + tok * LRU_W) + F.lane; const f32x4* pr = (const f32x4*)((const float*)(F.ws + WS_PC) + tok * LRU_W) + F.lane;
              const u32x2* gp = (const u32x2*)(proj + tok * IN_COLS + 3 * ATTN_W + LRU_W) + F.lane; const f32x4* gr = (const f32x4*)karg_in<11>() + F.lane;
              f32x4 v[4]; float s = 0.f;
#pragma unroll
              for (int j = 0; j < 4; ++j) { const f32x4 hv = hr[64 * j], pv = pr[64 * j]; const u32x2 gw = gp[64 * j]; const f32x4 hi = *(const LAS f32x4*)(Hin + (F.lane + 64 * j) * 4);
                  v[j][0] = (hv[0] + pv[0] * hi[0]) * gelu_tanh(bflo(gw.x)); v[j][1] = (hv[1] + pv[1] * hi[1]) * gelu_tanh(bfhi(gw.x));
                  v[j][2] = (hv[2] + pv[2] * hi[2]) * gelu_tanh(bflo(gw.y)); v[j][3] = (hv[3] + pv[3] * hi[3]) * gelu_tanh(bfhi(gw.y));
                  s += (v[j][0] * v[j][0] + v[j][1] * v[j][1]) + (v[j][2] * v[j][2] + v[j][3] * v[j][3]); }
              const float rs = rsqrtf(wave_sum(s) * (1.0f / 1024.0f) + EPS);
              u32x2* o = (u32x2*)(mixed + tok * D_MODEL + ATTN_W) + F.lane;
#pragma unroll
              for (int j = 0; j < 4; ++j) { const f32x4 g = gr[64 * j]; u32x2 w; w.x = pk2(v[j][0] * rs * g[0], v[j][1] * rs * g[1]); w.y = pk2(v[j][2] * rs * g[2], v[j][3] * rs * g[3]); o[64 * j] = w; } }
        }
    }
    __syncthreads();
}

__device__ __forceinline__ void p5_router(const Frame& F, const Args& a) {
    const float* x1 = (const float*)(F.ws + WS_X1); bf16_t* hn2s = (bf16_t*)(F.ws + WS_HN2S);
    const float* g = karg_in<13>(); const float* wr = karg_in<14>(); const float* br = karg_in<15>();
    int* cnt = (int*)(F.ctl + CW_CNT);
    int* sel_e = (int*)(F.ws + WS_SEL); int* sel_pos = sel_e + NSLOT; float* sel_g = (float*)(sel_pos + NSLOT);
    LAS float* PART = (LAS float*)F.lds;
    LAS float* SSQ = PART + 8 * 1024;
    LAS float* RS = SSQ + 256;
    LAS float* LG = RS + 32;
    LAS int* lcnt = (LAS int*)(LG + 1024);
    LAS int* gbase = lcnt + 32;
    LAS int* ent_e = gbase + 32;
    LAS int* ent_r = ent_e + 128;
    LAS float* ent_g = (LAS float*)(ent_r + 128);
    const int lane = F.lane, r16 = lane & 15, kq = lane >> 4;
    for (int grp = F.vcu; grp < NTOK / 32; grp += F.G) {
        const int tok0 = grp * 32;
        __syncthreads();
        if (F.tid < 32) lcnt[F.tid] = 0;
        f32x4 acc00 = {0.f, 0.f, 0.f, 0.f}, acc01 = acc00, acc10 = acc00, acc11 = acc00; float ss0 = 0.f, ss1 = 0.f;
        const float* xa = x1 + (size_t)(tok0 + r16) * D_MODEL + F.wave * 256 + 4 * kq;
        const float* gp = g + F.wave * 256 + 4 * kq;
        const float* wp = wr + (size_t)(F.wave * 256 + 4 * kq) * N_EXP + r16;
#pragma unroll 4
        for (int S = 0; S < 16; ++S) {
            const f32x4 xv0 = *(const f32x4*)(xa + 16 * S), xv1 = *(const f32x4*)(xa + 16 * S + (size_t)16 * D_MODEL), gv = *(const f32x4*)(gp + 16 * S);
            float b0[4], b1[4];
#pragma unroll
            for (int q = 0; q < 4; ++q) { b0[q] = wp[(size_t)(16 * S + q) * N_EXP]; b1[q] = wp[(size_t)(16 * S + q) * N_EXP + 16]; }
            ss0 += (xv0[0] * xv0[0] + xv0[1] * xv0[1]) + (xv0[2] * xv0[2] + xv0[3] * xv0[3]);
            ss1 += (xv1[0] * xv1[0] + xv1[1] * xv1[1]) + (xv1[2] * xv1[2] + xv1[3] * xv1[3]);
#pragma unroll
            for (int q = 0; q < 4; ++q) { const float a0 = xv0[q] * gv[q], a1 = xv1[q] * gv[q];
                acc00 = __builtin_amdgcn_mfma_f32_16x16x4f32(a0, b0[q], acc00, 0, 0, 0); acc01 = __builtin_amdgcn_mfma_f32_16x16x4f32(a0, b1[q], acc01, 0, 0, 0);
                acc10 = __builtin_amdgcn_mfma_f32_16x16x4f32(a1, b0[q], acc10, 0, 0, 0); acc11 = __builtin_amdgcn_mfma_f32_16x16x4f32(a1, b1[q], acc11, 0, 0, 0); }
        }
        { LAS float* pw = PART + F.wave * 1024;
#pragma unroll
          for (int q = 0; q < 4; ++q) { const int tr = 4 * kq + q;
              pw[tr * 32 + r16] = acc00[q]; pw[tr * 32 + 16 + r16] = acc01[q]; pw[(16 + tr) * 32 + r16] = acc10[q]; pw[(16 + tr) * 32 + 16 + r16] = acc11[q]; }
          ss0 += __shfl_xor(ss0, 16); ss0 += __shfl_xor(ss0, 32); ss1 += __shfl_xor(ss1, 16); ss1 += __shfl_xor(ss1, 32);
          if (kq == 0) { SSQ[F.wave * 32 + r16] = ss0; SSQ[F.wave * 32 + 16 + r16] = ss1; } }
        __syncthreads();
        if (F.tid < 32) { float t = 0.f;
#pragma unroll
            for (int w = 0; w < 8; ++w) t += SSQ[w * 32 + F.tid];
            RS[F.tid] = rsqrtf(t * (1.0f / 2048.0f) + EPS); }
        __syncthreads();
        { const int tt = F.tid >> 4, eg = F.tid & 15; float s0 = 0.f, s1 = 0.f;
#pragma unroll
          for (int w = 0; w < 8; ++w) { const f32x2 v = *(const LAS f32x2*)(PART + w * 1024 + tt * 32 + 2 * eg); s0 += v[0]; s1 += v[1]; }
          const float rs = RS[tt];
          LG[tt * 32 + 2 * eg] = s0 * rs + br[2 * eg]; LG[tt * 32 + 2 * eg + 1] = s1 * rs + br[2 * eg + 1]; }
        __syncthreads();
        for (int t4 = 0; t4 < 4; ++t4) {
            const int tk = F.wave * 4 + t4;
            float cur = (lane < 32) ? LG[tk * 32 + lane] : -INFINITY;
            int i0 = 0, i1 = 0, i2 = 0, i3 = 0; float v0 = 0.f, v1 = 0.f, v2 = 0.f, v3 = 0.f;
#pragma unroll
            for (int k = 0; k < 4; ++k) {
                const float mx = wave_max(cur);
                const unsigned long long bal = __ballot(cur == mx);
                const int bi = __ffsll((long long)bal) - 1;
                if (k == 0) { i0 = bi; v0 = mx; } else if (k == 1) { i1 = bi; v1 = mx; } else if (k == 2) { i2 = bi; v2 = mx; } else { i3 = bi; v3 = mx; }
                if (lane == bi) cur = -INFINITY;
            }
            if (lane == 0) {
                const float e1 = __expf(v1 - v0), e2 = __expf(v2 - v0), e3 = __expf(v3 - v0); const float inv = 1.0f / (1.0f + e1 + e2 + e3);
                const int base = tk * 4;
                ent_e[base + 0] = i0; ent_r[base + 0] = __hip_atomic_fetch_add(&lcnt[i0], 1, __ATOMIC_RELAXED, __HIP_MEMORY_SCOPE_WORKGROUP); ent_g[base + 0] = inv;
                ent_e[base + 1] = i1; ent_r[base + 1] = __hip_atomic_fetch_add(&lcnt[i1], 1, __ATOMIC_RELAXED, __HIP_MEMORY_SCOPE_WORKGROUP); ent_g[base + 1] = e1 * inv;
                ent_e[base + 2] = i2; ent_r[base + 2] = __hip_atomic_fetch_add(&lcnt[i2], 1, __ATOMIC_RELAXED, __HIP_MEMORY_SCOPE_WORKGROUP); ent_g[base + 2] = e2 * inv;
                ent_e[base + 3] = i3; ent_r[base + 3] = __hip_atomic_fetch_add(&lcnt[i3], 1, __ATOMIC_RELAXED, __HIP_MEMORY_SCOPE_WORKGROUP); ent_g[base + 3] = e3 * inv;
            }
        }
        __syncthreads();
        if (F.tid < 32) { const int n = lcnt[F.tid]; gbase[F.tid] = n > 0 ? atomicAdd(&cnt[F.tid], n) : 0; }
        __syncthreads();
        if (F.tid < 128) { const int e = ent_e[F.tid], pos = gbase[e] + ent_r[F.tid], tok = tok0 + (F.tid >> 2);
            sel_e[tok * 4 + (F.tid & 3)] = e; sel_pos[tok * 4 + (F.tid & 3)] = pos; sel_g[tok * 4 + (F.tid & 3)] = ent_g[F.tid]; }
        for (int t4 = 0; t4 < 4; ++t4) { const int tk = F.wave * 4 + t4; const float rs = RS[tk];
            const f32x4* xr = (const f32x4*)(x1 + (size_t)(tok0 + tk) * D_MODEL) + lane; const f32x4* gr = (const f32x4*)g + lane; u32x2 w[8];
#pragma unroll
            for (int j = 0; j < 8; ++j) { const f32x4 v = xr[64 * j], gg = gr[64 * j]; w[j].x = pk2(v[0] * rs * gg[0], v[1] * rs * gg[1]); w[j].y = pk2(v[2] * rs * gg[2], v[3] * rs * gg[3]); }
#pragma unroll
            for (int k = 0; k < 4; ++k) { const int e = ent_e[tk * 4 + k], pos = gbase[e] + ent_r[tk * 4 + k]; u32x2* o = (u32x2*)(hn2s + ((size_t)e * NTOK + pos) * D_MODEL) + lane;
#pragma unroll
                for (int j = 0; j < 8; ++j) o[64 * j] = w[j]; } }
    }
    __syncthreads();
}

__device__ __forceinline__ void build_tpre(const Frame& F) {
    LAS int* tpre = (LAS int*)(F.lds + L_TPRE);
    __syncthreads();
    if (F.tid == 0) { const int* cnt = (const int*)(F.ctl + CW_CNT); int acc = 0; for (int e = 0; e < N_EXP; ++e) { tpre[e] = acc; acc += (cnt[e] + 255) >> 8; } tpre[N_EXP] = acc; }
    __syncthreads();
}

__device__ __forceinline__ void p8_final(const Frame& F, const Args& a) {
    const LAS int* tpre = (const LAS int*)(F.lds + L_TPRE);
    const float* x1 = (const float*)(F.ws + WS_X1); const bf16_t* Y = (const bf16_t*)(F.ws + WS_Y);
    const int* sel_e = (const int*)(F.ws + WS_SEL); const int* sel_pos = sel_e + NSLOT; const float* sel_g = (const float*)(sel_pos + NSLOT);
    const f32x4* gr = (const f32x4*)karg_in<20>() + F.lane;
    for (int tok = F.gw; tok < NTOK; tok += F.NGW) {
        const f32x4* xr = (const f32x4*)(x1 + (size_t)tok * D_MODEL) + F.lane;
        f32x4 v[8];
#pragma unroll
        for (int j = 0; j < 8; ++j) v[j] = xr[64 * j];
#pragma unroll
        for (int k = 0; k < 4; ++k) {
            const int e = sel_e[tok * 4 + k]; const size_t row = (size_t)tpre[e] * 256 + sel_pos[tok * 4 + k]; const float gk = sel_g[tok * 4 + k];
            const u32x2* yp = (const u32x2*)(Y + row * D_MODEL) + F.lane;
#pragma unroll
            for (int j = 0; j < 8; ++j) { const u32x2 w = yp[64 * j]; v[j][0] += gk * bflo(w.x); v[j][1] += gk * bfhi(w.x); v[j][2] += gk * bflo(w.y); v[j][3] += gk * bfhi(w.y); }
        }
        float s = 0.f;
#pragma unroll
        for (int j = 0; j < 8; ++j) s += (v[j][0] * v[j][0] + v[j][1] * v[j][1]) + (v[j][2] * v[j][2] + v[j][3] * v[j][3]);
        const float rs = rsqrtf(wave_sum(s) * (1.0f / 2048.0f) + EPS);
        f32x4* o = (f32x4*)(karg_out() + (size_t)tok * D_MODEL) + F.lane;
#pragma unroll
        for (int j = 0; j < 8; ++j) { const f32x4 g = gr[64 * j]; o[64 * j] = (f32x4){v[j][0] * rs * g[0], v[j][1] * rs * g[1], v[j][2] * rs * g[2], v[j][3] * rs * g[3]}; }
    }
}

__device__ __forceinline__ void ph1_inproj(const Frame& F, const Args& args) {
    unsigned char* ws = F.ws;
    g8::DenseOrder S{(const char*)(ws + WS_HN), (const char*)karg_in<2>(), NTOK / 256, IN_COLS / 256, (NTOK / 256) * (IN_COLS / 256), F.G, (int)blockIdx.x, IN_COLS};
    g8::EpiBf16 E{(bf16_t*)(ws + WS_PROJ), IN_COLS, nullptr, 0};
    g8::gemm_phase<g8::EpiBf16, g8::DenseOrder>(F.lds, S, E);
}
__device__ __forceinline__ void ph4_outproj(const Frame& F, const Args& args) {
    unsigned char* ws = F.ws;
    g8::DenseOrder S{(const char*)(ws + WS_MIXED), (const char*)karg_in<12>(), NTOK / 256, D_MODEL / 256, (NTOK / 256) * (D_MODEL / 256), F.G, (int)blockIdx.x, D_MODEL};
    g8::EpiResF32 E{(float*)(ws + WS_X1), karg_in<0>(), D_MODEL};
    g8::gemm_phase<g8::EpiResF32, g8::DenseOrder>(F.lds, S, E);
}
__device__ __forceinline__ void ph6_gateup(const Frame& F, const Args& args) {
    unsigned char* ws = F.ws;
    build_tpre(F);
    g8::GroupedOrder S{(const char*)(ws + WS_HN2S), (const char*)karg_in<16>(), (const LAS int*)(F.lds + L_TPRE), 4096 / 256, F.G, (int)blockIdx.x, (size_t)4096 * KDIM * 4, true, 4096};
    g8::EpiSwiglu E{(bf16_t*)(ws + WS_ACT), karg_in<17>()};
    g8::gemm_phase<g8::EpiSwiglu, g8::GroupedOrder>(F.lds, S, E);
}
__device__ __forceinline__ void ph7_down(const Frame& F, const Args& args) {
    unsigned char* ws = F.ws;
    build_tpre(F);
    g8::GroupedOrder S{(const char*)(ws + WS_ACT), (const char*)karg_in<18>(), (const LAS int*)(F.lds + L_TPRE), D_MODEL / 256, F.G, (int)blockIdx.x, (size_t)D_MODEL * KDIM * 4, false, D_MODEL};
    g8::EpiBf16 E{(bf16_t*)(ws + WS_Y), D_MODEL, karg_in<19>(), D_MODEL};
    g8::gemm_phase<g8::EpiBf16, g8::GroupedOrder>(F.lds, S, E);
}

constexpr int N_PHASES = 9;
__global__ void __launch_bounds__(NTHR, 2) mk_fwd(Args args) {
    extern __shared__ __attribute__((aligned(16))) unsigned char lds_raw[];
    Frame F;
    F.lds = (LAS unsigned char*)lds_raw;
    F.tid = threadIdx.x; F.lane = F.tid & 63; F.wave = __builtin_amdgcn_readfirstlane(F.tid >> 6);
    F.G = gridDim.x; { const int bx = blockIdx.x; F.vcu = (F.G % 8 == 0) ? (bx % 8) * (F.G / 8) + bx / 8 : bx; }
    F.gw = F.vcu * NWAVES + F.wave; F.NGW = F.G * NWAVES;
    F.ws = args.ws; F.ctl = (unsigned*)(args.ws + WS_CTL);
    for (int u = F.tid; u < (LDS_BYTES - LDSCTL_OFF) / 4; u += NTHR) ((LAS unsigned*)(F.lds + LDSCTL_OFF))[u] = 0u;
    __syncthreads();
    const int lo = args.ph_lo, hi = args.ph_hi;
    XcdBarrier bar; bar.bar = F.ctl + CW_BAR; bar.x = 0; bar.st = nullptr;
    if (hi - lo > 1) bar = xcd_barrier_post(F.ctl + CW_BAR, (volatile LAS unsigned*)(F.lds + L_MISC) + 8);
#define IN(k) (lo <= (k) && (k) < hi)
#define SEAM(k) do { if (IN(k) && IN((k) + 1)) xcd_barrier(bar); } while (0)

#define PHASE(k, call) do { if (IN(k)) { call; } if ((PROBE_MASK >> (k)) & 1) { xcd_barrier(bar); if (IN(k)) { call; } } } while (0)
    PHASE(0, p0_prologue(F, args)); SEAM(0);
    PHASE(1, ph1_inproj(F, args)); SEAM(1);
    PHASE(2, p2_mixers(F, args)); SEAM(2);
    PHASE(3, p3_mix(F, args)); SEAM(3);
    PHASE(4, ph4_outproj(F, args)); SEAM(4);
    if (IN(5)) { p5_router(F, args); } SEAM(5);
    PHASE(6, ph6_gateup(F, args)); SEAM(6);
    PHASE(7, ph7_down(F, args)); SEAM(7);
    if (IN(8)) { build_tpre(F); p8_final(F, args); }
#undef IN
#undef SEAM
}

extern "C" void kernel_launch(void* const* d_in, const int* in_sizes, int n_in, void* d_out, int out_size, void* d_ws, size_t ws_size, hipStream_t stream) {
    static int grid = 0;
    if (grid == 0) {
        if (n_in != 21 || out_size != NTOK * D_MODEL || ws_size < WS_END) { fprintf(stderr, "kernel_launch: unexpected problem (n_in %d out %d ws %zu)\n", n_in, out_size, ws_size); grid = -1; return; }
        int dev = 0, cus = 0, per_cu = 0;
        if (hipGetDevice(&dev) != hipSuccess || hipDeviceGetAttribute(&cus, hipDeviceAttributeMultiprocessorCount, dev) != hipSuccess) { grid = -1; return; }
        if (hipFuncSetAttribute((const void*)mk_fwd, hipFuncAttributeMaxDynamicSharedMemorySize, LDS_BYTES) != hipSuccess) { fprintf(stderr, "kernel_launch: hipFuncSetAttribute failed\n"); grid = -1; return; }
        if (hipOccupancyMaxActiveBlocksPerMultiprocessor(&per_cu, (const void*)mk_fwd, NTHR, LDS_BYTES) != hipSuccess || per_cu < 1) { fprintf(stderr, "kernel_launch: occupancy query says %d\n", per_cu); }
        (void)hipGetLastError();
        grid = cus;
    }
    if (grid < 0) return;
    if (hipMemsetAsync((char*)d_ws + WS_CTL, 0, CTL_ZERO_BYTES, stream) != hipSuccess) return;
    Args a{};
    for (int i = 0; i < 21; ++i) a.in[i] = (const float*)d_in[i];
    a.out = (float*)d_out; a.ws = (unsigned char*)d_ws;
#if MK_N_LAUNCHES == 1
    a.ph_lo = 0; a.ph_hi = N_PHASES;
    hipLaunchKernelGGL(mk_fwd, dim3(grid), dim3(NTHR), LDS_BYTES, stream, a);
#else
    for (int p = 0; p < N_PHASES; ++p) { a.ph_lo = p; a.ph_hi = p + 1; hipLaunchKernelGGL(mk_fwd, dim3(grid), dim3(NTHR), LDS_BYTES, stream, a); }
#endif
}
```

```cpp
#include <hip/hip_runtime.h>
#include <stdint.h>
#include <stdio.h>

#ifndef MK_N_LAUNCHES
#define MK_N_LAUNCHES 1
#endif

#ifndef PROBE_MASK
#define PROBE_MASK 0
#endif
#define LAS __attribute__((address_space(3)))
#define GAS __attribute__((address_space(1)))
typedef unsigned short bf16_t;
typedef short bf16x8 __attribute__((ext_vector_type(8)));
typedef float f32x4 __attribute__((ext_vector_type(4)));
typedef float f32x2 __attribute__((ext_vector_type(2)));
typedef unsigned u32x4 __attribute__((ext_vector_type(4)));
typedef unsigned u32x2 __attribute__((ext_vector_type(2)));

constexpr int D_MODEL = 2048, BATCH = 4, SEQ = 2048, NTOK = BATCH * SEQ;
constexpr int N_HEADS = 16, ATTN_W = 1024, LRU_W = 1024;
constexpr int IN_COLS = 5120;
constexpr int N_EXP = 32, D_FF = 2048, NSLOT = NTOK * 4;
constexpr int KDIM = 2048;
constexpr float EPS = 1e-6f;
constexpr int NWAVES = 8, NTHR = 512;
constexpr int PADROWS = NSLOT + N_EXP * 256;

constexpr size_t MiB = 1u << 20;
constexpr size_t WS_CTL = 0, WS_LISTS = 1 * MiB, CTL_ZERO_BYTES = 2 * MiB;
constexpr size_t WS_SEL = 2 * MiB;
constexpr size_t WS_LRUE = 3 * MiB;
constexpr size_t WS_WIN = 4 * MiB, WS_WOUT = 24 * MiB, WS_HN = 32 * MiB, WS_PROJ = 64 * MiB, WS_ATT = 144 * MiB  , WS_HL = 192 * MiB, WS_PC = 224 * MiB;
constexpr size_t WS_MIXED = 256 * MiB, WS_X1 = 288 * MiB, WS_ACT = 352 * MiB, WS_Y = 512 * MiB, WS_WGU = 672 * MiB, WS_WDN = 1184 * MiB, WS_LSE = 1440 * MiB  , WS_HN2S = 1442 * MiB  , WS_END = 2466 * MiB;
static_assert((size_t)PADROWS * 2048 * 2 <= 160 * MiB, "ACT/Y size");
constexpr int CW_BAR = 4096, CW_CNT = 8192;

constexpr int RING_BYTES = 131072;
constexpr int LDSCTL_OFF = 139264;
constexpr int LDS_BYTES = 147456;
constexpr int L_MISC = LDSCTL_OFF;
constexpr int L_TPRE = LDSCTL_OFF + 256;
constexpr int L_CNT = LDSCTL_OFF + 512;

__device__ __forceinline__ unsigned f2bf(float f) { unsigned u = __builtin_bit_cast(unsigned, f); return (u + 0x7fffu + ((u >> 16) & 1u)) >> 16; }
__device__ __forceinline__ unsigned pk2(float lo, float hi) { return f2bf(lo) | (f2bf(hi) << 16); }
__device__ __forceinline__ float bf2f(unsigned short b) { return __builtin_bit_cast(float, (unsigned)b << 16); }
__device__ __forceinline__ float bflo(unsigned w) { return __builtin_bit_cast(float, w << 16); }
__device__ __forceinline__ float bfhi(unsigned w) { return __builtin_bit_cast(float, w & 0xffff0000u); }
__device__ __forceinline__ float wave_sum(float v) {
#pragma unroll
    for (int o = 1; o < 64; o <<= 1) v += __shfl_xor(v, o);
    return v;
}
__device__ __forceinline__ float wave_max(float v) {
#pragma unroll
    for (int o = 1; o < 64; o <<= 1) v = fmaxf(v, __shfl_xor(v, o));
    return v;
}
#define LDS_WAIT() asm volatile("s_waitcnt lgkmcnt(0)" ::: "memory")
#define VM_WAIT() asm volatile("s_waitcnt vmcnt(0)" ::: "memory")

#define XB_TMO      128
#define XB_XCNT(j)  (256  + 64 * (j))
#define XB_XSUB(j)  (1280 + 64 * (j))
#define XB_XGEN(j)  (2304 + 64 * (j))
#define XB_TOP      3328
#define XB_TOPGEN   3392
#define XCD_BAR_WORDS 3456
#define XB_SPIN_CAP (1u << 20)
__device__ __forceinline__ unsigned xb_ld(unsigned* p)              { return __hip_atomic_load(p, __ATOMIC_RELAXED, __HIP_MEMORY_SCOPE_AGENT); }
__device__ __forceinline__ unsigned xb_add(unsigned* p, unsigned v) { return __hip_atomic_fetch_add(p, v, __ATOMIC_RELAXED, __HIP_MEMORY_SCOPE_AGENT); }
__device__ __forceinline__ unsigned xb_xcc_id() { return (unsigned)__builtin_amdgcn_s_getreg((3 << 11) | 20) & 0xFu; }
#define XB_SPIN(cond, bar) do { unsigned _sp = 0; while (cond) { __builtin_amdgcn_s_sleep(1); \
    if ((++_sp & 255u) == 0u) { if (xb_ld(&(bar)[XB_TMO])) break; if (_sp > XB_SPIN_CAP) { atomicAdd(&(bar)[XB_TMO], 1u); break; } } } } while (0)
struct XcdBarrier { unsigned* bar; unsigned x; volatile LAS unsigned* st; };
__device__ __forceinline__ XcdBarrier xcd_barrier_post(unsigned* bar, volatile LAS unsigned* st) {
    XcdBarrier b; b.bar = bar; b.x = xb_xcc_id(); b.st = st;
    if (threadIdx.x == 0) (void)xb_add(&bar[XB_XCNT(b.x)], 1u);
    return b;
}
__device__ __forceinline__ void xcd_barrier_complete(unsigned* bar, unsigned x, unsigned& nloc, unsigned& nx) {
    const unsigned G = gridDim.x * gridDim.y * gridDim.z;
    unsigned sum, cnt, mine, sp = 0u;
    for (;;) {
        sum = 0u; cnt = 0u; mine = 0u;
#pragma unroll
        for (unsigned j = 0; j < 16; ++j) { const unsigned c = xb_ld(&bar[XB_XCNT(j)]); sum += c; cnt += (c > 0u) ? 1u : 0u; mine = (j == x) ? c : mine; }
        if (sum == G) break;
        __builtin_amdgcn_s_sleep(1);
        if ((++sp & 255u) == 0u) { if (xb_ld(&bar[XB_TMO])) break; if (sp > XB_SPIN_CAP) { atomicAdd(&bar[XB_TMO], 1u); break; } }
    }
    nloc = mine > 0u ? mine : 1u; nx = cnt > 0u ? cnt : 1u;
}
__device__ __forceinline__ void xcd_barrier(const XcdBarrier& b) {
    asm volatile("s_waitcnt vmcnt(0)" ::: "memory");
    __syncthreads();
    if (threadIdx.x == 0) {
        unsigned* bar = b.bar;
        __builtin_amdgcn_s_waitcnt(0);
        unsigned nloc = b.st[0], nx = b.st[1];
        if (nloc == 0u) { xcd_barrier_complete(bar, b.x, nloc, nx); b.st[0] = nloc; b.st[1] = nx; }
        const unsigned old = xb_add(&bar[XB_XSUB(b.x)], 1u);
        const unsigned gen = old / nloc;
        if (old + 1u == (gen + 1u) * nloc) {
            __builtin_amdgcn_fence(__ATOMIC_RELEASE, "agent");
            asm volatile("s_waitcnt vmcnt(0)" ::: "memory");
            const unsigned og = xb_add(&bar[XB_TOP], 1u);
            const unsigned tg = og / nx;
            if (og + 1u == (tg + 1u) * nx) xb_add(&bar[XB_TOPGEN], 1u);
            else XB_SPIN(xb_ld(&bar[XB_TOPGEN]) == tg, bar);
            __builtin_amdgcn_fence(__ATOMIC_ACQUIRE, "agent");
            xb_add(&bar[XB_XGEN(b.x)], 1u);
            asm volatile("s_waitcnt vmcnt(0)" ::: "memory");
        } else {
            XB_SPIN(xb_ld(&bar[XB_XGEN(b.x)]) == gen, bar);
            __builtin_amdgcn_fence(__ATOMIC_ACQUIRE, "agent");
            asm volatile("s_waitcnt vmcnt(0)" ::: "memory");
        }
    }
    __syncthreads();
}

typedef float f32x16 __attribute__((ext_vector_type(16)));
typedef short s16x4 __attribute__((ext_vector_type(4)));
typedef short v4i16_t __attribute__((ext_vector_type(4)));
__device__ __forceinline__ s16x4 vtr(const LAS unsigned char* p) { return __builtin_bit_cast(s16x4, __builtin_amdgcn_ds_read_tr16_b64_v4i16((LAS v4i16_t*)p)); }

namespace g8 {
constexpr int BM = 256, BK = 64, HALF = 128, HTB = HALF * BK * 2, STAGE_BYTES = 8 * HTB, NXCD = 8, WGM = 8;
__host__ __device__ __forceinline__ int lds_byte(int r, int c) { const int st = (r >> 4) * 2 + (c >> 5), rr = r & 15, cc = c & 31, ob = rr * 64 + cc * 2; return st * 1024 + (ob ^ (((ob >> 9) & 1) << 5)); }
__host__ __device__ __forceinline__ void stage_rc(int b, int& R, int& C) { const int st = b / 1024, sb = b % 1024, swz = sb ^ (((sb >> 9) & 1) << 5); R = (st >> 1) * 16 + swz / 64; C = (st & 1) * 32 + (swz % 64) / 2; }
__host__ __device__ __forceinline__ int perm32(int rho) { const int n = rho >> 4, i = rho & 15; return 8 * (i >> 2) + 4 * n + (i & 3); }

struct Unit { const char* a; const char* b; int crow, ccol, e, gi; };

struct DenseOrder {
    const char* A; const char* Bt; int nM, nN, nwg, G, c; int ldb;
    __device__ __forceinline__ bool next(int i, Unit& u) const {
        const long L = (long)i * G + c; if (L >= nwg) return false;
        int wgid = (int)L; { const int q = nwg / NXCD, r = nwg % NXCD, xcd = wgid % NXCD, off = wgid / NXCD; wgid = (xcd < r ? xcd * (q + 1) : r * (q + 1) + (xcd - r) * q) + off; }
        const int nig = WGM * nN, gid = wgid / nig, fm = gid * WGM, gsz = (nM - fm) < WGM ? (nM - fm) : WGM;
        const int pm = fm + ((wgid % nig) % gsz), pn = (wgid % nig) / gsz;
        u.a = A + (size_t)pm * BM * KDIM * 2; u.b = Bt + (size_t)pn * BM * 4; u.crow = pm * BM; u.ccol = pn * BM; u.e = 0; u.gi = 0; return true;
    }
};
struct GroupedOrder {
    const char* A; const char* Bt; const LAS int* tpre; int nN, G, c; size_t bstride;
    bool capA; int ldb;
    __device__ __forceinline__ bool next(int i, Unit& u) const {
        const int total = __builtin_amdgcn_readfirstlane(tpre[N_EXP]) * nN; const long L = (long)i * G + c; if (L >= total) return false;
        const int mtile = (int)L / nN, nt = (int)L % nN;
        int e = 0; while (mtile >= __builtin_amdgcn_readfirstlane(tpre[e + 1])) ++e;
        const int mt = mtile - __builtin_amdgcn_readfirstlane(tpre[e]);
        u.a = A + (capA ? ((size_t)e * NTOK + (size_t)mt * BM) : (size_t)mtile * BM) * KDIM * 2;
        u.b = Bt + (size_t)e * bstride + (size_t)nt * BM * 4; u.crow = mtile * BM; u.ccol = nt * BM; u.e = e; u.gi = 0; return true;
    }
};

__device__ __forceinline__ unsigned cvt_pk_bf16(float lo, float hi) { unsigned r; asm volatile("v_cvt_pk_bf16_f32 %0, %1, %2" : "=v"(r) : "v"(lo), "v"(hi)); return r; }

struct EpiBf16 {
    bf16_t* O; int ldc; const float* bias; int bias_stride;
    __device__ __forceinline__ void operator()(const f32x4 (&acc)[2][2][4][2], const Unit& u, int wr, int wc, int fr, int fq) const {
        const int row0 = u.crow + wr * 64 + fr, col0 = u.ccol + wc * 32 + 4 * fq;
        f32x4 bv[2][2];
#pragma unroll
        for (int bj = 0; bj < 2; ++bj)
#pragma unroll
            for (int n = 0; n < 2; ++n) bv[bj][n] = bias ? *(const f32x4*)(bias + (size_t)u.e * bias_stride + col0 + bj * HALF + 16 * n) : (f32x4){0.f, 0.f, 0.f, 0.f};
#pragma unroll
        for (int ai = 0; ai < 2; ++ai)
#pragma unroll
            for (int m = 0; m < 4; ++m) { bf16_t* rowp = O + (size_t)(row0 + ai * HALF + m * 16) * ldc + col0;
#pragma unroll
                for (int bj = 0; bj < 2; ++bj)
#pragma unroll
                    for (int n = 0; n < 2; ++n) { const f32x4 v = acc[ai][bj][m][n] + bv[bj][n];
                        u32x2 w; w.x = cvt_pk_bf16(v[0], v[1]); w.y = cvt_pk_bf16(v[2], v[3]);
                        *(u32x2*)(rowp + bj * HALF + 16 * n) = w; } }
    }
};
struct EpiResF32 {
    float* C; const float* res; int ldc;
    __device__ __forceinline__ void operator()(const f32x4 (&acc)[2][2][4][2], const Unit& u, int wr, int wc, int fr, int fq) const {
        const int row0 = u.crow + wr * 64 + fr, col0 = u.ccol + wc * 32 + 4 * fq;
#pragma unroll
        for (int ai = 0; ai < 2; ++ai)
#pragma unroll
            for (int m = 0; m < 4; ++m) { const size_t off = (size_t)(row0 + ai * HALF + m * 16) * ldc + col0;
#pragma unroll
                for (int bj = 0; bj < 2; ++bj)
#pragma unroll
                    for (int n = 0; n < 2; ++n) { const f32x4 r = *(const f32x4*)(res + off + bj * HALF + n * 16); *(f32x4*)(C + off + bj * HALF + n * 16) = acc[ai][bj][m][n] + r; } }
    }
};
struct EpiSwiglu {
    bf16_t* O; const float* bias;
    __device__ __forceinline__ float act(float g, float up) const {
        g = fminf(g, 7.0f); up = fminf(fmaxf(up, -7.0f), 7.0f);
        const float sg = 1.0f / (1.0f + __expf(-1.702f * g));
        return g * sg * (up + 1.0f);
    }
    __device__ __forceinline__ void operator()(const f32x4 (&acc)[2][2][4][2], const Unit& u, int wr, int wc, int fr, int fq) const {
        const int row0 = u.crow + wr * 64 + fr, col0 = u.ccol + wc * 32 + 4 * fq;
#pragma unroll
        for (int bj = 0; bj < 2; ++bj)
#pragma unroll
            for (int n = 0; n < 2; ++n) { const f32x4 bv = *(const f32x4*)(bias + (size_t)u.e * (2 * D_FF) + col0 + bj * HALF + 16 * n);
#pragma unroll
                for (int ai = 0; ai < 2; ++ai)
#pragma unroll
                    for (int m = 0; m < 4; ++m) { const f32x4 v = acc[ai][bj][m][n] + bv;
                        *(unsigned*)(O + (size_t)(row0 + ai * HALF + m * 16) * D_FF + (col0 >> 1) + bj * (HALF / 2) + 8 * n) = cvt_pk_bf16(act(v[0], v[1]), act(v[2], v[3])); } }
    }
};

template <class Epi, class Sched>
__device__ __forceinline__ void gemm_phase(LAS unsigned char* lds, const Sched& S, const Epi& E) {
    const int tid = threadIdx.x, wid = __builtin_amdgcn_readfirstlane(tid >> 6), lane = tid & 63, wr = wid >> 2, wc = wid & 3, fr = lane & 15, fq = lane >> 4;
    constexpr int K = KDIM, nt = K / BK;
    unsigned voffA[2];
#pragma unroll
    for (int i = 0; i < 2; ++i) { int R, C; stage_rc(tid * 16 + i * 8192, R, C); voffA[i] = (unsigned)(R * K + C) * 2u; }
    const int ldb = S.ldb;
    constexpr size_t kstep = (size_t)(BK * 2);
    constexpr size_t hstep = (size_t)HALF * K * 2;
    const size_t kstepB = (size_t)BK * ldb * 4;
    constexpr size_t hstepB = 512;
    const size_t jstepB = (size_t)16 * ldb * 4;
    const unsigned bvoff = (unsigned)((tid >> 5) * ldb * 4 + (tid & 31) * 16);
    const unsigned ldsbase = (unsigned)(size_t)lds;
    unsigned wbase;
    { const int k0 = tid >> 5, q = tid & 31, f = 2 * ((k0 & 3) + 4 * ((k0 >> 3) & 1)); wbase = ldsbase + (unsigned)(k0 * 256 + (((q >> 1) ^ f) * 16) + (q & 1) * 8); }
    const unsigned ldsw = (unsigned)wid * 1024u;
    const int aoff = lds_byte(wr * 64 + fr, fq * 8);
    int bb[2];
    { const int q = (lane & 15) >> 2, p = lane & 3, f = 2 * (q + 4 * (fq & 1));
#pragma unroll
      for (int nf = 0; nf < 2; ++nf) { const int ch = 4 * wc + 2 * nf + (p >> 1); bb[nf] = (8 * fq + q) * 256 + ((ch ^ f) * 16) + (p & 1) * 8; } }
#define G8_SA(b, h) (((b) * 2 + (h)) * HTB)
#define G8_SB(b, h) ((4 + (b) * 2 + (h)) * HTB)
#define G8_STAGE_A(bufoff, gbase) do { \
        __builtin_amdgcn_global_load_lds((const unsigned*)((const char*)(gbase) + voffA[0]), (LAS unsigned*)(lds + (bufoff) + ldsw), 16, 0, 0); \
        __builtin_amdgcn_global_load_lds((const unsigned*)((const char*)(gbase) + voffA[1]), (LAS unsigned*)(lds + (bufoff) + ldsw + 8192), 16, 0, 0); } while (0)
#define G8_LOADB(R, ptr) do { const char* _p = (const char*)(ptr); \
        asm volatile("s_nop 4\n\tglobal_load_dwordx4 %0, %1, %2" : "=&v"(R##0) : "v"(bvoff), "s"(_p) : "memory"); _p += jstepB; \
        asm volatile("global_load_dwordx4 %0, %1, %2" : "=&v"(R##1) : "v"(bvoff), "s"(_p) : "memory"); _p += jstepB; \
        asm volatile("global_load_dwordx4 %0, %1, %2" : "=&v"(R##2) : "v"(bvoff), "s"(_p) : "memory"); _p += jstepB; \
        asm volatile("global_load_dwordx4 %0, %1, %2" : "=&v"(R##3) : "v"(bvoff), "s"(_p) : "memory"); } while (0)
#define G8_CVT2(R) do { R[0] = __builtin_bit_cast(float, cvt_pk_bf16(R[0], R[1])); R[1] = __builtin_bit_cast(float, cvt_pk_bf16(R[2], R[3])); } while (0)
#define G8_LO2(R) __builtin_shufflevector(R, R, 0, 1)
#define G8_CVTW(R, bufoff, N) do { asm volatile("s_waitcnt vmcnt(" #N ")" : "+v"(R##0), "+v"(R##1), "+v"(R##2), "+v"(R##3) :: "memory"); __builtin_amdgcn_sched_barrier(0); \
        const unsigned _wa = wbase + (unsigned)(bufoff); G8_CVT2(R##0); G8_CVT2(R##1); G8_CVT2(R##2); G8_CVT2(R##3); \
        asm volatile("ds_write_b64 %0, %1\n\tds_write_b64 %0, %2 offset:4096\n\tds_write_b64 %0, %3 offset:8192\n\tds_write_b64 %0, %4 offset:12288" :: "v"(_wa), "v"(G8_LO2(R##0)), "v"(G8_LO2(R##1)), "v"(G8_LO2(R##2)), "v"(G8_LO2(R##3)) : "memory"); } while (0)
#define G8_LDA(dst, b, h) do { _Pragma("unroll") for (int m = 0; m < 4; ++m) _Pragma("unroll") for (int k = 0; k < 2; ++k) dst[m][k] = *(const LAS bf16x8*)(lds + G8_SA(b, h) + aoff + m * 2048 + k * 1024); } while (0)
#define G8_TR(dst, addr, off) asm volatile("ds_read_b64_tr_b16 %0, %1 offset:%2" : "=v"(dst) : "v"(addr), "i"(off) : "memory")
#define G8_LDB(lo, hi, b, h) do { _Pragma("unroll") for (int n = 0; n < 2; ++n) { const unsigned _ad = ldsbase + (unsigned)(G8_SB(b, h)) + (unsigned)bb[n]; \
        G8_TR(lo[n][0], _ad, 0); G8_TR(hi[n][0], _ad, 1024); G8_TR(lo[n][1], _ad, 8192); G8_TR(hi[n][1], _ad, 9216); } } while (0)
#define G8_BF(lo, hi, n, k) __builtin_shufflevector(lo[n][k], hi[n][k], 0, 1, 2, 3, 4, 5, 6, 7)
#define G8_MMA(ai, bj, At, Bl, Bh) do { __builtin_amdgcn_s_setprio(1); _Pragma("unroll") for (int m = 0; m < 4; ++m) _Pragma("unroll") for (int n = 0; n < 2; ++n) _Pragma("unroll") for (int k = 0; k < 2; ++k) \
        acc[ai][bj][m][n] = __builtin_amdgcn_mfma_f32_16x16x32_bf16(G8_BF(Bl, Bh, n, k), At[m][k], acc[ai][bj][m][n], 0, 0, 0); __builtin_amdgcn_s_setprio(0); } while (0)
#define G8_WAIT_V(n) asm volatile("s_waitcnt vmcnt(" #n ")" ::: "memory")
#define G8_WAIT_L(n) do { asm volatile("s_waitcnt lgkmcnt(" #n ")" ::: "memory"); __builtin_amdgcn_sched_barrier(0); } while (0)
#define G8_BAR __builtin_amdgcn_s_barrier()
#define G8_SCHED __builtin_amdgcn_sched_barrier(0)
    Unit cur, nxt; int ui = 0;
    if (!S.next(0, cur)) return;
    f32x4 acc[2][2][4][2];
#pragma unroll
    for (int a = 0; a < 2; ++a)
#pragma unroll
        for (int b = 0; b < 2; ++b)
#pragma unroll
            for (int m = 0; m < 4; ++m)
#pragma unroll
                for (int n = 0; n < 2; ++n) acc[a][b][m][n] = (f32x4){0.f, 0.f, 0.f, 0.f};
    bf16x8 At[4][2]; s16x4 B0l[2][2], B0h[2][2], B1l[2][2], B1h[2][2];
    f32x4 RA0, RA1, RA2, RA3, RB0, RB1, RB2, RB3;
    const char* cA = cur.a; const char* cB = cur.b;
    G8_STAGE_A(G8_SA(0, 0), cA); G8_STAGE_A(G8_SA(0, 1), cA + hstep);
    G8_LOADB(RA, cB); G8_LOADB(RB, cB + hstepB);
    G8_CVTW(RA, G8_SB(0, 0), 4); G8_LOADB(RA, cB + kstepB);
    G8_CVTW(RB, G8_SB(0, 1), 4); G8_LOADB(RB, cB + kstepB + hstepB);
    G8_CVTW(RA, G8_SB(1, 0), 4); G8_LOADB(RA, cB + 2 * kstepB);
    G8_STAGE_A(G8_SA(1, 0), cA + kstep);
    G8_CVTW(RB, G8_SB(1, 1), 6); G8_LOADB(RB, cB + 2 * kstepB + hstepB);
    G8_WAIT_L(0);
    if (wr == 1) G8_BAR;
    G8_BAR;
    const char* aq = cA + kstep; const char* bq = cB + 3 * kstepB;
    for (;;) {
        const bool has_next = S.next(ui + 1, nxt);
        const char* nA = has_next ? nxt.a : cA; const char* nB = has_next ? nxt.b : cB;
        for (int t = 0; t < nt; t += 2) {
            G8_LDB(B0l, B0h, 0, 0); G8_SCHED; G8_LDA(At, 0, 0); G8_STAGE_A(G8_SA(1, 1), aq + hstep); aq = (t == nt - 2) ? nA : aq + kstep;
            G8_WAIT_L(8); G8_BAR; G8_WAIT_L(0); G8_MMA(0, 0, At, B0l, B0h); G8_BAR; G8_SCHED;
            G8_LDB(B1l, B1h, 0, 1); G8_CVTW(RA, G8_SB(0, 0), 8); G8_LOADB(RA, bq);
            G8_BAR; G8_WAIT_L(0); G8_MMA(0, 1, At, B1l, B1h); G8_BAR; G8_SCHED;
            G8_LDA(At, 0, 1); G8_STAGE_A(G8_SA(0, 0), aq);
            G8_BAR; G8_WAIT_L(0); G8_MMA(1, 0, At, B0l, B0h); G8_BAR; G8_SCHED;
            G8_CVTW(RB, G8_SB(0, 1), 6); G8_LOADB(RB, bq + hstepB); bq = (t == nt - 4) ? nB : bq + kstepB;
            G8_BAR; G8_WAIT_L(0); G8_MMA(1, 1, At, B1l, B1h); G8_BAR; G8_SCHED;
            G8_LDB(B0l, B0h, 1, 0); G8_SCHED; G8_LDA(At, 1, 0); G8_STAGE_A(G8_SA(0, 1), aq + hstep); aq += kstep;
            G8_WAIT_L(8); G8_BAR; G8_WAIT_L(0); G8_MMA(0, 0, At, B0l, B0h); G8_BAR; G8_SCHED;
            G8_LDB(B1l, B1h, 1, 1); G8_CVTW(RA, G8_SB(1, 0), 8); G8_LOADB(RA, bq);
            G8_BAR; G8_WAIT_L(0); G8_MMA(0, 1, At, B1l, B1h); G8_BAR; G8_SCHED;
            G8_LDA(At, 1, 1); G8_STAGE_A(G8_SA(1, 0), aq);
            G8_BAR; G8_WAIT_L(0); G8_MMA(1, 0, At, B0l, B0h); G8_BAR; G8_SCHED;
            G8_CVTW(RB, G8_SB(1, 1), 6); G8_LOADB(RB, bq + hstepB); bq += kstepB;
            G8_BAR; G8_WAIT_L(0); G8_MMA(1, 1, At, B1l, B1h); G8_BAR; G8_SCHED;
        }
        asm volatile("s_waitcnt vmcnt(0)" : "+v"(RA0), "+v"(RA1), "+v"(RA2), "+v"(RA3), "+v"(RB0), "+v"(RB1), "+v"(RB2), "+v"(RB3) :: "memory"); __builtin_amdgcn_sched_barrier(0);
        E(acc, cur, wr, wc, fr, fq);
        if (!has_next) break;
#pragma unroll
        for (int a = 0; a < 2; ++a)
#pragma unroll
            for (int b = 0; b < 2; ++b)
#pragma unroll
                for (int m = 0; m < 4; ++m)
#pragma unroll
                    for (int n = 0; n < 2; ++n) acc[a][b][m][n] = (f32x4){0.f, 0.f, 0.f, 0.f};
        cur = nxt; cA = nA; cB = nB; ++ui;
    }
    G8_WAIT_V(0);
    asm volatile("" :: "v"(RA0), "v"(RA1), "v"(RA2), "v"(RA3), "v"(RB0), "v"(RB1), "v"(RB2), "v"(RB3));
    if (wr == 0) G8_BAR;
    G8_BAR;
#undef G8_SA
#undef G8_SB
#undef G8_STAGE_A
#undef G8_LOADB
#undef G8_CVTW
#undef G8_CVT2
#undef G8_LO2
#undef G8_LDA
#undef G8_TR
#undef G8_LDB
#undef G8_BF
#undef G8_MMA
#undef G8_WAIT_V
#undef G8_WAIT_L
#undef G8_BAR
#undef G8_SCHED
}
}

struct Frame {
    LAS unsigned char* lds;
    unsigned* ctl; unsigned char* ws;
    int tid, lane, wave, vcu, G, gw, NGW;
};
struct Args { const float* in[21]; float* out; unsigned char* ws; int ph_lo, ph_hi; };
template <int OFF> __device__ __forceinline__ unsigned long long karg_u64() { const auto kp = __builtin_amdgcn_kernarg_segment_ptr(); unsigned long long v;
    asm volatile("s_load_dwordx2 %0, %1, %2\n\ts_waitcnt lgkmcnt(0)" : "=s"(v) : "s"(kp), "i"(OFF)); return v; }
template <int I> __device__ __forceinline__ const float* karg_in() { return (const float*)karg_u64<8 * I>(); }
__device__ __forceinline__ float* karg_out() { return (float*)karg_u64<8 * 21>(); }


constexpr long CV_IN = (long)KDIM * IN_COLS / 512, CV_OUT = (long)KDIM * D_MODEL / 512, CV_GU = (long)N_EXP * KDIM * 4096 / 512, CV_DN = (long)N_EXP * KDIM * D_MODEL / 512;
__device__ __forceinline__ void conv_chunks(const float* __restrict__ src, bf16_t* __restrict__ dst, long c0, long c1, int gw, int NGW, int lane) {
    long c = c0 + gw;
    for (; c + 7L * NGW < c1; c += 8L * NGW) {
        f32x4 a[8], b[8];
#pragma unroll
        for (int i = 0; i < 8; ++i) { const f32x4* p = (const f32x4*)(src + (c + (long)i * NGW) * 512 + lane * 8); a[i] = __builtin_nontemporal_load(p); b[i] = __builtin_nontemporal_load(p + 1); }
#pragma unroll
        for (int i = 0; i < 8; ++i) { u32x4 w; w.x = pk2(a[i][0], a[i][1]); w.y = pk2(a[i][2], a[i][3]); w.z = pk2(b[i][0], b[i][1]); w.w = pk2(b[i][2], b[i][3]);
            __builtin_nontemporal_store(w, (u32x4*)(dst + (c + (long)i * NGW) * 512 + lane * 8)); }
    }
    for (; c < c1; c += NGW) { const f32x4* p = (const f32x4*)(src + c * 512 + lane * 8); const f32x4 a = __builtin_nontemporal_load(p), b = __builtin_nontemporal_load(p + 1);
        u32x4 w; w.x = pk2(a[0], a[1]); w.y = pk2(a[2], a[3]); w.z = pk2(b[0], b[1]); w.w = pk2(b[2], b[3]); __builtin_nontemporal_store(w, (u32x4*)(dst + c * 512 + lane * 8)); }
}
__device__ __forceinline__ void rms_row_bf16(const float* xrow, const float* g, bf16_t* orow, int lane) {
    const f32x4* xr = (const f32x4*)xrow + lane; const f32x4* gr = (const f32x4*)g + lane;
    f32x4 v[8]; float s = 0.f;
#pragma unroll
    for (int j = 0; j < 8; ++j) { v[j] = xr[64 * j]; s += (v[j][0] * v[j][0] + v[j][1] * v[j][1]) + (v[j][2] * v[j][2] + v[j][3] * v[j][3]); }
    const float rs = rsqrtf(wave_sum(s) * (1.0f / 2048.0f) + EPS);
    u32x2* o = (u32x2*)orow + lane;
#pragma unroll
    for (int j = 0; j < 8; ++j) { const f32x4 gg = gr[64 * j]; u32x2 w; w.x = pk2(v[j][0] * rs * gg[0], v[j][1] * rs * gg[1]); w.y = pk2(v[j][2] * rs * gg[2], v[j][3] * rs * gg[3]); o[64 * j] = w; }
}
__device__ __forceinline__ void p0_prologue(const Frame& F, const Args& a) {
    bf16_t* HN = (bf16_t*)(F.ws + WS_HN);
    for (int m = F.gw; m < NTOK; m += F.NGW) rms_row_bf16(karg_in<0>() + (size_t)m * D_MODEL, karg_in<1>(), HN + (size_t)m * D_MODEL, F.lane);
}

__device__ __forceinline__ float gelu_tanh(float x) { return 0.5f * x * (1.0f + tanhf(0.7978845608028654f * (x + 0.044715f * x * x * x))); }
__device__ __forceinline__ float sigmoidf_(float x) { return 1.0f / (1.0f + __expf(-x)); }
__device__ __forceinline__ void lru_unit(const Frame& F, const Args& a, int unit) {
    const int lane = F.lane;
    const int b = unit >> 9, k = (unit >> 4) & 31, blk = unit & 15;
    const bf16_t* proj = (const bf16_t*)(F.ws + WS_PROJ);
    LAS float* xs = (LAS float*)(F.lds + F.wave * 16384);
    const int ch = blk * 64 + lane;
    const float cw0 = karg_in<3>()[0 * LRU_W + ch], cw1 = karg_in<3>()[1 * LRU_W + ch], cw2 = karg_in<3>()[2 * LRU_W + ch], cw3 = karg_in<3>()[3 * LRU_W + ch], cb = karg_in<4>()[ch];
    const int t0 = k * 64; const size_t row0 = (size_t)b * SEQ + t0;
    const bf16_t* xp = proj + row0 * IN_COLS + 3 * ATTN_W + ch;
    float x0 = (t0 >= 3) ? bf2f(xp[-3 * IN_COLS]) : 0.f, x1 = (t0 >= 2) ? bf2f(xp[-2 * IN_COLS]) : 0.f, x2 = (t0 >= 1) ? bf2f(xp[-1 * IN_COLS]) : 0.f;
    for (int t = 0; t < 64; ++t) {
        const float x3 = bf2f(xp[(size_t)t * IN_COLS]);
        xs[t * 64 + lane] = cb + cw0 * x0 + cw1 * x1 + cw2 * x2 + cw3 * x3;
        x0 = x1; x1 = x2; x2 = x3;
    }
    float wa[64], wx[64];
    const float* wap = karg_in<5>() + (size_t)blk * 4096 + lane; const float* wxp = karg_in<7>() + (size_t)blk * 4096 + lane;
#pragma unroll
    for (int c = 0; c < 64; ++c) { wa[c] = wap[c * 64]; wx[c] = wxp[c * 64]; }
    const float ba = karg_in<6>()[ch], bx = karg_in<8>()[ch];
    const float sp = log1pf(__expf(-karg_in<9>()[ch]));
    float* hl = (float*)(F.ws + WS_HL) + row0 * LRU_W + ch; float* pc = (float*)(F.ws + WS_PC) + row0 * LRU_W + ch;
    LDS_WAIT();
    float h = 0.f, P = 1.f;
    for (int t = 0; t < 64; ++t) {
        float r = ba, ii = bx;
        const LAS f32x4* xr = (const LAS f32x4*)(xs + t * 64);
#pragma unroll
        for (int c4 = 0; c4 < 16; ++c4) { const f32x4 xv = xr[c4];
            r = fmaf(xv[0], wa[4 * c4], r); r = fmaf(xv[1], wa[4 * c4 + 1], r); r = fmaf(xv[2], wa[4 * c4 + 2], r); r = fmaf(xv[3], wa[4 * c4 + 3], r);
            ii = fmaf(xv[0], wx[4 * c4], ii); ii = fmaf(xv[1], wx[4 * c4 + 1], ii); ii = fmaf(xv[2], wx[4 * c4 + 2], ii); ii = fmaf(xv[3], wx[4 * c4 + 3], ii); }
        r = sigmoidf_(r); ii = sigmoidf_(ii);
        const float log_a = -8.0f * r * sp;
        const float av = __expf(log_a);
        const float bv = sqrtf(-expm1f(2.0f * log_a)) * (ii * xs[t * 64 + lane]);
        h = av * h + bv; P *= av;
        hl[(size_t)t * LRU_W] = h; pc[(size_t)t * LRU_W] = P;
    }
    float* ae = (float*)(F.ws + WS_LRUE); float* he = ae + 4 * 32 * 1024;
    ae[(size_t)(b * 32 + k) * 1024 + ch] = P; he[(size_t)(b * 32 + k) * 1024 + ch] = h;
    LDS_WAIT();
}
constexpr int VP = 192;
__device__ __forceinline__ void attn_unit(const Frame& F, const Args& a, int u) {
    const int lane = F.lane, c = lane & 31, hh = lane >> 5;
    const int br = u >> 12, rem = u & 4095, bh = rem >> 6, qt = rem & 63;
    const int b = bh >> 4, h = bh & 15;
    const int dsh = br * 2, d = 1 << dsh;
    const int r = qt & (d - 1), ltile = qt >> dsh, l0 = ltile * 32;
    const bf16_t* proj = (const bf16_t*)(F.ws + WS_PROJ) + (size_t)b * SEQ * IN_COLS + h * 64;
    LAS unsigned char* vl = F.lds + F.wave * 16384;
    bf16x8 qf[4];
    { const bf16_t* qrow = proj + (size_t)((l0 + c) * d + r) * IN_COLS + 8 * hh;
#pragma unroll
      for (int s = 0; s < 4; ++s) qf[s] = *(const bf16x8*)(qrow + 16 * s); }
    constexpr float LOG2E = 1.4426950408889634f;
    const float slope2 = exp2f(-0.5f * (float)(h + 1)) * LOG2E * (float)d;
    const float sc2 = 0.125f * LOG2E;
    float m = -INFINITY, lsum = 0.f;
    f32x16 o0, o1;
#pragma unroll
    for (int i = 0; i < 16; ++i) { o0[i] = 0.f; o1[i] = 0.f; }
    const int jfirst = ltile >= 4 ? 0 : 4 - ltile;
    bf16x8 kf[4], kn[4]; u32x4 vr[4], vn[4];
    const int vrow = lane >> 3, vch = lane & 7;
    { const int lk0 = l0 - 128 + 32 * jfirst;
      const bf16_t* krow = proj + (size_t)((lk0 + c) * d + r) * IN_COLS + ATTN_W + 8 * hh;
#pragma unroll
      for (int s = 0; s < 4; ++s) kf[s] = *(const bf16x8*)(krow + 16 * s);
#pragma unroll
      for (int i = 0; i < 4; ++i) vr[i] = *(const u32x4*)(proj + (size_t)((lk0 + vrow + 8 * i) * d + r) * IN_COLS + 2 * ATTN_W + vch * 8); }
    const LAS unsigned char* vtr_base = vl + (4 * hh + ((lane & 15) >> 2)) * VP + (16 * ((lane >> 4) & 1) + 4 * (lane & 3)) * 2;
    for (int j = jfirst; j <= 4; ++j) {
        if (j < 4) { const int lk0 = l0 - 128 + 32 * (j + 1);
            const bf16_t* krow = proj + (size_t)((lk0 + c) * d + r) * IN_COLS + ATTN_W + 8 * hh;
#pragma unroll
            for (int s = 0; s < 4; ++s) kn[s] = *(const bf16x8*)(krow + 16 * s);
#pragma unroll
            for (int i = 0; i < 4; ++i) vn[i] = *(const u32x4*)(proj + (size_t)((lk0 + vrow + 8 * i) * d + r) * IN_COLS + 2 * ATTN_W + vch * 8); }
#pragma unroll
        for (int i = 0; i < 4; ++i) *(LAS u32x4*)(vl + (vrow + 8 * i) * VP + vch * 16) = vr[i];
        f32x16 sa;
#pragma unroll
        for (int i = 0; i < 16; ++i) sa[i] = 0.f;
#pragma unroll
        for (int s = 0; s < 4; ++s) sa = __builtin_amdgcn_mfma_f32_32x32x16_bf16(kf[s], qf[s], sa, 0, 0, 0);
        const float relbase = (float)(c + 128 - 32 * j);
        float mx = -INFINITY;
#pragma unroll
        for (int i = 0; i < 16; ++i) { const int ki = (i & 3) + 8 * (i >> 2) + 4 * hh;
            float v = sa[i] * sc2 - slope2 * (relbase - (float)ki);
            const bool valid = (j == 0) ? (ki >= c) : ((j == 4) ? (ki <= c) : true);
            v = valid ? v : -INFINITY; sa[i] = v; mx = fmaxf(mx, v); }
        mx = fmaxf(mx, __shfl_xor(mx, 32));
        const float mnew = fmaxf(m, mx);
        const float alpha = __builtin_amdgcn_exp2f(m - mnew);
        float ps = 0.f;
#pragma unroll
        for (int i = 0; i < 16; ++i) { const float p = __builtin_amdgcn_exp2f(sa[i] - mnew); sa[i] = p; ps += p; }
        ps += __shfl_xor(ps, 32);
        lsum = lsum * alpha + ps; m = mnew;
#pragma unroll
        for (int i = 0; i < 16; ++i) { o0[i] *= alpha; o1[i] *= alpha; }
        bf16x8 pf[2];
#pragma unroll
        for (int s = 0; s < 2; ++s) { u32x4 w; w.x = g8::cvt_pk_bf16(sa[8 * s + 0], sa[8 * s + 1]); w.y = g8::cvt_pk_bf16(sa[8 * s + 2], sa[8 * s + 3]); w.z = g8::cvt_pk_bf16(sa[8 * s + 4], sa[8 * s + 5]); w.w = g8::cvt_pk_bf16(sa[8 * s + 6], sa[8 * s + 7]);
            pf[s] = __builtin_bit_cast(bf16x8, w); }
#pragma unroll
        for (int s = 0; s < 2; ++s) {
#pragma unroll
            for (int nt = 0; nt < 2; ++nt) {
                const s16x4 lo = vtr(vtr_base + (16 * s) * VP + nt * 64), hi = vtr(vtr_base + (16 * s + 8) * VP + nt * 64);
                bf16x8 af; af[0] = lo[0]; af[1] = lo[1]; af[2] = lo[2]; af[3] = lo[3]; af[4] = hi[0]; af[5] = hi[1]; af[6] = hi[2]; af[7] = hi[3];
                if (nt == 0) o0 = __builtin_amdgcn_mfma_f32_32x32x16_bf16(af, pf[s], o0, 0, 0, 0); else o1 = __builtin_amdgcn_mfma_f32_32x32x16_bf16(af, pf[s], o1, 0, 0, 0);
            }
        }
#pragma unroll
        for (int s = 0; s < 4; ++s) { kf[s] = kn[s]; vr[s] = vn[s]; }
    }
    const float inv = 1.0f / lsum;
    const size_t tok = (size_t)b * SEQ + (size_t)((l0 + c) * d + r);
    bf16_t* orow = (bf16_t*)(F.ws + WS_ATT) + ((size_t)br * NTOK + tok) * ATTN_W + h * 64 + 4 * hh;
#pragma unroll
    for (int g = 0; g < 4; ++g) {
        u32x2 w0, w1;
        w0.x = g8::cvt_pk_bf16(o0[4 * g] * inv, o0[4 * g + 1] * inv); w0.y = g8::cvt_pk_bf16(o0[4 * g + 2] * inv, o0[4 * g + 3] * inv);
        w1.x = g8::cvt_pk_bf16(o1[4 * g] * inv, o1[4 * g + 1] * inv); w1.y = g8::cvt_pk_bf16(o1[4 * g + 2] * inv, o1[4 * g + 3] * inv);
        *(u32x2*)(orow + 8 * g) = w0; *(u32x2*)(orow + 32 + 8 * g) = w1;
    }
    if (hh == 0) ((float*)(F.ws + WS_LSE))[((size_t)br * NTOK + tok) * 16 + h] = 0.6931471805599453f * (m + __builtin_amdgcn_logf(lsum));
}
__device__ __forceinline__ void p2_mixers(const Frame& F, const Args& a) {
    for (int u = F.gw; u < 2048; u += F.NGW) lru_unit(F, a, u);
    for (int u = F.gw; u < 3 * 4096; u += F.NGW) attn_unit(F, a, u);
}

__device__ __forceinline__ void p3_mix(const Frame& F, const Args& a) {
    LAS float* Hin = (LAS float*)F.lds;
    const float* ae = (const float*)(F.ws + WS_LRUE); const float* he = ae + 4 * 32 * 1024;
    const bf16_t* proj = (const bf16_t*)(F.ws + WS_PROJ);
    bf16_t* mixed = (bf16_t*)(F.ws + WS_MIXED);
    for (int grp = F.vcu; grp < NTOK / 32; grp += F.G) {
        const int tok0 = grp * 32, b = tok0 / SEQ, k = (tok0 % SEQ) / 64;
        __syncthreads();
        for (int d = F.tid; d < LRU_W; d += NTHR) { float H = 0.f;
            for (int j0 = 0; j0 < k; j0 += 8) { float av[8], hv[8];
#pragma unroll
                for (int jj = 0; jj < 8; ++jj) { const bool ok = (j0 + jj) < k; const size_t o = (size_t)(b * 32 + (ok ? j0 + jj : 0)) * 1024 + d; const float a1 = ae[o], h1 = he[o]; av[jj] = ok ? a1 : 1.0f; hv[jj] = ok ? h1 : 0.0f; }
#pragma unroll
                for (int jj = 0; jj < 8; ++jj) H = av[jj] * H + hv[jj]; }
            Hin[d] = H; }
        __syncthreads();
        for (int tt = F.wave; tt < 32; tt += NWAVES) {
            const size_t tok = (size_t)tok0 + tt;
            { const bf16_t* ao = (const bf16_t*)(F.ws + WS_ATT); const float* lse = (const float*)(F.ws + WS_LSE); const f32x4* gr = (const f32x4*)karg_in<10>() + F.lane;
              f32x4 v[4]; float s = 0.f;
#pragma unroll
              for (int j = 0; j < 4; ++j) { const int hd = (F.lane >> 4) + 4 * j;
                  const float l0 = lse[(0 * (size_t)NTOK + tok) * 16 + hd], l1 = lse[(1 * (size_t)NTOK + tok) * 16 + hd], l2 = lse[(2 * (size_t)NTOK + tok) * 16 + hd];
                  const float M = fmaxf(l0, fmaxf(l1, l2)); float w0 = __expf(l0 - M), w1 = __expf(l1 - M), w2 = __expf(l2 - M); const float iw = 1.0f / (w0 + w1 + w2); w0 *= iw; w1 *= iw; w2 *= iw;
                  const u32x2 a0 = *((const u32x2*)(ao + (0 * (size_t)NTOK + tok) * ATTN_W) + F.lane + 64 * j), a1 = *((const u32x2*)(ao + (1 * (size_t)NTOK + tok) * ATTN_W) + F.lane + 64 * j), a2 = *((const u32x2*)(ao + (2 * (size_t)NTOK + tok) * ATTN_W) + F.lane + 64 * j);
                  v[j][0] = w0 * bflo(a0.x) + w1 * bflo(a1.x) + w2 * bflo(a2.x); v[j][1] = w0 * bfhi(a0.x) + w1 * bfhi(a1.x) + w2 * bfhi(a2.x);
                  v[j][2] = w0 * bflo(a0.y) + w1 * bflo(a1.y) + w2 * bflo(a2.y); v[j][3] = w0 * bfhi(a0.y) + w1 * bfhi(a1.y) + w2 * bfhi(a2.y);
                  s += (v[j][0] * v[j][0] + v[j][1] * v[j][1]) + (v[j][2] * v[j][2] + v[j][3] * v[j][3]); }
              const float rs = rsqrtf(wave_sum(s) * (1.0f / 1024.0f) + EPS);
              u32x2* o = (u32x2*)(mixed + tok * D_MODEL) + F.lane;
#pragma unroll
              for (int j = 0; j < 4; ++j) { const f32x4 g = gr[64 * j]; u32x2 w; w.x = pk2(v[j][0] * rs * g[0], v[j][1] * rs * g[1]); w.y = pk2(v[j][2] * rs * g[2], v[j][3] * rs * g[3]); o[64 * j] = w; } }
            { const f32x4* hr = (const f32x4*)((const float*)(F.ws + WS_HL) + tok * LRU_W) + F.lane; const f32x4* pr = (const f32x4*)((const float*)(F.ws + WS_PC) + tok * LRU_W) + F.lane;
              const u32x2* gp = (const u32x2*)(proj + tok * IN_COLS + 3 * ATTN_W + LRU_W) + F.lane; const f32x4* gr = (const f32x4*)karg_in<11>() + F.lane;
              f32x4 v[4]; float s = 0.f;
#pragma unroll
              for (int j = 0; j < 4; ++j) { const f32x4 hv = hr[64 * j], pv = pr[64 * j]; const u32x2 gw = gp[64 * j]; const f32x4 hi = *(const LAS f32x4*)(Hin + (F.lane + 64 * j) * 4);
                  v[j][0] = (hv[0] + pv[0] * hi[0]) * gelu_tanh(bflo(gw.x)); v[j][1] = (hv[1] + pv[1] * hi[1]) * gelu_tanh(bfhi(gw.x));
                  v[j][2] = (hv[2] + pv[2] * hi[2]) * gelu_tanh(bflo(gw.y)); v[j][3] = (hv[3] + pv[3] * hi[3]) * gelu_tanh(bfhi(gw.y));
                  s += (v[j][0] * v[j][0] + v[j][1] * v[j][1]) + (v[j][2] * v[j][2] + v[j][3] * v[j][3]); }
              const float rs = rsqrtf(wave_sum(s) * (1.0f / 1024.0f) + EPS);
              u32x2* o = (u32x2*)(mixed + tok * D_MODEL + ATTN_W) + F.lane;
#pragma unroll
              for (int j = 0; j < 4; ++j) { const f32x4 g = gr[64 * j]; u32x2 w; w.x = pk2(v[j][0] * rs * g[0], v[j][1] * rs * g[1]); w.y = pk2(v[j][2] * rs * g[2], v[j][3] * rs * g[3]); o[64 * j] = w; } }
        }
    }
    __syncthreads();
}

__device__ __forceinline__ void p5_router(const Frame& F, const Args& a) {
    const float* x1 = (const float*)(F.ws + WS_X1); bf16_t* hn2s = (bf16_t*)(F.ws + WS_HN2S);
    const float* g = karg_in<13>(); const float* wr = karg_in<14>(); const float* br = karg_in<15>();
    int* cnt = (int*)(F.ctl + CW_CNT);
    int* sel_e = (int*)(F.ws + WS_SEL); int* sel_pos = sel_e + NSLOT; float* sel_g = (float*)(sel_pos + NSLOT);
    LAS float* PART = (LAS float*)F.lds;
    LAS float* SSQ = PART + 8 * 1024;
    LAS float* RS = SSQ + 256;
    LAS float* LG = RS + 32;
    LAS int* lcnt = (LAS int*)(LG + 1024);
    LAS int* gbase = lcnt + 32;
    LAS int* ent_e = gbase + 32;
    LAS int* ent_r = ent_e + 128;
    LAS float* ent_g = (LAS float*)(ent_r + 128);
    const int lane = F.lane, r16 = lane & 15, kq = lane >> 4;
    for (int grp = F.vcu; grp < NTOK / 32; grp += F.G) {
        const int tok0 = grp * 32;
        __syncthreads();
        if (F.tid < 32) lcnt[F.tid] = 0;
        f32x4 acc00 = {0.f, 0.f, 0.f, 0.f}, acc01 = acc00, acc10 = acc00, acc11 = acc00; float ss0 = 0.f, ss1 = 0.f;
        const float* xa = x1 + (size_t)(tok0 + r16) * D_MODEL + F.wave * 256 + 4 * kq;
        const float* gp = g + F.wave * 256 + 4 * kq;
        const float* wp = wr + (size_t)(F.wave * 256 + 4 * kq) * N_EXP + r16;
#pragma unroll 4
        for (int S = 0; S < 16; ++S) {
            const f32x4 xv0 = *(const f32x4*)(xa + 16 * S), xv1 = *(const f32x4*)(xa + 16 * S + (size_t)16 * D_MODEL), gv = *(const f32x4*)(gp + 16 * S);
            float b0[4], b1[4];
#pragma unroll
            for (int q = 0; q < 4; ++q) { b0[q] = wp[(size_t)(16 * S + q) * N_EXP]; b1[q] = wp[(size_t)(16 * S + q) * N_EXP + 16]; }
            ss0 += (xv0[0] * xv0[0] + xv0[1] * xv0[1]) + (xv0[2] * xv0[2] + xv0[3] * xv0[3]);
            ss1 += (xv1[0] * xv1[0] + xv1[1] * xv1[1]) + (xv1[2] * xv1[2] + xv1[3] * xv1[3]);
#pragma unroll
            for (int q = 0; q < 4; ++q) { const float a0 = xv0[q] * gv[q], a1 = xv1[q] * gv[q];
                acc00 = __builtin_amdgcn_mfma_f32_16x16x4f32(a0, b0[q], acc00, 0, 0, 0); acc01 = __builtin_amdgcn_mfma_f32_16x16x4f32(a0, b1[q], acc01, 0, 0, 0);
                acc10 = __builtin_amdgcn_mfma_f32_16x16x4f32(a1, b0[q], acc10, 0, 0, 0); acc11 = __builtin_amdgcn_mfma_f32_16x16x4f32(a1, b1[q], acc11, 0, 0, 0); }
        }
        { LAS float* pw = PART + F.wave * 1024;
#pragma unroll
          for (int q = 0; q < 4; ++q) { const int tr = 4 * kq + q;
              pw[tr * 32 + r16] = acc00[q]; pw[tr * 32 + 16 + r16] = acc01[q]; pw[(16 + tr) * 32 + r16] = acc10[q]; pw[(16 + tr) * 32 + 16 + r16] = acc11[q]; }
          ss0 += __shfl_xor(ss0, 16); ss0 += __shfl_xor(ss0, 32); ss1 += __shfl_xor(ss1, 16); ss1 += __shfl_xor(ss1, 32);
          if (kq == 0) { SSQ[F.wave * 32 + r16] = ss0; SSQ[F.wave * 32 + 16 + r16] = ss1; } }
        __syncthreads();
        if (F.tid < 32) { float t = 0.f;
#pragma unroll
            for (int w = 0; w < 8; ++w) t += SSQ[w * 32 + F.tid];
            RS[F.tid] = rsqrtf(t * (1.0f / 2048.0f) + EPS); }
        __syncthreads();
        { const int tt = F.tid >> 4, eg = F.tid & 15; float s0 = 0.f, s1 = 0.f;
#pragma unroll
          for (int w = 0; w < 8; ++w) { const f32x2 v = *(const LAS f32x2*)(PART + w * 1024 + tt * 32 + 2 * eg); s0 += v[0]; s1 += v[1]; }
          const float rs = RS[tt];
          LG[tt * 32 + 2 * eg] = s0 * rs + br[2 * eg]; LG[tt * 32 + 2 * eg + 1] = s1 * rs + br[2 * eg + 1]; }
        __syncthreads();
        for (int t4 = 0; t4 < 4; ++t4) {
            const int tk = F.wave * 4 + t4;
            float cur = (lane < 32) ? LG[tk * 32 + lane] : -INFINITY;
            int i0 = 0, i1 = 0, i2 = 0, i3 = 0; float v0 = 0.f, v1 = 0.f, v2 = 0.f, v3 = 0.f;
#pragma unroll
            for (int k = 0; k < 4; ++k) {
                const float mx = wave_max(cur);
                const unsigned long long bal = __ballot(cur == mx);
                const int bi = __ffsll((long long)bal) - 1;
                if (k == 0) { i0 = bi; v0 = mx; } else if (k == 1) { i1 = bi; v1 = mx; } else if (k == 2) { i2 = bi; v2 = mx; } else { i3 = bi; v3 = mx; }
                if (lane == bi) cur = -INFINITY;
            }
            if (lane == 0) {
                const float e1 = __expf(v1 - v0), e2 = __expf(v2 - v0), e3 = __expf(v3 - v0); const float inv = 1.0f / (1.0f + e1 + e2 + e3);
                const int base = tk * 4;
                ent_e[base + 0] = i0; ent_r[base + 0] = __hip_atomic_fetch_add(&lcnt[i0], 1, __ATOMIC_RELAXED, __HIP_MEMORY_SCOPE_WORKGROUP); ent_g[base + 0] = inv;
                ent_e[base + 1] = i1; ent_r[base + 1] = __hip_atomic_fetch_add(&lcnt[i1], 1, __ATOMIC_RELAXED, __HIP_MEMORY_SCOPE_WORKGROUP); ent_g[base + 1] = e1 * inv;
                ent_e[base + 2] = i2; ent_r[base + 2] = __hip_atomic_fetch_add(&lcnt[i2], 1, __ATOMIC_RELAXED, __HIP_MEMORY_SCOPE_WORKGROUP); ent_g[base + 2] = e2 * inv;
                ent_e[base + 3] = i3; ent_r[base + 3] = __hip_atomic_fetch_add(&lcnt[i3], 1, __ATOMIC_RELAXED, __HIP_MEMORY_SCOPE_WORKGROUP); ent_g[base + 3] = e3 * inv;
            }
        }
        __syncthreads();
        if (F.tid < 32) { const int n = lcnt[F.tid]; gbase[F.tid] = n > 0 ? atomicAdd(&cnt[F.tid], n) : 0; }
        __syncthreads();
        if (F.tid < 128) { const int e = ent_e[F.tid], pos = gbase[e] + ent_r[F.tid], tok = tok0 + (F.tid >> 2);
            sel_e[tok * 4 + (F.tid & 3)] = e; sel_pos[tok * 4 + (F.tid & 3)] = pos; sel_g[tok * 4 + (F.tid & 3)] = ent_g[F.tid]; }
        for (int t4 = 0; t4 < 4; ++t4) { const int tk = F.wave * 4 + t4; const float rs = RS[tk];
            const f32x4* xr = (const f32x4*)(x1 + (size_t)(tok0 + tk) * D_MODEL) + lane; const f32x4* gr = (const f32x4*)g + lane; u32x2 w[8];
#pragma unroll
            for (int j = 0; j < 8; ++j) { const f32x4 v = xr[64 * j], gg = gr[64 * j]; w[j].x = pk2(v[0] * rs * gg[0], v[1] * rs * gg[1]); w[j].y = pk2(v[2] * rs * gg[2], v[3] * rs * gg[3]); }
#pragma unroll
            for (int k = 0; k < 4; ++k) { const int e = ent_e[tk * 4 + k], pos = gbase[e] + ent_r[tk * 4 + k]; u32x2* o = (u32x2*)(hn2s + ((size_t)e * NTOK + pos) * D_MODEL) + lane;
#pragma unroll
                for (int j = 0; j < 8; ++j) o[64 * j] = w[j]; } }
    }
    __syncthreads();
}

__device__ __forceinline__ void build_tpre(const Frame& F) {
    LAS int* tpre = (LAS int*)(F.lds + L_TPRE);
    __syncthreads();
    if (F.tid == 0) { const int* cnt = (const int*)(F.ctl + CW_CNT); int acc = 0; for (int e = 0; e < N_EXP; ++e) { tpre[e] = acc; acc += (cnt[e] + 255) >> 8; } tpre[N_EXP] = acc; }
    __syncthreads();
}

__device__ __forceinline__ void p8_final(const Frame& F, const Args& a) {
    const LAS int* tpre = (const LAS int*)(F.lds + L_TPRE);
    const float* x1 = (const float*)(F.ws + WS_X1); const bf16_t* Y = (const bf16_t*)(F.ws + WS_Y);
    const int* sel_e = (const int*)(F.ws + WS_SEL); const int* sel_pos = sel_e + NSLOT; const float* sel_g = (const float*)(sel_pos + NSLOT);
    const f32x4* gr = (const f32x4*)karg_in<20>() + F.lane;
    for (int tok = F.gw; tok < NTOK; tok += F.NGW) {
        const f32x4* xr = (const f32x4*)(x1 + (size_t)tok * D_MODEL) + F.lane;
        f32x4 v[8];
#pragma unroll
        for (int j = 0; j < 8; ++j) v[j] = xr[64 * j];
#pragma unroll
        for (int k = 0; k < 4; ++k) {
            const int e = sel_e[tok * 4 + k]; const size_t row = (size_t)tpre[e] * 256 + sel_pos[tok * 4 + k]; const float gk = sel_g[tok * 4 + k];
            const u32x2* yp = (const u32x2*)(Y + row * D_MODEL) + F.lane;
#pragma unroll
            for (int j = 0; j < 8; ++j) { const u32x2 w = yp[64 * j]; v[j][0] += gk * bflo(w.x); v[j][1] += gk * bfhi(w.x); v[j][2] += gk * bflo(w.y); v[j][3] += gk * bfhi(w.y); }
        }
        float s = 0.f;
#pragma unroll
        for (int j = 0; j < 8; ++j) s += (v[j][0] * v[j][0] + v[j][1] * v[j][1]) + (v[j][2] * v[j][2] + v[j][3] * v[j][3]);
        const float rs = rsqrtf(wave_sum(s) * (1.0f / 2048.0f) + EPS);
        f32x4* o = (f32x4*)(karg_out() + (size_t)tok * D_MODEL) + F.lane;
#pragma unroll
        for (int j = 0; j < 8; ++j) { const f32x4 g = gr[64 * j]; o[64 * j] = (f32x4){v[j][0] * rs * g[0], v[j][1] * rs * g[1], v[j][2] * rs * g[2], v[j][3] * rs * g[3]}; }
    }
}

__device__ __forceinline__ void ph1_inproj(const Frame& F, const Args& args) {
    unsigned char* ws = F.ws;
    g8::DenseOrder S{(const char*)(ws + WS_HN), (const char*)karg_in<2>(), NTOK / 256, IN_COLS / 256, (NTOK / 256) * (IN_COLS / 256), F.G, (int)blockIdx.x, IN_COLS};
    g8::EpiBf16 E{(bf16_t*)(ws + WS_PROJ), IN_COLS, nullptr, 0};
    g8::gemm_phase<g8::EpiBf16, g8::DenseOrder>(F.lds, S, E);
}
__device__ __forceinline__ void ph4_outproj(const Frame& F, const Args& args) {
    unsigned char* ws = F.ws;
    g8::DenseOrder S{(const char*)(ws + WS_MIXED), (const char*)karg_in<12>(), NTOK / 256, D_MODEL / 256, (NTOK / 256) * (D_MODEL / 256), F.G, (int)blockIdx.x, D_MODEL};
    g8::EpiResF32 E{(float*)(ws + WS_X1), karg_in<0>(), D_MODEL};
    g8::gemm_phase<g8::EpiResF32, g8::DenseOrder>(F.lds, S, E);
}
__device__ __forceinline__ void ph6_gateup(const Frame& F, const Args& args) {
    unsigned char* ws = F.ws;
    build_tpre(F);
    g8::GroupedOrder S{(const char*)(ws + WS_HN2S), (const char*)karg_in<16>(), (const LAS int*)(F.lds + L_TPRE), 4096 / 256, F.G, (int)blockIdx.x, (size_t)4096 * KDIM * 4, true, 4096};
    g8::EpiSwiglu E{(bf16_t*)(ws + WS_ACT), karg_in<17>()};
    g8::gemm_phase<g8::EpiSwiglu, g8::GroupedOrder>(F.lds, S, E);
}
__device__ __forceinline__ void ph7_down(const Frame& F, const Args& args) {
    unsigned char* ws = F.ws;
    build_tpre(F);
    g8::GroupedOrder S{(const char*)(ws + WS_ACT), (const char*)karg_in<18>(), (const LAS int*)(F.lds + L_TPRE), D_MODEL / 256, F.G, (int)blockIdx.x, (size_t)D_MODEL * KDIM * 4, false, D_MODEL};
    g8::EpiBf16 E{(bf16_t*)(ws + WS_Y), D_MODEL, karg_in<19>(), D_MODEL};
    g8::gemm_phase<g8::EpiBf16, g8::GroupedOrder>(F.lds, S, E);
}

constexpr int N_PHASES = 9;
__global__ void __launch_bounds__(NTHR, 2) mk_fwd(Args args) {
    extern __shared__ __attribute__((aligned(16))) unsigned char lds_raw[];
    Frame F;
    F.lds = (LAS unsigned char*)lds_raw;
    F.tid = threadIdx.x; F.lane = F.tid & 63; F.wave = __builtin_amdgcn_readfirstlane(F.tid >> 6);
    F.G = gridDim.x; { const int bx = blockIdx.x; F.vcu = (F.G % 8 == 0) ? (bx % 8) * (F.G / 8) + bx / 8 : bx; }
    F.gw = F.vcu * NWAVES + F.wave; F.NGW = F.G * NWAVES;
    F.ws = args.ws; F.ctl = (unsigned*)(args.ws + WS_CTL);
    for (int u = F.tid; u < (LDS_BYTES - LDSCTL_OFF) / 4; u += NTHR) ((LAS unsigned*)(F.lds + LDSCTL_OFF))[u] = 0u;
    __syncthreads();
    const int lo = args.ph_lo, hi = args.ph_hi;
    XcdBarrier bar; bar.bar = F.ctl + CW_BAR; bar.x = 0; bar.st = nullptr;
    if (hi - lo > 1) bar = xcd_barrier_post(F.ctl + CW_BAR, (volatile LAS unsigned*)(F.lds + L_MISC) + 8);
#define IN(k) (lo <= (k) && (k) < hi)
#define SEAM(k) do { if (IN(k) && IN((k) + 1)) xcd_barrier(bar); } while (0)

#define PHASE(k, call) do { if (IN(k)) { call; } if ((PROBE_MASK >> (k)) & 1) { xcd_barrier(bar); if (IN(k)) { call; } } } while (0)
    PHASE(0, p0_prologue(F, args)); SEAM(0);
    PHASE(1, ph1_inproj(F, args)); SEAM(1);
    PHASE(2, p2_mixers(F, args)); SEAM(2);
    PHASE(3, p3_mix(F, args)); SEAM(3);
    PHASE(4, ph4_outproj(F, args)); SEAM(4);
    if (IN(5)) { p5_router(F, args); } SEAM(5);
    PHASE(6, ph6_gateup(F, args)); SEAM(6);
    PHASE(7, ph7_down(F, args)); SEAM(7);
    if (IN(8)) { build_tpre(F); p8_final(F, args); }
#undef IN
#undef SEAM
}

extern "C" void kernel_launch(void* const* d_in, const int* in_sizes, int n_in, void* d_out, int out_size, void* d_ws, size_t ws_size, hipStream_t stream) {
    static int grid = 0;
    if (grid == 0) {
        if (n_in != 21 || out_size != NTOK * D_MODEL || ws_size < WS_END) { fprintf(stderr, "kernel_launch: unexpected problem (n_in %d out %d ws %zu)\n", n_in, out_size, ws_size); grid = -1; return; }
        int dev = 0, cus = 0, per_cu = 0;
        if (hipGetDevice(&dev) != hipSuccess || hipDeviceGetAttribute(&cus, hipDeviceAttributeMultiprocessorCount, dev) != hipSuccess) { grid = -1; return; }
        if (hipFuncSetAttribute((const void*)mk_fwd, hipFuncAttributeMaxDynamicSharedMemorySize, LDS_BYTES) != hipSuccess) { fprintf(stderr, "kernel_launch: hipFuncSetAttribute failed\n"); grid = -1; return; }
        if (hipOccupancyMaxActiveBlocksPerMultiprocessor(&per_cu, (const void*)mk_fwd, NTHR, LDS_BYTES) != hipSuccess || per_cu < 1) { fprintf(stderr, "kernel_launch: occupancy query says %d\n", per_cu); }
        (void)hipGetLastError();
        grid = cus;
    }
    if (grid < 0) return;
    if (hipMemsetAsync((char*)d_ws + WS_CTL, 0, CTL_ZERO_BYTES, stream) != hipSuccess) return;
    Args a{};
    for (int i = 0; i < 21; ++i) a.in[i] = (const float*)d_in[i];
    a.out = (float*)d_out; a.ws = (unsigned char*)d_ws;
#if MK_N_LAUNCHES == 1
    a.ph_lo = 0; a.ph_hi = N_PHASES;
    hipLaunchKernelGGL(mk_fwd, dim3(grid), dim3(NTHR), LDS_BYTES, stream, a);
#else
    for (int p = 0; p < N_PHASES; ++p) { a.ph_lo = p; a.ph_hi = p + 1; hipLaunchKernelGGL(mk_fwd, dim3(grid), dim3(NTHR), LDS_BYTES, stream, a); }
#endif
}
```

```cpp
#include <hip/hip_runtime.h>
#include <stdint.h>
#include <stdio.h>

#ifndef MK_N_LAUNCHES
#define MK_N_LAUNCHES 1
#endif

#ifndef PROBE_MASK
#define PROBE_MASK 0
#endif
#define LAS __attribute__((address_space(3)))
#define GAS __attribute__((address_space(1)))
typedef unsigned short bf16_t;
typedef short bf16x8 __attribute__((ext_vector_type(8)));
typedef float f32x4 __attribute__((ext_vector_type(4)));
typedef float f32x2 __attribute__((ext_vector_type(2)));
typedef unsigned u32x4 __attribute__((ext_vector_type(4)));
typedef unsigned u32x2 __attribute__((ext_vector_type(2)));

constexpr int D_MODEL = 2048, BATCH = 4, SEQ = 2048, NTOK = BATCH * SEQ;
constexpr int N_HEADS = 16, ATTN_W = 1024, LRU_W = 1024;
constexpr int IN_COLS = 5120;
constexpr int N_EXP = 32, D_FF = 2048, NSLOT = NTOK * 4;
constexpr int KDIM = 2048;
constexpr float EPS = 1e-6f;
constexpr int NWAVES = 8, NTHR = 512;
constexpr int PADROWS = NSLOT + N_EXP * 256;

constexpr size_t MiB = 1u << 20;
constexpr size_t WS_CTL = 0, WS_LISTS = 1 * MiB, CTL_ZERO_BYTES = 2 * MiB;
constexpr size_t WS_SEL = 2 * MiB;
constexpr size_t WS_LRUE = 3 * MiB;
constexpr size_t WS_WIN = 4 * MiB, WS_WOUT = 24 * MiB, WS_HN = 32 * MiB, WS_PROJ = 64 * MiB, WS_ATT = 144 * MiB  , WS_HL = 192 * MiB, WS_PC = 224 * MiB;
constexpr size_t WS_MIXED = 256 * MiB, WS_X1 = 288 * MiB, WS_ACT = 352 * MiB, WS_Y = 512 * MiB, WS_WGU = 672 * MiB, WS_WDN = 1184 * MiB, WS_LSE = 1440 * MiB  , WS_HN2S = 1442 * MiB  , WS_END = 2466 * MiB;
static_assert((size_t)PADROWS * 2048 * 2 <= 160 * MiB, "ACT/Y size");
constexpr int CW_BAR = 4096, CW_CNT = 8192;

constexpr int RING_BYTES = 131072;
constexpr int LDSCTL_OFF = 139264;
constexpr int LDS_BYTES = 147456;
constexpr int L_MISC = LDSCTL_OFF;
constexpr int L_TPRE = LDSCTL_OFF + 256;
constexpr int L_CNT = LDSCTL_OFF + 512;
constexpr int L_BLKID = LDSCTL_OFF + 1024;
constexpr int L_BLKPRE = LDSCTL_OFF + 1280;

__device__ __forceinline__ unsigned f2bf(float f) { unsigned u = __builtin_bit_cast(unsigned, f); return (u + 0x7fffu + ((u >> 16) & 1u)) >> 16; }
__device__ __forceinline__ unsigned pk2(float lo, float hi) { return f2bf(lo) | (f2bf(hi) << 16); }
__device__ __forceinline__ float bf2f(unsigned short b) { return __builtin_bit_cast(float, (unsigned)b << 16); }
__device__ __forceinline__ float bflo(unsigned w) { return __builtin_bit_cast(float, w << 16); }
__device__ __forceinline__ float bfhi(unsigned w) { return __builtin_bit_cast(float, w & 0xffff0000u); }
__device__ __forceinline__ float wave_sum(float v) {
#pragma unroll
    for (int o = 1; o < 64; o <<= 1) v += __shfl_xor(v, o);
    return v;
}
__device__ __forceinline__ float wave_max(float v) {
#pragma unroll
    for (int o = 1; o < 64; o <<= 1) v = fmaxf(v, __shfl_xor(v, o));
    return v;
}
#define LDS_WAIT() asm volatile("s_waitcnt lgkmcnt(0)" ::: "memory")
#define VM_WAIT() asm volatile("s_waitcnt vmcnt(0)" ::: "memory")

__device__ __forceinline__ int lane_now() { int l; asm volatile("v_mbcnt_lo_u32_b32 %0, -1, 0\n\tv_mbcnt_hi_u32_b32 %0, -1, %0" : "=v"(l)); return l; }

#define XB_TMO      128
#define XB_XCNT(j)  (256  + 64 * (j))
#define XB_XSUB(j)  (1280 + 64 * (j))
#define XB_XGEN(j)  (2304 + 64 * (j))
#define XB_TOP      3328
#define XB_TOPGEN   3392
#define XCD_BAR_WORDS 3456
#define XB_SPIN_CAP (1u << 20)
__device__ __forceinline__ unsigned xb_ld(unsigned* p)              { return __hip_atomic_load(p, __ATOMIC_RELAXED, __HIP_MEMORY_SCOPE_AGENT); }
__device__ __forceinline__ unsigned xb_add(unsigned* p, unsigned v) { return __hip_atomic_fetch_add(p, v, __ATOMIC_RELAXED, __HIP_MEMORY_SCOPE_AGENT); }
__device__ __forceinline__ unsigned xb_xcc_id() { return (unsigned)__builtin_amdgcn_s_getreg((3 << 11) | 20) & 0xFu; }
#define XB_SPIN(cond, bar) do { unsigned _sp = 0; while (cond) { __builtin_amdgcn_s_sleep(1); \
    if ((++_sp & 255u) == 0u) { if (xb_ld(&(bar)[XB_TMO])) break; if (_sp > XB_SPIN_CAP) { atomicAdd(&(bar)[XB_TMO], 1u); break; } } } } while (0)
struct XcdBarrier { unsigned* bar; unsigned x; volatile LAS unsigned* st; };
__device__ __forceinline__ XcdBarrier xcd_barrier_post(unsigned* bar, volatile LAS unsigned* st, int tid) {
    XcdBarrier b; b.bar = bar; b.x = xb_xcc_id(); b.st = st;
    if (tid == 0) (void)xb_add(&bar[XB_XCNT(b.x)], 1u);
    return b;
}
__device__ __forceinline__ void xcd_barrier_complete(unsigned* bar, unsigned x, unsigned& nloc, unsigned& nx) {
    const unsigned G = gridDim.x * gridDim.y * gridDim.z;
    unsigned sum, cnt, mine, sp = 0u;
    for (;;) {
        sum = 0u; cnt = 0u; mine = 0u;
#pragma unroll
        for (unsigned j = 0; j < 16; ++j) { const unsigned c = xb_ld(&bar[XB_XCNT(j)]); sum += c; cnt += (c > 0u) ? 1u : 0u; mine = (j == x) ? c : mine; }
        if (sum == G) break;
        __builtin_amdgcn_s_sleep(1);
        if ((++sp & 255u) == 0u) { if (xb_ld(&bar[XB_TMO])) break; if (sp > XB_SPIN_CAP) { atomicAdd(&bar[XB_TMO], 1u); break; } }
    }
    nloc = mine > 0u ? mine : 1u; nx = cnt > 0u ? cnt : 1u;
}
__device__ __forceinline__ void xcd_barrier(const XcdBarrier& b, int tid) {
    asm volatile("s_waitcnt vmcnt(0)" ::: "memory");
    __syncthreads();
    if (tid == 0) {
        unsigned* bar = b.bar;
        __builtin_amdgcn_s_waitcnt(0);
        unsigned nloc = b.st[0], nx = b.st[1];
        if (nloc == 0u) { xcd_barrier_complete(bar, b.x, nloc, nx); b.st[0] = nloc; b.st[1] = nx; }
        const unsigned old = xb_add(&bar[XB_XSUB(b.x)], 1u);
        const unsigned gen = old / nloc;
        if (old + 1u == (gen + 1u) * nloc) {
            __builtin_amdgcn_fence(__ATOMIC_RELEASE, "agent");
            asm volatile("s_waitcnt vmcnt(0)" ::: "memory");
            const unsigned og = xb_add(&bar[XB_TOP], 1u);
            const unsigned tg = og / nx;
            if (og + 1u == (tg + 1u) * nx) xb_add(&bar[XB_TOPGEN], 1u);
            else XB_SPIN(xb_ld(&bar[XB_TOPGEN]) == tg, bar);
            __builtin_amdgcn_fence(__ATOMIC_ACQUIRE, "agent");
            xb_add(&bar[XB_XGEN(b.x)], 1u);
            asm volatile("s_waitcnt vmcnt(0)" ::: "memory");
        } else {
            XB_SPIN(xb_ld(&bar[XB_XGEN(b.x)]) == gen, bar);
            __builtin_amdgcn_fence(__ATOMIC_ACQUIRE, "agent");
            asm volatile("s_waitcnt vmcnt(0)" ::: "memory");
        }
    }
    __syncthreads();
}

typedef float f32x16 __attribute__((ext_vector_type(16)));
typedef short s16x4 __attribute__((ext_vector_type(4)));
typedef short v4i16_t __attribute__((ext_vector_type(4)));
__device__ __forceinline__ s16x4 vtr(const LAS unsigned char* p) { return __builtin_bit_cast(s16x4, __builtin_amdgcn_ds_read_tr16_b64_v4i16((LAS v4i16_t*)p)); }

namespace g8 {
constexpr int BM = 256, BK = 64, HALF = 128, HTB = HALF * BK * 2, STAGE_BYTES = 8 * HTB, NXCD = 8, WGM = 8;
__host__ __device__ __forceinline__ int lds_byte(int r, int c) { const int st = (r >> 4) * 2 + (c >> 5), rr = r & 15, cc = c & 31, ob = rr * 64 + cc * 2; return st * 1024 + (ob ^ (((ob >> 9) & 1) << 5)); }
__host__ __device__ __forceinline__ void stage_rc(int b, int& R, int& C) { const int st = b / 1024, sb = b % 1024, swz = sb ^ (((sb >> 9) & 1) << 5); R = (st >> 1) * 16 + swz / 64; C = (st & 1) * 32 + (swz % 64) / 2; }
__host__ __device__ __forceinline__ int perm32(int rho) { const int n = rho >> 4, i = rho & 15; return 8 * (i >> 2) + 4 * n + (i & 3); }

struct Unit { const char* a; const char* b; int crow, ccol, e, gi; };

struct DenseOrder {
    const char* A; const char* Bt; int nM, nN, nwg, G, c; int ldb;
    __device__ __forceinline__ bool next(int i, Unit& u) const {
        const long L = (long)i * G + c; if (L >= nwg) return false;
        int wgid = (int)L; { const int q = nwg / NXCD, r = nwg % NXCD, xcd = wgid % NXCD, off = wgid / NXCD; wgid = (xcd < r ? xcd * (q + 1) : r * (q + 1) + (xcd - r) * q) + off; }
        const int nig = WGM * nN, gid = wgid / nig, fm = gid * WGM, gsz = (nM - fm) < WGM ? (nM - fm) : WGM;
        const int pm = fm + ((wgid % nig) % gsz), pn = (wgid % nig) / gsz;
        u.a = A + (size_t)pm * BM * KDIM * 2; u.b = Bt + (size_t)pn * BM * 4; u.crow = pm * BM; u.ccol = pn * BM; u.e = 0; u.gi = 0; return true;
    }
};
struct GroupedOrder {
    const char* A; const char* Bt; const LAS int* tpre; const LAS int* bid; const LAS int* bpre; int nhb, G, c; size_t bstride;
    bool capA; int ldb;
    __device__ __forceinline__ bool next(int i, Unit& u) const {
        const int per = G >> 3, x = c & 7, j = c >> 3, Lx = i * per + j, nslots = 4 * nhb;
        const LAS int* bp = bpre + x * 9;
        if (Lx >= __builtin_amdgcn_readfirstlane(bp[nslots])) return false;
        int k = 0; while (Lx >= __builtin_amdgcn_readfirstlane(bp[k + 1])) ++k;
        const int b = __builtin_amdgcn_readfirstlane(bid[x * 8 + k]), within = Lx - __builtin_amdgcn_readfirstlane(bp[k]);
        const int e = b / nhb, hb = b - e * nhb, mt = within >> 3, nt = hb * 8 + (within & 7);
        const int mtile = __builtin_amdgcn_readfirstlane(tpre[e]) + mt;
        u.a = A + (capA ? ((size_t)e * NTOK + (size_t)mt * BM) : (size_t)mtile * BM) * KDIM * 2;
        u.b = Bt + (size_t)e * bstride + (size_t)nt * BM * 4; u.crow = mtile * BM; u.ccol = nt * BM; u.e = e; u.gi = 0; return true;
    }
};

__device__ __forceinline__ unsigned cvt_pk_bf16(float lo, float hi) { unsigned r; asm volatile("v_cvt_pk_bf16_f32 %0, %1, %2" : "=v"(r) : "v"(lo), "v"(hi)); return r; }

struct EpiBf16 {
    bf16_t* O; int ldc; const float* bias; int bias_stride;
    __device__ __forceinline__ void operator()(const f32x4 (&acc)[2][2][4][2], const Unit& u, int wr, int wc, int fr, int fq) const {
        const int row0 = u.crow + wr * 64 + fr, col0 = u.ccol + wc * 32 + 4 * fq;
        f32x4 bv[2][2];
#pragma unroll
        for (int bj = 0; bj < 2; ++bj)
#pragma unroll
            for (int n = 0; n < 2; ++n) bv[bj][n] = bias ? *(const f32x4*)(bias + (size_t)u.e * bias_stride + col0 + bj * HALF + 16 * n) : (f32x4){0.f, 0.f, 0.f, 0.f};
#pragma unroll
        for (int ai = 0; ai < 2; ++ai)
#pragma unroll
            for (int m = 0; m < 4; ++m) { bf16_t* rowp = O + (size_t)(row0 + ai * HALF + m * 16) * ldc + col0;
#pragma unroll
                for (int bj = 0; bj < 2; ++bj)
#pragma unroll
                    for (int n = 0; n < 2; ++n) { const f32x4 v = acc[ai][bj][m][n] + bv[bj][n];
                        u32x2 w; w.x = cvt_pk_bf16(v[0], v[1]); w.y = cvt_pk_bf16(v[2], v[3]);
                        *(u32x2*)(rowp + bj * HALF + 16 * n) = w; } }
    }
};
struct EpiResF32 {
    float* C; const float* res; int ldc;
    __device__ __forceinline__ void operator()(const f32x4 (&acc)[2][2][4][2], const Unit& u, int wr, int wc, int fr, int fq) const {
        const int row0 = u.crow + wr * 64 + fr, col0 = u.ccol + wc * 32 + 4 * fq;
#pragma unroll
        for (int ai = 0; ai < 2; ++ai)
#pragma unroll
            for (int m = 0; m < 4; ++m) { const size_t off = (size_t)(row0 + ai * HALF + m * 16) * ldc + col0;
#pragma unroll
                for (int bj = 0; bj < 2; ++bj)
#pragma unroll
                    for (int n = 0; n < 2; ++n) { const f32x4 r = *(const f32x4*)(res + off + bj * HALF + n * 16); *(f32x4*)(C + off + bj * HALF + n * 16) = acc[ai][bj][m][n] + r; } }
    }
};
struct EpiSwiglu {
    bf16_t* O; const float* bias;
    __device__ __forceinline__ float act(float g, float up) const {
        g = fminf(g, 7.0f); up = fminf(fmaxf(up, -7.0f), 7.0f);
        const float sg = 1.0f / (1.0f + __expf(-1.702f * g));
        return g * sg * (up + 1.0f);
    }
    __device__ __forceinline__ void operator()(const f32x4 (&acc)[2][2][4][2], const Unit& u, int wr, int wc, int fr, int fq) const {
        const int row0 = u.crow + wr * 64 + fr, col0 = u.ccol + wc * 32 + 4 * fq;
#pragma unroll
        for (int bj = 0; bj < 2; ++bj)
#pragma unroll
            for (int n = 0; n < 2; ++n) { const f32x4 bv = *(const f32x4*)(bias + (size_t)u.e * (2 * D_FF) + col0 + bj * HALF + 16 * n);
#pragma unroll
                for (int ai = 0; ai < 2; ++ai)
#pragma unroll
                    for (int m = 0; m < 4; ++m) { const f32x4 v = acc[ai][bj][m][n] + bv;
                        *(unsigned*)(O + (size_t)(row0 + ai * HALF + m * 16) * D_FF + (col0 >> 1) + bj * (HALF / 2) + 8 * n) = cvt_pk_bf16(act(v[0], v[1]), act(v[2], v[3])); } }
    }
};

template <class Epi, class Sched>
__device__ __forceinline__ void gemm_phase(LAS unsigned char* lds, const Sched& S, const Epi& E, int wave) {
    const int wid = wave, lane = lane_now(), tid = wid * 64 + lane, wr = wid >> 2, wc = wid & 3;
    constexpr int K = KDIM, nt = K / BK;
    unsigned voffA[2];
#pragma unroll
    for (int i = 0; i < 2; ++i) { int R, C; stage_rc(tid * 16 + i * 8192, R, C); voffA[i] = (unsigned)(R * K + C) * 2u; }
    const int ldb = S.ldb;
    constexpr size_t kstep = (size_t)(BK * 2);
    constexpr size_t hstep = (size_t)HALF * K * 2;
    const size_t kstepB = (size_t)BK * ldb * 4;
    constexpr size_t hstepB = 512;
    const size_t jstepB = (size_t)16 * ldb * 4;
    const unsigned bvoff = (unsigned)((tid >> 5) * ldb * 4 + (tid & 31) * 16);
    const unsigned ldsbase = (unsigned)(size_t)lds;
    unsigned wbase;
    { const int k0 = tid >> 5, q = tid & 31, f = 2 * ((k0 & 3) + 4 * ((k0 >> 3) & 1)); wbase = ldsbase + (unsigned)(k0 * 256 + (((q >> 1) ^ f) * 16) + (q & 1) * 8); }
    const unsigned ldsw = (unsigned)wid * 1024u;
    const int fr = lane & 15, fq = lane >> 4;
    const int aoff = lds_byte(wr * 64 + fr, fq * 8);
    int bb[2];
    { const int q = (lane & 15) >> 2, p = lane & 3, f = 2 * (q + 4 * (fq & 1));
#pragma unroll
      for (int nf = 0; nf < 2; ++nf) { const int ch = 4 * wc + 2 * nf + (p >> 1); bb[nf] = (8 * fq + q) * 256 + ((ch ^ f) * 16) + (p & 1) * 8; } }
#define G8_SA(b, h) (((b) * 2 + (h)) * HTB)
#define G8_SB(b, h) ((4 + (b) * 2 + (h)) * HTB)
#define G8_STAGE_A(bufoff, gbase) do { \
        __builtin_amdgcn_global_load_lds((const unsigned*)((const char*)(gbase) + voffA[0]), (LAS unsigned*)(lds + (bufoff) + ldsw), 16, 0, 0); \
        __builtin_amdgcn_global_load_lds((const unsigned*)((const char*)(gbase) + voffA[1]), (LAS unsigned*)(lds + (bufoff) + ldsw + 8192), 16, 0, 0); } while (0)
#define G8_LOADB(R, ptr) do { const char* _p = (const char*)(ptr); \
        asm volatile("s_nop 4\n\tglobal_load_dwordx4 %0, %1, %2" : "=&v"(R##0) : "v"(bvoff), "s"(_p) : "memory"); _p += jstepB; \
        asm volatile("global_load_dwordx4 %0, %1, %2" : "=&v"(R##1) : "v"(bvoff), "s"(_p) : "memory"); _p += jstepB; \
        asm volatile("global_load_dwordx4 %0, %1, %2" : "=&v"(R##2) : "v"(bvoff), "s"(_p) : "memory"); _p += jstepB; \
        asm volatile("global_load_dwordx4 %0, %1, %2" : "=&v"(R##3) : "v"(bvoff), "s"(_p) : "memory"); } while (0)
#define G8_CVT2(R) do { R[0] = __builtin_bit_cast(float, cvt_pk_bf16(R[0], R[1])); R[1] = __builtin_bit_cast(float, cvt_pk_bf16(R[2], R[3])); } while (0)
#define G8_LO2(R) __builtin_shufflevector(R, R, 0, 1)
#define G8_CVTW(R, bufoff, N) do { asm volatile("s_waitcnt vmcnt(" #N ")" : "+v"(R##0), "+v"(R##1), "+v"(R##2), "+v"(R##3) :: "memory"); __builtin_amdgcn_sched_barrier(0); \
        const unsigned _wa = wbase + (unsigned)(bufoff); G8_CVT2(R##0); G8_CVT2(R##1); G8_CVT2(R##2); G8_CVT2(R##3); \
        asm volatile("ds_write_b64 %0, %1\n\tds_write_b64 %0, %2 offset:4096\n\tds_write_b64 %0, %3 offset:8192\n\tds_write_b64 %0, %4 offset:12288" :: "v"(_wa), "v"(G8_LO2(R##0)), "v"(G8_LO2(R##1)), "v"(G8_LO2(R##2)), "v"(G8_LO2(R##3)) : "memory"); } while (0)
#define G8_LDA(dst, b, h) do { _Pragma("unroll") for (int m = 0; m < 4; ++m) _Pragma("unroll") for (int k = 0; k < 2; ++k) dst[m][k] = *(const LAS bf16x8*)(lds + G8_SA(b, h) + aoff + m * 2048 + k * 1024); } while (0)
#define G8_TR(dst, addr, off) asm volatile("ds_read_b64_tr_b16 %0, %1 offset:%2" : "=v"(dst) : "v"(addr), "i"(off) : "memory")
#define G8_LDB(lo, hi, b, h) do { _Pragma("unroll") for (int n = 0; n < 2; ++n) { const unsigned _ad = ldsbase + (unsigned)(G8_SB(b, h)) + (unsigned)bb[n]; \
        G8_TR(lo[n][0], _ad, 0); G8_TR(hi[n][0], _ad, 1024); G8_TR(lo[n][1], _ad, 8192); G8_TR(hi[n][1], _ad, 9216); } } while (0)
#define G8_BF(lo, hi, n, k) __builtin_shufflevector(lo[n][k], hi[n][k], 0, 1, 2, 3, 4, 5, 6, 7)
#define G8_MMA(ai, bj, At, Bl, Bh) do { __builtin_amdgcn_s_setprio(1); _Pragma("unroll") for (int m = 0; m < 4; ++m) _Pragma("unroll") for (int n = 0; n < 2; ++n) _Pragma("unroll") for (int k = 0; k < 2; ++k) \
        acc[ai][bj][m][n] = __builtin_amdgcn_mfma_f32_16x16x32_bf16(G8_BF(Bl, Bh, n, k), At[m][k], acc[ai][bj][m][n], 0, 0, 0); __builtin_amdgcn_s_setprio(0); } while (0)
#define G8_WAIT_V(n) asm volatile("s_waitcnt vmcnt(" #n ")" ::: "memory")
#define G8_WAIT_L(n) do { asm volatile("s_waitcnt lgkmcnt(" #n ")" ::: "memory"); __builtin_amdgcn_sched_barrier(0); } while (0)
#define G8_BAR __builtin_amdgcn_s_barrier()
#define G8_SCHED __builtin_amdgcn_sched_barrier(0)
    Unit cur, nxt; int ui = 0;
    if (!S.next(0, cur)) return;
    f32x4 acc[2][2][4][2];
#pragma unroll
    for (int a = 0; a < 2; ++a)
#pragma unroll
        for (int b = 0; b < 2; ++b)
#pragma unroll
            for (int m = 0; m < 4; ++m)
#pragma unroll
                for (int n = 0; n < 2; ++n) acc[a][b][m][n] = (f32x4){0.f, 0.f, 0.f, 0.f};
    bf16x8 At[4][2]; s16x4 B0l[2][2], B0h[2][2], B1l[2][2], B1h[2][2];
    f32x4 RA0, RA1, RA2, RA3, RB0, RB1, RB2, RB3;
    const char* cA = cur.a; const char* cB = cur.b;
    G8_STAGE_A(G8_SA(0, 0), cA); G8_STAGE_A(G8_SA(0, 1), cA + hstep);
    G8_LOADB(RA, cB); G8_LOADB(RB, cB + hstepB);
    G8_CVTW(RA, G8_SB(0, 0), 4); G8_LOADB(RA, cB + kstepB);
    G8_CVTW(RB, G8_SB(0, 1), 4); G8_LOADB(RB, cB + kstepB + hstepB);
    G8_CVTW(RA, G8_SB(1, 0), 4); G8_LOADB(RA, cB + 2 * kstepB);
    G8_STAGE_A(G8_SA(1, 0), cA + kstep);
    G8_CVTW(RB, G8_SB(1, 1), 6); G8_LOADB(RB, cB + 2 * kstepB + hstepB);
    G8_WAIT_L(0);
    if (wr == 1) G8_BAR;
    G8_BAR;
    const char* aq = cA + kstep; const char* bq = cB + 3 * kstepB;
    for (;;) {
        const bool has_next = S.next(ui + 1, nxt);
        const char* nA = has_next ? nxt.a : cA; const char* nB = has_next ? nxt.b : cB;
        for (int t = 0; t < nt; t += 2) {
            G8_LDB(B0l, B0h, 0, 0); G8_SCHED; G8_LDA(At, 0, 0); G8_STAGE_A(G8_SA(1, 1), aq + hstep); aq = (t == nt - 2) ? nA : aq + kstep;
            G8_WAIT_L(8); G8_BAR; G8_WAIT_L(0); G8_MMA(0, 0, At, B0l, B0h); G8_BAR; G8_SCHED;
            G8_LDB(B1l, B1h, 0, 1); G8_CVTW(RA, G8_SB(0, 0), 8); G8_LOADB(RA, bq);
            G8_BAR; G8_WAIT_L(0); G8_MMA(0, 1, At, B1l, B1h); G8_BAR; G8_SCHED;
            G8_LDA(At, 0, 1); G8_STAGE_A(G8_SA(0, 0), aq);
            G8_BAR; G8_WAIT_L(0); G8_MMA(1, 0, At, B0l, B0h); G8_BAR; G8_SCHED;
            G8_CVTW(RB, G8_SB(0, 1), 6); G8_LOADB(RB, bq + hstepB); bq = (t == nt - 4) ? nB : bq + kstepB;
            G8_BAR; G8_WAIT_L(0); G8_MMA(1, 1, At, B1l, B1h); G8_BAR; G8_SCHED;
            G8_LDB(B0l, B0h, 1, 0); G8_SCHED; G8_LDA(At, 1, 0); G8_STAGE_A(G8_SA(0, 1), aq + hstep); aq += kstep;
            G8_WAIT_L(8); G8_BAR; G8_WAIT_L(0); G8_MMA(0, 0, At, B0l, B0h); G8_BAR; G8_SCHED;
            G8_LDB(B1l, B1h, 1, 1); G8_CVTW(RA, G8_SB(1, 0), 8); G8_LOADB(RA, bq);
            G8_BAR; G8_WAIT_L(0); G8_MMA(0, 1, At, B1l, B1h); G8_BAR; G8_SCHED;
            G8_LDA(At, 1, 1); G8_STAGE_A(G8_SA(1, 0), aq);
            G8_BAR; G8_WAIT_L(0); G8_MMA(1, 0, At, B0l, B0h); G8_BAR; G8_SCHED;
            G8_CVTW(RB, G8_SB(1, 1), 6); G8_LOADB(RB, bq + hstepB); bq += kstepB;
            G8_BAR; G8_WAIT_L(0); G8_MMA(1, 1, At, B1l, B1h); G8_BAR; G8_SCHED;
        }
        asm volatile("s_waitcnt vmcnt(0)" : "+v"(RA0), "+v"(RA1), "+v"(RA2), "+v"(RA3), "+v"(RB0), "+v"(RB1), "+v"(RB2), "+v"(RB3) :: "memory"); __builtin_amdgcn_sched_barrier(0);
        { const int le = lane_now(); E(acc, cur, wr, wc, le & 15, le >> 4); }
        if (!has_next) break;
#pragma unroll
        for (int a = 0; a < 2; ++a)
#pragma unroll
            for (int b = 0; b < 2; ++b)
#pragma unroll
                for (int m = 0; m < 4; ++m)
#pragma unroll
                    for (int n = 0; n < 2; ++n) acc[a][b][m][n] = (f32x4){0.f, 0.f, 0.f, 0.f};
        cur = nxt; cA = nA; cB = nB; ++ui;
    }
    G8_WAIT_V(0);
    asm volatile("" :: "v"(RA0), "v"(RA1), "v"(RA2), "v"(RA3), "v"(RB0), "v"(RB1), "v"(RB2), "v"(RB3));
    if (wr == 0) G8_BAR;
    G8_BAR;
#undef G8_SA
#undef G8_SB
#undef G8_STAGE_A
#undef G8_LOADB
#undef G8_CVTW
#undef G8_CVT2
#undef G8_LO2
#undef G8_LDA
#undef G8_TR
#undef G8_LDB
#undef G8_BF
#undef G8_MMA
#undef G8_WAIT_V
#undef G8_WAIT_L
#undef G8_BAR
#undef G8_SCHED
}
}

struct Frame {
    LAS unsigned char* lds;
    unsigned* ctl; unsigned char* ws;
    int wave, vcu, G, gw, NGW;
    __device__ __forceinline__ int lane_() const { return lane_now(); }
    __device__ __forceinline__ int tid_() const { return wave * 64 + lane_now(); }
};
struct Args { const float* in[21]; float* out; unsigned char* ws; int ph_lo, ph_hi; };
template <int OFF> __device__ __forceinline__ unsigned long long karg_u64() { const auto kp = __builtin_amdgcn_kernarg_segment_ptr(); unsigned long long v;
    asm volatile("s_load_dwordx2 %0, %1, %2\n\ts_waitcnt lgkmcnt(0)" : "=s"(v) : "s"(kp), "i"(OFF)); return v; }
template <int I> __device__ __forceinline__ const float* karg_in() { return (const float*)karg_u64<8 * I>(); }
__device__ __forceinline__ float* karg_out() { return (float*)karg_u64<8 * 21>(); }


constexpr long CV_IN = (long)KDIM * IN_COLS / 512, CV_OUT = (long)KDIM * D_MODEL / 512, CV_GU = (long)N_EXP * KDIM * 4096 / 512, CV_DN = (long)N_EXP * KDIM * D_MODEL / 512;
__device__ __forceinline__ void conv_chunks(const float* __restrict__ src, bf16_t* __restrict__ dst, long c0, long c1, int gw, int NGW, int lane) {
    long c = c0 + gw;
    for (; c + 7L * NGW < c1; c += 8L * NGW) {
        f32x4 a[8], b[8];
#pragma unroll
        for (int i = 0; i < 8; ++i) { const f32x4* p = (const f32x4*)(src + (c + (long)i * NGW) * 512 + lane * 8); a[i] = __builtin_nontemporal_load(p); b[i] = __builtin_nontemporal_load(p + 1); }
#pragma unroll
        for (int i = 0; i < 8; ++i) { u32x4 w; w.x = pk2(a[i][0], a[i][1]); w.y = pk2(a[i][2], a[i][3]); w.z = pk2(b[i][0], b[i][1]); w.w = pk2(b[i][2], b[i][3]);
            __builtin_nontemporal_store(w, (u32x4*)(dst + (c + (long)i * NGW) * 512 + lane * 8)); }
    }
    for (; c < c1; c += NGW) { const f32x4* p = (const f32x4*)(src + c * 512 + lane * 8); const f32x4 a = __builtin_nontemporal_load(p), b = __builtin_nontemporal_load(p + 1);
        u32x4 w; w.x = pk2(a[0], a[1]); w.y = pk2(a[2], a[3]); w.z = pk2(b[0], b[1]); w.w = pk2(b[2], b[3]); __builtin_nontemporal_store(w, (u32x4*)(dst + c * 512 + lane * 8)); }
}
__device__ __forceinline__ void rms_row_bf16(const float* xrow, const float* g, bf16_t* orow, int lane) {
    const f32x4* xr = (const f32x4*)xrow + lane; const f32x4* gr = (const f32x4*)g + lane;
    f32x4 v[8]; float s = 0.f;
#pragma unroll
    for (int j = 0; j < 8; ++j) { v[j] = xr[64 * j]; s += (v[j][0] * v[j][0] + v[j][1] * v[j][1]) + (v[j][2] * v[j][2] + v[j][3] * v[j][3]); }
    const float rs = rsqrtf(wave_sum(s) * (1.0f / 2048.0f) + EPS);
    u32x2* o = (u32x2*)orow + lane;
#pragma unroll
    for (int j = 0; j < 8; ++j) { const f32x4 gg = gr[64 * j]; u32x2 w; w.x = pk2(v[j][0] * rs * gg[0], v[j][1] * rs * gg[1]); w.y = pk2(v[j][2] * rs * gg[2], v[j][3] * rs * gg[3]); o[64 * j] = w; }
}
__device__ __forceinline__ void p0_prologue(const Frame& F, const Args& a) {
    const int LANE = lane_now(), TID = F.wave * 64 + LANE; (void)TID;
    bf16_t* HN = (bf16_t*)(F.ws + WS_HN);
    for (int m = F.gw; m < NTOK; m += F.NGW) rms_row_bf16(karg_in<0>() + (size_t)m * D_MODEL, karg_in<1>(), HN + (size_t)m * D_MODEL, LANE);
}

__device__ __forceinline__ float gelu_tanh(float x) { return 0.5f * x * (1.0f + tanhf(0.7978845608028654f * (x + 0.044715f * x * x * x))); }
__device__ __forceinline__ float sigmoidf_(float x) { return 1.0f / (1.0f + __expf(-x)); }
__device__ __forceinline__ void lru_unit(const Frame& F, const Args& a, int unit) {
    const int lane = lane_now();
    const int b = unit >> 9, k = (unit >> 4) & 31, blk = unit & 15;
    const bf16_t* proj = (const bf16_t*)(F.ws + WS_PROJ);
    LAS float* xs = (LAS float*)(F.lds + F.wave * 16384);
    const int ch = blk * 64 + lane;
    const float cw0 = karg_in<3>()[0 * LRU_W + ch], cw1 = karg_in<3>()[1 * LRU_W + ch], cw2 = karg_in<3>()[2 * LRU_W + ch], cw3 = karg_in<3>()[3 * LRU_W + ch], cb = karg_in<4>()[ch];
    const int t0 = k * 64; const size_t row0 = (size_t)b * SEQ + t0;
    const bf16_t* xp = proj + row0 * IN_COLS + 3 * ATTN_W + ch;
    float x0 = (t0 >= 3) ? bf2f(xp[-3 * IN_COLS]) : 0.f, x1 = (t0 >= 2) ? bf2f(xp[-2 * IN_COLS]) : 0.f, x2 = (t0 >= 1) ? bf2f(xp[-1 * IN_COLS]) : 0.f;
    for (int t = 0; t < 64; ++t) {
        const float x3 = bf2f(xp[(size_t)t * IN_COLS]);
        xs[t * 64 + lane] = cb + cw0 * x0 + cw1 * x1 + cw2 * x2 + cw3 * x3;
        x0 = x1; x1 = x2; x2 = x3;
    }
    float wa[64], wx[64];
    const float* wap = karg_in<5>() + (size_t)blk * 4096 + lane; const float* wxp = karg_in<7>() + (size_t)blk * 4096 + lane;
#pragma unroll
    for (int c = 0; c < 64; ++c) { wa[c] = wap[c * 64]; wx[c] = wxp[c * 64]; }
    const float ba = karg_in<6>()[ch], bx = karg_in<8>()[ch];
    const float sp = log1pf(__expf(-karg_in<9>()[ch]));
    float* hl = (float*)(F.ws + WS_HL) + row0 * LRU_W + ch; float* pc = (float*)(F.ws + WS_PC) + row0 * LRU_W + ch;
    LDS_WAIT();
    float h = 0.f, P = 1.f;
    for (int t = 0; t < 64; ++t) {
        float r = ba, ii = bx;
        const LAS f32x4* xr = (const LAS f32x4*)(xs + t * 64);
#pragma unroll
        for (int c4 = 0; c4 < 16; ++c4) { const f32x4 xv = xr[c4];
            r = fmaf(xv[0], wa[4 * c4], r); r = fmaf(xv[1], wa[4 * c4 + 1], r); r = fmaf(xv[2], wa[4 * c4 + 2], r); r = fmaf(xv[3], wa[4 * c4 + 3], r);
            ii = fmaf(xv[0], wx[4 * c4], ii); ii = fmaf(xv[1], wx[4 * c4 + 1], ii); ii = fmaf(xv[2], wx[4 * c4 + 2], ii); ii = fmaf(xv[3], wx[4 * c4 + 3], ii); }
        r = sigmoidf_(r); ii = sigmoidf_(ii);
        const float log_a = -8.0f * r * sp;
        const float av = __expf(log_a);
        const float bv = sqrtf(-expm1f(2.0f * log_a)) * (ii * xs[t * 64 + lane]);
        h = av * h + bv; P *= av;
        hl[(size_t)t * LRU_W] = h; pc[(size_t)t * LRU_W] = P;
    }
    float* ae = (float*)(F.ws + WS_LRUE); float* he = ae + 4 * 32 * 1024;
    ae[(size_t)(b * 32 + k) * 1024 + ch] = P; he[(size_t)(b * 32 + k) * 1024 + ch] = h;
    LDS_WAIT();
}
constexpr int VP = 192;
__device__ __forceinline__ void attn_unit(const Frame& F, const Args& a, int u) {
    const int lane = lane_now();
    const int c = lane & 31, hh = lane >> 5, xaddr = (lane ^ 32) << 2;
    const int br = u >> 12, rem = u & 4095, bh = rem >> 6, qt = rem & 63;
    const int b = bh >> 4, h = bh & 15;
    const int dsh = br * 2, d = 1 << dsh;
    const int r = qt & (d - 1), ltile = qt >> dsh, l0 = ltile * 32;
    const bf16_t* proj = (const bf16_t*)(F.ws + WS_PROJ) + (size_t)b * SEQ * IN_COLS + h * 64;
    LAS unsigned char* vl = F.lds + F.wave * 16384;
    bf16x8 qf[4];
    { const bf16_t* qrow = proj + (size_t)((l0 + c) * d + r) * IN_COLS + 8 * hh;
#pragma unroll
      for (int s = 0; s < 4; ++s) qf[s] = *(const bf16x8*)(qrow + 16 * s); }
    constexpr float LOG2E = 1.4426950408889634f;
    const float slope2 = exp2f(-0.5f * (float)(h + 1)) * LOG2E * (float)d;
    const float sc2 = 0.125f * LOG2E;
    float m = -INFINITY, lsum = 0.f;
    f32x16 o0, o1;
#pragma unroll
    for (int i = 0; i < 16; ++i) { o0[i] = 0.f; o1[i] = 0.f; }
    const int jfirst = ltile >= 4 ? 0 : 4 - ltile;
    bf16x8 kf[3][4]; u32x4 vr[3][4];
    const int vrow = lane >> 3, vch = lane & 7;
    const unsigned rowb = (unsigned)d * (unsigned)(IN_COLS * 2);
    const unsigned kvo = (unsigned)c * rowb + (unsigned)((ATTN_W + 8 * hh) * 2);
    const unsigned vvo = (unsigned)vrow * rowb + (unsigned)((2 * ATTN_W + vch * 8) * 2);
#define ATT_LOAD(j) do { const char* tb = (const char*)proj + (size_t)((l0 - 128 + 32 * (j)) * d + r) * (size_t)(IN_COLS * 2);     \
        _Pragma("unroll") for (int s = 0; s < 4; ++s) kf[(j) % 3][s] = *(const bf16x8*)(tb + (kvo + 32u * s)); \
        _Pragma("unroll") for (int i = 0; i < 4; ++i) vr[(j) % 3][i] = *(const u32x4*)(tb + (size_t)(8 * i) * rowb + vvo); } while (0)
#pragma unroll
    for (int j = 0; j < 3; ++j) if (j >= jfirst) ATT_LOAD(j);
    const LAS unsigned char* vtr_base = vl + (4 * hh + ((lane & 15) >> 2)) * VP + (16 * ((lane >> 4) & 1) + 4 * (lane & 3)) * 2;
#pragma unroll
    for (int j = 0; j < 5; ++j) { if (j >= jfirst) {
#pragma unroll
        for (int i = 0; i < 4; ++i) *(LAS u32x4*)(vl + (vrow + 8 * i) * VP + vch * 16) = vr[j % 3][i];
        f32x16 sa;
#pragma unroll
        for (int i = 0; i < 16; ++i) sa[i] = 0.f;
#pragma unroll
        for (int s = 0; s < 4; ++s) sa = __builtin_amdgcn_mfma_f32_32x32x16_bf16(kf[j % 3][s], qf[s], sa, 0, 0, 0);
        const float relbase = (float)(c + 128 - 32 * j);
        float mx = -INFINITY;
#pragma unroll
        for (int i = 0; i < 16; ++i) { const int ki = (i & 3) + 8 * (i >> 2) + 4 * hh;
            float v = sa[i] * sc2 - slope2 * (relbase - (float)ki);
            const bool valid = (j == 0) ? (ki >= c) : ((j == 4) ? (ki <= c) : true);
            v = valid ? v : -INFINITY; sa[i] = v; mx = fmaxf(mx, v); }
        mx = fmaxf(mx, __builtin_bit_cast(float, __builtin_amdgcn_ds_bpermute(xaddr, __builtin_bit_cast(int, mx))));
        const float mnew = fmaxf(m, mx);
        const float alpha = __builtin_amdgcn_exp2f(m - mnew);
        float ps = 0.f;
#pragma unroll
        for (int i = 0; i < 16; ++i) { const float p = __builtin_amdgcn_exp2f(sa[i] - mnew); sa[i] = p; ps += p; }
        ps += __builtin_bit_cast(float, __builtin_amdgcn_ds_bpermute(xaddr, __builtin_bit_cast(int, ps)));
        lsum = lsum * alpha + ps; m = mnew;
#pragma unroll
        for (int i = 0; i < 16; ++i) { o0[i] *= alpha; o1[i] *= alpha; }
        bf16x8 pf[2];
#pragma unroll
        for (int s = 0; s < 2; ++s) { u32x4 w; w.x = g8::cvt_pk_bf16(sa[8 * s + 0], sa[8 * s + 1]); w.y = g8::cvt_pk_bf16(sa[8 * s + 2], sa[8 * s + 3]); w.z = g8::cvt_pk_bf16(sa[8 * s + 4], sa[8 * s + 5]); w.w = g8::cvt_pk_bf16(sa[8 * s + 6], sa[8 * s + 7]);
            pf[s] = __builtin_bit_cast(bf16x8, w); }
#pragma unroll
        for (int s = 0; s < 2; ++s) {
#pragma unroll
            for (int nt = 0; nt < 2; ++nt) {
                const s16x4 lo = vtr(vtr_base + (16 * s) * VP + nt * 64), hi = vtr(vtr_base + (16 * s + 8) * VP + nt * 64);
                const bf16x8 af = __builtin_shufflevector(lo, hi, 0, 1, 2, 3, 4, 5, 6, 7);
                if (nt == 0) o0 = __builtin_amdgcn_mfma_f32_32x32x16_bf16(af, pf[s], o0, 0, 0, 0); else o1 = __builtin_amdgcn_mfma_f32_32x32x16_bf16(af, pf[s], o1, 0, 0, 0);
            }
        }
        }
        if (j + 3 <= 4 && j + 3 >= jfirst) ATT_LOAD(j + 3);
    }
#undef ATT_LOAD
    const float inv = 1.0f / lsum;
    const size_t tok = (size_t)b * SEQ + (size_t)((l0 + c) * d + r);
    bf16_t* orow = (bf16_t*)(F.ws + WS_ATT) + ((size_t)br * NTOK + tok) * ATTN_W + h * 64 + 4 * hh;
#pragma unroll
    for (int g = 0; g < 4; ++g) {
        u32x2 w0, w1;
        w0.x = g8::cvt_pk_bf16(o0[4 * g] * inv, o0[4 * g + 1] * inv); w0.y = g8::cvt_pk_bf16(o0[4 * g + 2] * inv, o0[4 * g + 3] * inv);
        w1.x = g8::cvt_pk_bf16(o1[4 * g] * inv, o1[4 * g + 1] * inv); w1.y = g8::cvt_pk_bf16(o1[4 * g + 2] * inv, o1[4 * g + 3] * inv);
        *(u32x2*)(orow + 8 * g) = w0; *(u32x2*)(orow + 32 + 8 * g) = w1;
    }
    if (hh == 0) ((float*)(F.ws + WS_LSE))[((size_t)br * NTOK + tok) * 16 + h] = 0.6931471805599453f * (m + __builtin_amdgcn_logf(lsum));
}
__device__ __forceinline__ void p2_mixers(const Frame& F, const Args& a) {
    for (int u = F.gw; u < 2048; u += F.NGW) lru_unit(F, a, u);
#pragma nounroll
    for (int u = F.gw; u < 3 * 4096; u += F.NGW) { asm volatile("" ::: "memory"); const int uu = __builtin_amdgcn_readfirstlane(u); attn_unit(F, a, uu); }
}

__device__ __forceinline__ void p3_mix(const Frame& F, const Args& a) {
    const int LANE = lane_now(), TID = F.wave * 64 + LANE; (void)TID;
    LAS float* Hin = (LAS float*)F.lds;
    const float* ae = (const float*)(F.ws + WS_LRUE); const float* he = ae + 4 * 32 * 1024;
    const bf16_t* proj = (const bf16_t*)(F.ws + WS_PROJ);
    bf16_t* mixed = (bf16_t*)(F.ws + WS_MIXED);
    for (int grp = F.vcu; grp < NTOK / 32; grp += F.G) {
        const int tok0 = grp * 32, b = tok0 / SEQ, k = (tok0 % SEQ) / 64;
        __syncthreads();
        for (int d = TID; d < LRU_W; d += NTHR) { float H = 0.f;
            for (int j0 = 0; j0 < k; j0 += 8) { float av[8], hv[8];
#pragma unroll
                for (int jj = 0; jj < 8; ++jj) { const bool ok = (j0 + jj) < k; const size_t o = (size_t)(b * 32 + (ok ? j0 + jj : 0)) * 1024 + d; const float a1 = ae[o], h1 = he[o]; av[jj] = ok ? a1 : 1.0f; hv[jj] = ok ? h1 : 0.0f; }
#pragma unroll
                for (int jj = 0; jj < 8; ++jj) H = av[jj] * H + hv[jj]; }
            Hin[d] = H; }
        __syncthreads();
        for (int tt = F.wave; tt < 32; tt += NWAVES) {
            const size_t tok = (size_t)tok0 + tt;
            { const bf16_t* ao = (const bf16_t*)(F.ws + WS_ATT); const float* lse = (const float*)(F.ws + WS_LSE); const f32x4* gr = (const f32x4*)karg_in<10>() + LANE;
              f32x4 v[4]; float s = 0.f;
#pragma unroll
              for (int j = 0; j < 4; ++j) { const int hd = (LANE >> 4) + 4 * j;
                  const float l0 = lse[(0 * (size_t)NTOK + tok) * 16 + hd], l1 = lse[(1 * (size_t)NTOK + tok) * 16 + hd], l2 = lse[(2 * (size_t)NTOK + tok) * 16 + hd];
                  const float M = fmaxf(l0, fmaxf(l1, l2)); float w0 = __expf(l0 - M), w1 = __expf(l1 - M), w2 = __expf(l2 - M); const float iw = 1.0f / (w0 + w1 + w2); w0 *= iw; w1 *= iw; w2 *= iw;
                  const u32x2 a0 = *((const u32x2*)(ao + (0 * (size_t)NTOK + tok) * ATTN_W) + LANE + 64 * j), a1 = *((const u32x2*)(ao + (1 * (size_t)NTOK + tok) * ATTN_W) + LANE + 64 * j), a2 = *((const u32x2*)(ao + (2 * (size_t)NTOK + tok) * ATTN_W) + LANE + 64 * j);
                  v[j][0] = w0 * bflo(a0.x) + w1 * bflo(a1.x) + w2 * bflo(a2.x); v[j][1] = w0 * bfhi(a0.x) + w1 * bfhi(a1.x) + w2 * bfhi(a2.x);
                  v[j][2] = w0 * bflo(a0.y) + w1 * bflo(a1.y) + w2 * bflo(a2.y); v[j][3] = w0 * bfhi(a0.y) + w1 * bfhi(a1.y) + w2 * bfhi(a2.y);
                  s += (v[j][0] * v[j][0] + v[j][1] * v[j][1]) + (v[j][2] * v[j][2] + v[j][3] * v[j][3]); }
              const float rs = rsqrtf(wave_sum(s) * (1.0f / 1024.0f) + EPS);
              u32x2* o = (u32x2*)(mixed + tok * D_MODEL) + LANE;
#pragma unroll
              for (int j = 0; j < 4; ++j) { const f32x4 g = gr[64 * j]; u32x2 w; w.x = pk2(v[j][0] * rs * g[0], v[j][1] * rs * g[1]); w.y = pk2(v[j][2] * rs * g[2], v[j][3] * rs * g[3]); o[64 * j] = w; } }
            { const f32x4* hr = (const f32x4*)((const float*)(F.ws + WS_HL) + tok * LRU_W) + LANE; const f32x4* pr = (const f32x4*)((const float*)(F.ws + WS_PC) + tok * LRU_W) + LANE;
              const u32x2* gp = (const u32x2*)(proj + tok * IN_COLS + 3 * ATTN_W + LRU_W) + LANE; const f32x4* gr = (const f32x4*)karg_in<11>() + LANE;
              f32x4 v[4]; float s = 0.f;
#pragma unroll
              for (int j = 0; j < 4; ++j) { const f32x4 hv = hr[64 * j], pv = pr[64 * j]; const u32x2 gw = gp[64 * j]; const f32x4 hi = *(const LAS f32x4*)(Hin + (LANE + 64 * j) * 4);
                  v[j][0] = (hv[0] + pv[0] * hi[0]) * gelu_tanh(bflo(gw.x)); v[j][1] = (hv[1] + pv[1] * hi[1]) * gelu_tanh(bfhi(gw.x));
                  v[j][2] = (hv[2] + pv[2] * hi[2]) * gelu_tanh(bflo(gw.y)); v[j][3] = (hv[3] + pv[3] * hi[3]) * gelu_tanh(bfhi(gw.y));
                  s += (v[j][0] * v[j][0] + v[j][1] * v[j][1]) + (v[j][2] * v[j][2] + v[j][3] * v[j][3]); }
              const float rs = rsqrtf(wave_sum(s) * (1.0f / 1024.0f) + EPS);
              u32x2* o = (u32x2*)(mixed + tok * D_MODEL + ATTN_W) + LANE;
#pragma unroll
              for (int j = 0; j < 4; ++j) { const f32x4 g = gr[64 * j]; u32x2 w; w.x = pk2(v[j][0] * rs * g[0], v[j][1] * rs * g[1]); w.y = pk2(v[j][2] * rs * g[2], v[j][3] * rs * g[3]); o[64 * j] = w; } }
        }
    }
    __syncthreads();
}

__device__ __forceinline__ void p5_router(const Frame& F, const Args& a) {
    const int LANE = lane_now(), TID = F.wave * 64 + LANE; (void)TID;
    const float* x1 = (const float*)(F.ws + WS_X1); bf16_t* hn2s = (bf16_t*)(F.ws + WS_HN2S);
    const float* g = karg_in<13>(); const float* wr = karg_in<14>(); const float* br = karg_in<15>();
    int* cnt = (int*)(F.ctl + CW_CNT);
    int* sel_e = (int*)(F.ws + WS_SEL); int* sel_pos = sel_e + NSLOT; float* sel_g = (float*)(sel_pos + NSLOT);
    LAS float* PART = (LAS float*)F.lds;
    LAS float* SSQ = PART + 8 * 1024;
    LAS float* RS = SSQ + 256;
    LAS float* LG = RS + 32;
    LAS int* lcnt = (LAS int*)(LG + 1024);
    LAS int* gbase = lcnt + 32;
    LAS int* ent_e = gbase + 32;
    LAS int* ent_r = ent_e + 128;
    LAS float* ent_g = (LAS float*)(ent_r + 128);
    const int lane = LANE, r16 = lane & 15, kq = lane >> 4;
    for (int grp = F.vcu; grp < NTOK / 32; grp += F.G) {
        const int tok0 = grp * 32;
        __syncthreads();
        if (TID < 32) lcnt[TID] = 0;
        f32x4 acc00 = {0.f, 0.f, 0.f, 0.f}, acc01 = acc00, acc10 = acc00, acc11 = acc00; float ss0 = 0.f, ss1 = 0.f;
        const float* xa = x1 + (size_t)(tok0 + r16) * D_MODEL + F.wave * 256 + 4 * kq;
        const float* gp = g + F.wave * 256 + 4 * kq;
        const float* wp = wr + (size_t)(F.wave * 256 + 4 * kq) * N_EXP + r16;
#pragma unroll 4
        for (int S = 0; S < 16; ++S) {
            const f32x4 xv0 = *(const f32x4*)(xa + 16 * S), xv1 = *(const f32x4*)(xa + 16 * S + (size_t)16 * D_MODEL), gv = *(const f32x4*)(gp + 16 * S);
            float b0[4], b1[4];
#pragma unroll
            for (int q = 0; q < 4; ++q) { b0[q] = wp[(size_t)(16 * S + q) * N_EXP]; b1[q] = wp[(size_t)(16 * S + q) * N_EXP + 16]; }
            ss0 += (xv0[0] * xv0[0] + xv0[1] * xv0[1]) + (xv0[2] * xv0[2] + xv0[3] * xv0[3]);
            ss1 += (xv1[0] * xv1[0] + xv1[1] * xv1[1]) + (xv1[2] * xv1[2] + xv1[3] * xv1[3]);
#pragma unroll
            for (int q = 0; q < 4; ++q) { const float a0 = xv0[q] * gv[q], a1 = xv1[q] * gv[q];
                acc00 = __builtin_amdgcn_mfma_f32_16x16x4f32(a0, b0[q], acc00, 0, 0, 0); acc01 = __builtin_amdgcn_mfma_f32_16x16x4f32(a0, b1[q], acc01, 0, 0, 0);
                acc10 = __builtin_amdgcn_mfma_f32_16x16x4f32(a1, b0[q], acc10, 0, 0, 0); acc11 = __builtin_amdgcn_mfma_f32_16x16x4f32(a1, b1[q], acc11, 0, 0, 0); }
        }
        { LAS float* pw = PART + F.wave * 1024;
#pragma unroll
          for (int q = 0; q < 4; ++q) { const int tr = 4 * kq + q;
              pw[tr * 32 + r16] = acc00[q]; pw[tr * 32 + 16 + r16] = acc01[q]; pw[(16 + tr) * 32 + r16] = acc10[q]; pw[(16 + tr) * 32 + 16 + r16] = acc11[q]; }
          ss0 += __shfl_xor(ss0, 16); ss0 += __shfl_xor(ss0, 32); ss1 += __shfl_xor(ss1, 16); ss1 += __shfl_xor(ss1, 32);
          if (kq == 0) { SSQ[F.wave * 32 + r16] = ss0; SSQ[F.wave * 32 + 16 + r16] = ss1; } }
        __syncthreads();
        if (TID < 32) { float t = 0.f;
#pragma unroll
            for (int w = 0; w < 8; ++w) t += SSQ[w * 32 + TID];
            RS[TID] = rsqrtf(t * (1.0f / 2048.0f) + EPS); }
        __syncthreads();
        { const int tt = TID >> 4, eg = TID & 15; float s0 = 0.f, s1 = 0.f;
#pragma unroll
          for (int w = 0; w < 8; ++w) { const f32x2 v = *(const LAS f32x2*)(PART + w * 1024 + tt * 32 + 2 * eg); s0 += v[0]; s1 += v[1]; }
          const float rs = RS[tt];
          LG[tt * 32 + 2 * eg] = s0 * rs + br[2 * eg]; LG[tt * 32 + 2 * eg + 1] = s1 * rs + br[2 * eg + 1]; }
        __syncthreads();
        for (int t4 = 0; t4 < 4; ++t4) {
            const int tk = F.wave * 4 + t4;
            float cur = (lane < 32) ? LG[tk * 32 + lane] : -INFINITY;
            int i0 = 0, i1 = 0, i2 = 0, i3 = 0; float v0 = 0.f, v1 = 0.f, v2 = 0.f, v3 = 0.f;
#pragma unroll
            for (int k = 0; k < 4; ++k) {
                const float mx = wave_max(cur);
                const unsigned long long bal = __ballot(cur == mx);
                const int bi = __ffsll((long long)bal) - 1;
                if (k == 0) { i0 = bi; v0 = mx; } else if (k == 1) { i1 = bi; v1 = mx; } else if (k == 2) { i2 = bi; v2 = mx; } else { i3 = bi; v3 = mx; }
                if (lane == bi) cur = -INFINITY;
            }
            if (lane == 0) {
                const float e1 = __expf(v1 - v0), e2 = __expf(v2 - v0), e3 = __expf(v3 - v0); const float inv = 1.0f / (1.0f + e1 + e2 + e3);
                const int base = tk * 4;
                ent_e[base + 0] = i0; ent_r[base + 0] = __hip_atomic_fetch_add(&lcnt[i0], 1, __ATOMIC_RELAXED, __HIP_MEMORY_SCOPE_WORKGROUP); ent_g[base + 0] = inv;
                ent_e[base + 1] = i1; ent_r[base + 1] = __hip_atomic_fetch_add(&lcnt[i1], 1, __ATOMIC_RELAXED, __HIP_MEMORY_SCOPE_WORKGROUP); ent_g[base + 1] = e1 * inv;
                ent_e[base + 2] = i2; ent_r[base + 2] = __hip_atomic_fetch_add(&lcnt[i2], 1, __ATOMIC_RELAXED, __HIP_MEMORY_SCOPE_WORKGROUP); ent_g[base + 2] = e2 * inv;
                ent_e[base + 3] = i3; ent_r[base + 3] = __hip_atomic_fetch_add(&lcnt[i3], 1, __ATOMIC_RELAXED, __HIP_MEMORY_SCOPE_WORKGROUP); ent_g[base + 3] = e3 * inv;
            }
        }
        __syncthreads();
        if (TID < 32) { const int n = lcnt[TID]; gbase[TID] = n > 0 ? atomicAdd(&cnt[TID], n) : 0; }
        __syncthreads();
        if (TID < 128) { const int e = ent_e[TID], pos = gbase[e] + ent_r[TID], tok = tok0 + (TID >> 2);
            sel_e[tok * 4 + (TID & 3)] = e; sel_pos[tok * 4 + (TID & 3)] = pos; sel_g[tok * 4 + (TID & 3)] = ent_g[TID]; }
        for (int t4 = 0; t4 < 4; ++t4) { const int tk = F.wave * 4 + t4; const float rs = RS[tk];
            const f32x4* xr = (const f32x4*)(x1 + (size_t)(tok0 + tk) * D_MODEL) + lane; const f32x4* gr = (const f32x4*)g + lane; u32x2 w[8];
#pragma unroll
            for (int j = 0; j < 8; ++j) { const f32x4 v = xr[64 * j], gg = gr[64 * j]; w[j].x = pk2(v[0] * rs * gg[0], v[1] * rs * gg[1]); w[j].y = pk2(v[2] * rs * gg[2], v[3] * rs * gg[3]); }
#pragma unroll
            for (int k = 0; k < 4; ++k) { const int e = ent_e[tk * 4 + k], pos = gbase[e] + ent_r[tk * 4 + k]; u32x2* o = (u32x2*)(hn2s + ((size_t)e * NTOK + pos) * D_MODEL) + lane;
#pragma unroll
                for (int j = 0; j < 8; ++j) o[64 * j] = w[j]; } }
    }
    __syncthreads();
}

__device__ __forceinline__ void build_tpre(const Frame& F, int nhb) {
    const int TID = F.tid_();
    LAS int* tpre = (LAS int*)(F.lds + L_TPRE); LAS int* bid = (LAS int*)(F.lds + L_BLKID); LAS int* bpre = (LAS int*)(F.lds + L_BLKPRE); LAS int* bsz = (LAS int*)(F.lds + L_BLKPRE + 512);
    __syncthreads();
    if (TID == 0) { const int* cnt = (const int*)(F.ctl + CW_CNT); int acc = 0; for (int e = 0; e < N_EXP; ++e) { tpre[e] = acc; acc += (cnt[e] + 255) >> 8; } tpre[N_EXP] = acc; }
    __syncthreads();
    if (nhb) {
        const int nb = N_EXP * nhb;
        if (TID < nb) {
            const int e = TID / nhb, nm = tpre[e + 1] - tpre[e]; int r = 0;
            for (int b = 0; b < nb; ++b) { const int eb = b / nhb, nmb = tpre[eb + 1] - tpre[eb]; r += (nmb > nm || (nmb == nm && b < TID)) ? 1 : 0; }
            bid[(r & 7) * 8 + (r >> 3)] = TID; bsz[(r & 7) * 8 + (r >> 3)] = nm * 8;
        }
        __syncthreads();
        if (TID < 8) { int acc = 0; bpre[TID * 9] = 0; for (int k = 0; k < 4 * nhb; ++k) { acc += bsz[TID * 8 + k]; bpre[TID * 9 + k + 1] = acc; } }
        __syncthreads();
    }
}

__device__ __forceinline__ void p8_final(const Frame& F, const Args& a) {
    const int LANE = lane_now(), TID = F.wave * 64 + LANE; (void)TID;
    const LAS int* tpre = (const LAS int*)(F.lds + L_TPRE);
    const float* x1 = (const float*)(F.ws + WS_X1); const bf16_t* Y = (const bf16_t*)(F.ws + WS_Y);
    const int* sel_e = (const int*)(F.ws + WS_SEL); const int* sel_pos = sel_e + NSLOT; const float* sel_g = (const float*)(sel_pos + NSLOT);
    const f32x4* gr = (const f32x4*)karg_in<20>() + LANE;
    for (int tok = F.gw; tok < NTOK; tok += F.NGW) {
        const f32x4* xr = (const f32x4*)(x1 + (size_t)tok * D_MODEL) + LANE;
        f32x4 v[8];
#pragma unroll
        for (int j = 0; j < 8; ++j) v[j] = xr[64 * j];
#pragma unroll
        for (int k = 0; k < 4; ++k) {
            const int e = sel_e[tok * 4 + k]; const size_t row = (size_t)tpre[e] * 256 + sel_pos[tok * 4 + k]; const float gk = sel_g[tok * 4 + k];
            const u32x2* yp = (const u32x2*)(Y + row * D_MODEL) + LANE;
#pragma unroll
            for (int j = 0; j < 8; ++j) { const u32x2 w = yp[64 * j]; v[j][0] += gk * bflo(w.x); v[j][1] += gk * bfhi(w.x); v[j][2] += gk * bflo(w.y); v[j][3] += gk * bfhi(w.y); }
        }
        float s = 0.f;
#pragma unroll
        for (int j = 0; j < 8; ++j) s += (v[j][0] * v[j][0] + v[j][1] * v[j][1]) + (v[j][2] * v[j][2] + v[j][3] * v[j][3]);
        const float rs = rsqrtf(wave_sum(s) * (1.0f / 2048.0f) + EPS);
        f32x4* o = (f32x4*)(karg_out() + (size_t)tok * D_MODEL) + LANE;
#pragma unroll
        for (int j = 0; j < 8; ++j) { const f32x4 g = gr[64 * j]; o[64 * j] = (f32x4){v[j][0] * rs * g[0], v[j][1] * rs * g[1], v[j][2] * rs * g[2], v[j][3] * rs * g[3]}; }
    }
}

__device__ __forceinline__ void ph1_inproj(const Frame& F, const Args& args) {
    unsigned char* ws = F.ws;
    g8::DenseOrder S{(const char*)(ws + WS_HN), (const char*)karg_in<2>(), NTOK / 256, IN_COLS / 256, (NTOK / 256) * (IN_COLS / 256), F.G, (int)blockIdx.x, IN_COLS};
    g8::EpiBf16 E{(bf16_t*)(ws + WS_PROJ), IN_COLS, nullptr, 0};
    g8::gemm_phase<g8::EpiBf16, g8::DenseOrder>(F.lds, S, E, F.wave);
}
__device__ __forceinline__ void ph4_outproj(const Frame& F, const Args& args) {
    unsigned char* ws = F.ws;
    g8::DenseOrder S{(const char*)(ws + WS_MIXED), (const char*)karg_in<12>(), NTOK / 256, D_MODEL / 256, (NTOK / 256) * (D_MODEL / 256), F.G, (int)blockIdx.x, D_MODEL};
    g8::EpiResF32 E{(float*)(ws + WS_X1), karg_in<0>(), D_MODEL};
    g8::gemm_phase<g8::EpiResF32, g8::DenseOrder>(F.lds, S, E, F.wave);
}
__device__ __forceinline__ void ph6_gateup(const Frame& F, const Args& args) {
    unsigned char* ws = F.ws;
    build_tpre(F, 2);
    g8::GroupedOrder S{(const char*)(ws + WS_HN2S), (const char*)karg_in<16>(), (const LAS int*)(F.lds + L_TPRE), (const LAS int*)(F.lds + L_BLKID), (const LAS int*)(F.lds + L_BLKPRE), 2, F.G, (int)blockIdx.x, (size_t)4096 * KDIM * 4, true, 4096};
    g8::EpiSwiglu E{(bf16_t*)(ws + WS_ACT), karg_in<17>()};
    g8::gemm_phase<g8::EpiSwiglu, g8::GroupedOrder>(F.lds, S, E, F.wave);
}
__device__ __forceinline__ void ph7_down(const Frame& F, const Args& args) {
    unsigned char* ws = F.ws;
    build_tpre(F, 1);
    g8::GroupedOrder S{(const char*)(ws + WS_ACT), (const char*)karg_in<18>(), (const LAS int*)(F.lds + L_TPRE), (const LAS int*)(F.lds + L_BLKID), (const LAS int*)(F.lds + L_BLKPRE), 1, F.G, (int)blockIdx.x, (size_t)D_MODEL * KDIM * 4, false, D_MODEL};
    g8::EpiBf16 E{(bf16_t*)(ws + WS_Y), D_MODEL, karg_in<19>(), D_MODEL};
    g8::gemm_phase<g8::EpiBf16, g8::GroupedOrder>(F.lds, S, E, F.wave);
}

constexpr int N_PHASES = 9;
__global__ void __launch_bounds__(NTHR, 2) mk_fwd(Args args) {
    extern __shared__ __attribute__((aligned(16))) unsigned char lds_raw[];
    Frame F;
    F.lds = (LAS unsigned char*)lds_raw;
    F.wave = __builtin_amdgcn_readfirstlane((int)threadIdx.x >> 6);
    F.G = gridDim.x; { const int bx = blockIdx.x; F.vcu = (F.G % 8 == 0) ? (bx % 8) * (F.G / 8) + bx / 8 : bx; }
    F.gw = F.vcu * NWAVES + F.wave; F.NGW = F.G * NWAVES;
    F.ws = args.ws; F.ctl = (unsigned*)(args.ws + WS_CTL);
    for (int u = F.tid_(); u < (LDS_BYTES - LDSCTL_OFF) / 4; u += NTHR) ((LAS unsigned*)(F.lds + LDSCTL_OFF))[u] = 0u;
    __syncthreads();
    const int lo = args.ph_lo, hi = args.ph_hi;
    unsigned bar_x = 0;
    if (hi - lo > 1) bar_x = __builtin_amdgcn_readfirstlane(xcd_barrier_post(F.ctl + CW_BAR, (volatile LAS unsigned*)(F.lds + L_MISC) + 8, F.tid_()).x);
#define IN(k) (lo <= (k) && (k) < hi)
#define XBAR() do { unsigned* _bp = F.ctl + CW_BAR; asm volatile("" : "+s"(_bp)); XcdBarrier _b; _b.bar = _bp; _b.x = bar_x; _b.st = (volatile LAS unsigned*)(F.lds + L_MISC) + 8; xcd_barrier(_b, F.tid_()); } while (0)
#define SEAM(k) do { if (IN(k) && IN((k) + 1)) XBAR(); } while (0)

#define PHASE(k, call) do { if (IN(k)) { call; } if ((PROBE_MASK >> (k)) & 1) { XBAR(); if (IN(k)) { call; } } } while (0)
    PHASE(0, p0_prologue(F, args)); SEAM(0);
    PHASE(1, ph1_inproj(F, args)); SEAM(1);
    PHASE(2, p2_mixers(F, args)); SEAM(2);
    PHASE(3, p3_mix(F, args)); SEAM(3);
    PHASE(4, ph4_outproj(F, args)); SEAM(4);
    if (IN(5)) { p5_router(F, args); } SEAM(5);
    PHASE(6, ph6_gateup(F, args)); SEAM(6);
    PHASE(7, ph7_down(F, args)); SEAM(7);
    if (IN(8)) { build_tpre(F, 0); p8_final(F, args); }
#undef IN
#undef SEAM
}

extern "C" void kernel_launch(void* const* d_in, const int* in_sizes, int n_in, void* d_out, int out_size, void* d_ws, size_t ws_size, hipStream_t stream) {
    static int grid = 0;
    if (grid == 0) {
        if (n_in != 21 || out_size != NTOK * D_MODEL || ws_size < WS_END) { fprintf(stderr, "kernel_launch: unexpected problem (n_in %d out %d ws %zu)\n", n_in, out_size, ws_size); grid = -1; return; }
        int dev = 0, cus = 0, per_cu = 0;
        if (hipGetDevice(&dev) != hipSuccess || hipDeviceGetAttribute(&cus, hipDeviceAttributeMultiprocessorCount, dev) != hipSuccess) { grid = -1; return; }
        if (hipFuncSetAttribute((const void*)mk_fwd, hipFuncAttributeMaxDynamicSharedMemorySize, LDS_BYTES) != hipSuccess) { fprintf(stderr, "kernel_launch: hipFuncSetAttribute failed\n"); grid = -1; return; }
        if (hipOccupancyMaxActiveBlocksPerMultiprocessor(&per_cu, (const void*)mk_fwd, NTHR, LDS_BYTES) != hipSuccess || per_cu < 1) { fprintf(stderr, "kernel_launch: occupancy query says %d\n", per_cu); }
        (void)hipGetLastError();
        grid = cus;
    }
    if (grid < 0) return;
    if (hipMemsetAsync((char*)d_ws + WS_CTL, 0, CTL_ZERO_BYTES, stream) != hipSuccess) return;
    Args a{};
    for (int i = 0; i < 21; ++i) a.in[i] = (const float*)d_in[i];
    a.out = (float*)d_out; a.ws = (unsigned char*)d_ws;
#if MK_N_LAUNCHES == 1
    a.ph_lo = 0; a.ph_hi = N_PHASES;
    hipLaunchKernelGGL(mk_fwd, dim3(grid), dim3(NTHR), LDS_BYTES, stream, a);
#else
    for (int p = 0; p < N_PHASES; ++p) { a.ph_lo = p; a.ph_hi = p + 1; hipLaunchKernelGGL(mk_fwd, dim3(grid), dim3(NTHR), LDS_BYTES, stream, a); }
#endif
}
```

```cpp
#include <hip/hip_runtime.h>
#include <stdint.h>
#include <stdio.h>

#ifndef MK_N_LAUNCHES
#define MK_N_LAUNCHES 1
#endif

#ifndef PROBE_MASK
#define PROBE_MASK 0
#endif
#define LAS __attribute__((address_space(3)))
#define GAS __attribute__((address_space(1)))
typedef unsigned short bf16_t;
typedef short bf16x8 __attribute__((ext_vector_type(8)));
typedef float f32x4 __attribute__((ext_vector_type(4)));
typedef float f32x2 __attribute__((ext_vector_type(2)));
typedef unsigned u32x4 __attribute__((ext_vector_type(4)));
typedef unsigned u32x2 __attribute__((ext_vector_type(2)));

constexpr int D_MODEL = 2048, BATCH = 4, SEQ = 2048, NTOK = BATCH * SEQ;
constexpr int N_HEADS = 16, ATTN_W = 1024, LRU_W = 1024;
constexpr int IN_COLS = 5120;
constexpr int N_EXP = 32, D_FF = 2048, NSLOT = NTOK * 4;
constexpr int KDIM = 2048;
constexpr float EPS = 1e-6f;
constexpr int NWAVES = 8, NTHR = 512;
constexpr int PADROWS = NSLOT + N_EXP * 256;

constexpr size_t MiB = 1u << 20;
constexpr size_t WS_CTL = 0, WS_LISTS = 1 * MiB, CTL_ZERO_BYTES = 2 * MiB;
constexpr size_t WS_SEL = 2 * MiB;
constexpr size_t WS_LRUE = 3 * MiB;
constexpr size_t WS_WIN = 4 * MiB, WS_WOUT = 24 * MiB, WS_HN = 32 * MiB, WS_PROJ = 64 * MiB, WS_ATT = 144 * MiB  , WS_HL = 192 * MiB, WS_PC = 224 * MiB;
constexpr size_t WS_MIXED = 256 * MiB, WS_X1 = 288 * MiB, WS_ACT = 352 * MiB, WS_Y = 512 * MiB, WS_WGU = 672 * MiB, WS_WDN = 1184 * MiB, WS_LSE = 1440 * MiB  , WS_HN2S = 1442 * MiB  , WS_END = 2466 * MiB;
static_assert((size_t)PADROWS * 2048 * 2 <= 160 * MiB, "ACT/Y size");
constexpr int CW_BAR = 4096, CW_CNT = 8192;

constexpr int RING_BYTES = 131072;
constexpr int LDSCTL_OFF = 139264;
constexpr int LDS_BYTES = 147456;
constexpr int L_MISC = LDSCTL_OFF;
constexpr int L_TPRE = LDSCTL_OFF + 256;
constexpr int L_CNT = LDSCTL_OFF + 512;
constexpr int L_BLKID = LDSCTL_OFF + 1024;
constexpr int L_BLKPRE = LDSCTL_OFF + 1280;

__device__ __forceinline__ unsigned f2bf(float f) { unsigned u = __builtin_bit_cast(unsigned, f); return (u + 0x7fffu + ((u >> 16) & 1u)) >> 16; }
__device__ __forceinline__ unsigned pk2(float lo, float hi) { return f2bf(lo) | (f2bf(hi) << 16); }
__device__ __forceinline__ float bf2f(unsigned short b) { return __builtin_bit_cast(float, (unsigned)b << 16); }
__device__ __forceinline__ float bflo(unsigned w) { return __builtin_bit_cast(float, w << 16); }
__device__ __forceinline__ float bfhi(unsigned w) { return __builtin_bit_cast(float, w & 0xffff0000u); }
__device__ __forceinline__ float wave_sum(float v) {
#pragma unroll
    for (int o = 1; o < 64; o <<= 1) v += __shfl_xor(v, o);
    return v;
}
__device__ __forceinline__ float wave_max(float v) {
#pragma unroll
    for (int o = 1; o < 64; o <<= 1) v = fmaxf(v, __shfl_xor(v, o));
    return v;
}
#define LDS_WAIT() asm volatile("s_waitcnt lgkmcnt(0)" ::: "memory")
#define VM_WAIT() asm volatile("s_waitcnt vmcnt(0)" ::: "memory")

__device__ __forceinline__ int lane_now() { int l; asm volatile("v_mbcnt_lo_u32_b32 %0, -1, 0\n\tv_mbcnt_hi_u32_b32 %0, -1, %0" : "=v"(l)); return l; }

#define XB_TMO      128
#define XB_XCNT(j)  (256  + 64 * (j))
#define XB_XSUB(j)  (1280 + 64 * (j))
#define XB_XGEN(j)  (2304 + 64 * (j))
#define XB_TOP      3328
#define XB_TOPGEN   3392
#define XCD_BAR_WORDS 3456
#define XB_SPIN_CAP (1u << 20)
__device__ __forceinline__ unsigned xb_ld(unsigned* p)              { return __hip_atomic_load(p, __ATOMIC_RELAXED, __HIP_MEMORY_SCOPE_AGENT); }
__device__ __forceinline__ unsigned xb_add(unsigned* p, unsigned v) { return __hip_atomic_fetch_add(p, v, __ATOMIC_RELAXED, __HIP_MEMORY_SCOPE_AGENT); }
__device__ __forceinline__ unsigned xb_xcc_id() { return (unsigned)__builtin_amdgcn_s_getreg((3 << 11) | 20) & 0xFu; }
#define XB_SPIN(cond, bar) do { unsigned _sp = 0; while (cond) { __builtin_amdgcn_s_sleep(1); \
    if ((++_sp & 255u) == 0u) { if (xb_ld(&(bar)[XB_TMO])) break; if (_sp > XB_SPIN_CAP) { atomicAdd(&(bar)[XB_TMO], 1u); break; } } } } while (0)
struct XcdBarrier { unsigned* bar; unsigned x; volatile LAS unsigned* st; };
__device__ __forceinline__ XcdBarrier xcd_barrier_post(unsigned* bar, volatile LAS unsigned* st, int tid) {
    XcdBarrier b; b.bar = bar; b.x = xb_xcc_id(); b.st = st;
    if (tid == 0) (void)xb_add(&bar[XB_XCNT(b.x)], 1u);
    return b;
}
__device__ __forceinline__ void xcd_barrier_complete(unsigned* bar, unsigned x, unsigned& nloc, unsigned& nx) {
    const unsigned G = gridDim.x * gridDim.y * gridDim.z;
    unsigned sum, cnt, mine, sp = 0u;
    for (;;) {
        sum = 0u; cnt = 0u; mine = 0u;
#pragma unroll
        for (unsigned j = 0; j < 16; ++j) { const unsigned c = xb_ld(&bar[XB_XCNT(j)]); sum += c; cnt += (c > 0u) ? 1u : 0u; mine = (j == x) ? c : mine; }
        if (sum == G) break;
        __builtin_amdgcn_s_sleep(1);
        if ((++sp & 255u) == 0u) { if (xb_ld(&bar[XB_TMO])) break; if (sp > XB_SPIN_CAP) { atomicAdd(&bar[XB_TMO], 1u); break; } }
    }
    nloc = mine > 0u ? mine : 1u; nx = cnt > 0u ? cnt : 1u;
}
__device__ __forceinline__ void xcd_barrier(const XcdBarrier& b, int tid) {
    asm volatile("s_waitcnt vmcnt(0)" ::: "memory");
    __syncthreads();
    if (tid == 0) {
        unsigned* bar = b.bar;
        __builtin_amdgcn_s_waitcnt(0);
        unsigned nloc = b.st[0], nx = b.st[1];
        if (nloc == 0u) { xcd_barrier_complete(bar, b.x, nloc, nx); b.st[0] = nloc; b.st[1] = nx; }
        const unsigned old = xb_add(&bar[XB_XSUB(b.x)], 1u);
        const unsigned gen = old / nloc;
        if (old + 1u == (gen + 1u) * nloc) {
            __builtin_amdgcn_fence(__ATOMIC_RELEASE, "agent");
            asm volatile("s_waitcnt vmcnt(0)" ::: "memory");
            const unsigned og = xb_add(&bar[XB_TOP], 1u);
            const unsigned tg = og / nx;
            if (og + 1u == (tg + 1u) * nx) xb_add(&bar[XB_TOPGEN], 1u);
            else XB_SPIN(xb_ld(&bar[XB_TOPGEN]) == tg, bar);
            __builtin_amdgcn_fence(__ATOMIC_ACQUIRE, "agent");
            xb_add(&bar[XB_XGEN(b.x)], 1u);
            asm volatile("s_waitcnt vmcnt(0)" ::: "memory");
        } else {
            XB_SPIN(xb_ld(&bar[XB_XGEN(b.x)]) == gen, bar);
            __builtin_amdgcn_fence(__ATOMIC_ACQUIRE, "agent");
            asm volatile("s_waitcnt vmcnt(0)" ::: "memory");
        }
    }
    __syncthreads();
}

typedef float f32x16 __attribute__((ext_vector_type(16)));
typedef short s16x4 __attribute__((ext_vector_type(4)));
typedef short v4i16_t __attribute__((ext_vector_type(4)));
__device__ __forceinline__ s16x4 vtr(const LAS unsigned char* p) { return __builtin_bit_cast(s16x4, __builtin_amdgcn_ds_read_tr16_b64_v4i16((LAS v4i16_t*)p)); }

namespace g8 {
constexpr int BM = 256, BK = 64, HALF = 128, HTB = HALF * BK * 2, STAGE_BYTES = 8 * HTB, NXCD = 8, WGM = 8;
__host__ __device__ __forceinline__ int lds_byte(int r, int c) { const int st = (r >> 4) * 2 + (c >> 5), rr = r & 15, cc = c & 31, ob = rr * 64 + cc * 2; return st * 1024 + (ob ^ (((ob >> 9) & 1) << 5)); }
__host__ __device__ __forceinline__ void stage_rc(int b, int& R, int& C) { const int st = b / 1024, sb = b % 1024, swz = sb ^ (((sb >> 9) & 1) << 5); R = (st >> 1) * 16 + swz / 64; C = (st & 1) * 32 + (swz % 64) / 2; }
__host__ __device__ __forceinline__ int perm32(int rho) { const int n = rho >> 4, i = rho & 15; return 8 * (i >> 2) + 4 * n + (i & 3); }

struct Unit { const char* a; const char* b; int crow, ccol, e, gi; };

struct DenseOrder {
    const char* A; const char* Bt; int nM, nN, nwg, G, c; int ldb;
    __device__ __forceinline__ bool next(int i, Unit& u) const {
        const long L = (long)i * G + c; if (L >= nwg) return false;
        int wgid = (int)L; { const int q = nwg / NXCD, r = nwg % NXCD, xcd = wgid % NXCD, off = wgid / NXCD; wgid = (xcd < r ? xcd * (q + 1) : r * (q + 1) + (xcd - r) * q) + off; }
        const int nig = WGM * nN, gid = wgid / nig, fm = gid * WGM, gsz = (nM - fm) < WGM ? (nM - fm) : WGM;
        const int pm = fm + ((wgid % nig) % gsz), pn = (wgid % nig) / gsz;
        u.a = A + (size_t)pm * BM * KDIM * 2; u.b = Bt + (size_t)pn * BM * 4; u.crow = pm * BM; u.ccol = pn * BM; u.e = 0; u.gi = 0; return true;
    }
};
struct GroupedOrder {
    const char* A; const char* Bt; const LAS int* tpre; const LAS int* bid; const LAS int* bpre; int nhb, G, c; size_t bstride;
    bool capA; int ldb;
    __device__ __forceinline__ bool next(int i, Unit& u) const {
        const int per = G >> 3, x = c & 7, j = c >> 3, Lx = i * per + j, nslots = 4 * nhb;
        const LAS int* bp = bpre + x * 9;
        if (Lx >= __builtin_amdgcn_readfirstlane(bp[nslots])) return false;
        int k = 0; while (Lx >= __builtin_amdgcn_readfirstlane(bp[k + 1])) ++k;
        const int b = __builtin_amdgcn_readfirstlane(bid[x * 8 + k]), within = Lx - __builtin_amdgcn_readfirstlane(bp[k]);
        const int e = b / nhb, hb = b - e * nhb, mt = within >> 3, nt = hb * 8 + (within & 7);
        const int mtile = __builtin_amdgcn_readfirstlane(tpre[e]) + mt;
        u.a = A + (capA ? ((size_t)e * NTOK + (size_t)mt * BM) : (size_t)mtile * BM) * KDIM * 2;
        u.b = Bt + (size_t)e * bstride + (size_t)nt * BM * 4; u.crow = mtile * BM; u.ccol = nt * BM; u.e = e; u.gi = 0; return true;
    }
};

__device__ __forceinline__ unsigned cvt_pk_bf16(float lo, float hi) { unsigned r; asm volatile("v_cvt_pk_bf16_f32 %0, %1, %2" : "=v"(r) : "v"(lo), "v"(hi)); return r; }

struct EpiBf16 {
    bf16_t* O; int ldc; const float* bias; int bias_stride;
    __device__ __forceinline__ void operator()(const f32x4 (&acc)[2][2][4][2], const Unit& u, int wr, int wc, int fr, int fq) const {
        const int row0 = u.crow + wr * 64 + fr, col0 = u.ccol + wc * 32 + 8 * fq;
#pragma unroll
        for (int bj = 0; bj < 2; ++bj) {
            const f32x4 b0 = bias ? *(const f32x4*)(bias + (size_t)u.e * bias_stride + col0 + bj * HALF) : (f32x4){0.f, 0.f, 0.f, 0.f};
            const f32x4 b1 = bias ? *(const f32x4*)(bias + (size_t)u.e * bias_stride + col0 + bj * HALF + 4) : (f32x4){0.f, 0.f, 0.f, 0.f};
#pragma unroll
            for (int ai = 0; ai < 2; ++ai)
#pragma unroll
                for (int m = 0; m < 4; ++m) { const f32x4 v0 = acc[ai][bj][m][0] + b0, v1 = acc[ai][bj][m][1] + b1;
                    u32x4 w; w.x = cvt_pk_bf16(v0[0], v0[1]); w.y = cvt_pk_bf16(v0[2], v0[3]); w.z = cvt_pk_bf16(v1[0], v1[1]); w.w = cvt_pk_bf16(v1[2], v1[3]);
                    *(u32x4*)(O + (size_t)(row0 + ai * HALF + m * 16) * ldc + col0 + bj * HALF) = w; } }
    }
};
struct EpiResF32 {
    float* C; const float* res; int ldc;
    __device__ __forceinline__ void operator()(const f32x4 (&acc)[2][2][4][2], const Unit& u, int wr, int wc, int fr, int fq) const {
        const int row0 = u.crow + wr * 64 + fr, col0 = u.ccol + wc * 32 + 8 * fq;
#pragma unroll
        for (int ai = 0; ai < 2; ++ai)
#pragma unroll
            for (int m = 0; m < 4; ++m) { const size_t off = (size_t)(row0 + ai * HALF + m * 16) * ldc + col0;
#pragma unroll
                for (int bj = 0; bj < 2; ++bj)
#pragma unroll
                    for (int n = 0; n < 2; ++n) { const f32x4 r = *(const f32x4*)(res + off + bj * HALF + n * 4); *(f32x4*)(C + off + bj * HALF + n * 4) = acc[ai][bj][m][n] + r; } }
    }
};
struct EpiSwiglu {
    bf16_t* O; const float* bias;
    __device__ __forceinline__ float act(float g, float up) const {
        g = fminf(g, 7.0f); up = fminf(fmaxf(up, -7.0f), 7.0f);
        const float sg = 1.0f / (1.0f + __expf(-1.702f * g));
        return g * sg * (up + 1.0f);
    }
    __device__ __forceinline__ void operator()(const f32x4 (&acc)[2][2][4][2], const Unit& u, int wr, int wc, int fr, int fq) const {
        const int row0 = u.crow + wr * 64 + fr, col0 = u.ccol + wc * 32 + 8 * fq;
#pragma unroll
        for (int bj = 0; bj < 2; ++bj) {
            const f32x4 b0 = *(const f32x4*)(bias + (size_t)u.e * (2 * D_FF) + col0 + bj * HALF), b1 = *(const f32x4*)(bias + (size_t)u.e * (2 * D_FF) + col0 + bj * HALF + 4);
#pragma unroll
            for (int ai = 0; ai < 2; ++ai)
#pragma unroll
                for (int m = 0; m < 4; ++m) { const f32x4 v0 = acc[ai][bj][m][0] + b0, v1 = acc[ai][bj][m][1] + b1;
                    u32x2 w; w.x = cvt_pk_bf16(act(v0[0], v0[1]), act(v0[2], v0[3])); w.y = cvt_pk_bf16(act(v1[0], v1[1]), act(v1[2], v1[3]));
                    *(u32x2*)(O + (size_t)(row0 + ai * HALF + m * 16) * D_FF + ((col0 + bj * HALF) >> 1)) = w; } }
    }
};


template <class Epi, class Sched>
__device__ __forceinline__ void gemm_phase(LAS unsigned char* lds, const Sched& S, const Epi& E, int wave) {
    const int wid = wave, lane = lane_now(), tid = wid * 64 + lane, wr = wid >> 2, wc = wid & 3;
    constexpr int K = KDIM, nt = K / BK;
    unsigned voffA[2];
#pragma unroll
    for (int i = 0; i < 2; ++i) { int R, C; stage_rc(tid * 16 + i * 8192, R, C); voffA[i] = (unsigned)(R * K + C) * 2u; }
    const int ldb = S.ldb;
    constexpr size_t kstep = (size_t)(BK * 2);
    constexpr size_t hstep = (size_t)HALF * K * 2;
    const size_t kstepB = (size_t)BK * ldb * 4;
    constexpr size_t hstepB = 512;
    const size_t jstepB = (size_t)16 * ldb * 4;
    const unsigned bvoff = (unsigned)((tid >> 5) * ldb * 4 + (tid & 31) * 16);
    const unsigned ldsbase = (unsigned)(size_t)lds;
    unsigned wbase;
    { const int k0 = tid >> 5, q = tid & 31, f = 2 * ((k0 & 3) + 4 * ((k0 >> 3) & 1)); wbase = ldsbase + (unsigned)(k0 * 256 + (((q >> 1) ^ f) * 16) + (q & 1) * 8); }
    const unsigned ldsw = (unsigned)wid * 1024u;
    const int fr = lane & 15, fq = lane >> 4;
    const int aoff = lds_byte(wr * 64 + fr, fq * 8);
    int bb[2];
    { const int q = (lane & 15) >> 2, p = lane & 3, f = 2 * (q + 4 * (fq & 1));
#pragma unroll
      for (int nf = 0; nf < 2; ++nf) { const int ch = 4 * wc + p; bb[nf] = (8 * fq + q) * 256 + ((ch ^ f) * 16) + nf * 8; } }
#define G8_SA(b, h) (((b) * 2 + (h)) * HTB)
#define G8_SB(b, h) ((4 + (b) * 2 + (h)) * HTB)
#define G8_STAGE_A(bufoff, gbase) do { \
        __builtin_amdgcn_global_load_lds((const unsigned*)((const char*)(gbase) + voffA[0]), (LAS unsigned*)(lds + (bufoff) + ldsw), 16, 0, 0); \
        __builtin_amdgcn_global_load_lds((const unsigned*)((const char*)(gbase) + voffA[1]), (LAS unsigned*)(lds + (bufoff) + ldsw + 8192), 16, 0, 0); } while (0)
#define G8_LOADB(R, ptr) do { const char* _p = (const char*)(ptr); \
        asm volatile("s_nop 4\n\tglobal_load_dwordx4 %0, %1, %2" : "=&v"(R##0) : "v"(bvoff), "s"(_p) : "memory"); _p += jstepB; \
        asm volatile("global_load_dwordx4 %0, %1, %2" : "=&v"(R##1) : "v"(bvoff), "s"(_p) : "memory"); _p += jstepB; \
        asm volatile("global_load_dwordx4 %0, %1, %2" : "=&v"(R##2) : "v"(bvoff), "s"(_p) : "memory"); _p += jstepB; \
        asm volatile("global_load_dwordx4 %0, %1, %2" : "=&v"(R##3) : "v"(bvoff), "s"(_p) : "memory"); } while (0)
#define G8_CVT2(R) do { R[0] = __builtin_bit_cast(float, cvt_pk_bf16(R[0], R[1])); R[1] = __builtin_bit_cast(float, cvt_pk_bf16(R[2], R[3])); } while (0)
#define G8_LO2(R) __builtin_shufflevector(R, R, 0, 1)
#define G8_CVTW(R, bufoff, N) do { asm volatile("s_waitcnt vmcnt(" #N ")" : "+v"(R##0), "+v"(R##1), "+v"(R##2), "+v"(R##3) :: "memory"); __builtin_amdgcn_sched_barrier(0); \
        const unsigned _wa = wbase + (unsigned)(bufoff); G8_CVT2(R##0); G8_CVT2(R##1); G8_CVT2(R##2); G8_CVT2(R##3); \
        asm volatile("ds_write_b64 %0, %1\n\tds_write_b64 %0, %2 offset:4096\n\tds_write_b64 %0, %3 offset:8192\n\tds_write_b64 %0, %4 offset:12288" :: "v"(_wa), "v"(G8_LO2(R##0)), "v"(G8_LO2(R##1)), "v"(G8_LO2(R##2)), "v"(G8_LO2(R##3)) : "memory"); } while (0)
#define G8_LDA(dst, b, h) do { _Pragma("unroll") for (int m = 0; m < 4; ++m) _Pragma("unroll") for (int k = 0; k < 2; ++k) dst[m][k] = *(const LAS bf16x8*)(lds + G8_SA(b, h) + aoff + m * 2048 + k * 1024); } while (0)
#define G8_TR(dst, addr, off) asm volatile("ds_read_b64_tr_b16 %0, %1 offset:%2" : "=v"(dst) : "v"(addr), "i"(off) : "memory")
#define G8_LDB(lo, hi, b, h) do { _Pragma("unroll") for (int n = 0; n < 2; ++n) { const unsigned _ad = ldsbase + (unsigned)(G8_SB(b, h)) + (unsigned)bb[n]; \
        G8_TR(lo[n][0], _ad, 0); G8_TR(hi[n][0], _ad, 1024); G8_TR(lo[n][1], _ad, 8192); G8_TR(hi[n][1], _ad, 9216); } } while (0)
#define G8_BF(lo, hi, n, k) __builtin_shufflevector(lo[n][k], hi[n][k], 0, 1, 2, 3, 4, 5, 6, 7)
#define G8_MMA(ai, bj, At, Bl, Bh) do { __builtin_amdgcn_s_setprio(1); _Pragma("unroll") for (int m = 0; m < 4; ++m) _Pragma("unroll") for (int n = 0; n < 2; ++n) _Pragma("unroll") for (int k = 0; k < 2; ++k) \
        acc[ai][bj][m][n] = __builtin_amdgcn_mfma_f32_16x16x32_bf16(G8_BF(Bl, Bh, n, k), At[m][k], acc[ai][bj][m][n], 0, 0, 0); __builtin_amdgcn_s_setprio(0); } while (0)
#define G8_WAIT_V(n) asm volatile("s_waitcnt vmcnt(" #n ")" ::: "memory")
#define G8_WAIT_L(n) do { asm volatile("s_waitcnt lgkmcnt(" #n ")" ::: "memory"); __builtin_amdgcn_sched_barrier(0); } while (0)
#define G8_BAR __builtin_amdgcn_s_barrier()
#define G8_SCHED __builtin_amdgcn_sched_barrier(0)
    Unit cur, nxt; int ui = 0;
    if (!S.next(0, cur)) return;
    f32x4 acc[2][2][4][2];
#pragma unroll
    for (int a = 0; a < 2; ++a)
#pragma unroll
        for (int b = 0; b < 2; ++b)
#pragma unroll
            for (int m = 0; m < 4; ++m)
#pragma unroll
                for (int n = 0; n < 2; ++n) acc[a][b][m][n] = (f32x4){0.f, 0.f, 0.f, 0.f};
    bf16x8 At[4][2]; s16x4 B0l[2][2], B0h[2][2], B1l[2][2], B1h[2][2];
    f32x4 RA0, RA1, RA2, RA3, RB0, RB1, RB2, RB3;
    const char* cA = cur.a; const char* cB = cur.b;
    G8_STAGE_A(G8_SA(0, 0), cA); G8_STAGE_A(G8_SA(0, 1), cA + hstep);
    G8_LOADB(RA, cB); G8_LOADB(RB, cB + hstepB);
    G8_CVTW(RA, G8_SB(0, 0), 4); G8_LOADB(RA, cB + kstepB);
    G8_CVTW(RB, G8_SB(0, 1), 4); G8_LOADB(RB, cB + kstepB + hstepB);
    G8_CVTW(RA, G8_SB(1, 0), 4); G8_LOADB(RA, cB + 2 * kstepB);
    G8_STAGE_A(G8_SA(1, 0), cA + kstep);
    G8_CVTW(RB, G8_SB(1, 1), 6); G8_LOADB(RB, cB + 2 * kstepB + hstepB);
    G8_WAIT_L(0);
    if (wr == 1) G8_BAR;
    G8_BAR;
    const char* aq = cA + kstep; const char* bq = cB + 3 * kstepB;
    for (;;) {
        const bool has_next = S.next(ui + 1, nxt);
        const char* nA = has_next ? nxt.a : cA; const char* nB = has_next ? nxt.b : cB;
        for (int t = 0; t < nt; t += 2) {
            G8_LDB(B0l, B0h, 0, 0); G8_SCHED; G8_LDA(At, 0, 0); G8_STAGE_A(G8_SA(1, 1), aq + hstep); aq = (t == nt - 2) ? nA : aq + kstep;
            G8_WAIT_L(8); G8_BAR; G8_WAIT_L(0); G8_MMA(0, 0, At, B0l, B0h); G8_BAR; G8_SCHED;
            G8_LDB(B1l, B1h, 0, 1); G8_CVTW(RA, G8_SB(0, 0), 8); G8_LOADB(RA, bq);
            G8_BAR; G8_WAIT_L(0); G8_MMA(0, 1, At, B1l, B1h); G8_BAR; G8_SCHED;
            G8_LDA(At, 0, 1); G8_STAGE_A(G8_SA(0, 0), aq);
            G8_BAR; G8_WAIT_L(0); G8_MMA(1, 0, At, B0l, B0h); G8_BAR; G8_SCHED;
            G8_CVTW(RB, G8_SB(0, 1), 6); G8_LOADB(RB, bq + hstepB); bq = (t == nt - 4) ? nB : bq + kstepB;
            G8_BAR; G8_WAIT_L(0); G8_MMA(1, 1, At, B1l, B1h); G8_BAR; G8_SCHED;
            G8_LDB(B0l, B0h, 1, 0); G8_SCHED; G8_LDA(At, 1, 0); G8_STAGE_A(G8_SA(0, 1), aq + hstep); aq += kstep;
            G8_WAIT_L(8); G8_BAR; G8_WAIT_L(0); G8_MMA(0, 0, At, B0l, B0h); G8_BAR; G8_SCHED;
            G8_LDB(B1l, B1h, 1, 1); G8_CVTW(RA, G8_SB(1, 0), 8); G8_LOADB(RA, bq);
            G8_BAR; G8_WAIT_L(0); G8_MMA(0, 1, At, B1l, B1h); G8_BAR; G8_SCHED;
            G8_LDA(At, 1, 1); G8_STAGE_A(G8_SA(1, 0), aq);
            G8_BAR; G8_WAIT_L(0); G8_MMA(1, 0, At, B0l, B0h); G8_BAR; G8_SCHED;
            G8_CVTW(RB, G8_SB(1, 1), 6); G8_LOADB(RB, bq + hstepB); bq += kstepB;
            G8_BAR; G8_WAIT_L(0); G8_MMA(1, 1, At, B1l, B1h); G8_BAR; G8_SCHED;
        }
        asm volatile("s_waitcnt vmcnt(0)" : "+v"(RA0), "+v"(RA1), "+v"(RA2), "+v"(RA3), "+v"(RB0), "+v"(RB1), "+v"(RB2), "+v"(RB3) :: "memory"); __builtin_amdgcn_sched_barrier(0);
        { const int le = lane_now(); E(acc, cur, wr, wc, le & 15, le >> 4); }
        if (!has_next) break;
#pragma unroll
        for (int a = 0; a < 2; ++a)
#pragma unroll
            for (int b = 0; b < 2; ++b)
#pragma unroll
                for (int m = 0; m < 4; ++m)
#pragma unroll
                    for (int n = 0; n < 2; ++n) acc[a][b][m][n] = (f32x4){0.f, 0.f, 0.f, 0.f};
        cur = nxt; cA = nA; cB = nB; ++ui;
    }
    G8_WAIT_V(0);
    asm volatile("" :: "v"(RA0), "v"(RA1), "v"(RA2), "v"(RA3), "v"(RB0), "v"(RB1), "v"(RB2), "v"(RB3));
    if (wr == 0) G8_BAR;
    G8_BAR;
#undef G8_SA
#undef G8_SB
#undef G8_STAGE_A
#undef G8_LOADB
#undef G8_CVTW
#undef G8_CVT2
#undef G8_LO2
#undef G8_LDA
#undef G8_TR
#undef G8_LDB
#undef G8_BF
#undef G8_MMA
#undef G8_WAIT_V
#undef G8_WAIT_L
#undef G8_BAR
#undef G8_SCHED
}
}

struct Frame {
    LAS unsigned char* lds;
    unsigned* ctl; unsigned char* ws;
    int wave, vcu, G, gw, NGW;
    __device__ __forceinline__ int lane_() const { return lane_now(); }
    __device__ __forceinline__ int tid_() const { return wave * 64 + lane_now(); }
};
struct Args { const float* in[21]; float* out; unsigned char* ws; int ph_lo, ph_hi; };
template <int OFF> __device__ __forceinline__ unsigned long long karg_u64() { const auto kp = __builtin_amdgcn_kernarg_segment_ptr(); unsigned long long v;
    asm volatile("s_load_dwordx2 %0, %1, %2\n\ts_waitcnt lgkmcnt(0)" : "=s"(v) : "s"(kp), "i"(OFF)); return v; }
template <int I> __device__ __forceinline__ const float* karg_in() { return (const float*)karg_u64<8 * I>(); }
__device__ __forceinline__ float* karg_out() { return (float*)karg_u64<8 * 21>(); }


constexpr long CV_IN = (long)KDIM * IN_COLS / 512, CV_OUT = (long)KDIM * D_MODEL / 512, CV_GU = (long)N_EXP * KDIM * 4096 / 512, CV_DN = (long)N_EXP * KDIM * D_MODEL / 512;
__device__ __forceinline__ void conv_chunks(const float* __restrict__ src, bf16_t* __restrict__ dst, long c0, long c1, int gw, int NGW, int lane) {
    long c = c0 + gw;
    for (; c + 7L * NGW < c1; c += 8L * NGW) {
        f32x4 a[8], b[8];
#pragma unroll
        for (int i = 0; i < 8; ++i) { const f32x4* p = (const f32x4*)(src + (c + (long)i * NGW) * 512 + lane * 8); a[i] = __builtin_nontemporal_load(p); b[i] = __builtin_nontemporal_load(p + 1); }
#pragma unroll
        for (int i = 0; i < 8; ++i) { u32x4 w; w.x = pk2(a[i][0], a[i][1]); w.y = pk2(a[i][2], a[i][3]); w.z = pk2(b[i][0], b[i][1]); w.w = pk2(b[i][2], b[i][3]);
            __builtin_nontemporal_store(w, (u32x4*)(dst + (c + (long)i * NGW) * 512 + lane * 8)); }
    }
    for (; c < c1; c += NGW) { const f32x4* p = (const f32x4*)(src + c * 512 + lane * 8); const f32x4 a = __builtin_nontemporal_load(p), b = __builtin_nontemporal_load(p + 1);
        u32x4 w; w.x = pk2(a[0], a[1]); w.y = pk2(a[2], a[3]); w.z = pk2(b[0], b[1]); w.w = pk2(b[2], b[3]); __builtin_nontemporal_store(w, (u32x4*)(dst + c * 512 + lane * 8)); }
}
__device__ __forceinline__ void rms_row_bf16(const float* xrow, const float* g, bf16_t* orow, int lane) {
    const f32x4* xr = (const f32x4*)xrow + lane; const f32x4* gr = (const f32x4*)g + lane;
    f32x4 v[8]; float s = 0.f;
#pragma unroll
    for (int j = 0; j < 8; ++j) { v[j] = xr[64 * j]; s += (v[j][0] * v[j][0] + v[j][1] * v[j][1]) + (v[j][2] * v[j][2] + v[j][3] * v[j][3]); }
    const float rs = rsqrtf(wave_sum(s) * (1.0f / 2048.0f) + EPS);
    u32x2* o = (u32x2*)orow + lane;
#pragma unroll
    for (int j = 0; j < 8; ++j) { const f32x4 gg = gr[64 * j]; u32x2 w; w.x = pk2(v[j][0] * rs * gg[0], v[j][1] * rs * gg[1]); w.y = pk2(v[j][2] * rs * gg[2], v[j][3] * rs * gg[3]); o[64 * j] = w; }
}
__device__ __forceinline__ void p0_prologue(const Frame& F, const Args& a) {
    const int LANE = lane_now(), TID = F.wave * 64 + LANE; (void)TID;
    bf16_t* HN = (bf16_t*)(F.ws + WS_HN);
    for (int m = F.gw; m < NTOK; m += F.NGW) rms_row_bf16(karg_in<0>() + (size_t)m * D_MODEL, karg_in<1>(), HN + (size_t)m * D_MODEL, LANE);
}

__device__ __forceinline__ float gelu_tanh(float x) { return 0.5f * x * (1.0f + tanhf(0.7978845608028654f * (x + 0.044715f * x * x * x))); }
__device__ __forceinline__ float sigmoidf_(float x) { return 1.0f / (1.0f + __expf(-x)); }
__device__ __forceinline__ void lru_unit(const Frame& F, const Args& a, int unit) {
    const int lane = lane_now();
    const int b = unit >> 9, k = (unit >> 4) & 31, blk = unit & 15;
    const bf16_t* proj = (const bf16_t*)(F.ws + WS_PROJ);
    LAS float* xs = (LAS float*)(F.lds + F.wave * 16384);
    const int ch = blk * 64 + lane;
    const float cw0 = karg_in<3>()[0 * LRU_W + ch], cw1 = karg_in<3>()[1 * LRU_W + ch], cw2 = karg_in<3>()[2 * LRU_W + ch], cw3 = karg_in<3>()[3 * LRU_W + ch], cb = karg_in<4>()[ch];
    const int t0 = k * 64; const size_t row0 = (size_t)b * SEQ + t0;
    const bf16_t* xp = proj + row0 * IN_COLS + 3 * ATTN_W + ch;
    float xv[67];
#pragma unroll
    for (int i = 0; i < 67; ++i) xv[i] = (i >= 3 || t0 > 0) ? bf2f(xp[(i - 3) * IN_COLS]) : 0.f;
#pragma unroll
    for (int t = 0; t < 64; ++t) xs[t * 64 + lane] = cb + cw0 * xv[t] + cw1 * xv[t + 1] + cw2 * xv[t + 2] + cw3 * xv[t + 3];
    float wa[64], wx[64];
    const float* wap = karg_in<5>() + (size_t)blk * 4096 + lane; const float* wxp = karg_in<7>() + (size_t)blk * 4096 + lane;
#pragma unroll
    for (int c = 0; c < 64; ++c) { wa[c] = wap[c * 64]; wx[c] = wxp[c * 64]; }
    const float ba = karg_in<6>()[ch], bx = karg_in<8>()[ch];
    const float sp = log1pf(__expf(-karg_in<9>()[ch]));
    float* hl = (float*)(F.ws + WS_HL) + row0 * LRU_W + ch; float* pc = (float*)(F.ws + WS_PC) + row0 * LRU_W + ch;
    LDS_WAIT();
    float h = 0.f, P = 1.f;
    for (int t = 0; t < 64; ++t) {
        float r = ba, ii = bx;
        const LAS f32x4* xr = (const LAS f32x4*)(xs + t * 64);
#pragma unroll
        for (int c4 = 0; c4 < 16; ++c4) { const f32x4 xv = xr[c4];
            r = fmaf(xv[0], wa[4 * c4], r); r = fmaf(xv[1], wa[4 * c4 + 1], r); r = fmaf(xv[2], wa[4 * c4 + 2], r); r = fmaf(xv[3], wa[4 * c4 + 3], r);
            ii = fmaf(xv[0], wx[4 * c4], ii); ii = fmaf(xv[1], wx[4 * c4 + 1], ii); ii = fmaf(xv[2], wx[4 * c4 + 2], ii); ii = fmaf(xv[3], wx[4 * c4 + 3], ii); }
        r = sigmoidf_(r); ii = sigmoidf_(ii);
        const float log_a = -8.0f * r * sp;
        const float av = __expf(log_a);
        const float bv = sqrtf(-expm1f(2.0f * log_a)) * (ii * xs[t * 64 + lane]);
        h = av * h + bv; P *= av;
        hl[(size_t)t * LRU_W] = h; pc[(size_t)t * LRU_W] = P;
    }
    float* ae = (float*)(F.ws + WS_LRUE); float* he = ae + 4 * 32 * 1024;
    ae[(size_t)(b * 32 + k) * 1024 + ch] = P; he[(size_t)(b * 32 + k) * 1024 + ch] = h;
    LDS_WAIT();
}
constexpr int VP = 192;
__device__ __forceinline__ void attn_unit(const Frame& F, const Args& a, int u) {
    const int lane = lane_now();
    const int c = lane & 31, hh = lane >> 5, xaddr = (lane ^ 32) << 2;
    const int br = u >> 12, rem = u & 4095, bh = rem >> 6, qt = rem & 63;
    const int b = bh >> 4, h = bh & 15;
    const int dsh = br * 2, d = 1 << dsh;
    const int r = qt & (d - 1), ltile = qt >> dsh, l0 = ltile * 32;
    const bf16_t* proj = (const bf16_t*)(F.ws + WS_PROJ) + (size_t)b * SEQ * IN_COLS + h * 64;
    LAS unsigned char* vl = F.lds + F.wave * 16384;
    bf16x8 qf[4];
    { const bf16_t* qrow = proj + (size_t)((l0 + c) * d + r) * IN_COLS + 8 * hh;
#pragma unroll
      for (int s = 0; s < 4; ++s) qf[s] = *(const bf16x8*)(qrow + 16 * s); }
    constexpr float LOG2E = 1.4426950408889634f;
    const float slope2 = exp2f(-0.5f * (float)(h + 1)) * LOG2E * (float)d;
    const float sc2 = 0.125f * LOG2E;
    float m = -INFINITY, lsum = 0.f;
    f32x16 o0, o1;
#pragma unroll
    for (int i = 0; i < 16; ++i) { o0[i] = 0.f; o1[i] = 0.f; }
    const int jfirst = ltile >= 4 ? 0 : 4 - ltile;
    bf16x8 kf[3][4]; u32x4 vr[3][4];
    const int vrow = lane >> 3, vch = lane & 7;
    const unsigned rowb = (unsigned)d * (unsigned)(IN_COLS * 2);
    const unsigned kvo = (unsigned)c * rowb + (unsigned)((ATTN_W + 8 * hh) * 2);
    const unsigned vvo = (unsigned)vrow * rowb + (unsigned)((2 * ATTN_W + vch * 8) * 2);
#define ATT_LOAD(j) do { const char* tb = (const char*)proj + (size_t)((l0 - 128 + 32 * (j)) * d + r) * (size_t)(IN_COLS * 2);     \
        _Pragma("unroll") for (int s = 0; s < 4; ++s) kf[(j) % 3][s] = *(const bf16x8*)(tb + (kvo + 32u * s)); \
        _Pragma("unroll") for (int i = 0; i < 4; ++i) vr[(j) % 3][i] = *(const u32x4*)(tb + (size_t)(8 * i) * rowb + vvo); } while (0)
#pragma unroll
    for (int j = 0; j < 3; ++j) if (j >= jfirst) ATT_LOAD(j);
    const LAS unsigned char* vtr_base = vl + (4 * hh + ((lane & 15) >> 2)) * VP + (16 * ((lane >> 4) & 1) + 4 * (lane & 3)) * 2;
#pragma unroll
    for (int j = 0; j < 5; ++j) { if (j >= jfirst) {
#pragma unroll
        for (int i = 0; i < 4; ++i) *(LAS u32x4*)(vl + (vrow + 8 * i) * VP + vch * 16) = vr[j % 3][i];
        f32x16 sa;
#pragma unroll
        for (int i = 0; i < 16; ++i) sa[i] = 0.f;
#pragma unroll
        for (int s = 0; s < 4; ++s) sa = __builtin_amdgcn_mfma_f32_32x32x16_bf16(kf[j % 3][s], qf[s], sa, 0, 0, 0);
        const float relbase = (float)(c + 128 - 32 * j);
        float mx = -INFINITY;
#pragma unroll
        for (int i = 0; i < 16; ++i) { const int ki = (i & 3) + 8 * (i >> 2) + 4 * hh;
            float v = sa[i] * sc2 - slope2 * (relbase - (float)ki);
            const bool valid = (j == 0) ? (ki >= c) : ((j == 4) ? (ki <= c) : true);
            v = valid ? v : -INFINITY; sa[i] = v; mx = fmaxf(mx, v); }
        mx = fmaxf(mx, __builtin_bit_cast(float, __builtin_amdgcn_ds_bpermute(xaddr, __builtin_bit_cast(int, mx))));
        const float mnew = fmaxf(m, mx);
        const float alpha = __builtin_amdgcn_exp2f(m - mnew);
        float ps = 0.f;
#pragma unroll
        for (int i = 0; i < 16; ++i) { const float p = __builtin_amdgcn_exp2f(sa[i] - mnew); sa[i] = p; ps += p; }
        ps += __builtin_bit_cast(float, __builtin_amdgcn_ds_bpermute(xaddr, __builtin_bit_cast(int, ps)));
        lsum = lsum * alpha + ps; m = mnew;
#pragma unroll
        for (int i = 0; i < 16; ++i) { o0[i] *= alpha; o1[i] *= alpha; }
        bf16x8 pf[2];
#pragma unroll
        for (int s = 0; s < 2; ++s) { u32x4 w; w.x = g8::cvt_pk_bf16(sa[8 * s + 0], sa[8 * s + 1]); w.y = g8::cvt_pk_bf16(sa[8 * s + 2], sa[8 * s + 3]); w.z = g8::cvt_pk_bf16(sa[8 * s + 4], sa[8 * s + 5]); w.w = g8::cvt_pk_bf16(sa[8 * s + 6], sa[8 * s + 7]);
            pf[s] = __builtin_bit_cast(bf16x8, w); }
#pragma unroll
        for (int s = 0; s < 2; ++s) {
#pragma unroll
            for (int nt = 0; nt < 2; ++nt) {
                const s16x4 lo = vtr(vtr_base + (16 * s) * VP + nt * 64), hi = vtr(vtr_base + (16 * s + 8) * VP + nt * 64);
                const bf16x8 af = __builtin_shufflevector(lo, hi, 0, 1, 2, 3, 4, 5, 6, 7);
                if (nt == 0) o0 = __builtin_amdgcn_mfma_f32_32x32x16_bf16(af, pf[s], o0, 0, 0, 0); else o1 = __builtin_amdgcn_mfma_f32_32x32x16_bf16(af, pf[s], o1, 0, 0, 0);
            }
        }
        }
        if (j + 3 <= 4 && j + 3 >= jfirst) ATT_LOAD(j + 3);
    }
#undef ATT_LOAD
    const float inv = 1.0f / lsum;
    const size_t tok = (size_t)b * SEQ + (size_t)((l0 + c) * d + r);
    bf16_t* orow = (bf16_t*)(F.ws + WS_ATT) + ((size_t)br * NTOK + tok) * ATTN_W + h * 64 + 4 * hh;
#pragma unroll
    for (int g = 0; g < 4; ++g) {
        u32x2 w0, w1;
        w0.x = g8::cvt_pk_bf16(o0[4 * g] * inv, o0[4 * g + 1] * inv); w0.y = g8::cvt_pk_bf16(o0[4 * g + 2] * inv, o0[4 * g + 3] * inv);
        w1.x = g8::cvt_pk_bf16(o1[4 * g] * inv, o1[4 * g + 1] * inv); w1.y = g8::cvt_pk_bf16(o1[4 * g + 2] * inv, o1[4 * g + 3] * inv);
        *(u32x2*)(orow + 8 * g) = w0; *(u32x2*)(orow + 32 + 8 * g) = w1;
    }
    if (hh == 0) ((float*)(F.ws + WS_LSE))[((size_t)br * NTOK + tok) * 16 + h] = 0.6931471805599453f * (m + __builtin_amdgcn_logf(lsum));
}
#ifndef PROBE_P2
#define PROBE_P2 0
#endif
__device__ __forceinline__ void p2_mixers(const Frame& F, const Args& a) {
    for (int rep = 0; rep < (PROBE_P2 == 1 ? 2 : 1); ++rep)
    for (int u = F.gw; u < 2048; u += F.NGW) lru_unit(F, a, u);
    for (int rep = 0; rep < (PROBE_P2 == 2 ? 2 : 1); ++rep)
#pragma nounroll
    for (int u = F.gw; u < 3 * 4096; u += F.NGW) { asm volatile("" ::: "memory"); const int uu = __builtin_amdgcn_readfirstlane(u); attn_unit(F, a, uu); }
}

__device__ __forceinline__ void p3_mix(const Frame& F, const Args& a) {
    const int LANE = lane_now(), TID = F.wave * 64 + LANE; (void)TID;
    LAS float* Hin = (LAS float*)F.lds;
    const float* ae = (const float*)(F.ws + WS_LRUE); const float* he = ae + 4 * 32 * 1024;
    const bf16_t* proj = (const bf16_t*)(F.ws + WS_PROJ);
    bf16_t* mixed = (bf16_t*)(F.ws + WS_MIXED);
    for (int grp = F.vcu; grp < NTOK / 32; grp += F.G) {
        const int tok0 = grp * 32, b = tok0 / SEQ, k = (tok0 % SEQ) / 64;
        __syncthreads();
        for (int d = TID; d < LRU_W; d += NTHR) { float H = 0.f;
            for (int j0 = 0; j0 < k; j0 += 8) { float av[8], hv[8];
#pragma unroll
                for (int jj = 0; jj < 8; ++jj) { const bool ok = (j0 + jj) < k; const size_t o = (size_t)(b * 32 + (ok ? j0 + jj : 0)) * 1024 + d; const float a1 = ae[o], h1 = he[o]; av[jj] = ok ? a1 : 1.0f; hv[jj] = ok ? h1 : 0.0f; }
#pragma unroll
                for (int jj = 0; jj < 8; ++jj) H = av[jj] * H + hv[jj]; }
            Hin[d] = H; }
        __syncthreads();
        for (int tt = F.wave; tt < 32; tt += NWAVES) {
            const size_t tok = (size_t)tok0 + tt;
            { const bf16_t* ao = (const bf16_t*)(F.ws + WS_ATT); const float* lse = (const float*)(F.ws + WS_LSE); const f32x4* gr = (const f32x4*)karg_in<10>() + LANE;
              f32x4 v[4]; float s = 0.f;
#pragma unroll
              for (int j = 0; j < 4; ++j) { const int hd = (LANE >> 4) + 4 * j;
                  const float l0 = lse[(0 * (size_t)NTOK + tok) * 16 + hd], l1 = lse[(1 * (size_t)NTOK + tok) * 16 + hd], l2 = lse[(2 * (size_t)NTOK + tok) * 16 + hd];
                  const float M = fmaxf(l0, fmaxf(l1, l2)); float w0 = __expf(l0 - M), w1 = __expf(l1 - M), w2 = __expf(l2 - M); const float iw = 1.0f / (w0 + w1 + w2); w0 *= iw; w1 *= iw; w2 *= iw;
                  const u32x2 a0 = *((const u32x2*)(ao + (0 * (size_t)NTOK + tok) * ATTN_W) + LANE + 64 * j), a1 = *((const u32x2*)(ao + (1 * (size_t)NTOK + tok) * ATTN_W) + LANE + 64 * j), a2 = *((const u32x2*)(ao + (2 * (size_t)NTOK + tok) * ATTN_W) + LANE + 64 * j);
                  v[j][0] = w0 * bflo(a0.x) + w1 * bflo(a1.x) + w2 * bflo(a2.x); v[j][1] = w0 * bfhi(a0.x) + w1 * bfhi(a1.x) + w2 * bfhi(a2.x);
                  v[j][2] = w0 * bflo(a0.y) + w1 * bflo(a1.y) + w2 * bflo(a2.y); v[j][3] = w0 * bfhi(a0.y) + w1 * bfhi(a1.y) + w2 * bfhi(a2.y);
                  s += (v[j][0] * v[j][0] + v[j][1] * v[j][1]) + (v[j][2] * v[j][2] + v[j][3] * v[j][3]); }
              const float rs = rsqrtf(wave_sum(s) * (1.0f / 1024.0f) + EPS);
              u32x2* o = (u32x2*)(mixed + tok * D_MODEL) + LANE;
#pragma unroll
              for (int j = 0; j < 4; ++j) { const f32x4 g = gr[64 * j]; u32x2 w; w.x = pk2(v[j][0] * rs * g[0], v[j][1] * rs * g[1]); w.y = pk2(v[j][2] * rs * g[2], v[j][3] * rs * g[3]); o[64 * j] = w; } }
            { const f32x4* hr = (const f32x4*)((const float*)(F.ws + WS_HL) + tok * LRU_W) + LANE; const f32x4* pr = (const f32x4*)((const float*)(F.ws + WS_PC) + tok * LRU_W) + LANE;
              const u32x2* gp = (const u32x2*)(proj + tok * IN_COLS + 3 * ATTN_W + LRU_W) + LANE; const f32x4* gr = (const f32x4*)karg_in<11>() + LANE;
              f32x4 v[4]; float s = 0.f;
#pragma unroll
              for (int j = 0; j < 4; ++j) { const f32x4 hv = hr[64 * j], pv = pr[64 * j]; const u32x2 gw = gp[64 * j]; const f32x4 hi = *(const LAS f32x4*)(Hin + (LANE + 64 * j) * 4);
                  v[j][0] = (hv[0] + pv[0] * hi[0]) * gelu_tanh(bflo(gw.x)); v[j][1] = (hv[1] + pv[1] * hi[1]) * gelu_tanh(bfhi(gw.x));
                  v[j][2] = (hv[2] + pv[2] * hi[2]) * gelu_tanh(bflo(gw.y)); v[j][3] = (hv[3] + pv[3] * hi[3]) * gelu_tanh(bfhi(gw.y));
                  s += (v[j][0] * v[j][0] + v[j][1] * v[j][1]) + (v[j][2] * v[j][2] + v[j][3] * v[j][3]); }
              const float rs = rsqrtf(wave_sum(s) * (1.0f / 1024.0f) + EPS);
              u32x2* o = (u32x2*)(mixed + tok * D_MODEL + ATTN_W) + LANE;
#pragma unroll
              for (int j = 0; j < 4; ++j) { const f32x4 g = gr[64 * j]; u32x2 w; w.x = pk2(v[j][0] * rs * g[0], v[j][1] * rs * g[1]); w.y = pk2(v[j][2] * rs * g[2], v[j][3] * rs * g[3]); o[64 * j] = w; } }
        }
    }
    __syncthreads();
}

__device__ __forceinline__ void p5_router(const Frame& F, const Args& a) {
    const int LANE = lane_now(), TID = F.wave * 64 + LANE; (void)TID;
    const float* x1 = (const float*)(F.ws + WS_X1); bf16_t* hn2s = (bf16_t*)(F.ws + WS_HN2S);
    const float* g = karg_in<13>(); const float* wr = karg_in<14>(); const float* br = karg_in<15>();
    int* cnt = (int*)(F.ctl + CW_CNT);
    int* sel_e = (int*)(F.ws + WS_SEL); int* sel_pos = sel_e + NSLOT; float* sel_g = (float*)(sel_pos + NSLOT);
    LAS float* PART = (LAS float*)F.lds;
    LAS float* SSQ = PART + 8 * 1024;
    LAS float* RS = SSQ + 256;
    LAS float* LG = RS + 32;
    LAS int* lcnt = (LAS int*)(LG + 1024);
    LAS int* gbase = lcnt + 32;
    LAS int* ent_e = gbase + 32;
    LAS int* ent_r = ent_e + 128;
    LAS float* ent_g = (LAS float*)(ent_r + 128);
    const int lane = LANE, r16 = lane & 15, kq = lane >> 4;
    for (int grp = F.vcu; grp < NTOK / 32; grp += F.G) {
        const int tok0 = grp * 32;
        __syncthreads();
        if (TID < 32) lcnt[TID] = 0;
        f32x4 acc00 = {0.f, 0.f, 0.f, 0.f}, acc01 = acc00, acc10 = acc00, acc11 = acc00; float ss0 = 0.f, ss1 = 0.f;
        const float* xa = x1 + (size_t)(tok0 + r16) * D_MODEL + F.wave * 256 + 4 * kq;
        const float* gp = g + F.wave * 256 + 4 * kq;
        const float* wp = wr + (size_t)(F.wave * 256 + 4 * kq) * N_EXP + r16;
#pragma unroll 4
        for (int S = 0; S < 16; ++S) {
            const f32x4 xv0 = *(const f32x4*)(xa + 16 * S), xv1 = *(const f32x4*)(xa + 16 * S + (size_t)16 * D_MODEL), gv = *(const f32x4*)(gp + 16 * S);
            float b0[4], b1[4];
#pragma unroll
            for (int q = 0; q < 4; ++q) { b0[q] = wp[(size_t)(16 * S + q) * N_EXP]; b1[q] = wp[(size_t)(16 * S + q) * N_EXP + 16]; }
            ss0 += (xv0[0] * xv0[0] + xv0[1] * xv0[1]) + (xv0[2] * xv0[2] + xv0[3] * xv0[3]);
            ss1 += (xv1[0] * xv1[0] + xv1[1] * xv1[1]) + (xv1[2] * xv1[2] + xv1[3] * xv1[3]);
#pragma unroll
            for (int q = 0; q < 4; ++q) { const float a0 = xv0[q] * gv[q], a1 = xv1[q] * gv[q];
                acc00 = __builtin_amdgcn_mfma_f32_16x16x4f32(a0, b0[q], acc00, 0, 0, 0); acc01 = __builtin_amdgcn_mfma_f32_16x16x4f32(a0, b1[q], acc01, 0, 0, 0);
                acc10 = __builtin_amdgcn_mfma_f32_16x16x4f32(a1, b0[q], acc10, 0, 0, 0); acc11 = __builtin_amdgcn_mfma_f32_16x16x4f32(a1, b1[q], acc11, 0, 0, 0); }
        }
        { LAS float* pw = PART + F.wave * 1024;
#pragma unroll
          for (int q = 0; q < 4; ++q) { const int tr = 4 * kq + q;
              pw[tr * 32 + r16] = acc00[q]; pw[tr * 32 + 16 + r16] = acc01[q]; pw[(16 + tr) * 32 + r16] = acc10[q]; pw[(16 + tr) * 32 + 16 + r16] = acc11[q]; }
          ss0 += __shfl_xor(ss0, 16); ss0 += __shfl_xor(ss0, 32); ss1 += __shfl_xor(ss1, 16); ss1 += __shfl_xor(ss1, 32);
          if (kq == 0) { SSQ[F.wave * 32 + r16] = ss0; SSQ[F.wave * 32 + 16 + r16] = ss1; } }
        __syncthreads();
        if (TID < 32) { float t = 0.f;
#pragma unroll
            for (int w = 0; w < 8; ++w) t += SSQ[w * 32 + TID];
            RS[TID] = rsqrtf(t * (1.0f / 2048.0f) + EPS); }
        __syncthreads();
        { const int tt = TID >> 4, eg = TID & 15; float s0 = 0.f, s1 = 0.f;
#pragma unroll
          for (int w = 0; w < 8; ++w) { const f32x2 v = *(const LAS f32x2*)(PART + w * 1024 + tt * 32 + 2 * eg); s0 += v[0]; s1 += v[1]; }
          const float rs = RS[tt];
          LG[tt * 32 + 2 * eg] = s0 * rs + br[2 * eg]; LG[tt * 32 + 2 * eg + 1] = s1 * rs + br[2 * eg + 1]; }
        __syncthreads();
        for (int t4 = 0; t4 < 4; ++t4) {
            const int tk = F.wave * 4 + t4;
            float cur = (lane < 32) ? LG[tk * 32 + lane] : -INFINITY;
            int i0 = 0, i1 = 0, i2 = 0, i3 = 0; float v0 = 0.f, v1 = 0.f, v2 = 0.f, v3 = 0.f;
#pragma unroll
            for (int k = 0; k < 4; ++k) {
                const float mx = wave_max(cur);
                const unsigned long long bal = __ballot(cur == mx);
                const int bi = __ffsll((long long)bal) - 1;
                if (k == 0) { i0 = bi; v0 = mx; } else if (k == 1) { i1 = bi; v1 = mx; } else if (k == 2) { i2 = bi; v2 = mx; } else { i3 = bi; v3 = mx; }
                if (lane == bi) cur = -INFINITY;
            }
            if (lane == 0) {
                const float e1 = __expf(v1 - v0), e2 = __expf(v2 - v0), e3 = __expf(v3 - v0); const float inv = 1.0f / (1.0f + e1 + e2 + e3);
                const int base = tk * 4;
                ent_e[base + 0] = i0; ent_r[base + 0] = __hip_atomic_fetch_add(&lcnt[i0], 1, __ATOMIC_RELAXED, __HIP_MEMORY_SCOPE_WORKGROUP); ent_g[base + 0] = inv;
                ent_e[base + 1] = i1; ent_r[base + 1] = __hip_atomic_fetch_add(&lcnt[i1], 1, __ATOMIC_RELAXED, __HIP_MEMORY_SCOPE_WORKGROUP); ent_g[base + 1] = e1 * inv;
                ent_e[base + 2] = i2; ent_r[base + 2] = __hip_atomic_fetch_add(&lcnt[i2], 1, __ATOMIC_RELAXED, __HIP_MEMORY_SCOPE_WORKGROUP); ent_g[base + 2] = e2 * inv;
                ent_e[base + 3] = i3; ent_r[base + 3] = __hip_atomic_fetch_add(&lcnt[i3], 1, __ATOMIC_RELAXED, __HIP_MEMORY_SCOPE_WORKGROUP); ent_g[base + 3] = e3 * inv;
            }
        }
        __syncthreads();
        if (TID < 32) { const int n = lcnt[TID]; gbase[TID] = n > 0 ? atomicAdd(&cnt[TID], n) : 0; }
        __syncthreads();
        if (TID < 128) { const int e = ent_e[TID], pos = gbase[e] + ent_r[TID], tok = tok0 + (TID >> 2);
            sel_e[tok * 4 + (TID & 3)] = e; sel_pos[tok * 4 + (TID & 3)] = pos; sel_g[tok * 4 + (TID & 3)] = ent_g[TID]; }
        for (int t4 = 0; t4 < 4; ++t4) { const int tk = F.wave * 4 + t4; const float rs = RS[tk];
            const f32x4* xr = (const f32x4*)(x1 + (size_t)(tok0 + tk) * D_MODEL) + lane; const f32x4* gr = (const f32x4*)g + lane; u32x2 w[8];
#pragma unroll
            for (int j = 0; j < 8; ++j) { const f32x4 v = xr[64 * j], gg = gr[64 * j]; w[j].x = pk2(v[0] * rs * gg[0], v[1] * rs * gg[1]); w[j].y = pk2(v[2] * rs * gg[2], v[3] * rs * gg[3]); }
#pragma unroll
            for (int k = 0; k < 4; ++k) { const int e = ent_e[tk * 4 + k], pos = gbase[e] + ent_r[tk * 4 + k]; u32x2* o = (u32x2*)(hn2s + ((size_t)e * NTOK + pos) * D_MODEL) + lane;
#pragma unroll
                for (int j = 0; j < 8; ++j) o[64 * j] = w[j]; } }
    }
    __syncthreads();
}

__device__ __forceinline__ void build_tpre(const Frame& F, int nhb) {
    const int TID = F.tid_();
    LAS int* tpre = (LAS int*)(F.lds + L_TPRE); LAS int* bid = (LAS int*)(F.lds + L_BLKID); LAS int* bpre = (LAS int*)(F.lds + L_BLKPRE); LAS int* bsz = (LAS int*)(F.lds + L_BLKPRE + 512);
    __syncthreads();
    if (TID == 0) { const int* cnt = (const int*)(F.ctl + CW_CNT); int acc = 0; for (int e = 0; e < N_EXP; ++e) { tpre[e] = acc; acc += (cnt[e] + 255) >> 8; } tpre[N_EXP] = acc; }
    __syncthreads();
    if (nhb) {
        const int nb = N_EXP * nhb;
        if (TID < nb) {
            const int e = TID / nhb, nm = tpre[e + 1] - tpre[e]; int r = 0;
            for (int b = 0; b < nb; ++b) { const int eb = b / nhb, nmb = tpre[eb + 1] - tpre[eb]; r += (nmb > nm || (nmb == nm && b < TID)) ? 1 : 0; }
            bid[(r & 7) * 8 + (r >> 3)] = TID; bsz[(r & 7) * 8 + (r >> 3)] = nm * 8;
        }
        __syncthreads();
        if (TID < 8) { int acc = 0; bpre[TID * 9] = 0; for (int k = 0; k < 4 * nhb; ++k) { acc += bsz[TID * 8 + k]; bpre[TID * 9 + k + 1] = acc; } }
        __syncthreads();
    }
}

__device__ __forceinline__ void p8_final(const Frame& F, const Args& a) {
    const int LANE = lane_now(), TID = F.wave * 64 + LANE; (void)TID;
    const LAS int* tpre = (const LAS int*)(F.lds + L_TPRE);
    const float* x1 = (const float*)(F.ws + WS_X1); const bf16_t* Y = (const bf16_t*)(F.ws + WS_Y);
    const int* sel_e = (const int*)(F.ws + WS_SEL); const int* sel_pos = sel_e + NSLOT; const float* sel_g = (const float*)(sel_pos + NSLOT);
    const f32x4* gr = (const f32x4*)karg_in<20>() + LANE;
    for (int tok = F.gw; tok < NTOK; tok += F.NGW) {
        const f32x4* xr = (const f32x4*)(x1 + (size_t)tok * D_MODEL) + LANE;
        f32x4 v[8];
#pragma unroll
        for (int j = 0; j < 8; ++j) v[j] = xr[64 * j];
#pragma unroll
        for (int k = 0; k < 4; ++k) {
            const int e = sel_e[tok * 4 + k]; const size_t row = (size_t)tpre[e] * 256 + sel_pos[tok * 4 + k]; const float gk = sel_g[tok * 4 + k];
            const u32x2* yp = (const u32x2*)(Y + row * D_MODEL) + LANE;
#pragma unroll
            for (int j = 0; j < 8; ++j) { const u32x2 w = yp[64 * j]; v[j][0] += gk * bflo(w.x); v[j][1] += gk * bfhi(w.x); v[j][2] += gk * bflo(w.y); v[j][3] += gk * bfhi(w.y); }
        }
        float s = 0.f;
#pragma unroll
        for (int j = 0; j < 8; ++j) s += (v[j][0] * v[j][0] + v[j][1] * v[j][1]) + (v[j][2] * v[j][2] + v[j][3] * v[j][3]);
        const float rs = rsqrtf(wave_sum(s) * (1.0f / 2048.0f) + EPS);
        f32x4* o = (f32x4*)(karg_out() + (size_t)tok * D_MODEL) + LANE;
#pragma unroll
        for (int j = 0; j < 8; ++j) { const f32x4 g = gr[64 * j]; o[64 * j] = (f32x4){v[j][0] * rs * g[0], v[j][1] * rs * g[1], v[j][2] * rs * g[2], v[j][3] * rs * g[3]}; }
    }
}

__device__ __forceinline__ void ph1_inproj(const Frame& F, const Args& args) {
    unsigned char* ws = F.ws;
    g8::DenseOrder S{(const char*)(ws + WS_HN), (const char*)karg_in<2>(), NTOK / 256, IN_COLS / 256, (NTOK / 256) * (IN_COLS / 256), F.G, (int)blockIdx.x, IN_COLS};
    g8::EpiBf16 E{(bf16_t*)(ws + WS_PROJ), IN_COLS, nullptr, 0};
    g8::gemm_phase<g8::EpiBf16, g8::DenseOrder>(F.lds, S, E, F.wave);
}
__device__ __forceinline__ void ph4_outproj(const Frame& F, const Args& args) {
    unsigned char* ws = F.ws;
    g8::DenseOrder S{(const char*)(ws + WS_MIXED), (const char*)karg_in<12>(), NTOK / 256, D_MODEL / 256, (NTOK / 256) * (D_MODEL / 256), F.G, (int)blockIdx.x, D_MODEL};
    g8::EpiResF32 E{(float*)(ws + WS_X1), karg_in<0>(), D_MODEL};
    g8::gemm_phase<g8::EpiResF32, g8::DenseOrder>(F.lds, S, E, F.wave);
}
__device__ __forceinline__ void ph6_gateup(const Frame& F, const Args& args) {
    unsigned char* ws = F.ws;
    build_tpre(F, 2);
    g8::GroupedOrder S{(const char*)(ws + WS_HN2S), (const char*)karg_in<16>(), (const LAS int*)(F.lds + L_TPRE), (const LAS int*)(F.lds + L_BLKID), (const LAS int*)(F.lds + L_BLKPRE), 2, F.G, (int)blockIdx.x, (size_t)4096 * KDIM * 4, true, 4096};
    g8::EpiSwiglu E{(bf16_t*)(ws + WS_ACT), karg_in<17>()};
    g8::gemm_phase<g8::EpiSwiglu, g8::GroupedOrder>(F.lds, S, E, F.wave);
}
__device__ __forceinline__ void ph7_down(const Frame& F, const Args& args) {
    unsigned char* ws = F.ws;
    build_tpre(F, 1);
    g8::GroupedOrder S{(const char*)(ws + WS_ACT), (const char*)karg_in<18>(), (const LAS int*)(F.lds + L_TPRE), (const LAS int*)(F.lds + L_BLKID), (const LAS int*)(F.lds + L_BLKPRE), 1, F.G, (int)blockIdx.x, (size_t)D_MODEL * KDIM * 4, false, D_MODEL};
    g8::EpiBf16 E{(bf16_t*)(ws + WS_Y), D_MODEL, karg_in<19>(), D_MODEL};
    g8::gemm_phase<g8::EpiBf16, g8::GroupedOrder>(F.lds, S, E, F.wave);
}

constexpr int N_PHASES = 9;
__global__ void __launch_bounds__(NTHR, 2) mk_fwd(Args args) {
    extern __shared__ __attribute__((aligned(16))) unsigned char lds_raw[];
    Frame F;
    F.lds = (LAS unsigned char*)lds_raw;
    F.wave = __builtin_amdgcn_readfirstlane((int)threadIdx.x >> 6);
    F.G = gridDim.x; { const int bx = blockIdx.x; F.vcu = (F.G % 8 == 0) ? (bx % 8) * (F.G / 8) + bx / 8 : bx; }
    F.gw = F.vcu * NWAVES + F.wave; F.NGW = F.G * NWAVES;
    F.ws = args.ws; F.ctl = (unsigned*)(args.ws + WS_CTL);
    for (int u = F.tid_(); u < (LDS_BYTES - LDSCTL_OFF) / 4; u += NTHR) ((LAS unsigned*)(F.lds + LDSCTL_OFF))[u] = 0u;
    __syncthreads();
    const int lo = args.ph_lo, hi = args.ph_hi;
    unsigned bar_x = 0;
    if (hi - lo > 1) bar_x = __builtin_amdgcn_readfirstlane(xcd_barrier_post(F.ctl + CW_BAR, (volatile LAS unsigned*)(F.lds + L_MISC) + 8, F.tid_()).x);
#define IN(k) (lo <= (k) && (k) < hi)
#define XBAR() do { unsigned* _bp = F.ctl + CW_BAR; asm volatile("" : "+s"(_bp)); XcdBarrier _b; _b.bar = _bp; _b.x = bar_x; _b.st = (volatile LAS unsigned*)(F.lds + L_MISC) + 8; xcd_barrier(_b, F.tid_()); } while (0)
#define SEAM(k) do { if (IN(k) && IN((k) + 1)) XBAR(); } while (0)

#define PHASE(k, call) do { if (IN(k)) { call; } if ((PROBE_MASK >> (k)) & 1) { XBAR(); if (IN(k)) { call; } } } while (0)
    PHASE(0, p0_prologue(F, args)); SEAM(0);
    PHASE(1, ph1_inproj(F, args)); SEAM(1);
    PHASE(2, p2_mixers(F, args)); SEAM(2);
    PHASE(3, p3_mix(F, args)); SEAM(3);
    PHASE(4, ph4_outproj(F, args)); SEAM(4);
    if (IN(5)) { p5_router(F, args); } SEAM(5);
    PHASE(6, ph6_gateup(F, args)); SEAM(6);
    PHASE(7, ph7_down(F, args)); SEAM(7);
    if (IN(8)) { build_tpre(F, 0); p8_final(F, args); }
#undef IN
#undef SEAM
}

extern "C" void kernel_launch(void* const* d_in, const int* in_sizes, int n_in, void* d_out, int out_size, void* d_ws, size_t ws_size, hipStream_t stream) {
    static int grid = 0;
    if (grid == 0) {
        if (n_in != 21 || out_size != NTOK * D_MODEL || ws_size < WS_END) { fprintf(stderr, "kernel_launch: unexpected problem (n_in %d out %d ws %zu)\n", n_in, out_size, ws_size); grid = -1; return; }
        int dev = 0, cus = 0, per_cu = 0;
        if (hipGetDevice(&dev) != hipSuccess || hipDeviceGetAttribute(&cus, hipDeviceAttributeMultiprocessorCount, dev) != hipSuccess) { grid = -1; return; }
        if (hipFuncSetAttribute((const void*)mk_fwd, hipFuncAttributeMaxDynamicSharedMemorySize, LDS_BYTES) != hipSuccess) { fprintf(stderr, "kernel_launch: hipFuncSetAttribute failed\n"); grid = -1; return; }
        if (hipOccupancyMaxActiveBlocksPerMultiprocessor(&per_cu, (const void*)mk_fwd, NTHR, LDS_BYTES) != hipSuccess || per_cu < 1) { fprintf(stderr, "kernel_launch: occupancy query says %d\n", per_cu); }
        (void)hipGetLastError();
        grid = cus;
    }
    if (grid < 0) return;
    if (hipMemsetAsync((char*)d_ws + WS_CTL, 0, CTL_ZERO_BYTES, stream) != hipSuccess) return;
    Args a{};
    for (int i = 0; i < 21; ++i) a.in[i] = (const float*)d_in[i];
    a.out = (float*)d_out; a.ws = (unsigned char*)d_ws;
#if MK_N_LAUNCHES == 1
    a.ph_lo = 0; a.ph_hi = N_PHASES;
    hipLaunchKernelGGL(mk_fwd, dim3(grid), dim3(NTHR), LDS_BYTES, stream, a);
#else
    for (int p = 0; p < N_PHASES; ++p) { a.ph_lo = p; a.ph_hi = p + 1; hipLaunchKernelGGL(mk_fwd, dim3(grid), dim3(NTHR), LDS_BYTES, stream, a); }
#endif
}
```

```cpp
#include <hip/hip_runtime.h>
#include <stdint.h>
#include <stdio.h>

#ifndef MK_N_LAUNCHES
#define MK_N_LAUNCHES 1
#endif

#ifndef PROBE_MASK
#define PROBE_MASK 0
#endif
#define LAS __attribute__((address_space(3)))
#define GAS __attribute__((address_space(1)))
typedef unsigned short bf16_t;
typedef short bf16x8 __attribute__((ext_vector_type(8)));
typedef float f32x4 __attribute__((ext_vector_type(4)));
typedef float f32x2 __attribute__((ext_vector_type(2)));
typedef unsigned u32x4 __attribute__((ext_vector_type(4)));
typedef unsigned u32x2 __attribute__((ext_vector_type(2)));

constexpr int D_MODEL = 2048, BATCH = 4, SEQ = 2048, NTOK = BATCH * SEQ;
constexpr int N_HEADS = 16, ATTN_W = 1024, LRU_W = 1024;
constexpr int IN_COLS = 5120;
constexpr int N_EXP = 32, D_FF = 2048, NSLOT = NTOK * 4;
constexpr int KDIM = 2048;
constexpr float EPS = 1e-6f;
constexpr int NWAVES = 8, NTHR = 512;
constexpr int PADROWS = NSLOT + N_EXP * 256;

constexpr size_t MiB = 1u << 20;
constexpr size_t WS_CTL = 0, WS_LISTS = 1 * MiB, CTL_ZERO_BYTES = 2 * MiB;
constexpr size_t WS_SEL = 2 * MiB;
constexpr size_t WS_LRUE = 3 * MiB;
constexpr size_t WS_WIN = 4 * MiB, WS_WOUT = 24 * MiB, WS_HN = 32 * MiB, WS_PROJ = 64 * MiB, WS_ATT = 144 * MiB  , WS_HL = 192 * MiB, WS_PC = 224 * MiB;
constexpr size_t WS_MIXED = 256 * MiB, WS_X1 = 288 * MiB, WS_ACT = 352 * MiB, WS_Y = 512 * MiB, WS_WGU = 672 * MiB, WS_WDN = 1184 * MiB, WS_LSE = 1440 * MiB  , WS_HN2S = 1442 * MiB  , WS_END = 2466 * MiB;
static_assert((size_t)PADROWS * 2048 * 2 <= 160 * MiB, "ACT/Y size");
constexpr int CW_BAR = 4096, CW_CNT = 8192;

constexpr int RING_BYTES = 131072;
constexpr int LDSCTL_OFF = 139264;
constexpr int LDS_BYTES = 147456;
constexpr int L_MISC = LDSCTL_OFF;
constexpr int L_TPRE = LDSCTL_OFF + 256;
constexpr int L_CNT = LDSCTL_OFF + 512;
constexpr int L_BLKID = LDSCTL_OFF + 1024;
constexpr int L_BLKPRE = LDSCTL_OFF + 1280;

__device__ __forceinline__ unsigned f2bf(float f) { unsigned u = __builtin_bit_cast(unsigned, f); return (u + 0x7fffu + ((u >> 16) & 1u)) >> 16; }
__device__ __forceinline__ unsigned pk2(float lo, float hi) { return f2bf(lo) | (f2bf(hi) << 16); }
__device__ __forceinline__ float bf2f(unsigned short b) { return __builtin_bit_cast(float, (unsigned)b << 16); }
__device__ __forceinline__ float bflo(unsigned w) { return __builtin_bit_cast(float, w << 16); }
__device__ __forceinline__ float bfhi(unsigned w) { return __builtin_bit_cast(float, w & 0xffff0000u); }
__device__ __forceinline__ float wave_sum(float v) {
#pragma unroll
    for (int o = 1; o < 64; o <<= 1) v += __shfl_xor(v, o);
    return v;
}
__device__ __forceinline__ float wave_max(float v) {
#pragma unroll
    for (int o = 1; o < 64; o <<= 1) v = fmaxf(v, __shfl_xor(v, o));
    return v;
}
#define LDS_WAIT() asm volatile("s_waitcnt lgkmcnt(0)" ::: "memory")
#define VM_WAIT() asm volatile("s_waitcnt vmcnt(0)" ::: "memory")

__device__ __forceinline__ int lane_now() { int l; asm volatile("v_mbcnt_lo_u32_b32 %0, -1, 0\n\tv_mbcnt_hi_u32_b32 %0, -1, %0" : "=v"(l)); return l; }

#define XB_TMO      128
#define XB_XCNT(j)  (256  + 64 * (j))
#define XB_XSUB(j)  (1280 + 64 * (j))
#define XB_XGEN(j)  (2304 + 64 * (j))
#define XB_TOP      3328
#define XB_TOPGEN   3392
#define XCD_BAR_WORDS 3456
#define XB_SPIN_CAP (1u << 20)
__device__ __forceinline__ unsigned xb_ld(unsigned* p)              { return __hip_atomic_load(p, __ATOMIC_RELAXED, __HIP_MEMORY_SCOPE_AGENT); }
__device__ __forceinline__ unsigned xb_add(unsigned* p, unsigned v) { return __hip_atomic_fetch_add(p, v, __ATOMIC_RELAXED, __HIP_MEMORY_SCOPE_AGENT); }
__device__ __forceinline__ unsigned xb_xcc_id() { return (unsigned)__builtin_amdgcn_s_getreg((3 << 11) | 20) & 0xFu; }
#define XB_SPIN(cond, bar) do { unsigned _sp = 0; while (cond) { __builtin_amdgcn_s_sleep(1); \
    if ((++_sp & 255u) == 0u) { if (xb_ld(&(bar)[XB_TMO])) break; if (_sp > XB_SPIN_CAP) { atomicAdd(&(bar)[XB_TMO], 1u); break; } } } } while (0)
struct XcdBarrier { unsigned* bar; unsigned x; volatile LAS unsigned* st; };
__device__ __forceinline__ XcdBarrier xcd_barrier_post(unsigned* bar, volatile LAS unsigned* st, int tid) {
    XcdBarrier b; b.bar = bar; b.x = xb_xcc_id(); b.st = st;
    if (tid == 0) (void)xb_add(&bar[XB_XCNT(b.x)], 1u);
    return b;
}
__device__ __forceinline__ void xcd_barrier_complete(unsigned* bar, unsigned x, unsigned& nloc, unsigned& nx) {
    const unsigned G = gridDim.x * gridDim.y * gridDim.z;
    unsigned sum, cnt, mine, sp = 0u;
    for (;;) {
        sum = 0u; cnt = 0u; mine = 0u;
#pragma unroll
        for (unsigned j = 0; j < 16; ++j) { const unsigned c = xb_ld(&bar[XB_XCNT(j)]); sum += c; cnt += (c > 0u) ? 1u : 0u; mine = (j == x) ? c : mine; }
        if (sum == G) break;
        __builtin_amdgcn_s_sleep(1);
        if ((++sp & 255u) == 0u) { if (xb_ld(&bar[XB_TMO])) break; if (sp > XB_SPIN_CAP) { atomicAdd(&bar[XB_TMO], 1u); break; } }
    }
    nloc = mine > 0u ? mine : 1u; nx = cnt > 0u ? cnt : 1u;
}
__device__ __forceinline__ void xcd_barrier(const XcdBarrier& b, int tid) {
    asm volatile("s_waitcnt vmcnt(0)" ::: "memory");
    __syncthreads();
    if (tid == 0) {
        unsigned* bar = b.bar;
        __builtin_amdgcn_s_waitcnt(0);
        unsigned nloc = b.st[0], nx = b.st[1];
        if (nloc == 0u) { xcd_barrier_complete(bar, b.x, nloc, nx); b.st[0] = nloc; b.st[1] = nx; }
        const unsigned old = xb_add(&bar[XB_XSUB(b.x)], 1u);
        const unsigned gen = old / nloc;
        if (old + 1u == (gen + 1u) * nloc) {
            __builtin_amdgcn_fence(__ATOMIC_RELEASE, "agent");
            asm volatile("s_waitcnt vmcnt(0)" ::: "memory");
            const unsigned og = xb_add(&bar[XB_TOP], 1u);
            const unsigned tg = og / nx;
            if (og + 1u == (tg + 1u) * nx) xb_add(&bar[XB_TOPGEN], 1u);
            else XB_SPIN(xb_ld(&bar[XB_TOPGEN]) == tg, bar);
            __builtin_amdgcn_fence(__ATOMIC_ACQUIRE, "agent");
            xb_add(&bar[XB_XGEN(b.x)], 1u);
            asm volatile("s_waitcnt vmcnt(0)" ::: "memory");
        } else {
            XB_SPIN(xb_ld(&bar[XB_XGEN(b.x)]) == gen, bar);
            __builtin_amdgcn_fence(__ATOMIC_ACQUIRE, "agent");
            asm volatile("s_waitcnt vmcnt(0)" ::: "memory");
        }
    }
    __syncthreads();
}

typedef float f32x16 __attribute__((ext_vector_type(16)));
typedef short s16x4 __attribute__((ext_vector_type(4)));
typedef short v4i16_t __attribute__((ext_vector_type(4)));
__device__ __forceinline__ s16x4 vtr(const LAS unsigned char* p) { return __builtin_bit_cast(s16x4, __builtin_amdgcn_ds_read_tr16_b64_v4i16((LAS v4i16_t*)p)); }

namespace g8 {
constexpr int BM = 256, BK = 64, HALF = 128, HTB = HALF * BK * 2, STAGE_BYTES = 8 * HTB, NXCD = 8, WGM = 8;
__host__ __device__ __forceinline__ int lds_byte(int r, int c) { const int st = (r >> 4) * 2 + (c >> 5), rr = r & 15, cc = c & 31, ob = rr * 64 + cc * 2; return st * 1024 + (ob ^ (((ob >> 9) & 1) << 5)); }
__host__ __device__ __forceinline__ void stage_rc(int b, int& R, int& C) { const int st = b / 1024, sb = b % 1024, swz = sb ^ (((sb >> 9) & 1) << 5); R = (st >> 1) * 16 + swz / 64; C = (st & 1) * 32 + (swz % 64) / 2; }
__host__ __device__ __forceinline__ int perm32(int rho) { const int n = rho >> 4, i = rho & 15; return 8 * (i >> 2) + 4 * n + (i & 3); }

struct Unit { const char* a; const char* b; int crow, ccol, e, gi; };

struct DenseOrder {
    const char* A; const char* Bt; int nM, nN, nwg, G, c; int ldb;
    __device__ __forceinline__ bool next(int i, Unit& u) const {
        const long L = (long)i * G + c; if (L >= nwg) return false;
        int wgid = (int)L; { const int q = nwg / NXCD, r = nwg % NXCD, xcd = wgid % NXCD, off = wgid / NXCD; wgid = (xcd < r ? xcd * (q + 1) : r * (q + 1) + (xcd - r) * q) + off; }
        const int nig = WGM * nN, gid = wgid / nig, fm = gid * WGM, gsz = (nM - fm) < WGM ? (nM - fm) : WGM;
        const int pm = fm + ((wgid % nig) % gsz), pn = (wgid % nig) / gsz;
        u.a = A + (size_t)pm * BM * KDIM * 2; u.b = Bt + (size_t)pn * BM * 4; u.crow = pm * BM; u.ccol = pn * BM; u.e = 0; u.gi = 0; return true;
    }
};
struct GroupedOrder {
    const char* A; const char* Bt; const LAS int* tpre; const LAS int* bid; const LAS int* bpre; int nhb, G, c; size_t bstride;
    bool capA; int ldb;
    __device__ __forceinline__ bool next(int i, Unit& u) const {
        const int per = G >> 3, x = c & 7, j = c >> 3, Lx = i * per + j, nslots = 4 * nhb;
        const LAS int* bp = bpre + x * 9;
        if (Lx >= __builtin_amdgcn_readfirstlane(bp[nslots])) return false;
        int k = 0; while (Lx >= __builtin_amdgcn_readfirstlane(bp[k + 1])) ++k;
        const int b = __builtin_amdgcn_readfirstlane(bid[x * 8 + k]), within = Lx - __builtin_amdgcn_readfirstlane(bp[k]);
        const int e = b / nhb, hb = b - e * nhb, mt = within >> 3, nt = hb * 8 + (within & 7);
        const int mtile = __builtin_amdgcn_readfirstlane(tpre[e]) + mt;
        u.a = A + (capA ? ((size_t)e * NTOK + (size_t)mt * BM) : (size_t)mtile * BM) * KDIM * 2;
        u.b = Bt + (size_t)e * bstride + (size_t)nt * BM * 4; u.crow = mtile * BM; u.ccol = nt * BM; u.e = e; u.gi = 0; return true;
    }
};

__device__ __forceinline__ unsigned cvt_pk_bf16(float lo, float hi) { unsigned r; asm volatile("v_cvt_pk_bf16_f32 %0, %1, %2" : "=v"(r) : "v"(lo), "v"(hi)); return r; }

struct EpiBf16 {
    bf16_t* O; int ldc; const float* bias; int bias_stride;
    __device__ __forceinline__ void operator()(const f32x4 (&acc)[2][2][4][2], const Unit& u, int wr, int wc, int fr, int fq) const {
        const int row0 = u.crow + wr * 64 + fr, col0 = u.ccol + wc * 32 + 8 * fq;
#pragma unroll
        for (int bj = 0; bj < 2; ++bj) {
            const f32x4 b0 = bias ? *(const f32x4*)(bias + (size_t)u.e * bias_stride + col0 + bj * HALF) : (f32x4){0.f, 0.f, 0.f, 0.f};
            const f32x4 b1 = bias ? *(const f32x4*)(bias + (size_t)u.e * bias_stride + col0 + bj * HALF + 4) : (f32x4){0.f, 0.f, 0.f, 0.f};
#pragma unroll
            for (int ai = 0; ai < 2; ++ai)
#pragma unroll
                for (int m = 0; m < 4; ++m) { const f32x4 v0 = acc[ai][bj][m][0] + b0, v1 = acc[ai][bj][m][1] + b1;
                    u32x4 w; w.x = cvt_pk_bf16(v0[0], v0[1]); w.y = cvt_pk_bf16(v0[2], v0[3]); w.z = cvt_pk_bf16(v1[0], v1[1]); w.w = cvt_pk_bf16(v1[2], v1[3]);
                    *(u32x4*)(O + (size_t)(row0 + ai * HALF + m * 16) * ldc + col0 + bj * HALF) = w; } }
    }
};
struct EpiResF32 {
    float* C; const float* res; int ldc;
    __device__ __forceinline__ void operator()(const f32x4 (&acc)[2][2][4][2], const Unit& u, int wr, int wc, int fr, int fq) const {
        const int row0 = u.crow + wr * 64 + fr, col0 = u.ccol + wc * 32 + 8 * fq;
#pragma unroll
        for (int ai = 0; ai < 2; ++ai)
#pragma unroll
            for (int m = 0; m < 4; ++m) { const size_t off = (size_t)(row0 + ai * HALF + m * 16) * ldc + col0;
#pragma unroll
                for (int bj = 0; bj < 2; ++bj)
#pragma unroll
                    for (int n = 0; n < 2; ++n) { const f32x4 r = *(const f32x4*)(res + off + bj * HALF + n * 4); *(f32x4*)(C + off + bj * HALF + n * 4) = acc[ai][bj][m][n] + r; } }
    }
};
struct EpiSwiglu {
    bf16_t* O; const float* bias;
    __device__ __forceinline__ float act(float g, float up) const {
        g = fminf(g, 7.0f); up = fminf(fmaxf(up, -7.0f), 7.0f);
        const float sg = 1.0f / (1.0f + __expf(-1.702f * g));
        return g * sg * (up + 1.0f);
    }
    __device__ __forceinline__ void operator()(const f32x4 (&acc)[2][2][4][2], const Unit& u, int wr, int wc, int fr, int fq) const {
        const int row0 = u.crow + wr * 64 + fr, col0 = u.ccol + wc * 32 + 8 * fq;
#pragma unroll
        for (int bj = 0; bj < 2; ++bj) {
            const f32x4 b0 = *(const f32x4*)(bias + (size_t)u.e * (2 * D_FF) + col0 + bj * HALF), b1 = *(const f32x4*)(bias + (size_t)u.e * (2 * D_FF) + col0 + bj * HALF + 4);
#pragma unroll
            for (int ai = 0; ai < 2; ++ai)
#pragma unroll
                for (int m = 0; m < 4; ++m) { const f32x4 v0 = acc[ai][bj][m][0] + b0, v1 = acc[ai][bj][m][1] + b1;
                    u32x2 w; w.x = cvt_pk_bf16(act(v0[0], v0[1]), act(v0[2], v0[3])); w.y = cvt_pk_bf16(act(v1[0], v1[1]), act(v1[2], v1[3]));
                    *(u32x2*)(O + (size_t)(row0 + ai * HALF + m * 16) * D_FF + ((col0 + bj * HALF) >> 1)) = w; } }
    }
};


template <class Epi, class Sched>
__device__ __forceinline__ void gemm_phase(LAS unsigned char* lds, const Sched& S, const Epi& E, int wave) {
    const int wid = wave, lane = lane_now(), tid = wid * 64 + lane, wr = wid >> 2, wc = wid & 3;
    constexpr int K = KDIM, nt = K / BK;
    unsigned voffA[2];
#pragma unroll
    for (int i = 0; i < 2; ++i) { int R, C; stage_rc(tid * 16 + i * 8192, R, C); voffA[i] = (unsigned)(R * K + C) * 2u; }
    const int ldb = S.ldb;
    constexpr size_t kstep = (size_t)(BK * 2);
    constexpr size_t hstep = (size_t)HALF * K * 2;
    const size_t kstepB = (size_t)BK * ldb * 4;
    constexpr size_t hstepB = 512;
    const size_t jstepB = (size_t)16 * ldb * 4;
    const unsigned bvoff = (unsigned)((tid >> 5) * ldb * 4 + (tid & 31) * 16);
    const unsigned ldsbase = (unsigned)(size_t)lds;
    unsigned wbase;
    { const int k0 = tid >> 5, q = tid & 31, f = 2 * ((k0 & 3) + 4 * ((k0 >> 3) & 1)); wbase = ldsbase + (unsigned)(k0 * 256 + (((q >> 1) ^ f) * 16) + (q & 1) * 8); }
    const unsigned ldsw = (unsigned)wid * 1024u;
    const int fr = lane & 15, fq = lane >> 4;
    const int aoff = lds_byte(wr * 64 + fr, fq * 8);
    int bb[2];
    { const int q = (lane & 15) >> 2, p = lane & 3, f = 2 * (q + 4 * (fq & 1));
#pragma unroll
      for (int nf = 0; nf < 2; ++nf) { const int ch = 4 * wc + p; bb[nf] = (8 * fq + q) * 256 + ((ch ^ f) * 16) + nf * 8; } }
#define G8_SA(b, h) (((b) * 2 + (h)) * HTB)
#define G8_SB(b, h) ((4 + (b) * 2 + (h)) * HTB)
#define G8_STAGE_A(bufoff, gbase) do { \
        __builtin_amdgcn_global_load_lds((const unsigned*)((const char*)(gbase) + voffA[0]), (LAS unsigned*)(lds + (bufoff) + ldsw), 16, 0, 0); \
        __builtin_amdgcn_global_load_lds((const unsigned*)((const char*)(gbase) + voffA[1]), (LAS unsigned*)(lds + (bufoff) + ldsw + 8192), 16, 0, 0); } while (0)
#define G8_LOADB(R, ptr) do { const char* _p = (const char*)(ptr); \
        asm volatile("s_nop 4\n\tglobal_load_dwordx4 %0, %1, %2" : "=&v"(R##0) : "v"(bvoff), "s"(_p) : "memory"); _p += jstepB; \
        asm volatile("global_load_dwordx4 %0, %1, %2" : "=&v"(R##1) : "v"(bvoff), "s"(_p) : "memory"); _p += jstepB; \
        asm volatile("global_load_dwordx4 %0, %1, %2" : "=&v"(R##2) : "v"(bvoff), "s"(_p) : "memory"); _p += jstepB; \
        asm volatile("global_load_dwordx4 %0, %1, %2" : "=&v"(R##3) : "v"(bvoff), "s"(_p) : "memory"); } while (0)
#define G8_CVT2(R) do { R[0] = __builtin_bit_cast(float, cvt_pk_bf16(R[0], R[1])); R[1] = __builtin_bit_cast(float, cvt_pk_bf16(R[2], R[3])); } while (0)
#define G8_LO2(R) __builtin_shufflevector(R, R, 0, 1)
#define G8_CVTW(R, bufoff, N) do { asm volatile("s_waitcnt vmcnt(" #N ")" : "+v"(R##0), "+v"(R##1), "+v"(R##2), "+v"(R##3) :: "memory"); __builtin_amdgcn_sched_barrier(0); \
        const unsigned _wa = wbase + (unsigned)(bufoff); G8_CVT2(R##0); G8_CVT2(R##1); G8_CVT2(R##2); G8_CVT2(R##3); \
        asm volatile("ds_write_b64 %0, %1\n\tds_write_b64 %0, %2 offset:4096\n\tds_write_b64 %0, %3 offset:8192\n\tds_write_b64 %0, %4 offset:12288" :: "v"(_wa), "v"(G8_LO2(R##0)), "v"(G8_LO2(R##1)), "v"(G8_LO2(R##2)), "v"(G8_LO2(R##3)) : "memory"); } while (0)
#define G8_LDA(dst, b, h) do { _Pragma("unroll") for (int m = 0; m < 4; ++m) _Pragma("unroll") for (int k = 0; k < 2; ++k) dst[m][k] = *(const LAS bf16x8*)(lds + G8_SA(b, h) + aoff + m * 2048 + k * 1024); } while (0)
#define G8_TR(dst, addr, off) asm volatile("ds_read_b64_tr_b16 %0, %1 offset:%2" : "=v"(dst) : "v"(addr), "i"(off) : "memory")
#define G8_LDB(lo, hi, b, h) do { _Pragma("unroll") for (int n = 0; n < 2; ++n) { const unsigned _ad = ldsbase + (unsigned)(G8_SB(b, h)) + (unsigned)bb[n]; \
        G8_TR(lo[n][0], _ad, 0); G8_TR(hi[n][0], _ad, 1024); G8_TR(lo[n][1], _ad, 8192); G8_TR(hi[n][1], _ad, 9216); } } while (0)
#define G8_BF(lo, hi, n, k) __builtin_shufflevector(lo[n][k], hi[n][k], 0, 1, 2, 3, 4, 5, 6, 7)
#define G8_MMA(ai, bj, At, Bl, Bh) do { __builtin_amdgcn_s_setprio(1); _Pragma("unroll") for (int m = 0; m < 4; ++m) _Pragma("unroll") for (int n = 0; n < 2; ++n) _Pragma("unroll") for (int k = 0; k < 2; ++k) \
        acc[ai][bj][m][n] = __builtin_amdgcn_mfma_f32_16x16x32_bf16(G8_BF(Bl, Bh, n, k), At[m][k], acc[ai][bj][m][n], 0, 0, 0); __builtin_amdgcn_s_setprio(0); } while (0)
#define G8_WAIT_V(n) asm volatile("s_waitcnt vmcnt(" #n ")" ::: "memory")
#define G8_WAIT_L(n) do { asm volatile("s_waitcnt lgkmcnt(" #n ")" ::: "memory"); __builtin_amdgcn_sched_barrier(0); } while (0)
#define G8_BAR __builtin_amdgcn_s_barrier()
#define G8_SCHED __builtin_amdgcn_sched_barrier(0)
    Unit cur, nxt; int ui = 0;
    if (!S.next(0, cur)) return;
    f32x4 acc[2][2][4][2];
#pragma unroll
    for (int a = 0; a < 2; ++a)
#pragma unroll
        for (int b = 0; b < 2; ++b)
#pragma unroll
            for (int m = 0; m < 4; ++m)
#pragma unroll
                for (int n = 0; n < 2; ++n) acc[a][b][m][n] = (f32x4){0.f, 0.f, 0.f, 0.f};
    bf16x8 At[4][2]; s16x4 B0l[2][2], B0h[2][2], B1l[2][2], B1h[2][2];
    f32x4 RA0, RA1, RA2, RA3, RB0, RB1, RB2, RB3;
    const char* cA = cur.a; const char* cB = cur.b;
    G8_STAGE_A(G8_SA(0, 0), cA); G8_STAGE_A(G8_SA(0, 1), cA + hstep);
    G8_LOADB(RA, cB); G8_LOADB(RB, cB + hstepB);
    G8_CVTW(RA, G8_SB(0, 0), 4); G8_LOADB(RA, cB + kstepB);
    G8_CVTW(RB, G8_SB(0, 1), 4); G8_LOADB(RB, cB + kstepB + hstepB);
    G8_CVTW(RA, G8_SB(1, 0), 4); G8_LOADB(RA, cB + 2 * kstepB);
    G8_STAGE_A(G8_SA(1, 0), cA + kstep);
    G8_CVTW(RB, G8_SB(1, 1), 6); G8_LOADB(RB, cB + 2 * kstepB + hstepB);
    G8_WAIT_L(0);
    if (wr == 1) G8_BAR;
    G8_BAR;
    const char* aq = cA + kstep; const char* bq = cB + 3 * kstepB;
    for (;;) {
        const bool has_next = S.next(ui + 1, nxt);
        const char* nA = has_next ? nxt.a : cA; const char* nB = has_next ? nxt.b : cB;
        for (int t = 0; t < nt; t += 2) {
            G8_LDB(B0l, B0h, 0, 0); G8_SCHED; G8_LDA(At, 0, 0); G8_STAGE_A(G8_SA(1, 1), aq + hstep); aq = (t == nt - 2) ? nA : aq + kstep;
            G8_WAIT_L(8); G8_BAR; G8_WAIT_L(0); G8_MMA(0, 0, At, B0l, B0h); G8_BAR; G8_SCHED;
            G8_LDB(B1l, B1h, 0, 1); G8_CVTW(RA, G8_SB(0, 0), 8); G8_LOADB(RA, bq);
            G8_BAR; G8_WAIT_L(0); G8_MMA(0, 1, At, B1l, B1h); G8_BAR; G8_SCHED;
            G8_LDA(At, 0, 1); G8_STAGE_A(G8_SA(0, 0), aq);
            G8_BAR; G8_WAIT_L(0); G8_MMA(1, 0, At, B0l, B0h); G8_BAR; G8_SCHED;
            G8_CVTW(RB, G8_SB(0, 1), 6); G8_LOADB(RB, bq + hstepB); bq = (t == nt - 4) ? nB : bq + kstepB;
            G8_BAR; G8_WAIT_L(0); G8_MMA(1, 1, At, B1l, B1h); G8_BAR; G8_SCHED;
            G8_LDB(B0l, B0h, 1, 0); G8_SCHED; G8_LDA(At, 1, 0); G8_STAGE_A(G8_SA(0, 1), aq + hstep); aq += kstep;
            G8_WAIT_L(8); G8_BAR; G8_WAIT_L(0); G8_MMA(0, 0, At, B0l, B0h); G8_BAR; G8_SCHED;
            G8_LDB(B1l, B1h, 1, 1); G8_CVTW(RA, G8_SB(1, 0), 8); G8_LOADB(RA, bq);
            G8_BAR; G8_WAIT_L(0); G8_MMA(0, 1, At, B1l, B1h); G8_BAR; G8_SCHED;
            G8_LDA(At, 1, 1); G8_STAGE_A(G8_SA(1, 0), aq);
            G8_BAR; G8_WAIT_L(0); G8_MMA(1, 0, At, B0l, B0h); G8_BAR; G8_SCHED;
            G8_CVTW(RB, G8_SB(1, 1), 6); G8_LOADB(RB, bq + hstepB); bq += kstepB;
            G8_BAR; G8_WAIT_L(0); G8_MMA(1, 1, At, B1l, B1h); G8_BAR; G8_SCHED;
        }
        asm volatile("s_waitcnt vmcnt(0)" : "+v"(RA0), "+v"(RA1), "+v"(RA2), "+v"(RA3), "+v"(RB0), "+v"(RB1), "+v"(RB2), "+v"(RB3) :: "memory"); __builtin_amdgcn_sched_barrier(0);
        { const int le = lane_now(); E(acc, cur, wr, wc, le & 15, le >> 4); }
        if (!has_next) break;
#pragma unroll
        for (int a = 0; a < 2; ++a)
#pragma unroll
            for (int b = 0; b < 2; ++b)
#pragma unroll
                for (int m = 0; m < 4; ++m)
#pragma unroll
                    for (int n = 0; n < 2; ++n) acc[a][b][m][n] = (f32x4){0.f, 0.f, 0.f, 0.f};
        cur = nxt; cA = nA; cB = nB; ++ui;
    }
    G8_WAIT_V(0);
    asm volatile("" :: "v"(RA0), "v"(RA1), "v"(RA2), "v"(RA3), "v"(RB0), "v"(RB1), "v"(RB2), "v"(RB3));
    if (wr == 0) G8_BAR;
    G8_BAR;
#undef G8_SA
#undef G8_SB
#undef G8_STAGE_A
#undef G8_LOADB
#undef G8_CVTW
#undef G8_CVT2
#undef G8_LO2
#undef G8_LDA
#undef G8_TR
#undef G8_LDB
#undef G8_BF
#undef G8_MMA
#undef G8_WAIT_V
#undef G8_WAIT_L
#undef G8_BAR
#undef G8_SCHED
}
}

struct Frame {
    LAS unsigned char* lds;
    unsigned* ctl; unsigned char* ws;
    int wave, vcu, G, gw, NGW;
    __device__ __forceinline__ int lane_() const { return lane_now(); }
    __device__ __forceinline__ int tid_() const { return wave * 64 + lane_now(); }
};
struct Args { const float* in[21]; float* out; unsigned char* ws; int ph_lo, ph_hi; };
template <int OFF> __device__ __forceinline__ unsigned long long karg_u64() { const auto kp = __builtin_amdgcn_kernarg_segment_ptr(); unsigned long long v;
    asm volatile("s_load_dwordx2 %0, %1, %2\n\ts_waitcnt lgkmcnt(0)" : "=s"(v) : "s"(kp), "i"(OFF)); return v; }
template <int I> __device__ __forceinline__ const float* karg_in() { return (const float*)karg_u64<8 * I>(); }
__device__ __forceinline__ float* karg_out() { return (float*)karg_u64<8 * 21>(); }


constexpr long CV_IN = (long)KDIM * IN_COLS / 512, CV_OUT = (long)KDIM * D_MODEL / 512, CV_GU = (long)N_EXP * KDIM * 4096 / 512, CV_DN = (long)N_EXP * KDIM * D_MODEL / 512;
__device__ __forceinline__ void conv_chunks(const float* __restrict__ src, bf16_t* __restrict__ dst, long c0, long c1, int gw, int NGW, int lane) {
    long c = c0 + gw;
    for (; c + 7L * NGW < c1; c += 8L * NGW) {
        f32x4 a[8], b[8];
#pragma unroll
        for (int i = 0; i < 8; ++i) { const f32x4* p = (const f32x4*)(src + (c + (long)i * NGW) * 512 + lane * 8); a[i] = __builtin_nontemporal_load(p); b[i] = __builtin_nontemporal_load(p + 1); }
#pragma unroll
        for (int i = 0; i < 8; ++i) { u32x4 w; w.x = pk2(a[i][0], a[i][1]); w.y = pk2(a[i][2], a[i][3]); w.z = pk2(b[i][0], b[i][1]); w.w = pk2(b[i][2], b[i][3]);
            __builtin_nontemporal_store(w, (u32x4*)(dst + (c + (long)i * NGW) * 512 + lane * 8)); }
    }
    for (; c < c1; c += NGW) { const f32x4* p = (const f32x4*)(src + c * 512 + lane * 8); const f32x4 a = __builtin_nontemporal_load(p), b = __builtin_nontemporal_load(p + 1);
        u32x4 w; w.x = pk2(a[0], a[1]); w.y = pk2(a[2], a[3]); w.z = pk2(b[0], b[1]); w.w = pk2(b[2], b[3]); __builtin_nontemporal_store(w, (u32x4*)(dst + c * 512 + lane * 8)); }
}
__device__ __forceinline__ void rms_row_bf16(const float* xrow, const float* g, bf16_t* orow, int lane) {
    const f32x4* xr = (const f32x4*)xrow + lane; const f32x4* gr = (const f32x4*)g + lane;
    f32x4 v[8]; float s = 0.f;
#pragma unroll
    for (int j = 0; j < 8; ++j) { v[j] = xr[64 * j]; s += (v[j][0] * v[j][0] + v[j][1] * v[j][1]) + (v[j][2] * v[j][2] + v[j][3] * v[j][3]); }
    const float rs = rsqrtf(wave_sum(s) * (1.0f / 2048.0f) + EPS);
    u32x2* o = (u32x2*)orow + lane;
#pragma unroll
    for (int j = 0; j < 8; ++j) { const f32x4 gg = gr[64 * j]; u32x2 w; w.x = pk2(v[j][0] * rs * gg[0], v[j][1] * rs * gg[1]); w.y = pk2(v[j][2] * rs * gg[2], v[j][3] * rs * gg[3]); o[64 * j] = w; }
}
__device__ __forceinline__ void p0_prologue(const Frame& F, const Args& a) {
    const int LANE = lane_now(), TID = F.wave * 64 + LANE; (void)TID;
    bf16_t* HN = (bf16_t*)(F.ws + WS_HN);
    for (int m = F.gw; m < NTOK; m += F.NGW) rms_row_bf16(karg_in<0>() + (size_t)m * D_MODEL, karg_in<1>(), HN + (size_t)m * D_MODEL, LANE);
}

__device__ __forceinline__ float gelu_tanh(float x) { return 0.5f * x * (1.0f + tanhf(0.7978845608028654f * (x + 0.044715f * x * x * x))); }
__device__ __forceinline__ float sigmoidf_(float x) { return 1.0f / (1.0f + __expf(-x)); }
__device__ __forceinline__ void lru_unit(const Frame& F, const Args& a, int unit) {
    const int lane = lane_now();
    const int b = unit >> 9, k = (unit >> 4) & 31, blk = unit & 15;
    const bf16_t* proj = (const bf16_t*)(F.ws + WS_PROJ);
    LAS float* xs = (LAS float*)(F.lds + F.wave * 16384);
    const int ch = blk * 64 + lane;
    const float cw0 = karg_in<3>()[0 * LRU_W + ch], cw1 = karg_in<3>()[1 * LRU_W + ch], cw2 = karg_in<3>()[2 * LRU_W + ch], cw3 = karg_in<3>()[3 * LRU_W + ch], cb = karg_in<4>()[ch];
    const int t0 = k * 64; const size_t row0 = (size_t)b * SEQ + t0;
    const bf16_t* xp = proj + row0 * IN_COLS + 3 * ATTN_W + ch;
    float xv[67];
#pragma unroll
    for (int i = 0; i < 67; ++i) xv[i] = (i >= 3 || t0 > 0) ? bf2f(xp[(i - 3) * IN_COLS]) : 0.f;
#pragma unroll
    for (int t = 0; t < 64; ++t) xs[t * 64 + lane] = cb + cw0 * xv[t] + cw1 * xv[t + 1] + cw2 * xv[t + 2] + cw3 * xv[t + 3];
    float wa[64], wx[64];
    const float* wap = karg_in<5>() + (size_t)blk * 4096 + lane; const float* wxp = karg_in<7>() + (size_t)blk * 4096 + lane;
#pragma unroll
    for (int c = 0; c < 64; ++c) { wa[c] = wap[c * 64]; wx[c] = wxp[c * 64]; }
    const float ba = karg_in<6>()[ch], bx = karg_in<8>()[ch];
    const float sp = log1pf(__expf(-karg_in<9>()[ch]));
    float* hl = (float*)(F.ws + WS_HL) + row0 * LRU_W + ch; float* pc = (float*)(F.ws + WS_PC) + row0 * LRU_W + ch;
    LDS_WAIT();
    float h = 0.f, P = 1.f;
    for (int t = 0; t < 64; ++t) {
        float r = ba, ii = bx;
        const LAS f32x4* xr = (const LAS f32x4*)(xs + t * 64);
#pragma unroll
        for (int c4 = 0; c4 < 16; ++c4) { const f32x4 xv = xr[c4];
            r = fmaf(xv[0], wa[4 * c4], r); r = fmaf(xv[1], wa[4 * c4 + 1], r); r = fmaf(xv[2], wa[4 * c4 + 2], r); r = fmaf(xv[3], wa[4 * c4 + 3], r);
            ii = fmaf(xv[0], wx[4 * c4], ii); ii = fmaf(xv[1], wx[4 * c4 + 1], ii); ii = fmaf(xv[2], wx[4 * c4 + 2], ii); ii = fmaf(xv[3], wx[4 * c4 + 3], ii); }
        r = sigmoidf_(r); ii = sigmoidf_(ii);
        const float log_a = -8.0f * r * sp;
        const float av = __expf(log_a);
        const float bv = sqrtf(-expm1f(2.0f * log_a)) * (ii * xs[t * 64 + lane]);
        h = av * h + bv; P *= av;
        hl[(size_t)t * LRU_W] = h; pc[(size_t)t * LRU_W] = P;
    }
    float* ae = (float*)(F.ws + WS_LRUE); float* he = ae + 4 * 32 * 1024;
    ae[(size_t)(b * 32 + k) * 1024 + ch] = P; he[(size_t)(b * 32 + k) * 1024 + ch] = h;
    LDS_WAIT();
}
constexpr int VP = 192;
__device__ __forceinline__ void attn_unit(const Frame& F, const Args& a, int u) {
    const int lane = lane_now();
    const int c = lane & 31, hh = lane >> 5, xaddr = (lane ^ 32) << 2;
    const int br = u >> 12, rem = u & 4095, bh = rem >> 6, qt = rem & 63;
    const int b = bh >> 4, h = bh & 15;
    const int dsh = br * 2, d = 1 << dsh;
    const int r = qt & (d - 1), ltile = qt >> dsh, l0 = ltile * 32;
    const bf16_t* proj = (const bf16_t*)(F.ws + WS_PROJ) + (size_t)b * SEQ * IN_COLS + h * 64;
    LAS unsigned char* vl = F.lds + F.wave * 16384;
    bf16x8 qf[4];
    { const bf16_t* qrow = proj + (size_t)((l0 + c) * d + r) * IN_COLS + 8 * hh;
#pragma unroll
      for (int s = 0; s < 4; ++s) qf[s] = *(const bf16x8*)(qrow + 16 * s); }
    constexpr float LOG2E = 1.4426950408889634f;
    const float slope2 = exp2f(-0.5f * (float)(h + 1)) * LOG2E * (float)d;
    const float sc2 = 0.125f * LOG2E;
    float m = -INFINITY, lsum = 0.f;
    f32x16 o0, o1;
#pragma unroll
    for (int i = 0; i < 16; ++i) { o0[i] = 0.f; o1[i] = 0.f; }
    const int jfirst = ltile >= 4 ? 0 : 4 - ltile;
    bf16x8 kf[3][4]; u32x4 vr[3][4];
    const int vrow = lane >> 3, vch = lane & 7;
    const unsigned rowb = (unsigned)d * (unsigned)(IN_COLS * 2);
    const unsigned kvo = (unsigned)c * rowb + (unsigned)((ATTN_W + 8 * hh) * 2);
    const unsigned vvo = (unsigned)vrow * rowb + (unsigned)((2 * ATTN_W + vch * 8) * 2);
#define ATT_LOAD(j) do { const char* tb = (const char*)proj + (size_t)((l0 - 128 + 32 * (j)) * d + r) * (size_t)(IN_COLS * 2);     \
        _Pragma("unroll") for (int s = 0; s < 4; ++s) kf[(j) % 3][s] = *(const bf16x8*)(tb + (kvo + 32u * s)); \
        _Pragma("unroll") for (int i = 0; i < 4; ++i) vr[(j) % 3][i] = *(const u32x4*)(tb + (size_t)(8 * i) * rowb + vvo); } while (0)
#pragma unroll
    for (int o = 0; o < 3; ++o) if (4 - o >= jfirst) ATT_LOAD(4 - o);
    const LAS unsigned char* vtr_base = vl + (4 * hh + ((lane & 15) >> 2)) * VP + (16 * ((lane >> 4) & 1) + 4 * (lane & 3)) * 2;
#pragma unroll
    for (int o = 0; o < 5; ++o) { constexpr int dummy = 0; (void)dummy; const int j = 4 - o; if (j >= jfirst) {
#pragma unroll
        for (int i = 0; i < 4; ++i) *(LAS u32x4*)(vl + (vrow + 8 * i) * VP + vch * 16) = vr[j % 3][i];
        f32x16 sa;
#pragma unroll
        for (int i = 0; i < 16; ++i) sa[i] = 0.f;
#pragma unroll
        for (int s = 0; s < 4; ++s) sa = __builtin_amdgcn_mfma_f32_32x32x16_bf16(kf[j % 3][s], qf[s], sa, 0, 0, 0);
        const float relbase = (float)(c + 128 - 32 * j);
        float mx = -INFINITY;
#pragma unroll
        for (int i = 0; i < 16; ++i) { const int ki = (i & 3) + 8 * (i >> 2) + 4 * hh;
            float v = sa[i] * sc2 - slope2 * (relbase - (float)ki);
            const bool valid = (j == 0) ? (ki >= c) : ((j == 4) ? (ki <= c) : true);
            v = valid ? v : -INFINITY; sa[i] = v; mx = fmaxf(mx, v); }
        mx = fmaxf(mx, __builtin_bit_cast(float, __builtin_amdgcn_ds_bpermute(xaddr, __builtin_bit_cast(int, mx))));
        const float mnew = fmaxf(m, mx);
        const float alpha = __builtin_amdgcn_exp2f(m - mnew);
        float ps = 0.f;
#pragma unroll
        for (int i = 0; i < 16; ++i) { const float p = __builtin_amdgcn_exp2f(sa[i] - mnew); sa[i] = p; ps += p; }
        ps += __builtin_bit_cast(float, __builtin_amdgcn_ds_bpermute(xaddr, __builtin_bit_cast(int, ps)));
        lsum = lsum * alpha + ps;
        if (o > 0 && __builtin_amdgcn_ballot_w64(mnew > m) != 0ull) {
#pragma unroll
            for (int i = 0; i < 16; ++i) { o0[i] *= alpha; o1[i] *= alpha; } }
        m = mnew;
        bf16x8 pf[2];
#pragma unroll
        for (int s = 0; s < 2; ++s) { u32x4 w; w.x = g8::cvt_pk_bf16(sa[8 * s + 0], sa[8 * s + 1]); w.y = g8::cvt_pk_bf16(sa[8 * s + 2], sa[8 * s + 3]); w.z = g8::cvt_pk_bf16(sa[8 * s + 4], sa[8 * s + 5]); w.w = g8::cvt_pk_bf16(sa[8 * s + 6], sa[8 * s + 7]);
            pf[s] = __builtin_bit_cast(bf16x8, w); }
#pragma unroll
        for (int s = 0; s < 2; ++s) {
#pragma unroll
            for (int nt = 0; nt < 2; ++nt) {
                const s16x4 lo = vtr(vtr_base + (16 * s) * VP + nt * 64), hi = vtr(vtr_base + (16 * s + 8) * VP + nt * 64);
                const bf16x8 af = __builtin_shufflevector(lo, hi, 0, 1, 2, 3, 4, 5, 6, 7);
                if (nt == 0) o0 = __builtin_amdgcn_mfma_f32_32x32x16_bf16(af, pf[s], o0, 0, 0, 0); else o1 = __builtin_amdgcn_mfma_f32_32x32x16_bf16(af, pf[s], o1, 0, 0, 0);
            }
        }
        }
        if (o + 3 <= 4 && 4 - (o + 3) >= jfirst) ATT_LOAD(4 - (o + 3));
    }
#undef ATT_LOAD
    const float inv = 1.0f / lsum;
    const size_t tok = (size_t)b * SEQ + (size_t)((l0 + c) * d + r);
    bf16_t* orow = (bf16_t*)(F.ws + WS_ATT) + ((size_t)br * NTOK + tok) * ATTN_W + h * 64 + 4 * hh;
#pragma unroll
    for (int g = 0; g < 4; ++g) {
        u32x2 w0, w1;
        w0.x = g8::cvt_pk_bf16(o0[4 * g] * inv, o0[4 * g + 1] * inv); w0.y = g8::cvt_pk_bf16(o0[4 * g + 2] * inv, o0[4 * g + 3] * inv);
        w1.x = g8::cvt_pk_bf16(o1[4 * g] * inv, o1[4 * g + 1] * inv); w1.y = g8::cvt_pk_bf16(o1[4 * g + 2] * inv, o1[4 * g + 3] * inv);
        *(u32x2*)(orow + 8 * g) = w0; *(u32x2*)(orow + 32 + 8 * g) = w1;
    }
    if (hh == 0) ((float*)(F.ws + WS_LSE))[((size_t)br * NTOK + tok) * 16 + h] = 0.6931471805599453f * (m + __builtin_amdgcn_logf(lsum));
}
#ifndef PROBE_P2
#define PROBE_P2 0
#endif
__device__ __forceinline__ void p2_mixers(const Frame& F, const Args& a) {
    for (int rep = 0; rep < (PROBE_P2 == 1 ? 2 : 1); ++rep)
    for (int u = F.gw; u < 2048; u += F.NGW) lru_unit(F, a, u);
    for (int rep = 0; rep < (PROBE_P2 == 2 ? 2 : 1); ++rep)
#pragma nounroll
    for (int u = F.gw; u < 3 * 4096; u += F.NGW) { asm volatile("" ::: "memory"); const int u0 = __builtin_amdgcn_readfirstlane(u), pass = u0 / F.NGW;
        const int uu = (u0 & ~63) | ((u0 + 21 * pass) & 63);
        attn_unit(F, a, uu); }
}

__device__ __forceinline__ void p3_mix(const Frame& F, const Args& a) {
    const int LANE = lane_now(), TID = F.wave * 64 + LANE; (void)TID;
    LAS float* Hin = (LAS float*)F.lds;
    const float* ae = (const float*)(F.ws + WS_LRUE); const float* he = ae + 4 * 32 * 1024;
    const bf16_t* proj = (const bf16_t*)(F.ws + WS_PROJ);
    bf16_t* mixed = (bf16_t*)(F.ws + WS_MIXED);
    for (int grp = F.vcu; grp < NTOK / 32; grp += F.G) {
        const int tok0 = grp * 32, b = tok0 / SEQ, k = (tok0 % SEQ) / 64;
        __syncthreads();
        for (int d = TID; d < LRU_W; d += NTHR) { float H = 0.f;
            for (int j0 = 0; j0 < k; j0 += 8) { float av[8], hv[8];
#pragma unroll
                for (int jj = 0; jj < 8; ++jj) { const bool ok = (j0 + jj) < k; const size_t o = (size_t)(b * 32 + (ok ? j0 + jj : 0)) * 1024 + d; const float a1 = ae[o], h1 = he[o]; av[jj] = ok ? a1 : 1.0f; hv[jj] = ok ? h1 : 0.0f; }
#pragma unroll
                for (int jj = 0; jj < 8; ++jj) H = av[jj] * H + hv[jj]; }
            Hin[d] = H; }
        __syncthreads();
        for (int tt = F.wave; tt < 32; tt += NWAVES) {
            const size_t tok = (size_t)tok0 + tt;
            { const bf16_t* ao = (const bf16_t*)(F.ws + WS_ATT); const float* lse = (const float*)(F.ws + WS_LSE); const f32x4* gr = (const f32x4*)karg_in<10>() + LANE;
              f32x4 v[4]; float s = 0.f;
#pragma unroll
              for (int j = 0; j < 4; ++j) { const int hd = (LANE >> 4) + 4 * j;
                  const float l0 = lse[(0 * (size_t)NTOK + tok) * 16 + hd], l1 = lse[(1 * (size_t)NTOK + tok) * 16 + hd], l2 = lse[(2 * (size_t)NTOK + tok) * 16 + hd];
                  const float M = fmaxf(l0, fmaxf(l1, l2)); float w0 = __expf(l0 - M), w1 = __expf(l1 - M), w2 = __expf(l2 - M); const float iw = 1.0f / (w0 + w1 + w2); w0 *= iw; w1 *= iw; w2 *= iw;
                  const u32x2 a0 = *((const u32x2*)(ao + (0 * (size_t)NTOK + tok) * ATTN_W) + LANE + 64 * j), a1 = *((const u32x2*)(ao + (1 * (size_t)NTOK + tok) * ATTN_W) + LANE + 64 * j), a2 = *((const u32x2*)(ao + (2 * (size_t)NTOK + tok) * ATTN_W) + LANE + 64 * j);
                  v[j][0] = w0 * bflo(a0.x) + w1 * bflo(a1.x) + w2 * bflo(a2.x); v[j][1] = w0 * bfhi(a0.x) + w1 * bfhi(a1.x) + w2 * bfhi(a2.x);
                  v[j][2] = w0 * bflo(a0.y) + w1 * bflo(a1.y) + w2 * bflo(a2.y); v[j][3] = w0 * bfhi(a0.y) + w1 * bfhi(a1.y) + w2 * bfhi(a2.y);
                  s += (v[j][0] * v[j][0] + v[j][1] * v[j][1]) + (v[j][2] * v[j][2] + v[j][3] * v[j][3]); }
              const float rs = rsqrtf(wave_sum(s) * (1.0f / 1024.0f) + EPS);
              u32x2* o = (u32x2*)(mixed + tok * D_MODEL) + LANE;
#pragma unroll
              for (int j = 0; j < 4; ++j) { const f32x4 g = gr[64 * j]; u32x2 w; w.x = pk2(v[j][0] * rs * g[0], v[j][1] * rs * g[1]); w.y = pk2(v[j][2] * rs * g[2], v[j][3] * rs * g[3]); o[64 * j] = w; } }
            { const f32x4* hr = (const f32x4*)((const float*)(F.ws + WS_HL) + tok * LRU_W) + LANE; const f32x4* pr = (const f32x4*)((const float*)(F.ws + WS_PC) + tok * LRU_W) + LANE;
              const u32x2* gp = (const u32x2*)(proj + tok * IN_COLS + 3 * ATTN_W + LRU_W) + LANE; const f32x4* gr = (const f32x4*)karg_in<11>() + LANE;
              f32x4 v[4]; float s = 0.f;
#pragma unroll
              for (int j = 0; j < 4; ++j) { const f32x4 hv = hr[64 * j], pv = pr[64 * j]; const u32x2 gw = gp[64 * j]; const f32x4 hi = *(const LAS f32x4*)(Hin + (LANE + 64 * j) * 4);
                  v[j][0] = (hv[0] + pv[0] * hi[0]) * gelu_tanh(bflo(gw.x)); v[j][1] = (hv[1] + pv[1] * hi[1]) * gelu_tanh(bfhi(gw.x));
                  v[j][2] = (hv[2] + pv[2] * hi[2]) * gelu_tanh(bflo(gw.y)); v[j][3] = (hv[3] + pv[3] * hi[3]) * gelu_tanh(bfhi(gw.y));
                  s += (v[j][0] * v[j][0] + v[j][1] * v[j][1]) + (v[j][2] * v[j][2] + v[j][3] * v[j][3]); }
              const float rs = rsqrtf(wave_sum(s) * (1.0f / 1024.0f) + EPS);
              u32x2* o = (u32x2*)(mixed + tok * D_MODEL + ATTN_W) + LANE;
#pragma unroll
              for (int j = 0; j < 4; ++j) { const f32x4 g = gr[64 * j]; u32x2 w; w.x = pk2(v[j][0] * rs * g[0], v[j][1] * rs * g[1]); w.y = pk2(v[j][2] * rs * g[2], v[j][3] * rs * g[3]); o[64 * j] = w; } }
        }
    }
    __syncthreads();
}

__device__ __forceinline__ void p5_router(const Frame& F, const Args& a) {
    const int LANE = lane_now(), TID = F.wave * 64 + LANE; (void)TID;
    const float* x1 = (const float*)(F.ws + WS_X1); bf16_t* hn2s = (bf16_t*)(F.ws + WS_HN2S);
    const float* g = karg_in<13>(); const float* wr = karg_in<14>(); const float* br = karg_in<15>();
    int* cnt = (int*)(F.ctl + CW_CNT);
    int* sel_e = (int*)(F.ws + WS_SEL); int* sel_pos = sel_e + NSLOT; float* sel_g = (float*)(sel_pos + NSLOT);
    LAS float* PART = (LAS float*)F.lds;
    LAS float* SSQ = PART + 8 * 1024;
    LAS float* RS = SSQ + 256;
    LAS float* LG = RS + 32;
    LAS int* lcnt = (LAS int*)(LG + 1024);
    LAS int* gbase = lcnt + 32;
    LAS int* ent_e = gbase + 32;
    LAS int* ent_r = ent_e + 128;
    LAS float* ent_g = (LAS float*)(ent_r + 128);
    const int lane = LANE, r16 = lane & 15, kq = lane >> 4;
    for (int grp = F.vcu; grp < NTOK / 32; grp += F.G) {
        const int tok0 = grp * 32;
        __syncthreads();
        if (TID < 32) lcnt[TID] = 0;
        f32x4 acc00 = {0.f, 0.f, 0.f, 0.f}, acc01 = acc00, acc10 = acc00, acc11 = acc00; float ss0 = 0.f, ss1 = 0.f;
        const float* xa = x1 + (size_t)(tok0 + r16) * D_MODEL + F.wave * 256 + 4 * kq;
        const float* gp = g + F.wave * 256 + 4 * kq;
        const float* wp = wr + (size_t)(F.wave * 256 + 4 * kq) * N_EXP + r16;
#pragma unroll 4
        for (int S = 0; S < 16; ++S) {
            const f32x4 xv0 = *(const f32x4*)(xa + 16 * S), xv1 = *(const f32x4*)(xa + 16 * S + (size_t)16 * D_MODEL), gv = *(const f32x4*)(gp + 16 * S);
            float b0[4], b1[4];
#pragma unroll
            for (int q = 0; q < 4; ++q) { b0[q] = wp[(size_t)(16 * S + q) * N_EXP]; b1[q] = wp[(size_t)(16 * S + q) * N_EXP + 16]; }
            ss0 += (xv0[0] * xv0[0] + xv0[1] * xv0[1]) + (xv0[2] * xv0[2] + xv0[3] * xv0[3]);
            ss1 += (xv1[0] * xv1[0] + xv1[1] * xv1[1]) + (xv1[2] * xv1[2] + xv1[3] * xv1[3]);
#pragma unroll
            for (int q = 0; q < 4; ++q) { const float a0 = xv0[q] * gv[q], a1 = xv1[q] * gv[q];
                acc00 = __builtin_amdgcn_mfma_f32_16x16x4f32(a0, b0[q], acc00, 0, 0, 0); acc01 = __builtin_amdgcn_mfma_f32_16x16x4f32(a0, b1[q], acc01, 0, 0, 0);
                acc10 = __builtin_amdgcn_mfma_f32_16x16x4f32(a1, b0[q], acc10, 0, 0, 0); acc11 = __builtin_amdgcn_mfma_f32_16x16x4f32(a1, b1[q], acc11, 0, 0, 0); }
        }
        { LAS float* pw = PART + F.wave * 1024;
#pragma unroll
          for (int q = 0; q < 4; ++q) { const int tr = 4 * kq + q;
              pw[tr * 32 + r16] = acc00[q]; pw[tr * 32 + 16 + r16] = acc01[q]; pw[(16 + tr) * 32 + r16] = acc10[q]; pw[(16 + tr) * 32 + 16 + r16] = acc11[q]; }
          ss0 += __shfl_xor(ss0, 16); ss0 += __shfl_xor(ss0, 32); ss1 += __shfl_xor(ss1, 16); ss1 += __shfl_xor(ss1, 32);
          if (kq == 0) { SSQ[F.wave * 32 + r16] = ss0; SSQ[F.wave * 32 + 16 + r16] = ss1; } }
        __syncthreads();
        if (TID < 32) { float t = 0.f;
#pragma unroll
            for (int w = 0; w < 8; ++w) t += SSQ[w * 32 + TID];
            RS[TID] = rsqrtf(t * (1.0f / 2048.0f) + EPS); }
        __syncthreads();
        { const int tt = TID >> 4, eg = TID & 15; float s0 = 0.f, s1 = 0.f;
#pragma unroll
          for (int w = 0; w < 8; ++w) { const f32x2 v = *(const LAS f32x2*)(PART + w * 1024 + tt * 32 + 2 * eg); s0 += v[0]; s1 += v[1]; }
          const float rs = RS[tt];
          LG[tt * 32 + 2 * eg] = s0 * rs + br[2 * eg]; LG[tt * 32 + 2 * eg + 1] = s1 * rs + br[2 * eg + 1]; }
        __syncthreads();
        for (int t4 = 0; t4 < 4; ++t4) {
            const int tk = F.wave * 4 + t4;
            float cur = (lane < 32) ? LG[tk * 32 + lane] : -INFINITY;
            int i0 = 0, i1 = 0, i2 = 0, i3 = 0; float v0 = 0.f, v1 = 0.f, v2 = 0.f, v3 = 0.f;
#pragma unroll
            for (int k = 0; k < 4; ++k) {
                const float mx = wave_max(cur);
                const unsigned long long bal = __ballot(cur == mx);
                const int bi = __ffsll((long long)bal) - 1;
                if (k == 0) { i0 = bi; v0 = mx; } else if (k == 1) { i1 = bi; v1 = mx; } else if (k == 2) { i2 = bi; v2 = mx; } else { i3 = bi; v3 = mx; }
                if (lane == bi) cur = -INFINITY;
            }
            if (lane == 0) {
                const float e1 = __expf(v1 - v0), e2 = __expf(v2 - v0), e3 = __expf(v3 - v0); const float inv = 1.0f / (1.0f + e1 + e2 + e3);
                const int base = tk * 4;
                ent_e[base + 0] = i0; ent_r[base + 0] = __hip_atomic_fetch_add(&lcnt[i0], 1, __ATOMIC_RELAXED, __HIP_MEMORY_SCOPE_WORKGROUP); ent_g[base + 0] = inv;
                ent_e[base + 1] = i1; ent_r[base + 1] = __hip_atomic_fetch_add(&lcnt[i1], 1, __ATOMIC_RELAXED, __HIP_MEMORY_SCOPE_WORKGROUP); ent_g[base + 1] = e1 * inv;
                ent_e[base + 2] = i2; ent_r[base + 2] = __hip_atomic_fetch_add(&lcnt[i2], 1, __ATOMIC_RELAXED, __HIP_MEMORY_SCOPE_WORKGROUP); ent_g[base + 2] = e2 * inv;
                ent_e[base + 3] = i3; ent_r[base + 3] = __hip_atomic_fetch_add(&lcnt[i3], 1, __ATOMIC_RELAXED, __HIP_MEMORY_SCOPE_WORKGROUP); ent_g[base + 3] = e3 * inv;
            }
        }
        __syncthreads();
        if (TID < 32) { const int n = lcnt[TID]; gbase[TID] = n > 0 ? atomicAdd(&cnt[TID], n) : 0; }
        __syncthreads();
        if (TID < 128) { const int e = ent_e[TID], pos = gbase[e] + ent_r[TID], tok = tok0 + (TID >> 2);
            sel_e[tok * 4 + (TID & 3)] = e; sel_pos[tok * 4 + (TID & 3)] = pos; sel_g[tok * 4 + (TID & 3)] = ent_g[TID]; }
        for (int t4 = 0; t4 < 4; ++t4) { const int tk = F.wave * 4 + t4; const float rs = RS[tk];
            const f32x4* xr = (const f32x4*)(x1 + (size_t)(tok0 + tk) * D_MODEL) + lane; const f32x4* gr = (const f32x4*)g + lane; u32x2 w[8];
#pragma unroll
            for (int j = 0; j < 8; ++j) { const f32x4 v = xr[64 * j], gg = gr[64 * j]; w[j].x = pk2(v[0] * rs * gg[0], v[1] * rs * gg[1]); w[j].y = pk2(v[2] * rs * gg[2], v[3] * rs * gg[3]); }
#pragma unroll
            for (int k = 0; k < 4; ++k) { const int e = ent_e[tk * 4 + k], pos = gbase[e] + ent_r[tk * 4 + k]; u32x2* o = (u32x2*)(hn2s + ((size_t)e * NTOK + pos) * D_MODEL) + lane;
#pragma unroll
                for (int j = 0; j < 8; ++j) o[64 * j] = w[j]; } }
    }
    __syncthreads();
}

__device__ __forceinline__ void build_tpre(const Frame& F, int nhb) {
    const int TID = F.tid_();
    LAS int* tpre = (LAS int*)(F.lds + L_TPRE); LAS int* bid = (LAS int*)(F.lds + L_BLKID); LAS int* bpre = (LAS int*)(F.lds + L_BLKPRE); LAS int* bsz = (LAS int*)(F.lds + L_BLKPRE + 512);
    __syncthreads();
    if (TID == 0) { const int* cnt = (const int*)(F.ctl + CW_CNT); int acc = 0; for (int e = 0; e < N_EXP; ++e) { tpre[e] = acc; acc += (cnt[e] + 255) >> 8; } tpre[N_EXP] = acc; }
    __syncthreads();
    if (nhb) {
        const int nb = N_EXP * nhb;
        if (TID < nb) {
            const int e = TID / nhb, nm = tpre[e + 1] - tpre[e]; int r = 0;
            for (int b = 0; b < nb; ++b) { const int eb = b / nhb, nmb = tpre[eb + 1] - tpre[eb]; r += (nmb > nm || (nmb == nm && b < TID)) ? 1 : 0; }
            bid[(r & 7) * 8 + (r >> 3)] = TID; bsz[(r & 7) * 8 + (r >> 3)] = nm * 8;
        }
        __syncthreads();
        if (TID < 8) { int acc = 0; bpre[TID * 9] = 0; for (int k = 0; k < 4 * nhb; ++k) { acc += bsz[TID * 8 + k]; bpre[TID * 9 + k + 1] = acc; } }
        __syncthreads();
    }
}

__device__ __forceinline__ void p8_final(const Frame& F, const Args& a) {
    const int LANE = lane_now(), TID = F.wave * 64 + LANE; (void)TID;
    const LAS int* tpre = (const LAS int*)(F.lds + L_TPRE);
    const float* x1 = (const float*)(F.ws + WS_X1); const bf16_t* Y = (const bf16_t*)(F.ws + WS_Y);
    const int* sel_e = (const int*)(F.ws + WS_SEL); const int* sel_pos = sel_e + NSLOT; const float* sel_g = (const float*)(sel_pos + NSLOT);
    const f32x4* gr = (const f32x4*)karg_in<20>() + LANE;
    for (int tok = F.gw; tok < NTOK; tok += F.NGW) {
        const f32x4* xr = (const f32x4*)(x1 + (size_t)tok * D_MODEL) + LANE;
        f32x4 v[8];
#pragma unroll
        for (int j = 0; j < 8; ++j) v[j] = xr[64 * j];
#pragma unroll
        for (int k = 0; k < 4; ++k) {
            const int e = sel_e[tok * 4 + k]; const size_t row = (size_t)tpre[e] * 256 + sel_pos[tok * 4 + k]; const float gk = sel_g[tok * 4 + k];
            const u32x2* yp = (const u32x2*)(Y + row * D_MODEL) + LANE;
#pragma unroll
            for (int j = 0; j < 8; ++j) { const u32x2 w = yp[64 * j]; v[j][0] += gk * bflo(w.x); v[j][1] += gk * bfhi(w.x); v[j][2] += gk * bflo(w.y); v[j][3] += gk * bfhi(w.y); }
        }
        float s = 0.f;
#pragma unroll
        for (int j = 0; j < 8; ++j) s += (v[j][0] * v[j][0] + v[j][1] * v[j][1]) + (v[j][2] * v[j][2] + v[j][3] * v[j][3]);
        const float rs = rsqrtf(wave_sum(s) * (1.0f / 2048.0f) + EPS);
        f32x4* o = (f32x4*)(karg_out() + (size_t)tok * D_MODEL) + LANE;
#pragma unroll
        for (int j = 0; j < 8; ++j) { const f32x4 g = gr[64 * j]; o[64 * j] = (f32x4){v[j][0] * rs * g[0], v[j][1] * rs * g[1], v[j][2] * rs * g[2], v[j][3] * rs * g[3]}; }
    }
}

__device__ __forceinline__ void ph1_inproj(const Frame& F, const Args& args) {
    unsigned char* ws = F.ws;
    g8::DenseOrder S{(const char*)(ws + WS_HN), (const char*)karg_in<2>(), NTOK / 256, IN_COLS / 256, (NTOK / 256) * (IN_COLS / 256), F.G, (int)blockIdx.x, IN_COLS};
    g8::EpiBf16 E{(bf16_t*)(ws + WS_PROJ), IN_COLS, nullptr, 0};
    g8::gemm_phase<g8::EpiBf16, g8::DenseOrder>(F.lds, S, E, F.wave);
}
__device__ __forceinline__ void ph4_outproj(const Frame& F, const Args& args) {
    unsigned char* ws = F.ws;
    g8::DenseOrder S{(const char*)(ws + WS_MIXED), (const char*)karg_in<12>(), NTOK / 256, D_MODEL / 256, (NTOK / 256) * (D_MODEL / 256), F.G, (int)blockIdx.x, D_MODEL};
    g8::EpiResF32 E{(float*)(ws + WS_X1), karg_in<0>(), D_MODEL};
    g8::gemm_phase<g8::EpiResF32, g8::DenseOrder>(F.lds, S, E, F.wave);
}
__device__ __forceinline__ void ph6_gateup(const Frame& F, const Args& args) {
    unsigned char* ws = F.ws;
    build_tpre(F, 2);
    g8::GroupedOrder S{(const char*)(ws + WS_HN2S), (const char*)karg_in<16>(), (const LAS int*)(F.lds + L_TPRE), (const LAS int*)(F.lds + L_BLKID), (const LAS int*)(F.lds + L_BLKPRE), 2, F.G, (int)blockIdx.x, (size_t)4096 * KDIM * 4, true, 4096};
    g8::EpiSwiglu E{(bf16_t*)(ws + WS_ACT), karg_in<17>()};
    g8::gemm_phase<g8::EpiSwiglu, g8::GroupedOrder>(F.lds, S, E, F.wave);
}
__device__ __forceinline__ void ph7_down(const Frame& F, const Args& args) {
    unsigned char* ws = F.ws;
    build_tpre(F, 1);
    g8::GroupedOrder S{(const char*)(ws + WS_ACT), (const char*)karg_in<18>(), (const LAS int*)(F.lds + L_TPRE), (const LAS int*)(F.lds + L_BLKID), (const LAS int*)(F.lds + L_BLKPRE), 1, F.G, (int)blockIdx.x, (size_t)D_MODEL * KDIM * 4, false, D_MODEL};
    g8::EpiBf16 E{(bf16_t*)(ws + WS_Y), D_MODEL, karg_in<19>(), D_MODEL};
    g8::gemm_phase<g8::EpiBf16, g8::GroupedOrder>(F.lds, S, E, F.wave);
}

constexpr int N_PHASES = 9;
__global__ void __launch_bounds__(NTHR, 2) mk_fwd(Args args) {
    extern __shared__ __attribute__((aligned(16))) unsigned char lds_raw[];
    Frame F;
    F.lds = (LAS unsigned char*)lds_raw;
    F.wave = __builtin_amdgcn_readfirstlane((int)threadIdx.x >> 6);
    F.G = gridDim.x; { const int bx = blockIdx.x; F.vcu = (F.G % 8 == 0) ? (bx % 8) * (F.G / 8) + bx / 8 : bx; }
    F.gw = F.vcu * NWAVES + F.wave; F.NGW = F.G * NWAVES;
    F.ws = args.ws; F.ctl = (unsigned*)(args.ws + WS_CTL);
    for (int u = F.tid_(); u < (LDS_BYTES - LDSCTL_OFF) / 4; u += NTHR) ((LAS unsigned*)(F.lds + LDSCTL_OFF))[u] = 0u;
    __syncthreads();
    const int lo = args.ph_lo, hi = args.ph_hi;
    unsigned bar_x = 0;
    if (hi - lo > 1) bar_x = __builtin_amdgcn_readfirstlane(xcd_barrier_post(F.ctl + CW_BAR, (volatile LAS unsigned*)(F.lds + L_MISC) + 8, F.tid_()).x);
#define IN(k) (lo <= (k) && (k) < hi)
#define XBAR() do { unsigned* _bp = F.ctl + CW_BAR; asm volatile("" : "+s"(_bp)); XcdBarrier _b; _b.bar = _bp; _b.x = bar_x; _b.st = (volatile LAS unsigned*)(F.lds + L_MISC) + 8; xcd_barrier(_b, F.tid_()); } while (0)
#define SEAM(k) do { if (IN(k) && IN((k) + 1)) XBAR(); } while (0)

#define PHASE(k, call) do { if (IN(k)) { call; } if ((PROBE_MASK >> (k)) & 1) { XBAR(); if (IN(k)) { call; } } } while (0)
    PHASE(0, p0_prologue(F, args)); SEAM(0);
    PHASE(1, ph1_inproj(F, args)); SEAM(1);
    PHASE(2, p2_mixers(F, args)); SEAM(2);
    PHASE(3, p3_mix(F, args)); SEAM(3);
    PHASE(4, ph4_outproj(F, args)); SEAM(4);
    if (IN(5)) { p5_router(F, args); } SEAM(5);
    PHASE(6, ph6_gateup(F, args)); SEAM(6);
    PHASE(7, ph7_down(F, args)); SEAM(7);
    if (IN(8)) { build_tpre(F, 0); p8_final(F, args); }
#undef IN
#undef SEAM
}

extern "C" void kernel_launch(void* const* d_in, const int* in_sizes, int n_in, void* d_out, int out_size, void* d_ws, size_t ws_size, hipStream_t stream) {
    static int grid = 0;
    if (grid == 0) {
        if (n_in != 21 || out_size != NTOK * D_MODEL || ws_size < WS_END) { fprintf(stderr, "kernel_launch: unexpected problem (n_in %d out %d ws %zu)\n", n_in, out_size, ws_size); grid = -1; return; }
        int dev = 0, cus = 0, per_cu = 0;
        if (hipGetDevice(&dev) != hipSuccess || hipDeviceGetAttribute(&cus, hipDeviceAttributeMultiprocessorCount, dev) != hipSuccess) { grid = -1; return; }
        if (hipFuncSetAttribute((const void*)mk_fwd, hipFuncAttributeMaxDynamicSharedMemorySize, LDS_BYTES) != hipSuccess) { fprintf(stderr, "kernel_launch: hipFuncSetAttribute failed\n"); grid = -1; return; }
        if (hipOccupancyMaxActiveBlocksPerMultiprocessor(&per_cu, (const void*)mk_fwd, NTHR, LDS_BYTES) != hipSuccess || per_cu < 1) { fprintf(stderr, "kernel_launch: occupancy query says %d\n", per_cu); }
        (void)hipGetLastError();
        grid = cus;
    }
    if (grid < 0) return;
    if (hipMemsetAsync((char*)d_ws + WS_CTL, 0, CTL_ZERO_BYTES, stream) != hipSuccess) return;
    Args a{};
    for (int i = 0; i < 21; ++i) a.in[i] = (const float*)d_in[i];
    a.out = (float*)d_out; a.ws = (unsigned char*)d_ws;
#if MK_N_LAUNCHES == 1
    a.ph_lo = 0; a.ph_hi = N_PHASES;
    hipLaunchKernelGGL(mk_fwd, dim3(grid), dim3(NTHR), LDS_BYTES, stream, a);
#else
    for (int p = 0; p < N_PHASES; ++p) { a.ph_lo = p; a.ph_hi = p + 1; hipLaunchKernelGGL(mk_fwd, dim3(grid), dim3(NTHR), LDS_BYTES, stream, a); }
#endif
}
```

```cpp
#include <hip/hip_runtime.h>
#include <stdint.h>
#include <stdio.h>

#ifndef MK_N_LAUNCHES
#define MK_N_LAUNCHES 1
#endif

#ifndef PROBE_MASK
#define PROBE_MASK 0
#endif
#define LAS __attribute__((address_space(3)))
#define GAS __attribute__((address_space(1)))
typedef unsigned short bf16_t;
typedef short bf16x8 __attribute__((ext_vector_type(8)));
typedef float f32x4 __attribute__((ext_vector_type(4)));
typedef float f32x2 __attribute__((ext_vector_type(2)));
typedef unsigned u32x4 __attribute__((ext_vector_type(4)));
typedef unsigned u32x2 __attribute__((ext_vector_type(2)));

constexpr int D_MODEL = 2048, BATCH = 4, SEQ = 2048, NTOK = BATCH * SEQ;
constexpr int N_HEADS = 16, ATTN_W = 1024, LRU_W = 1024;
constexpr int IN_COLS = 5120;
constexpr int N_EXP = 32, D_FF = 2048, NSLOT = NTOK * 4;
constexpr int KDIM = 2048;
constexpr float EPS = 1e-6f;
constexpr int NWAVES = 8, NTHR = 512;
constexpr int PADROWS = NSLOT + N_EXP * 256;

constexpr size_t MiB = 1u << 20;
constexpr size_t WS_CTL = 0, WS_LISTS = 1 * MiB, CTL_ZERO_BYTES = 2 * MiB;
constexpr size_t WS_SEL = 2 * MiB;
constexpr size_t WS_LRUE = 3 * MiB;
constexpr size_t WS_WIN = 4 * MiB, WS_WOUT = 24 * MiB, WS_HN = 32 * MiB, WS_PROJ = 64 * MiB, WS_ATT = 144 * MiB  , WS_HL = 192 * MiB, WS_PC = 224 * MiB;
constexpr size_t WS_MIXED = 256 * MiB, WS_X1 = 288 * MiB, WS_ACT = 352 * MiB, WS_Y = 512 * MiB, WS_WGU = 672 * MiB, WS_WDN = 1184 * MiB, WS_LSE = 1440 * MiB  , WS_HN2S = 1442 * MiB  , WS_RIDX = 1506 * MiB  , WS_END = 2466 * MiB;
static_assert((size_t)PADROWS * 2048 * 2 <= 160 * MiB, "ACT/Y size");
constexpr int CW_BAR = 4096, CW_CNT = 8192;

constexpr int RING_BYTES = 131072;
constexpr int LDSCTL_OFF = 139264;
constexpr int LDS_BYTES = 147456;
constexpr int L_GTAB = 131072;
constexpr int L_MISC = LDSCTL_OFF;
constexpr int L_TPRE = LDSCTL_OFF + 256;
constexpr int L_CNT = LDSCTL_OFF + 512;
constexpr int L_BLKID = LDSCTL_OFF + 1024;
constexpr int L_BLKPRE = LDSCTL_OFF + 1280;

__device__ __forceinline__ unsigned f2bf(float f) { unsigned u = __builtin_bit_cast(unsigned, f); return (u + 0x7fffu + ((u >> 16) & 1u)) >> 16; }
__device__ __forceinline__ unsigned pk2(float lo, float hi) { unsigned r; asm("v_cvt_pk_bf16_f32 %0, %1, %2" : "=v"(r) : "v"(lo), "v"(hi)); return r; }
__device__ __forceinline__ float bf2f(unsigned short b) { return __builtin_bit_cast(float, (unsigned)b << 16); }
__device__ __forceinline__ float bflo(unsigned w) { return __builtin_bit_cast(float, w << 16); }
__device__ __forceinline__ float bfhi(unsigned w) { return __builtin_bit_cast(float, w & 0xffff0000u); }
template <int CTRL> __device__ __forceinline__ float dpp_f(float v) { return __builtin_bit_cast(float, __builtin_amdgcn_update_dpp(0, __builtin_bit_cast(int, v), CTRL, 0xF, 0xF, true)); }
__device__ __forceinline__ float lane_f(float v, int l) { return __builtin_bit_cast(float, __builtin_amdgcn_readlane(__builtin_bit_cast(int, v), l)); }
__device__ __forceinline__ float wave_sum(float v) {
    v += dpp_f<0xB1>(v); v += dpp_f<0x4E>(v); v += dpp_f<0x141>(v); v += dpp_f<0x140>(v);
    return (lane_f(v, 0) + lane_f(v, 16)) + (lane_f(v, 32) + lane_f(v, 48));
}
__device__ __forceinline__ float wave_max(float v) {
    v = fmaxf(v, dpp_f<0xB1>(v)); v = fmaxf(v, dpp_f<0x4E>(v)); v = fmaxf(v, dpp_f<0x141>(v)); v = fmaxf(v, dpp_f<0x140>(v));
    return fmaxf(fmaxf(lane_f(v, 0), lane_f(v, 16)), fmaxf(lane_f(v, 32), lane_f(v, 48)));
}
#define LDS_WAIT() asm volatile("s_waitcnt lgkmcnt(0)" ::: "memory")
#define VM_WAIT() asm volatile("s_waitcnt vmcnt(0)" ::: "memory")

__device__ __forceinline__ int lane_now() { int l; asm volatile("v_mbcnt_lo_u32_b32 %0, -1, 0\n\tv_mbcnt_hi_u32_b32 %0, -1, %0" : "=v"(l)); return l; }

#define XB_TMO      128
#define XB_XCNT(j)  (256  + 64 * (j))
#define XB_XSUB(j)  (1280 + 64 * (j))
#define XB_XGEN(j)  (2304 + 64 * (j))
#define XB_TOP      3328
#define XB_TOPGEN   3392
#define XCD_BAR_WORDS 3456
#define XB_SPIN_CAP (1u << 20)
__device__ __forceinline__ unsigned xb_ld(unsigned* p)              { return __hip_atomic_load(p, __ATOMIC_RELAXED, __HIP_MEMORY_SCOPE_AGENT); }
__device__ __forceinline__ unsigned xb_add(unsigned* p, unsigned v) { return __hip_atomic_fetch_add(p, v, __ATOMIC_RELAXED, __HIP_MEMORY_SCOPE_AGENT); }
__device__ __forceinline__ unsigned xb_xcc_id() { return (unsigned)__builtin_amdgcn_s_getreg((3 << 11) | 20) & 0xFu; }
#define XB_SPIN(cond, bar) do { unsigned _sp = 0; while (cond) { __builtin_amdgcn_s_sleep(1); \
    if ((++_sp & 255u) == 0u) { if (xb_ld(&(bar)[XB_TMO])) break; if (_sp > XB_SPIN_CAP) { atomicAdd(&(bar)[XB_TMO], 1u); break; } } } } while (0)
struct XcdBarrier { unsigned* bar; unsigned x; volatile LAS unsigned* st; };
__device__ __forceinline__ XcdBarrier xcd_barrier_post(unsigned* bar, volatile LAS unsigned* st, int tid) {
    XcdBarrier b; b.bar = bar; b.x = xb_xcc_id(); b.st = st;
    if (tid == 0) (void)xb_add(&bar[XB_XCNT(b.x)], 1u);
    return b;
}
__device__ __forceinline__ void xcd_barrier_complete(unsigned* bar, unsigned x, unsigned& nloc, unsigned& nx) {
    const unsigned G = gridDim.x * gridDim.y * gridDim.z;
    unsigned sum, cnt, mine, sp = 0u;
    for (;;) {
        sum = 0u; cnt = 0u; mine = 0u;
#pragma unroll
        for (unsigned j = 0; j < 16; ++j) { const unsigned c = xb_ld(&bar[XB_XCNT(j)]); sum += c; cnt += (c > 0u) ? 1u : 0u; mine = (j == x) ? c : mine; }
        if (sum == G) break;
        __builtin_amdgcn_s_sleep(1);
        if ((++sp & 255u) == 0u) { if (xb_ld(&bar[XB_TMO])) break; if (sp > XB_SPIN_CAP) { atomicAdd(&bar[XB_TMO], 1u); break; } }
    }
    nloc = mine > 0u ? mine : 1u; nx = cnt > 0u ? cnt : 1u;
}
__device__ __forceinline__ void xcd_barrier(const XcdBarrier& b, int tid) {
    asm volatile("s_waitcnt vmcnt(0)" ::: "memory");
    __syncthreads();
    if (tid == 0) {
        unsigned* bar = b.bar;
        __builtin_amdgcn_s_waitcnt(0);
        unsigned nloc = b.st[0], nx = b.st[1];
        if (nloc == 0u) { xcd_barrier_complete(bar, b.x, nloc, nx); b.st[0] = nloc; b.st[1] = nx; }
        const unsigned old = xb_add(&bar[XB_XSUB(b.x)], 1u);
        const unsigned gen = old / nloc;
        if (old + 1u == (gen + 1u) * nloc) {
            __builtin_amdgcn_fence(__ATOMIC_RELEASE, "agent");
            asm volatile("s_waitcnt vmcnt(0)" ::: "memory");
            const unsigned og = xb_add(&bar[XB_TOP], 1u);
            const unsigned tg = og / nx;
            if (og + 1u == (tg + 1u) * nx) xb_add(&bar[XB_TOPGEN], 1u);
            else XB_SPIN(xb_ld(&bar[XB_TOPGEN]) == tg, bar);
            __builtin_amdgcn_fence(__ATOMIC_ACQUIRE, "agent");
            xb_add(&bar[XB_XGEN(b.x)], 1u);
            asm volatile("s_waitcnt vmcnt(0)" ::: "memory");
        } else {
            XB_SPIN(xb_ld(&bar[XB_XGEN(b.x)]) == gen, bar);
            __builtin_amdgcn_fence(__ATOMIC_ACQUIRE, "agent");
            asm volatile("s_waitcnt vmcnt(0)" ::: "memory");
        }
    }
    __syncthreads();
}

typedef float f32x16 __attribute__((ext_vector_type(16)));
typedef short s16x4 __attribute__((ext_vector_type(4)));
typedef short v4i16_t __attribute__((ext_vector_type(4)));
__device__ __forceinline__ s16x4 vtr(const LAS unsigned char* p) { return __builtin_bit_cast(s16x4, __builtin_amdgcn_ds_read_tr16_b64_v4i16((LAS v4i16_t*)p)); }

namespace g8 {
constexpr int BM = 256, BK = 64, HALF = 128, HTB = HALF * BK * 2, STAGE_BYTES = 8 * HTB, NXCD = 8, WGM = 8;
__host__ __device__ __forceinline__ int lds_byte(int r, int c) { const int st = (r >> 4) * 2 + (c >> 5), rr = r & 15, cc = c & 31, ob = rr * 64 + cc * 2; return st * 1024 + (ob ^ (((ob >> 9) & 1) << 5)); }
__host__ __device__ __forceinline__ void stage_rc(int b, int& R, int& C) { const int st = b / 1024, sb = b % 1024, swz = sb ^ (((sb >> 9) & 1) << 5); R = (st >> 1) * 16 + swz / 64; C = (st & 1) * 32 + (swz % 64) / 2; }
__host__ __device__ __forceinline__ int perm32(int rho) { const int n = rho >> 4, i = rho & 15; return 8 * (i >> 2) + 4 * n + (i & 3); }

struct Unit { const char* a; const char* b; int crow, ccol, e, gi; };

struct DenseOrder {
    static constexpr bool GATHER = false;
    const char* A; const char* Bt; int nM, nN, nwg, G, c; int ldb;
    __device__ __forceinline__ bool next(int i, Unit& u) const {
        const long L = (long)i * G + c; if (L >= nwg) return false;
        int wgid = (int)L; { const int q = nwg / NXCD, r = nwg % NXCD, xcd = wgid % NXCD, off = wgid / NXCD; wgid = (xcd < r ? xcd * (q + 1) : r * (q + 1) + (xcd - r) * q) + off; }
        const int nig = WGM * nN, gid = wgid / nig, fm = gid * WGM, gsz = (nM - fm) < WGM ? (nM - fm) : WGM;
        const int pm = fm + ((wgid % nig) % gsz), pn = (wgid % nig) / gsz;
        u.a = A + (size_t)pm * BM * KDIM * 2; u.b = Bt + (size_t)pn * BM * 4; u.crow = pm * BM; u.ccol = pn * BM; u.e = 0; u.gi = 0; return true;
    }
};
template <bool GATHER_>
struct GroupedOrderT {
    static constexpr bool GATHER = GATHER_;
    const char* A; const char* Bt; const LAS int* tpre; const LAS int* bid; const LAS int* bpre; int nhb, G, c; size_t bstride;
    bool capA; int ldb;
    __device__ __forceinline__ bool next(int i, Unit& u) const {
        const int per = G >> 3, x = c & 7, j = c >> 3, Lx = i * per + j, nslots = 4 * nhb;
        const LAS int* bp = bpre + x * 9;
        if (Lx >= __builtin_amdgcn_readfirstlane(bp[nslots])) return false;
        int k = 0; while (Lx >= __builtin_amdgcn_readfirstlane(bp[k + 1])) ++k;
        const int b = __builtin_amdgcn_readfirstlane(bid[x * 8 + k]), within = Lx - __builtin_amdgcn_readfirstlane(bp[k]);
        const int e = b / nhb, hb = b - e * nhb, mt = within >> 3, nt = hb * 8 + (within & 7);
        const int mtile = __builtin_amdgcn_readfirstlane(tpre[e]) + mt;
        u.a = GATHER ? A : A + (capA ? ((size_t)e * NTOK + (size_t)mt * BM) : (size_t)mtile * BM) * KDIM * 2;
        u.b = Bt + (size_t)e * bstride + (size_t)nt * BM * 4; u.crow = mtile * BM; u.ccol = nt * BM; u.e = e; u.gi = mt * BM; return true;
    }
};

__device__ __forceinline__ unsigned cvt_pk_bf16(float lo, float hi) { unsigned r; asm volatile("v_cvt_pk_bf16_f32 %0, %1, %2" : "=v"(r) : "v"(lo), "v"(hi)); return r; }

struct EpiBf16 {
    bf16_t* O; int ldc; const float* bias; int bias_stride;
    struct Pre { f32x4 b[2][2]; __device__ __forceinline__ f32x4 init(int bj, int n) const { return b[bj][n]; } };
    __device__ __forceinline__ Pre pre(const Unit& u, int wc, int fq) const { Pre p; const int col0 = u.ccol + wc * 32 + 8 * (((fq & 1) << 1) | (fq >> 1));
#pragma unroll
        for (int bj = 0; bj < 2; ++bj)
#pragma unroll
            for (int n = 0; n < 2; ++n) p.b[bj][n] = bias ? *(const f32x4*)(bias + (size_t)u.e * bias_stride + col0 + bj * HALF + 4 * n) : (f32x4){0.f, 0.f, 0.f, 0.f};
        return p; }
    __device__ __forceinline__ void operator()(const f32x4 (&acc)[2][2][4][2], const Unit& u, int wr, int wc, int fr, int fq, const Pre& pr) const {
        const int row0 = u.crow + wr * 64 + fr, col0 = u.ccol + wc * 32 + 8 * (((fq & 1) << 1) | (fq >> 1));
#pragma unroll
        for (int bj = 0; bj < 2; ++bj) {
#pragma unroll
            for (int ai = 0; ai < 2; ++ai)
#pragma unroll
                for (int m = 0; m < 4; ++m) { const f32x4 v0 = acc[ai][bj][m][0], v1 = acc[ai][bj][m][1];
                    u32x4 w; w.x = cvt_pk_bf16(v0[0], v0[1]); w.y = cvt_pk_bf16(v0[2], v0[3]); w.z = cvt_pk_bf16(v1[0], v1[1]); w.w = cvt_pk_bf16(v1[2], v1[3]);
                    *(u32x4*)(O + (size_t)(row0 + ai * HALF + m * 16) * ldc + col0 + bj * HALF) = w; } }
    }
};
struct EpiResF32 {
    float* C; const float* res; int ldc;
    struct Pre { __device__ __forceinline__ f32x4 init(int, int) const { return (f32x4){0.f, 0.f, 0.f, 0.f}; } };
    __device__ __forceinline__ Pre pre(const Unit&, int, int) const { return Pre{}; }
    __device__ __forceinline__ void operator()(const f32x4 (&acc)[2][2][4][2], const Unit& u, int wr, int wc, int fr, int fq, const Pre&) const {
        const int row0 = u.crow + wr * 64 + fr, col0 = u.ccol + wc * 32 + 8 * (((fq & 1) << 1) | (fq >> 1));
#pragma unroll
        for (int ai = 0; ai < 2; ++ai)
#pragma unroll
            for (int m = 0; m < 4; ++m) { const size_t off = (size_t)(row0 + ai * HALF + m * 16) * ldc + col0;
#pragma unroll
                for (int bj = 0; bj < 2; ++bj)
#pragma unroll
                    for (int n = 0; n < 2; ++n) { const f32x4 r = *(const f32x4*)(res + off + bj * HALF + n * 4); *(f32x4*)(C + off + bj * HALF + n * 4) = acc[ai][bj][m][n] + r; } }
    }
};
struct EpiSwiglu {
    bf16_t* O; const float* bias;
    __device__ __forceinline__ float act(float g, float up) const {
        g = fminf(g, 7.0f); up = fminf(fmaxf(up, -7.0f), 7.0f);
        const float sg = __builtin_amdgcn_rcpf(1.0f + __builtin_amdgcn_exp2f(-2.4554670416f * g));
        const float gs = g * sg; return __builtin_fmaf(gs, up, gs);
    }
    struct Pre { f32x4 b[2][2]; __device__ __forceinline__ f32x4 init(int bj, int n) const { return b[bj][n]; } };
    __device__ __forceinline__ Pre pre(const Unit& u, int wc, int fq) const { Pre p; const int col0 = u.ccol + wc * 32 + 8 * (((fq & 1) << 1) | (fq >> 1));
#pragma unroll
        for (int bj = 0; bj < 2; ++bj)
#pragma unroll
            for (int n = 0; n < 2; ++n) p.b[bj][n] = *(const f32x4*)(bias + (size_t)u.e * (2 * D_FF) + col0 + bj * HALF + 4 * n);
        return p; }
    __device__ __forceinline__ void operator()(const f32x4 (&acc)[2][2][4][2], const Unit& u, int wr, int wc, int fr, int fq, const Pre& pr) const {
        const int pf = ((fq & 1) << 1) | (fq >> 1);
        const int row0 = u.crow + wr * 64 + fr, col0 = u.ccol + wc * 32 + 8 * pf;
        const bool up = fq >= 2;
#pragma unroll
        for (int bj = 0; bj < 2; ++bj) {
#pragma unroll
            for (int ai = 0; ai < 2; ++ai) {
                u32x2 w[4];
#pragma unroll
                for (int m = 0; m < 4; ++m) { const f32x4 v0 = acc[ai][bj][m][0], v1 = acc[ai][bj][m][1];
                    w[m].x = cvt_pk_bf16(act(v0[0], v0[1]), act(v0[2], v0[3])); w[m].y = cvt_pk_bf16(act(v1[0], v1[1]), act(v1[2], v1[3])); }
#pragma unroll
                for (int mp = 0; mp < 2; ++mp) { unsigned ax = w[2 * mp].x, ay = w[2 * mp].y, bx = w[2 * mp + 1].x, by = w[2 * mp + 1].y;
                    asm volatile("s_nop 1\n\tv_permlane32_swap_b32 %0, %1" : "+v"(ax), "+v"(bx));
                    asm volatile("s_nop 1\n\tv_permlane32_swap_b32 %0, %1" : "+v"(ay), "+v"(by));
                    const int mrow = 2 * mp + (up ? 1 : 0), ccolact = ((col0 + bj * HALF) >> 1) - (up ? 4 : 0);
                    u32x4 o; o.x = ax; o.y = ay; o.z = bx; o.w = by;
                    *(u32x4*)(O + (size_t)(row0 + ai * HALF + mrow * 16) * D_FF + ccolact) = o; }
            }
        }
    }
};


template <class Epi, class Sched>
__device__ __forceinline__ void gemm_phase(LAS unsigned char* lds, const Sched& S, const Epi& E, int wave) {
    const int wid = wave, lane = lane_now(), tid = wid * 64 + lane, wr = wid >> 2, wc = wid & 3;
    constexpr int K = KDIM, nt = K / BK;
    unsigned voffA[2];
#pragma unroll
    for (int i = 0; i < 2; ++i) { int R, C; stage_rc(tid * 16 + i * 8192, R, C); voffA[i] = (unsigned)(R * K + C) * 2u; }
    unsigned goff[2][2];
#define G8_GOFF(h, unit_idx) do { const int _t = wid * 64 + lane_now(); const LAS unsigned short* _g = (const LAS unsigned short*)(lds + L_GTAB) + ((unit_idx) & 15) * 256 + 128 * (h); \
        _Pragma("unroll") for (int i = 0; i < 2; ++i) { int R, C; stage_rc(_t * 16 + i * 8192, R, C); goff[h][i] = (unsigned)_g[R] * (unsigned)(K * 2) + (unsigned)C * 2u; } } while (0)
    const int ldb = S.ldb;
    constexpr size_t kstep = (size_t)(BK * 2);
    constexpr size_t hstep = (size_t)HALF * K * 2;
    const size_t kstepB = (size_t)BK * ldb * 4;
    constexpr size_t hstepB = 512;
    const size_t jstepB = (size_t)16 * ldb * 4;
    const unsigned bvoff = (unsigned)((tid >> 5) * ldb * 4 + (tid & 31) * 16);
    const unsigned ldsbase = (unsigned)(size_t)lds;
    unsigned wbase;
    { const int k0 = tid >> 5, q = tid & 31, f = 2 * ((k0 & 3) + 4 * ((k0 >> 3) & 1)); wbase = ldsbase + (unsigned)(k0 * 256 + (((q >> 1) ^ f) * 16) + (q & 1) * 8); }
    const unsigned ldsw = (unsigned)wid * 1024u;
    const unsigned la0 = __builtin_amdgcn_readfirstlane(ldsbase + ldsw);
    const int fr = lane & 15, fq = lane >> 4;
    const int aoff = lds_byte(wr * 64 + fr, fq * 8);
    int bb[2];
    { const int q = (lane & 15) >> 2, p = lane & 3, f = 2 * (q + 4 * (fq & 1));
#pragma unroll
      for (int nf = 0; nf < 2; ++nf) { const int ch = 4 * wc + (((p & 1) << 1) | (p >> 1)); bb[nf] = (8 * fq + q) * 256 + ((ch ^ f) * 16) + nf * 8; } }
#define G8_SA(b, h) (((b) * 2 + (h)) * HTB)
#define G8_SB(b, h) ((4 + (b) * 2 + (h)) * HTB)
#define G8_GLDS(ldsaddr, voff, gbase) asm volatile("s_mov_b32 m0, %0\n\ts_nop 0\n\tglobal_load_lds_dwordx4 %1, %2" :: "s"(ldsaddr), "v"(voff), "s"(gbase) : "memory")
#define G8_STAGE_A(bufoff, gbase, h) do { const unsigned _la = la0 + (unsigned)(bufoff); if (Sched::GATHER) { \
        G8_GLDS(_la, goff[h][0], (const char*)(gbase)); G8_GLDS(_la + 8192u, goff[h][1], (const char*)(gbase)); } else { const char* _gb = (const char*)(gbase) + (h) * hstep; \
        G8_GLDS(_la, voffA[0], _gb); G8_GLDS(_la + 8192u, voffA[1], _gb); } } while (0)
#define G8_LOADB(R, ptr) do { const char* _p = (const char*)(ptr); \
        asm volatile("global_load_dwordx4 %0, %1, %2" : "=&v"(R##0) : "v"(bvoff), "s"(_p) : "memory"); _p += jstepB; \
        asm volatile("global_load_dwordx4 %0, %1, %2" : "=&v"(R##1) : "v"(bvoff), "s"(_p) : "memory"); _p += jstepB; \
        asm volatile("global_load_dwordx4 %0, %1, %2" : "=&v"(R##2) : "v"(bvoff), "s"(_p) : "memory"); _p += jstepB; \
        asm volatile("global_load_dwordx4 %0, %1, %2" : "=&v"(R##3) : "v"(bvoff), "s"(_p) : "memory"); } while (0)
#define G8_CVT2(R) do { R[0] = __builtin_bit_cast(float, cvt_pk_bf16(R[0], R[1])); R[1] = __builtin_bit_cast(float, cvt_pk_bf16(R[2], R[3])); } while (0)
#define G8_LO2(R) __builtin_shufflevector(R, R, 0, 1)
#define G8_CVTW(R, bufoff, N) do { asm volatile("s_waitcnt vmcnt(" #N ")" : "+v"(R##0), "+v"(R##1), "+v"(R##2), "+v"(R##3) :: "memory"); __builtin_amdgcn_sched_barrier(0); \
        const unsigned _wa = wbase + (unsigned)(bufoff); G8_CVT2(R##0); G8_CVT2(R##1); G8_CVT2(R##2); G8_CVT2(R##3); \
        asm volatile("ds_write_b64 %0, %1\n\tds_write_b64 %0, %2 offset:4096\n\tds_write_b64 %0, %3 offset:8192\n\tds_write_b64 %0, %4 offset:12288" :: "v"(_wa), "v"(G8_LO2(R##0)), "v"(G8_LO2(R##1)), "v"(G8_LO2(R##2)), "v"(G8_LO2(R##3)) : "memory"); } while (0)
#define G8_LDA(dst, b, h) do { _Pragma("unroll") for (int m = 0; m < 4; ++m) _Pragma("unroll") for (int k = 0; k < 2; ++k) dst[m][k] = *(const LAS bf16x8*)(lds + G8_SA(b, h) + aoff + m * 2048 + k * 1024); } while (0)
#define G8_TR(dst, addr, off) asm volatile("ds_read_b64_tr_b16 %0, %1 offset:%2" : "=v"(dst) : "v"(addr), "i"(off) : "memory")
#define G8_LDB(lo, hi, b, h) do { _Pragma("unroll") for (int n = 0; n < 2; ++n) { const unsigned _ad = ldsbase + (unsigned)(G8_SB(b, h)) + (unsigned)bb[n]; \
        G8_TR(lo[n][0], _ad, 0); G8_TR(hi[n][0], _ad, 1024); G8_TR(lo[n][1], _ad, 8192); G8_TR(hi[n][1], _ad, 9216); } } while (0)
#define G8_BF(lo, hi, n, k) __builtin_shufflevector(lo[n][k], hi[n][k], 0, 1, 2, 3, 4, 5, 6, 7)
#define G8_MMA(ai, bj, At, Bl, Bh) do { __builtin_amdgcn_s_setprio(1); _Pragma("unroll") for (int m = 0; m < 4; ++m) _Pragma("unroll") for (int n = 0; n < 2; ++n) _Pragma("unroll") for (int k = 0; k < 2; ++k) \
        acc[ai][bj][m][n] = __builtin_amdgcn_mfma_f32_16x16x32_bf16(G8_BF(Bl, Bh, n, k), At[m][k], acc[ai][bj][m][n], 0, 0, 0); __builtin_amdgcn_s_setprio(0); } while (0)
#define G8_WAIT_V(n) asm volatile("s_waitcnt vmcnt(" #n ")" ::: "memory")
#define G8_WAIT_L(n) do { asm volatile("s_waitcnt lgkmcnt(" #n ")" ::: "memory"); __builtin_amdgcn_sched_barrier(0); } while (0)
#define G8_BAR __builtin_amdgcn_s_barrier()
#define G8_SCHED __builtin_amdgcn_sched_barrier(0)
    Unit cur, nxt; int ui = 0;
    if (!S.next(0, cur)) return;
    f32x4 acc[2][2][4][2];
    { const typename Epi::Pre p0 = E.pre(cur, wc, lane_now() >> 4);
#pragma unroll
    for (int a = 0; a < 2; ++a)
#pragma unroll
        for (int b = 0; b < 2; ++b)
#pragma unroll
            for (int m = 0; m < 4; ++m)
#pragma unroll
                for (int n = 0; n < 2; ++n) acc[a][b][m][n] = p0.init(b, n); }
    bf16x8 At[4][2]; s16x4 B0l[2][2], B0h[2][2], B1l[2][2], B1h[2][2];
    f32x4 RA0, RA1, RA2, RA3, RB0, RB1, RB2, RB3;
    const char* cA = cur.a; const char* cB = cur.b;
    if (Sched::GATHER) { G8_GOFF(0, 0); G8_GOFF(1, 0); }
    G8_STAGE_A(G8_SA(0, 0), cA, 0); G8_STAGE_A(G8_SA(0, 1), cA, 1);
    G8_LOADB(RA, cB); G8_LOADB(RB, cB + hstepB);
    G8_CVTW(RA, G8_SB(0, 0), 4); G8_LOADB(RA, cB + kstepB);
    G8_CVTW(RB, G8_SB(0, 1), 4); G8_LOADB(RB, cB + kstepB + hstepB);
    G8_CVTW(RA, G8_SB(1, 0), 4); G8_LOADB(RA, cB + 2 * kstepB);
    G8_STAGE_A(G8_SA(1, 0), cA + kstep, 0);
    G8_CVTW(RB, G8_SB(1, 1), 6); G8_LOADB(RB, cB + 2 * kstepB + hstepB);
    G8_WAIT_L(0);
    if (wr == 1) G8_BAR;
    G8_BAR;
    const char* aq = cA + kstep; const char* bq = cB + 3 * kstepB;
    for (;;) {
        const bool has_next = S.next(ui + 1, nxt);
        const char* nA = has_next ? nxt.a : cA; const char* nB = has_next ? nxt.b : cB;
        for (int t = 0; t < nt; t += 2) {
            if (Sched::GATHER && t == nt - 2 && has_next) G8_GOFF(0, ui + 1);
            G8_LDB(B0l, B0h, 0, 0); G8_SCHED; G8_LDA(At, 0, 0); G8_STAGE_A(G8_SA(1, 1), aq, 1); aq = (t == nt - 2) ? nA : aq + kstep;
            G8_WAIT_L(8); G8_BAR; G8_WAIT_L(0); G8_MMA(0, 0, At, B0l, B0h); G8_BAR; G8_SCHED;
            if (Sched::GATHER && t == nt - 2 && has_next) G8_GOFF(1, ui + 1);
            G8_LDB(B1l, B1h, 0, 1); G8_CVTW(RA, G8_SB(0, 0), 8); G8_LOADB(RA, bq);
            G8_BAR; G8_WAIT_L(0); G8_MMA(0, 1, At, B1l, B1h); G8_BAR; G8_SCHED;
            G8_LDA(At, 0, 1); G8_STAGE_A(G8_SA(0, 0), aq, 0);
            G8_BAR; G8_WAIT_L(0); G8_MMA(1, 0, At, B0l, B0h); G8_BAR; G8_SCHED;
            G8_CVTW(RB, G8_SB(0, 1), 6); G8_LOADB(RB, bq + hstepB); bq = (t == nt - 4) ? nB : bq + kstepB;
            G8_BAR; G8_WAIT_L(0); G8_MMA(1, 1, At, B1l, B1h); G8_BAR; G8_SCHED;
            G8_LDB(B0l, B0h, 1, 0); G8_SCHED; G8_LDA(At, 1, 0); G8_STAGE_A(G8_SA(0, 1), aq, 1); aq += kstep;
            G8_WAIT_L(8); G8_BAR; G8_WAIT_L(0); G8_MMA(0, 0, At, B0l, B0h); G8_BAR; G8_SCHED;
            G8_LDB(B1l, B1h, 1, 1); G8_CVTW(RA, G8_SB(1, 0), 8); G8_LOADB(RA, bq);
            G8_BAR; G8_WAIT_L(0); G8_MMA(0, 1, At, B1l, B1h); G8_BAR; G8_SCHED;
            G8_LDA(At, 1, 1); G8_STAGE_A(G8_SA(1, 0), aq, 0);
            G8_BAR; G8_WAIT_L(0); G8_MMA(1, 0, At, B0l, B0h); G8_BAR; G8_SCHED;
            G8_CVTW(RB, G8_SB(1, 1), 6); G8_LOADB(RB, bq + hstepB); bq += kstepB;
            G8_BAR; G8_WAIT_L(0); G8_MMA(1, 1, At, B1l, B1h); G8_BAR; G8_SCHED;
        }
        const typename Epi::Pre epre = E.pre(has_next ? nxt : cur, wc, lane_now() >> 4);
        asm volatile("s_waitcnt vmcnt(0)" : "+v"(RA0), "+v"(RA1), "+v"(RA2), "+v"(RA3), "+v"(RB0), "+v"(RB1), "+v"(RB2), "+v"(RB3) :: "memory"); __builtin_amdgcn_sched_barrier(0);
        { const int le = lane_now(); E(acc, cur, wr, wc, le & 15, le >> 4, epre); }
        if (!has_next) break;
#pragma unroll
        for (int a = 0; a < 2; ++a)
#pragma unroll
            for (int b = 0; b < 2; ++b)
#pragma unroll
                for (int m = 0; m < 4; ++m)
#pragma unroll
                    for (int n = 0; n < 2; ++n) acc[a][b][m][n] = epre.init(b, n);
        cur = nxt; cA = nA; cB = nB; ++ui;
    }
    G8_WAIT_V(0);
    asm volatile("" :: "v"(RA0), "v"(RA1), "v"(RA2), "v"(RA3), "v"(RB0), "v"(RB1), "v"(RB2), "v"(RB3));
    if (wr == 0) G8_BAR;
    G8_BAR;
#undef G8_SA
#undef G8_SB
#undef G8_STAGE_A
#undef G8_GLDS
#undef G8_GOFF
#undef G8_LOADB
#undef G8_CVTW
#undef G8_CVT2
#undef G8_LO2
#undef G8_LDA
#undef G8_TR
#undef G8_LDB
#undef G8_BF
#undef G8_MMA
#undef G8_WAIT_V
#undef G8_WAIT_L
#undef G8_BAR
#undef G8_SCHED
}
}

struct Frame {
    LAS unsigned char* lds;
    unsigned* ctl; unsigned char* ws;
    int wave, vcu, G, gw, NGW;
    __device__ __forceinline__ int lane_() const { return lane_now(); }
    __device__ __forceinline__ int tid_() const { return wave * 64 + lane_now(); }
};
struct Args { const float* in[21]; float* out; unsigned char* ws; int ph_lo, ph_hi; };
template <int OFF> __device__ __forceinline__ unsigned long long karg_u64() { const auto kp = __builtin_amdgcn_kernarg_segment_ptr(); unsigned long long v;
    asm volatile("s_load_dwordx2 %0, %1, %2\n\ts_waitcnt lgkmcnt(0)" : "=s"(v) : "s"(kp), "i"(OFF)); return v; }
typedef const float __attribute__((address_space(1)))* gcf_ptr; typedef float __attribute__((address_space(1)))* gf_ptr;
template <int I> __device__ __forceinline__ const float* karg_in() { return (const float*)(gcf_ptr)karg_u64<8 * I>(); }
__device__ __forceinline__ float* karg_out() { return (float*)(gf_ptr)karg_u64<8 * 21>(); }


constexpr long CV_IN = (long)KDIM * IN_COLS / 512, CV_OUT = (long)KDIM * D_MODEL / 512, CV_GU = (long)N_EXP * KDIM * 4096 / 512, CV_DN = (long)N_EXP * KDIM * D_MODEL / 512;
__device__ __forceinline__ void conv_chunks(const float* __restrict__ src, bf16_t* __restrict__ dst, long c0, long c1, int gw, int NGW, int lane) {
    long c = c0 + gw;
    for (; c + 7L * NGW < c1; c += 8L * NGW) {
        f32x4 a[8], b[8];
#pragma unroll
        for (int i = 0; i < 8; ++i) { const f32x4* p = (const f32x4*)(src + (c + (long)i * NGW) * 512 + lane * 8); a[i] = __builtin_nontemporal_load(p); b[i] = __builtin_nontemporal_load(p + 1); }
#pragma unroll
        for (int i = 0; i < 8; ++i) { u32x4 w; w.x = pk2(a[i][0], a[i][1]); w.y = pk2(a[i][2], a[i][3]); w.z = pk2(b[i][0], b[i][1]); w.w = pk2(b[i][2], b[i][3]);
            __builtin_nontemporal_store(w, (u32x4*)(dst + (c + (long)i * NGW) * 512 + lane * 8)); }
    }
    for (; c < c1; c += NGW) { const f32x4* p = (const f32x4*)(src + c * 512 + lane * 8); const f32x4 a = __builtin_nontemporal_load(p), b = __builtin_nontemporal_load(p + 1);
        u32x4 w; w.x = pk2(a[0], a[1]); w.y = pk2(a[2], a[3]); w.z = pk2(b[0], b[1]); w.w = pk2(b[2], b[3]); __builtin_nontemporal_store(w, (u32x4*)(dst + c * 512 + lane * 8)); }
}
__device__ __forceinline__ void rms_row_bf16(const float* xrow, const float* g, bf16_t* orow, int lane) {
    const f32x4* xr = (const f32x4*)xrow + lane; const f32x4* gr = (const f32x4*)g + lane;
    f32x4 v[8]; float s = 0.f;
#pragma unroll
    for (int j = 0; j < 8; ++j) { v[j] = xr[64 * j]; s += (v[j][0] * v[j][0] + v[j][1] * v[j][1]) + (v[j][2] * v[j][2] + v[j][3] * v[j][3]); }
    const float rs = rsqrtf(wave_sum(s) * (1.0f / 2048.0f) + EPS);
    u32x2* o = (u32x2*)orow + lane;
#pragma unroll
    for (int j = 0; j < 8; ++j) { const f32x4 gg = gr[64 * j]; u32x2 w; w.x = pk2(v[j][0] * rs * gg[0], v[j][1] * rs * gg[1]); w.y = pk2(v[j][2] * rs * gg[2], v[j][3] * rs * gg[3]); o[64 * j] = w; }
}
__device__ __forceinline__ void p0_prologue(const Frame& F, const Args& a) {
    const int LANE = lane_now(), TID = F.wave * 64 + LANE; (void)TID;
    bf16_t* HN = (bf16_t*)(F.ws + WS_HN);
    const float* xin = karg_in<0>(); const float* nw = karg_in<1>();
    for (int m = F.gw; m < NTOK; m += F.NGW) rms_row_bf16(xin + (size_t)m * D_MODEL, nw, HN + (size_t)m * D_MODEL, LANE);
}

__device__ __forceinline__ float gelu_tanh(float x) { const float u = 0.7978845608028654f * (x + 0.044715f * x * x * x); return x * __builtin_amdgcn_rcpf(1.0f + __expf(-2.0f * u)); }
__device__ __forceinline__ float sigmoidf_(float x) { return __builtin_amdgcn_rcpf(1.0f + __expf(-x)); }
__device__ __forceinline__ void lru_unit(const Frame& F, const Args& a, int unit) {
    const int lane = lane_now();
    const int b = unit >> 9, k = (unit >> 4) & 31, blk = unit & 15;
    const bf16_t* proj = (const bf16_t*)(F.ws + WS_PROJ);
    LAS float* xs = (LAS float*)(F.lds + F.wave * 16384);
    const int ch = blk * 64 + lane;
    const float* cwp = karg_in<3>();
    const float cw0 = cwp[0 * LRU_W + ch], cw1 = cwp[1 * LRU_W + ch], cw2 = cwp[2 * LRU_W + ch], cw3 = cwp[3 * LRU_W + ch], cb = karg_in<4>()[ch];
    const int t0 = k * 64; const size_t row0 = (size_t)b * SEQ + t0;
    const bf16_t* xp = proj + row0 * IN_COLS + 3 * ATTN_W + ch;
    float xv[67];
#pragma unroll
    for (int i = 0; i < 67; ++i) xv[i] = (i >= 3 || t0 > 0) ? bf2f(xp[(i - 3) * IN_COLS]) : 0.f;
#define XS(t, c) ((t) * 64 + (((((c) >> 2) ^ ((t) & 15)) << 2) | ((c) & 3)))
#pragma unroll
    for (int t = 0; t < 64; ++t) xs[XS(t, lane)] = cb + cw0 * xv[t] + cw1 * xv[t + 1] + cw2 * xv[t + 2] + cw3 * xv[t + 3];
    const int c32 = lane & 31, hh = lane >> 5, xaddr = (lane ^ 32) << 2;
    bf16x8 wf[2][2][4];
#pragma unroll
    for (int g = 0; g < 2; ++g) { const float* wp = (g == 0 ? karg_in<5>() : karg_in<7>()) + (size_t)blk * 4096 + c32 + 512 * hh;
#pragma unroll
        for (int j = 0; j < 2; ++j)
#pragma unroll
            for (int s4 = 0; s4 < 4; ++s4) { const float* p = wp + 1024 * s4 + 32 * j; union { bf16x8 v; unsigned u[4]; } pk;
#pragma unroll
                for (int e = 0; e < 4; ++e) pk.u[e] = g8::cvt_pk_bf16(p[128 * e], p[128 * e + 64]);
                wf[g][j][s4] = pk.v; } }
    const float ba = karg_in<6>()[ch], bx = karg_in<8>()[ch];
    const float sp = log1pf(__expf(-karg_in<9>()[ch])); const float csp = -8.0f * 1.4426950408889634f * sp;
    bf16_t* hl = (bf16_t*)(F.ws + WS_HL) + row0 * LRU_W + ch; bf16_t* pc = (bf16_t*)(F.ws + WS_PC) + row0 * LRU_W + ch;
    LDS_WAIT();
    float h = 0.f, P = 1.f;
#pragma unroll 1
    for (int mt = 0; mt < 2; ++mt) {
        f32x16 acc[2][2];
#pragma unroll
        for (int g = 0; g < 2; ++g)
#pragma unroll
            for (int j = 0; j < 2; ++j)
#pragma unroll
                for (int i = 0; i < 16; ++i) acc[g][j][i] = 0.f;
        { const int tr = 32 * mt + c32;
#pragma unroll
          for (int s4 = 0; s4 < 4; ++s4) { const int g0 = 4 * s4 + 2 * hh;
              const f32x4 x0 = *(const LAS f32x4*)(xs + tr * 64 + ((g0 ^ (tr & 15)) << 2)), x1 = *(const LAS f32x4*)(xs + tr * 64 + (((g0 + 1) ^ (tr & 15)) << 2));
              union { bf16x8 v; unsigned u[4]; } pk; pk.u[0] = g8::cvt_pk_bf16(x0[0], x0[1]); pk.u[1] = g8::cvt_pk_bf16(x0[2], x0[3]); pk.u[2] = g8::cvt_pk_bf16(x1[0], x1[1]); pk.u[3] = g8::cvt_pk_bf16(x1[2], x1[3]);
#pragma unroll
              for (int g = 0; g < 2; ++g)
#pragma unroll
                  for (int j = 0; j < 2; ++j) acc[g][j] = __builtin_amdgcn_mfma_f32_32x32x16_bf16(pk.v, wf[g][j][s4], acc[g][j], 0, 0, 0); } }
        float own[2][16], rcv[2][16];
#pragma unroll
        for (int g = 0; g < 2; ++g)
#pragma unroll
            for (int i = 0; i < 16; ++i) { const float snd = hh ? acc[g][0][i] : acc[g][1][i]; own[g][i] = hh ? acc[g][1][i] : acc[g][0][i];
                rcv[g][i] = __builtin_bit_cast(float, __builtin_amdgcn_ds_bpermute(xaddr, __builtin_bit_cast(int, snd))); }
#pragma unroll 1
        for (int q = 0; q < 4; ++q) {
#pragma unroll
            for (int t8 = 0; t8 < 8; ++t8) { const int idx = t8 & 3, t = 32 * mt + 8 * q + t8; const bool mine = (((t8 >> 2) & 1) != 0) == (hh != 0);
                float r = (mine ? own[0][idx] : rcv[0][idx]) + ba, ii = (mine ? own[1][idx] : rcv[1][idx]) + bx;
                r = sigmoidf_(r); ii = sigmoidf_(ii);
                const float av = __builtin_amdgcn_exp2f(r * csp);
                const float bv = __builtin_amdgcn_sqrtf(fmaf(-av, av, 1.0f)) * (ii * xs[XS(t, lane)]);
                h = av * h + bv; P *= av;
                { const unsigned hp = pk2(h, P); hl[(size_t)t * LRU_W] = (bf16_t)(hp & 0xffffu); pc[(size_t)t * LRU_W] = (bf16_t)(hp >> 16); } }
#pragma unroll
            for (int g = 0; g < 2; ++g)
#pragma unroll
                for (int i = 0; i < 12; ++i) { own[g][i] = own[g][i + 4]; rcv[g][i] = rcv[g][i + 4]; }
        }
    }
#undef XS
    float* ae = (float*)(F.ws + WS_LRUE); float* he = ae + 4 * 32 * 1024;
    ae[(size_t)(b * 32 + k) * 1024 + ch] = P; he[(size_t)(b * 32 + k) * 1024 + ch] = h;
    LDS_WAIT();
}
constexpr int VP = 192;
constexpr int KP = 144;
__device__ __forceinline__ void attn_unit(const Frame& F, const Args& a, int u) {
    const int lane = lane_now();
    const int c = lane & 31, hh = lane >> 5, xaddr = (lane ^ 32) << 2;
    const int br = u >> 12, rem = u & 4095, bh = rem >> 6, qt = rem & 63;
    const int b = bh >> 4, h = bh & 15;
    const int dsh = br * 2, d = 1 << dsh;
    const int r = qt & (d - 1), ltile = qt >> dsh, l0 = ltile * 32;
    const bf16_t* proj = (const bf16_t*)(F.ws + WS_PROJ) + (size_t)b * SEQ * IN_COLS + h * 64;
    LAS unsigned char* vl = F.lds + F.wave * 16384;
    bf16x8 qf[4];
    {
      const int qrow_ = lane >> 3, qch = lane & 7; const char* qb = (const char*)proj + (size_t)(l0 * d + r) * (size_t)(IN_COLS * 2) + (size_t)qrow_ * ((size_t)d * (IN_COLS * 2)) + qch * 16;
      u32x4 qr[4];
#pragma unroll
      for (int i = 0; i < 4; ++i) qr[i] = *(const u32x4*)(qb + (size_t)(8 * i) * ((size_t)d * (IN_COLS * 2)));
#pragma unroll
      for (int i = 0; i < 4; ++i) *(LAS u32x4*)(vl + 32 * VP + (qrow_ + 8 * i) * KP + qch * 16) = qr[i];
#pragma unroll
      for (int s = 0; s < 4; ++s) qf[s] = *(const LAS bf16x8*)(vl + 32 * VP + c * KP + 16 * hh + 32 * s); }
    constexpr float LOG2E = 1.4426950408889634f;
    const float slope2 = exp2f(-0.5f * (float)(h + 1)) * LOG2E * (float)d;
    const float sc2 = 0.125f * LOG2E;
    float m = -INFINITY, lsum = 0.f;
    float kb[16];
#pragma unroll
    for (int i = 0; i < 16; ++i) { kb[i] = slope2 * (float)((i & 3) + 8 * (i >> 2) + 4 * hh); asm volatile("" : "+v"(kb[i])); }
    f32x16 o0, o1;
#pragma unroll
    for (int i = 0; i < 16; ++i) { o0[i] = 0.f; o1[i] = 0.f; }
    const int jfirst = ltile >= 4 ? 0 : 4 - ltile;
    u32x4 kr[3][4]; u32x4 vr[3][4];
    const int vrow = lane >> 3, vch = lane & 7;
    const unsigned rowb = (unsigned)d * (unsigned)(IN_COLS * 2);
    const unsigned kvo = (unsigned)vrow * rowb + (unsigned)((ATTN_W + vch * 8) * 2);
    const unsigned vvo = (unsigned)vrow * rowb + (unsigned)((2 * ATTN_W + vch * 8) * 2);
#define ATT_LOAD(j) do { const char* tb = (const char*)proj + (size_t)((l0 - 128 + 32 * (j)) * d + r) * (size_t)(IN_COLS * 2);     \
        _Pragma("unroll") for (int i = 0; i < 4; ++i) kr[(j) % 3][i] = *(const u32x4*)(tb + (size_t)(8 * i) * rowb + kvo); \
        _Pragma("unroll") for (int i = 0; i < 4; ++i) vr[(j) % 3][i] = *(const u32x4*)(tb + (size_t)(8 * i) * rowb + vvo); } while (0)
#pragma unroll
    for (int o = 0; o < 3; ++o) if (4 - o >= jfirst) ATT_LOAD(4 - o);
    const LAS unsigned char* vtr_base = vl + (4 * hh + ((lane & 15) >> 2)) * VP + (16 * ((lane >> 4) & 1) + 4 * (lane & 3)) * 2;
#pragma unroll
    for (int o = 0; o < 5; ++o) { constexpr int dummy = 0; (void)dummy; const int j = 4 - o; if (j >= jfirst) {
#pragma unroll
        for (int i = 0; i < 4; ++i) *(LAS u32x4*)(vl + (vrow + 8 * i) * VP + vch * 16) = vr[j % 3][i];
#pragma unroll
        for (int i = 0; i < 4; ++i) *(LAS u32x4*)(vl + 32 * VP + (vrow + 8 * i) * KP + vch * 16) = kr[j % 3][i];
        bf16x8 kf[4];
#pragma unroll
        for (int s = 0; s < 4; ++s) kf[s] = *(const LAS bf16x8*)(vl + 32 * VP + c * KP + 16 * hh + 32 * s);
        f32x16 sa;
#pragma unroll
        for (int i = 0; i < 16; ++i) sa[i] = 0.f;
#pragma unroll
        for (int s = 0; s < 4; ++s) sa = __builtin_amdgcn_mfma_f32_32x32x16_bf16(kf[s], qf[s], sa, 0, 0, 0);
        const float base = -slope2 * (float)(c + 128 - 32 * j);
        float mx = -INFINITY;
#pragma unroll
        for (int i = 0; i < 16; ++i) { const int ki = (i & 3) + 8 * (i >> 2) + 4 * hh;
            float v = __builtin_fmaf(sa[i], sc2, kb[i]);
            const bool valid = (j == 0) ? (ki >= c) : ((j == 4) ? (ki <= c) : true);
            v = valid ? v : -INFINITY; sa[i] = v; mx = fmaxf(mx, v); }
        mx += base;
        mx = fmaxf(mx, __builtin_bit_cast(float, __builtin_amdgcn_ds_bpermute(xaddr, __builtin_bit_cast(int, mx))));
        const float mnew = fmaxf(m, mx);
        const float alpha = __builtin_amdgcn_exp2f(m - mnew);
        const float msh = mnew - base;
        float ps = 0.f;
#pragma unroll
        for (int i = 0; i < 16; ++i) { const float p = __builtin_amdgcn_exp2f(sa[i] - msh); sa[i] = p; ps += p; }
        lsum = lsum * alpha + ps;
        if (o > 0 && __builtin_amdgcn_ballot_w64(mnew > m) != 0ull) {
#pragma unroll
            for (int i = 0; i < 16; ++i) { o0[i] *= alpha; o1[i] *= alpha; } }
        m = mnew;
        bf16x8 pf[2];
#pragma unroll
        for (int s = 0; s < 2; ++s) { u32x4 w; w.x = g8::cvt_pk_bf16(sa[8 * s + 0], sa[8 * s + 1]); w.y = g8::cvt_pk_bf16(sa[8 * s + 2], sa[8 * s + 3]); w.z = g8::cvt_pk_bf16(sa[8 * s + 4], sa[8 * s + 5]); w.w = g8::cvt_pk_bf16(sa[8 * s + 6], sa[8 * s + 7]);
            pf[s] = __builtin_bit_cast(bf16x8, w); }
#pragma unroll
        for (int s = 0; s < 2; ++s) {
#pragma unroll
            for (int nt = 0; nt < 2; ++nt) {
                const s16x4 lo = vtr(vtr_base + (16 * s) * VP + nt * 64), hi = vtr(vtr_base + (16 * s + 8) * VP + nt * 64);
                const bf16x8 af = __builtin_shufflevector(lo, hi, 0, 1, 2, 3, 4, 5, 6, 7);
                if (nt == 0) o0 = __builtin_amdgcn_mfma_f32_32x32x16_bf16(af, pf[s], o0, 0, 0, 0); else o1 = __builtin_amdgcn_mfma_f32_32x32x16_bf16(af, pf[s], o1, 0, 0, 0);
            }
        }
        }
        if (o + 3 <= 4 && 4 - (o + 3) >= jfirst) ATT_LOAD(4 - (o + 3));
    }
#undef ATT_LOAD
    lsum += __builtin_bit_cast(float, __builtin_amdgcn_ds_bpermute(xaddr, __builtin_bit_cast(int, lsum)));
    const float inv = __builtin_amdgcn_rcpf(lsum);
    const size_t tok = (size_t)b * SEQ + (size_t)((l0 + c) * d + r);
    { LAS unsigned char* ob = vl + 32 * VP + c * KP + 8 * hh;
#pragma unroll
      for (int g = 0; g < 4; ++g) {
        u32x2 w0, w1;
        w0.x = g8::cvt_pk_bf16(o0[4 * g] * inv, o0[4 * g + 1] * inv); w0.y = g8::cvt_pk_bf16(o0[4 * g + 2] * inv, o0[4 * g + 3] * inv);
        w1.x = g8::cvt_pk_bf16(o1[4 * g] * inv, o1[4 * g + 1] * inv); w1.y = g8::cvt_pk_bf16(o1[4 * g + 2] * inv, o1[4 * g + 3] * inv);
        *(LAS u32x2*)(ob + 16 * g) = w0; *(LAS u32x2*)(ob + 64 + 16 * g) = w1; }
      const int orow_ = lane >> 3, och = lane & 7;
#pragma unroll
      for (int i = 0; i < 4; ++i) { const u32x4 w = *(const LAS u32x4*)(vl + 32 * VP + (orow_ + 8 * i) * KP + och * 16);
        const size_t tk = (size_t)b * SEQ + (size_t)((l0 + orow_ + 8 * i) * d + r);
        *(u32x4*)((bf16_t*)(F.ws + WS_ATT) + ((size_t)br * NTOK + tk) * ATTN_W + h * 64 + och * 8) = w; } }
    if (hh == 0) ((float*)(F.ws + WS_LSE))[((size_t)br * NTOK + tok) * 16 + h] = 0.6931471805599453f * (m + __builtin_amdgcn_logf(lsum));
}
#ifndef PROBE_P2
#define PROBE_P2 0
#endif
__device__ __forceinline__ void p2_mixers(const Frame& F, const Args& a) {
    for (int u = F.gw; u < 2048; u += F.NGW) lru_unit(F, a, u);
    const bool split = F.G == 256, late = split && blockIdx.x < 128;
    const int bx = blockIdx.x, sub = split ? ((bx & 7) * 16 + ((bx >> 3) & 15)) * NWAVES + F.wave : F.gw;
    const int ustart = split ? (late ? 9216 + sub : sub) : F.gw, ustride = split ? 1024 : F.NGW, uend = split ? (late ? 12288 : 9216) : 3 * 4096;
#pragma nounroll
    for (int u = ustart; u < uend; u += ustride) { asm volatile("" ::: "memory"); const int u0 = __builtin_amdgcn_readfirstlane(u), pass = (u0 - ustart) / ustride;
        const int uu = (u0 & ~63) | ((u0 + 21 * pass) & 63);
        attn_unit(F, a, uu); }
}

__device__ __forceinline__ void p3_mix(const Frame& F, const Args& a) {
    const int LANE = lane_now(), TID = F.wave * 64 + LANE; (void)TID;
    LAS float* Hin = (LAS float*)F.lds;
    const float* ae = (const float*)(F.ws + WS_LRUE); const float* he = ae + 4 * 32 * 1024;
    const bf16_t* proj = (const bf16_t*)(F.ws + WS_PROJ);
    bf16_t* mixed = (bf16_t*)(F.ws + WS_MIXED);
    const f32x4* gr_att = (const f32x4*)karg_in<10>() + 2 * LANE; const f32x4* gr_rec = (const f32x4*)karg_in<11>() + 2 * LANE;
    for (int grp = F.vcu; grp < NTOK / 32; grp += F.G) {
        const int tok0 = grp * 32, b = tok0 / SEQ, k = (tok0 % SEQ) / 64;
        __syncthreads();
        for (int d = TID; d < LRU_W; d += NTHR) { float H = 0.f;
            for (int j0 = 0; j0 < k; j0 += 8) { float av[8], hv[8];
#pragma unroll
                for (int jj = 0; jj < 8; ++jj) { const bool ok = (j0 + jj) < k; const size_t o = (size_t)(b * 32 + (ok ? j0 + jj : 0)) * 1024 + d; const float a1 = ae[o], h1 = he[o]; av[jj] = ok ? a1 : 1.0f; hv[jj] = ok ? h1 : 0.0f; }
#pragma unroll
                for (int jj = 0; jj < 8; ++jj) H = av[jj] * H + hv[jj]; }
            Hin[d] = H; }
        __syncthreads();
        for (int tt = F.wave; tt < 32; tt += NWAVES) {
            const size_t tok = (size_t)tok0 + tt;
            { const bf16_t* ao = (const bf16_t*)(F.ws + WS_ATT); const float* lse = (const float*)(F.ws + WS_LSE); const f32x4* gr = gr_att;
              float v[2][8]; float s = 0.f;
#pragma unroll
              for (int j = 0; j < 2; ++j) { const int hd = (LANE >> 3) + 8 * j;
                  const float l0 = lse[(0 * (size_t)NTOK + tok) * 16 + hd], l1 = lse[(1 * (size_t)NTOK + tok) * 16 + hd], l2 = lse[(2 * (size_t)NTOK + tok) * 16 + hd];
                  const float M = fmaxf(l0, fmaxf(l1, l2)); float w0 = __expf(l0 - M), w1 = __expf(l1 - M), w2 = __expf(l2 - M); const float iw = __builtin_amdgcn_rcpf(w0 + w1 + w2); w0 *= iw; w1 *= iw; w2 *= iw;
                  const u32x4 a0 = *((const u32x4*)(ao + (0 * (size_t)NTOK + tok) * ATTN_W) + LANE + 64 * j), a1 = *((const u32x4*)(ao + (1 * (size_t)NTOK + tok) * ATTN_W) + LANE + 64 * j), a2 = *((const u32x4*)(ao + (2 * (size_t)NTOK + tok) * ATTN_W) + LANE + 64 * j);
#pragma unroll
                  for (int e = 0; e < 4; ++e) { v[j][2 * e] = w0 * bflo(a0[e]) + w1 * bflo(a1[e]) + w2 * bflo(a2[e]); v[j][2 * e + 1] = w0 * bfhi(a0[e]) + w1 * bfhi(a1[e]) + w2 * bfhi(a2[e]);
                      s += v[j][2 * e] * v[j][2 * e] + v[j][2 * e + 1] * v[j][2 * e + 1]; } }
              const float rs = rsqrtf(wave_sum(s) * (1.0f / 1024.0f) + EPS);
              u32x4* o = (u32x4*)(mixed + tok * D_MODEL) + LANE;
#pragma unroll
              for (int j = 0; j < 2; ++j) { const f32x4 g0 = gr[128 * j], g1 = gr[128 * j + 1]; u32x4 w;
                  w.x = pk2(v[j][0] * rs * g0[0], v[j][1] * rs * g0[1]); w.y = pk2(v[j][2] * rs * g0[2], v[j][3] * rs * g0[3]); w.z = pk2(v[j][4] * rs * g1[0], v[j][5] * rs * g1[1]); w.w = pk2(v[j][6] * rs * g1[2], v[j][7] * rs * g1[3]); o[64 * j] = w; } }
            { const u32x4* hr = (const u32x4*)((const bf16_t*)(F.ws + WS_HL) + tok * LRU_W) + LANE; const u32x4* pr = (const u32x4*)((const bf16_t*)(F.ws + WS_PC) + tok * LRU_W) + LANE;
              const u32x4* gp = (const u32x4*)(proj + tok * IN_COLS + 3 * ATTN_W + LRU_W) + LANE; const f32x4* gr = gr_rec;
              float v[2][8]; float s = 0.f;
#pragma unroll
              for (int j = 0; j < 2; ++j) { const u32x4 hw = hr[64 * j], pw = pr[64 * j], gw = gp[64 * j];
                  const f32x4 hi0 = *(const LAS f32x4*)(Hin + (LANE + 64 * j) * 8), hi1 = *(const LAS f32x4*)(Hin + (LANE + 64 * j) * 8 + 4);
#pragma unroll
                  for (int e = 0; e < 4; ++e) { const float ha = (e < 2) ? hi0[2 * e] : hi1[2 * e - 4], hb = (e < 2) ? hi0[2 * e + 1] : hi1[2 * e - 3];
                      v[j][2 * e] = (bflo(hw[e]) + bflo(pw[e]) * ha) * gelu_tanh(bflo(gw[e])); v[j][2 * e + 1] = (bfhi(hw[e]) + bfhi(pw[e]) * hb) * gelu_tanh(bfhi(gw[e]));
                      s += v[j][2 * e] * v[j][2 * e] + v[j][2 * e + 1] * v[j][2 * e + 1]; } }
              const float rs = rsqrtf(wave_sum(s) * (1.0f / 1024.0f) + EPS);
              u32x4* o = (u32x4*)(mixed + tok * D_MODEL + ATTN_W) + LANE;
#pragma unroll
              for (int j = 0; j < 2; ++j) { const f32x4 g0 = gr[128 * j], g1 = gr[128 * j + 1]; u32x4 w;
                  w.x = pk2(v[j][0] * rs * g0[0], v[j][1] * rs * g0[1]); w.y = pk2(v[j][2] * rs * g0[2], v[j][3] * rs * g0[3]); w.z = pk2(v[j][4] * rs * g1[0], v[j][5] * rs * g1[1]); w.w = pk2(v[j][6] * rs * g1[2], v[j][7] * rs * g1[3]); o[64 * j] = w; } }
        }
    }
    __syncthreads();
}

__device__ __forceinline__ void p5_router(const Frame& F, const Args& a) {
    const int LANE = lane_now(), TID = F.wave * 64 + LANE; (void)TID;
    const float* x1 = (const float*)(F.ws + WS_X1); bf16_t* hn2 = (bf16_t*)(F.ws + WS_HN2S); int* ridx = (int*)(F.ws + WS_RIDX);
    const float* g = karg_in<13>(); const float* wr = karg_in<14>(); const float* br = karg_in<15>();
    int* cnt = (int*)(F.ctl + CW_CNT);
    int* sel_e = (int*)(F.ws + WS_SEL); int* sel_pos = sel_e + NSLOT; float* sel_g = (float*)(sel_pos + NSLOT);
    LAS float* PART = (LAS float*)F.lds;
    LAS float* SSQ = PART + 8 * 1024;
    LAS float* RS = SSQ + 256;
    LAS float* LG = RS + 32;
    LAS int* lcnt = (LAS int*)(LG + 1024);
    LAS int* gbase = lcnt + 32;
    LAS int* ent_e = gbase + 32;
    LAS int* ent_r = ent_e + 128;
    LAS float* ent_g = (LAS float*)(ent_r + 128);
    const int lane = LANE, r16 = lane & 15, kq = lane >> 4;
    for (int grp = F.vcu; grp < NTOK / 32; grp += F.G) {
        const int tok0 = grp * 32;
        __syncthreads();
        if (TID < 32) lcnt[TID] = 0;
        f32x4 acc00 = {0.f, 0.f, 0.f, 0.f}, acc01 = acc00, acc10 = acc00, acc11 = acc00; float ss0 = 0.f, ss1 = 0.f;
        const float* xa = x1 + (size_t)(tok0 + r16) * D_MODEL + F.wave * 256 + 4 * kq;
        const float* gp = g + F.wave * 256 + 4 * kq;
        const float* wp = wr + (size_t)(F.wave * 256 + 4 * kq) * N_EXP + r16;
#pragma unroll 8
        for (int S = 0; S < 16; ++S) {
            const f32x4 xv0 = *(const f32x4*)(xa + 16 * S), xv1 = *(const f32x4*)(xa + 16 * S + (size_t)16 * D_MODEL), gv = *(const f32x4*)(gp + 16 * S);
            float b0[4], b1[4];
#pragma unroll
            for (int q = 0; q < 4; ++q) { b0[q] = wp[(size_t)(16 * S + q) * N_EXP]; b1[q] = wp[(size_t)(16 * S + q) * N_EXP + 16]; }
            ss0 += (xv0[0] * xv0[0] + xv0[1] * xv0[1]) + (xv0[2] * xv0[2] + xv0[3] * xv0[3]);
            ss1 += (xv1[0] * xv1[0] + xv1[1] * xv1[1]) + (xv1[2] * xv1[2] + xv1[3] * xv1[3]);
#pragma unroll
            for (int q = 0; q < 4; ++q) { const float a0 = xv0[q] * gv[q], a1 = xv1[q] * gv[q];
                acc00 = __builtin_amdgcn_mfma_f32_16x16x4f32(a0, b0[q], acc00, 0, 0, 0); acc01 = __builtin_amdgcn_mfma_f32_16x16x4f32(a0, b1[q], acc01, 0, 0, 0);
                acc10 = __builtin_amdgcn_mfma_f32_16x16x4f32(a1, b0[q], acc10, 0, 0, 0); acc11 = __builtin_amdgcn_mfma_f32_16x16x4f32(a1, b1[q], acc11, 0, 0, 0); }
        }
        { LAS float* pw = PART + F.wave * 1024;
#pragma unroll
          for (int q = 0; q < 4; ++q) { const int tr = 4 * kq + q;
              pw[tr * 32 + r16] = acc00[q]; pw[tr * 32 + 16 + r16] = acc01[q]; pw[(16 + tr) * 32 + r16] = acc10[q]; pw[(16 + tr) * 32 + 16 + r16] = acc11[q]; }
          ss0 += __shfl_xor(ss0, 16); ss0 += __shfl_xor(ss0, 32); ss1 += __shfl_xor(ss1, 16); ss1 += __shfl_xor(ss1, 32);
          if (kq == 0) { SSQ[F.wave * 32 + r16] = ss0; SSQ[F.wave * 32 + 16 + r16] = ss1; } }
        __syncthreads();
        if (TID < 32) { float t = 0.f;
#pragma unroll
            for (int w = 0; w < 8; ++w) t += SSQ[w * 32 + TID];
            RS[TID] = rsqrtf(t * (1.0f / 2048.0f) + EPS); }
        __syncthreads();
        { const int tt = TID >> 4, eg = TID & 15; float s0 = 0.f, s1 = 0.f;
#pragma unroll
          for (int w = 0; w < 8; ++w) { const f32x2 v = *(const LAS f32x2*)(PART + w * 1024 + tt * 32 + 2 * eg); s0 += v[0]; s1 += v[1]; }
          const float rs = RS[tt];
          LG[tt * 32 + 2 * eg] = s0 * rs + br[2 * eg]; LG[tt * 32 + 2 * eg + 1] = s1 * rs + br[2 * eg + 1]; }
        __syncthreads();
        for (int t4 = 0; t4 < 4; ++t4) {
            const int tk = F.wave * 4 + t4;
            float cur = (lane < 32) ? LG[tk * 32 + lane] : -INFINITY;
            int i0 = 0, i1 = 0, i2 = 0, i3 = 0; float v0 = 0.f, v1 = 0.f, v2 = 0.f, v3 = 0.f;
#pragma unroll
            for (int k = 0; k < 4; ++k) {
                const float mx = wave_max(cur);
                const unsigned long long bal = __ballot(cur == mx);
                const int bi = __ffsll((long long)bal) - 1;
                if (k == 0) { i0 = bi; v0 = mx; } else if (k == 1) { i1 = bi; v1 = mx; } else if (k == 2) { i2 = bi; v2 = mx; } else { i3 = bi; v3 = mx; }
                if (lane == bi) cur = -INFINITY;
            }
            if (lane == 0) {
                const float e1 = __expf(v1 - v0), e2 = __expf(v2 - v0), e3 = __expf(v3 - v0); const float inv = 1.0f / (1.0f + e1 + e2 + e3);
                const int base = tk * 4;
                ent_e[base + 0] = i0; ent_r[base + 0] = __hip_atomic_fetch_add(&lcnt[i0], 1, __ATOMIC_RELAXED, __HIP_MEMORY_SCOPE_WORKGROUP); ent_g[base + 0] = inv;
                ent_e[base + 1] = i1; ent_r[base + 1] = __hip_atomic_fetch_add(&lcnt[i1], 1, __ATOMIC_RELAXED, __HIP_MEMORY_SCOPE_WORKGROUP); ent_g[base + 1] = e1 * inv;
                ent_e[base + 2] = i2; ent_r[base + 2] = __hip_atomic_fetch_add(&lcnt[i2], 1, __ATOMIC_RELAXED, __HIP_MEMORY_SCOPE_WORKGROUP); ent_g[base + 2] = e2 * inv;
                ent_e[base + 3] = i3; ent_r[base + 3] = __hip_atomic_fetch_add(&lcnt[i3], 1, __ATOMIC_RELAXED, __HIP_MEMORY_SCOPE_WORKGROUP); ent_g[base + 3] = e3 * inv;
            }
        }
        __syncthreads();
        if (TID < 32) { const int n = lcnt[TID]; gbase[TID] = n > 0 ? atomicAdd(&cnt[TID], n) : 0; }
        __syncthreads();
        if (TID < 128) { const int e = ent_e[TID], pos = gbase[e] + ent_r[TID], tok = tok0 + (TID >> 2);
            sel_e[tok * 4 + (TID & 3)] = e; sel_pos[tok * 4 + (TID & 3)] = pos; sel_g[tok * 4 + (TID & 3)] = ent_g[TID]; ridx[e * NTOK + pos] = tok; }
        for (int t4 = 0; t4 < 4; ++t4) { const int tk = F.wave * 4 + t4; const float rs = RS[tk];
            const f32x4* xr = (const f32x4*)(x1 + (size_t)(tok0 + tk) * D_MODEL) + lane; const f32x4* gr = (const f32x4*)g + lane; u32x2 w[8];
#pragma unroll
            for (int j = 0; j < 8; ++j) { const f32x4 v = xr[64 * j], gg = gr[64 * j]; w[j].x = pk2(v[0] * rs * gg[0], v[1] * rs * gg[1]); w[j].y = pk2(v[2] * rs * gg[2], v[3] * rs * gg[3]); }
            { u32x2* o = (u32x2*)(hn2 + (size_t)(tok0 + tk) * D_MODEL) + lane;
#pragma unroll
              for (int j = 0; j < 8; ++j) o[64 * j] = w[j]; } }
    }
    __syncthreads();
}

__device__ __forceinline__ void build_tpre(const Frame& F, int nhb) {
    const int TID = F.tid_();
    LAS int* tpre = (LAS int*)(F.lds + L_TPRE); LAS int* bid = (LAS int*)(F.lds + L_BLKID); LAS int* bpre = (LAS int*)(F.lds + L_BLKPRE); LAS int* bsz = (LAS int*)(F.lds + L_BLKPRE + 512);
    __syncthreads();
    if (TID == 0) { const int* cnt = (const int*)(F.ctl + CW_CNT); int acc = 0; for (int e = 0; e < N_EXP; ++e) { tpre[e] = acc; acc += (cnt[e] + 255) >> 8; tpre[64 + e] = cnt[e]; } tpre[N_EXP] = acc; }
    __syncthreads();
    if (nhb) {
        const int nb = N_EXP * nhb;
        if (TID < nb) {
            const int e = TID / nhb, nm = tpre[e + 1] - tpre[e]; int r = 0;
            for (int b = 0; b < nb; ++b) { const int eb = b / nhb, nmb = tpre[eb + 1] - tpre[eb]; r += (nmb > nm || (nmb == nm && b < TID)) ? 1 : 0; }
            bid[(r & 7) * 8 + (r >> 3)] = TID; bsz[(r & 7) * 8 + (r >> 3)] = nm * 8;
        }
        __syncthreads();
        if (TID < 8) { int acc = 0; bpre[TID * 9] = 0; for (int k = 0; k < 4 * nhb; ++k) { acc += bsz[TID * 8 + k]; bpre[TID * 9 + k + 1] = acc; } }
        __syncthreads();
    }
}

__device__ __forceinline__ void p8_final(const Frame& F, const Args& a) {
    const int LANE = lane_now(), TID = F.wave * 64 + LANE; (void)TID;
    const LAS int* tpre = (const LAS int*)(F.lds + L_TPRE);
    const float* x1 = (const float*)(F.ws + WS_X1); const bf16_t* Y = (const bf16_t*)(F.ws + WS_Y);
    const int* sel_e = (const int*)(F.ws + WS_SEL); const int* sel_pos = sel_e + NSLOT; const float* sel_g = (const float*)(sel_pos + NSLOT);
    const f32x4* gr = (const f32x4*)karg_in<20>() + LANE; float* outp = karg_out();
    for (int tok = F.gw; tok < NTOK; tok += F.NGW) {
        const f32x4* xr = (const f32x4*)(x1 + (size_t)tok * D_MODEL) + LANE;
        f32x4 v[8];
#pragma unroll
        for (int j = 0; j < 8; ++j) v[j] = xr[64 * j];
#pragma unroll
        for (int k = 0; k < 4; ++k) {
            const int e = sel_e[tok * 4 + k]; const size_t row = (size_t)tpre[e] * 256 + sel_pos[tok * 4 + k]; const float gk = sel_g[tok * 4 + k];
            const u32x2* yp = (const u32x2*)(Y + row * D_MODEL) + LANE;
#pragma unroll
            for (int j = 0; j < 8; ++j) { const u32x2 w = yp[64 * j]; v[j][0] += gk * bflo(w.x); v[j][1] += gk * bfhi(w.x); v[j][2] += gk * bflo(w.y); v[j][3] += gk * bfhi(w.y); }
        }
        float s = 0.f;
#pragma unroll
        for (int j = 0; j < 8; ++j) s += (v[j][0] * v[j][0] + v[j][1] * v[j][1]) + (v[j][2] * v[j][2] + v[j][3] * v[j][3]);
        const float rs = rsqrtf(wave_sum(s) * (1.0f / 2048.0f) + EPS);
        f32x4* o = (f32x4*)(outp + (size_t)tok * D_MODEL) + LANE;
#pragma unroll
        for (int j = 0; j < 8; ++j) { const f32x4 g = gr[64 * j]; o[64 * j] = (f32x4){v[j][0] * rs * g[0], v[j][1] * rs * g[1], v[j][2] * rs * g[2], v[j][3] * rs * g[3]}; }
    }
}

__device__ __forceinline__ void ph1_inproj(const Frame& F, const Args& args) {
    unsigned char* ws = F.ws;
    const int ncol = (F.G == 256) ? 4096 / 256 : IN_COLS / 256;
    g8::DenseOrder S{(const char*)(ws + WS_HN), (const char*)karg_in<2>(), NTOK / 256, ncol, (NTOK / 256) * ncol, F.G, (int)blockIdx.x, IN_COLS};
    g8::EpiBf16 E{(bf16_t*)(ws + WS_PROJ), IN_COLS, nullptr, 0};
    g8::gemm_phase<g8::EpiBf16, g8::DenseOrder>(F.lds, S, E, F.wave);
}
__device__ __forceinline__ void ph1_gate(const Frame& F, const Args& args) {
    unsigned char* ws = F.ws;
    g8::DenseOrder S{(const char*)(ws + WS_HN), (const char*)(karg_in<2>() + 4096), NTOK / 256, 4, (NTOK / 256) * 4, F.G, (int)blockIdx.x, IN_COLS};
    g8::EpiBf16 E{(bf16_t*)(ws + WS_PROJ) + 4096, IN_COLS, nullptr, 0};
    g8::gemm_phase<g8::EpiBf16, g8::DenseOrder>(F.lds, S, E, F.wave);
}
__device__ __forceinline__ void ph4_outproj(const Frame& F, const Args& args) {
    unsigned char* ws = F.ws;
    g8::DenseOrder S{(const char*)(ws + WS_MIXED), (const char*)karg_in<12>(), NTOK / 256, D_MODEL / 256, (NTOK / 256) * (D_MODEL / 256), F.G, (int)blockIdx.x, D_MODEL};
    g8::EpiResF32 E{(float*)(ws + WS_X1), karg_in<0>(), D_MODEL};
    g8::gemm_phase<g8::EpiResF32, g8::DenseOrder>(F.lds, S, E, F.wave);
}
__device__ __forceinline__ void ph6_gateup(const Frame& F, const Args& args) {
    unsigned char* ws = F.ws;
    build_tpre(F, 2);
    g8::GroupedOrderT<true> S{(const char*)(ws + WS_HN2S), (const char*)karg_in<16>(), (const LAS int*)(F.lds + L_TPRE), (const LAS int*)(F.lds + L_BLKID), (const LAS int*)(F.lds + L_BLKPRE), 2, F.G, (int)blockIdx.x, (size_t)4096 * KDIM * 4, true, 4096};
    g8::EpiSwiglu E{(bf16_t*)(ws + WS_ACT), karg_in<17>()};
    {
        LAS unsigned short* gt = (LAS unsigned short*)(F.lds + L_GTAB); const int* ridx = (const int*)(ws + WS_RIDX); const LAS int* tp = (const LAS int*)(F.lds + L_TPRE);
        const int TID = F.tid_(); int val[8];
#pragma unroll
        for (int j = 0; j < 8; ++j) { const int idx = TID + 512 * j, i = idx >> 8, r = idx & 255; g8::Unit u; val[j] = 0;
            if (S.next(i, u)) { const int pos = u.gi + r, cn = tp[64 + u.e]; val[j] = ridx[u.e * NTOK + (pos < cn ? pos : u.gi)]; } }
#pragma unroll
        for (int j = 0; j < 8; ++j) gt[TID + 512 * j] = (unsigned short)val[j];
        __syncthreads();
    }
    g8::gemm_phase<g8::EpiSwiglu, g8::GroupedOrderT<true>>(F.lds, S, E, F.wave);
}
__device__ __forceinline__ void ph7_down(const Frame& F, const Args& args) {
    unsigned char* ws = F.ws;
    build_tpre(F, 1);
    g8::GroupedOrderT<false> S{(const char*)(ws + WS_ACT), (const char*)karg_in<18>(), (const LAS int*)(F.lds + L_TPRE), (const LAS int*)(F.lds + L_BLKID), (const LAS int*)(F.lds + L_BLKPRE), 1, F.G, (int)blockIdx.x, (size_t)D_MODEL * KDIM * 4, false, D_MODEL};
    g8::EpiBf16 E{(bf16_t*)(ws + WS_Y), D_MODEL, karg_in<19>(), D_MODEL};
    g8::gemm_phase<g8::EpiBf16, g8::GroupedOrderT<false>>(F.lds, S, E, F.wave);
}

constexpr int N_PHASES = 9;
__global__ void __launch_bounds__(NTHR, 2) mk_fwd(Args args) {
    extern __shared__ __attribute__((aligned(16))) unsigned char lds_raw[];
    Frame F;
    F.lds = (LAS unsigned char*)lds_raw;
    F.wave = __builtin_amdgcn_readfirstlane((int)threadIdx.x >> 6);
    F.G = gridDim.x; { const int bx = blockIdx.x; F.vcu = (F.G % 8 == 0) ? (bx % 8) * (F.G / 8) + bx / 8 : bx; }
    F.gw = F.vcu * NWAVES + F.wave; F.NGW = F.G * NWAVES;
    F.ws = (unsigned char*)(unsigned char __attribute__((address_space(1)))*)args.ws; F.ctl = (unsigned*)(F.ws + WS_CTL);
    for (int u = F.tid_(); u < (LDS_BYTES - LDSCTL_OFF) / 4; u += NTHR) ((LAS unsigned*)(F.lds + LDSCTL_OFF))[u] = 0u;
    __syncthreads();
    const int lo = args.ph_lo, hi = args.ph_hi;
    unsigned bar_x = 0;
    if (hi - lo > 1) bar_x = __builtin_amdgcn_readfirstlane(xcd_barrier_post(F.ctl + CW_BAR, (volatile LAS unsigned*)(F.lds + L_MISC) + 8, F.tid_()).x);
#define IN(k) (lo <= (k) && (k) < hi)
#define XBAR() do { unsigned* _bp = F.ctl + CW_BAR; asm volatile("" : "+s"(_bp)); XcdBarrier _b; _b.bar = _bp; _b.x = bar_x; _b.st = (volatile LAS unsigned*)(F.lds + L_MISC) + 8; xcd_barrier(_b, F.tid_()); } while (0)
#define SEAM(k) do { if (IN(k) && IN((k) + 1)) XBAR(); } while (0)

#define PHASE(k, call) do { if (IN(k)) { call; } if ((PROBE_MASK >> (k)) & 1) { XBAR(); if (IN(k)) { call; } } } while (0)
    PHASE(0, p0_prologue(F, args)); SEAM(0);
    PHASE(1, ph1_inproj(F, args)); SEAM(1);
    if (IN(2)) { if (F.G == 256 && blockIdx.x < 128) ph1_gate(F, args); p2_mixers(F, args); } SEAM(2);
    PHASE(3, p3_mix(F, args)); SEAM(3);
    PHASE(4, ph4_outproj(F, args)); SEAM(4);
    if (IN(5)) { p5_router(F, args); } SEAM(5);
    PHASE(6, ph6_gateup(F, args)); SEAM(6);
    PHASE(7, ph7_down(F, args)); SEAM(7);
    if (IN(8)) { build_tpre(F, 0); p8_final(F, args); }
#undef IN
#undef SEAM
}

extern "C" void kernel_launch(void* const* d_in, const int* in_sizes, int n_in, void* d_out, int out_size, void* d_ws, size_t ws_size, hipStream_t stream) {
    static int grid = 0;
    if (grid == 0) {
        if (n_in != 21 || out_size != NTOK * D_MODEL || ws_size < WS_END) { fprintf(stderr, "kernel_launch: unexpected problem (n_in %d out %d ws %zu)\n", n_in, out_size, ws_size); grid = -1; return; }
        int dev = 0, cus = 0, per_cu = 0;
        if (hipGetDevice(&dev) != hipSuccess || hipDeviceGetAttribute(&cus, hipDeviceAttributeMultiprocessorCount, dev) != hipSuccess) { grid = -1; return; }
        if (hipFuncSetAttribute((const void*)mk_fwd, hipFuncAttributeMaxDynamicSharedMemorySize, LDS_BYTES) != hipSuccess) { fprintf(stderr, "kernel_launch: hipFuncSetAttribute failed\n"); grid = -1; return; }
        if (hipOccupancyMaxActiveBlocksPerMultiprocessor(&per_cu, (const void*)mk_fwd, NTHR, LDS_BYTES) != hipSuccess || per_cu < 1) { fprintf(stderr, "kernel_launch: occupancy query says %d\n", per_cu); }
        (void)hipGetLastError();
        grid = cus;
    }
    if (grid < 0) return;
    if (hipMemsetAsync((char*)d_ws + WS_CTL, 0, CTL_ZERO_BYTES, stream) != hipSuccess) return;
    Args a{};
    for (int i = 0; i < 21; ++i) a.in[i] = (const float*)d_in[i];
    a.out = (float*)d_out; a.ws = (unsigned char*)d_ws;
#if MK_N_LAUNCHES == 1
    a.ph_lo = 0; a.ph_hi = N_PHASES;
    hipLaunchKernelGGL(mk_fwd, dim3(grid), dim3(NTHR), LDS_BYTES, stream, a);
#else
    for (int p = 0; p < N_PHASES; ++p) { a.ph_lo = p; a.ph_hi = p + 1; hipLaunchKernelGGL(mk_fwd, dim3(grid), dim3(NTHR), LDS_BYTES, stream, a); }
#endif
}
```

```cpp
#include <hip/hip_runtime.h>
#include <stdint.h>
#include <stdio.h>

#ifndef MK_N_LAUNCHES
#define MK_N_LAUNCHES 1
#endif

#ifndef PROBE_MASK
#define PROBE_MASK 0
#endif
#define LAS __attribute__((address_space(3)))
#define GAS __attribute__((address_space(1)))
typedef unsigned short bf16_t;
typedef short bf16x8 __attribute__((ext_vector_type(8)));
typedef float f32x4 __attribute__((ext_vector_type(4)));
typedef float f32x2 __attribute__((ext_vector_type(2)));
typedef unsigned u32x4 __attribute__((ext_vector_type(4)));
typedef unsigned u32x2 __attribute__((ext_vector_type(2)));

constexpr int D_MODEL = 2048, BATCH = 4, SEQ = 2048, NTOK = BATCH * SEQ;
constexpr int N_HEADS = 16, ATTN_W = 1024, LRU_W = 1024;
constexpr int IN_COLS = 5120;
constexpr int N_EXP = 32, D_FF = 2048, NSLOT = NTOK * 4;
constexpr int KDIM = 2048;
constexpr float EPS = 1e-6f;
constexpr int NWAVES = 8, NTHR = 512;
constexpr int PADROWS = NSLOT + N_EXP * 256;

constexpr size_t MiB = 1u << 20;
constexpr size_t WS_CTL = 0, WS_LISTS = 1 * MiB, CTL_ZERO_BYTES = 2 * MiB;
constexpr size_t WS_SEL = 2 * MiB;
constexpr size_t WS_LRUE = 3 * MiB;
constexpr size_t WS_WIN = 4 * MiB, WS_WOUT = 24 * MiB, WS_HN = 32 * MiB, WS_PROJ = 64 * MiB, WS_ATT = 144 * MiB  , WS_HL = 192 * MiB, WS_PC = 224 * MiB;
constexpr size_t WS_MIXED = 256 * MiB, WS_X1 = 288 * MiB, WS_ACT = 352 * MiB, WS_Y = 512 * MiB, WS_WGU = 672 * MiB, WS_WDN = 1184 * MiB, WS_LSE = 1440 * MiB  , WS_HN2S = 1442 * MiB  , WS_RIDX = 1506 * MiB  , WS_END = 2466 * MiB;
static_assert((size_t)PADROWS * 2048 * 2 <= 160 * MiB, "ACT/Y size");
constexpr int CW_BAR = 4096, CW_CNT = 8192;

constexpr int RING_BYTES = 131072;
constexpr int LDSCTL_OFF = 139264;
constexpr int LDS_BYTES = 147456;
constexpr int L_GTAB = 131072;
constexpr int L_MISC = LDSCTL_OFF;
constexpr int L_TPRE = LDSCTL_OFF + 256;
constexpr int L_CNT = LDSCTL_OFF + 512;
constexpr int L_BLKID = LDSCTL_OFF + 1024;
constexpr int L_BLKPRE = LDSCTL_OFF + 1280;

__device__ __forceinline__ unsigned f2bf(float f) { unsigned u = __builtin_bit_cast(unsigned, f); return (u + 0x7fffu + ((u >> 16) & 1u)) >> 16; }
__device__ __forceinline__ unsigned pk2(float lo, float hi) { unsigned r; asm("v_cvt_pk_bf16_f32 %0, %1, %2" : "=v"(r) : "v"(lo), "v"(hi)); return r; }
__device__ __forceinline__ float bf2f(unsigned short b) { return __builtin_bit_cast(float, (unsigned)b << 16); }
__device__ __forceinline__ float bflo(unsigned w) { return __builtin_bit_cast(float, w << 16); }
__device__ __forceinline__ float bfhi(unsigned w) { return __builtin_bit_cast(float, w & 0xffff0000u); }
template <int CTRL> __device__ __forceinline__ float dpp_f(float v) { return __builtin_bit_cast(float, __builtin_amdgcn_update_dpp(0, __builtin_bit_cast(int, v), CTRL, 0xF, 0xF, true)); }
__device__ __forceinline__ float lane_f(float v, int l) { return __builtin_bit_cast(float, __builtin_amdgcn_readlane(__builtin_bit_cast(int, v), l)); }
__device__ __forceinline__ float wave_sum(float v) {
    v += dpp_f<0xB1>(v); v += dpp_f<0x4E>(v); v += dpp_f<0x141>(v); v += dpp_f<0x140>(v);
    return (lane_f(v, 0) + lane_f(v, 16)) + (lane_f(v, 32) + lane_f(v, 48));
}
__device__ __forceinline__ float wave_max(float v) {
    v = fmaxf(v, dpp_f<0xB1>(v)); v = fmaxf(v, dpp_f<0x4E>(v)); v = fmaxf(v, dpp_f<0x141>(v)); v = fmaxf(v, dpp_f<0x140>(v));
    return fmaxf(fmaxf(lane_f(v, 0), lane_f(v, 16)), fmaxf(lane_f(v, 32), lane_f(v, 48)));
}
#define LDS_WAIT() asm volatile("s_waitcnt lgkmcnt(0)" ::: "memory")
#define VM_WAIT() asm volatile("s_waitcnt vmcnt(0)" ::: "memory")

__device__ __forceinline__ int lane_now() { int l; asm volatile("v_mbcnt_lo_u32_b32 %0, -1, 0\n\tv_mbcnt_hi_u32_b32 %0, -1, %0" : "=v"(l)); return l; }

#define XB_TMO      128
#define XB_XCNT(j)  (256  + 64 * (j))
#define XB_XSUB(j)  (1280 + 64 * (j))
#define XB_XGEN(j)  (2304 + 64 * (j))
#define XB_TOP      3328
#define XB_TOPGEN   3392
#define XCD_BAR_WORDS 3456
#define XB_SPIN_CAP (1u << 20)
__device__ __forceinline__ unsigned xb_ld(unsigned* p)              { return __hip_atomic_load(p, __ATOMIC_RELAXED, __HIP_MEMORY_SCOPE_AGENT); }
__device__ __forceinline__ unsigned xb_add(unsigned* p, unsigned v) { return __hip_atomic_fetch_add(p, v, __ATOMIC_RELAXED, __HIP_MEMORY_SCOPE_AGENT); }
__device__ __forceinline__ unsigned xb_xcc_id() { return (unsigned)__builtin_amdgcn_s_getreg((3 << 11) | 20) & 0xFu; }
#define XB_SPIN(cond, bar) do { unsigned _sp = 0; while (cond) { __builtin_amdgcn_s_sleep(1); \
    if ((++_sp & 255u) == 0u) { if (xb_ld(&(bar)[XB_TMO])) break; if (_sp > XB_SPIN_CAP) { atomicAdd(&(bar)[XB_TMO], 1u); break; } } } } while (0)
struct XcdBarrier { unsigned* bar; unsigned x; volatile LAS unsigned* st; };
__device__ __forceinline__ XcdBarrier xcd_barrier_post(unsigned* bar, volatile LAS unsigned* st, int tid) {
    XcdBarrier b; b.bar = bar; b.x = xb_xcc_id(); b.st = st;
    if (tid == 0) (void)xb_add(&bar[XB_XCNT(b.x)], 1u);
    return b;
}
__device__ __forceinline__ void xcd_barrier_complete(unsigned* bar, unsigned x, unsigned& nloc, unsigned& nx) {
    const unsigned G = gridDim.x * gridDim.y * gridDim.z;
    unsigned sum, cnt, mine, sp = 0u;
    for (;;) {
        sum = 0u; cnt = 0u; mine = 0u;
#pragma unroll
        for (unsigned j = 0; j < 16; ++j) { const unsigned c = xb_ld(&bar[XB_XCNT(j)]); sum += c; cnt += (c > 0u) ? 1u : 0u; mine = (j == x) ? c : mine; }
        if (sum == G) break;
        __builtin_amdgcn_s_sleep(1);
        if ((++sp & 255u) == 0u) { if (xb_ld(&bar[XB_TMO])) break; if (sp > XB_SPIN_CAP) { atomicAdd(&bar[XB_TMO], 1u); break; } }
    }
    nloc = mine > 0u ? mine : 1u; nx = cnt > 0u ? cnt : 1u;
}
__device__ __forceinline__ void xcd_barrier(const XcdBarrier& b, int tid) {
    asm volatile("s_waitcnt vmcnt(0)" ::: "memory");
    __syncthreads();
    if (tid == 0) {
        unsigned* bar = b.bar;
        __builtin_amdgcn_s_waitcnt(0);
        unsigned nloc = b.st[0], nx = b.st[1];
        if (nloc == 0u) { xcd_barrier_complete(bar, b.x, nloc, nx); b.st[0] = nloc; b.st[1] = nx; }
        const unsigned old = xb_add(&bar[XB_XSUB(b.x)], 1u);
        const unsigned gen = old / nloc;
        if (old + 1u == (gen + 1u) * nloc) {
            __builtin_amdgcn_fence(__ATOMIC_RELEASE, "agent");
            asm volatile("s_waitcnt vmcnt(0)" ::: "memory");
            const unsigned og = xb_add(&bar[XB_TOP], 1u);
            const unsigned tg = og / nx;
            if (og + 1u == (tg + 1u) * nx) xb_add(&bar[XB_TOPGEN], 1u);
            else XB_SPIN(xb_ld(&bar[XB_TOPGEN]) == tg, bar);
            __builtin_amdgcn_fence(__ATOMIC_ACQUIRE, "agent");
            xb_add(&bar[XB_XGEN(b.x)], 1u);
            asm volatile("s_waitcnt vmcnt(0)" ::: "memory");
        } else {
            XB_SPIN(xb_ld(&bar[XB_XGEN(b.x)]) == gen, bar);
            __builtin_amdgcn_fence(__ATOMIC_ACQUIRE, "agent");
            asm volatile("s_waitcnt vmcnt(0)" ::: "memory");
        }
    }
    __syncthreads();
}

typedef float f32x16 __attribute__((ext_vector_type(16)));
typedef short s16x4 __attribute__((ext_vector_type(4)));
typedef short v4i16_t __attribute__((ext_vector_type(4)));
__device__ __forceinline__ s16x4 vtr(const LAS unsigned char* p) { return __builtin_bit_cast(s16x4, __builtin_amdgcn_ds_read_tr16_b64_v4i16((LAS v4i16_t*)p)); }

namespace g8 {
constexpr int BM = 256, BK = 64, HALF = 128, HTB = HALF * BK * 2, STAGE_BYTES = 8 * HTB, NXCD = 8, WGM = 8;
__host__ __device__ __forceinline__ int lds_byte(int r, int c) { const int st = (r >> 4) * 2 + (c >> 5), rr = r & 15, cc = c & 31, ob = rr * 64 + cc * 2; return st * 1024 + (ob ^ (((ob >> 9) & 1) << 5)); }
__host__ __device__ __forceinline__ void stage_rc(int b, int& R, int& C) { const int st = b / 1024, sb = b % 1024, swz = sb ^ (((sb >> 9) & 1) << 5); R = (st >> 1) * 16 + swz / 64; C = (st & 1) * 32 + (swz % 64) / 2; }
__host__ __device__ __forceinline__ int perm32(int rho) { const int n = rho >> 4, i = rho & 15; return 8 * (i >> 2) + 4 * n + (i & 3); }

struct Unit { const char* a; const char* b; int crow, ccol, e, gi; };

struct DenseOrder {
    static constexpr bool GATHER = false;
    const char* A; const char* Bt; int nM, nN, nwg, G, c; int ldb;
    __device__ __forceinline__ bool next(int i, Unit& u) const {
        const long L = (long)i * G + c; if (L >= nwg) return false;
        int wgid = (int)L; { const int q = nwg / NXCD, r = nwg % NXCD, xcd = wgid % NXCD, off = wgid / NXCD; wgid = (xcd < r ? xcd * (q + 1) : r * (q + 1) + (xcd - r) * q) + off; }
        const int nig = WGM * nN, gid = wgid / nig, fm = gid * WGM, gsz = (nM - fm) < WGM ? (nM - fm) : WGM;
        const int pm = fm + ((wgid % nig) % gsz), pn = (wgid % nig) / gsz;
        u.a = A + (size_t)pm * BM * KDIM * 2; u.b = Bt + (size_t)pn * BM * 4; u.crow = pm * BM; u.ccol = pn * BM; u.e = 0; u.gi = 0; return true;
    }
};
template <bool GATHER_>
struct GroupedOrderT {
    static constexpr bool GATHER = GATHER_;
    const char* A; const char* Bt; const LAS int* tpre; const LAS int* bid; const LAS int* bpre; int nhb, G, c; size_t bstride;
    bool capA; int ldb;
    __device__ __forceinline__ bool next(int i, Unit& u) const {
        const int per = G >> 3, x = c & 7, j = c >> 3, Lx = i * per + j, nslots = 4 * nhb;
        const LAS int* bp = bpre + x * 9;
        if (Lx >= __builtin_amdgcn_readfirstlane(bp[nslots])) return false;
        int k = 0; while (Lx >= __builtin_amdgcn_readfirstlane(bp[k + 1])) ++k;
        const int b = __builtin_amdgcn_readfirstlane(bid[x * 8 + k]), within = Lx - __builtin_amdgcn_readfirstlane(bp[k]);
        const int e = b / nhb, hb = b - e * nhb, mt = within >> 3, nt = hb * 8 + (within & 7);
        const int mtile = __builtin_amdgcn_readfirstlane(tpre[e]) + mt;
        u.a = GATHER ? A : A + (capA ? ((size_t)e * NTOK + (size_t)mt * BM) : (size_t)mtile * BM) * KDIM * 2;
        u.b = Bt + (size_t)e * bstride + (size_t)nt * BM * 4; u.crow = mtile * BM; u.ccol = nt * BM; u.e = e; u.gi = mt * BM; return true;
    }
};

__device__ __forceinline__ unsigned cvt_pk_bf16(float lo, float hi) { unsigned r; asm volatile("v_cvt_pk_bf16_f32 %0, %1, %2" : "=v"(r) : "v"(lo), "v"(hi)); return r; }

struct EpiBf16 {
    bf16_t* O; int ldc; const float* bias; int bias_stride;
    struct Pre { f32x4 b[2][2]; __device__ __forceinline__ f32x4 init(int bj, int n) const { return b[bj][n]; } };
    __device__ __forceinline__ Pre pre(const Unit& u, int wc, int fq) const { Pre p; const int col0 = u.ccol + wc * 32 + 8 * (((fq & 1) << 1) | (fq >> 1));
#pragma unroll
        for (int bj = 0; bj < 2; ++bj)
#pragma unroll
            for (int n = 0; n < 2; ++n) p.b[bj][n] = bias ? *(const f32x4*)(bias + (size_t)u.e * bias_stride + col0 + bj * HALF + 4 * n) : (f32x4){0.f, 0.f, 0.f, 0.f};
        return p; }
    __device__ __forceinline__ void operator()(const f32x4 (&acc)[2][2][4][2], const Unit& u, int wr, int wc, int fr, int fq, const Pre& pr) const {
        const int row0 = u.crow + wr * 64 + fr, col0 = u.ccol + wc * 32 + 8 * (((fq & 1) << 1) | (fq >> 1));
#pragma unroll
        for (int bj = 0; bj < 2; ++bj) {
#pragma unroll
            for (int ai = 0; ai < 2; ++ai)
#pragma unroll
                for (int m = 0; m < 4; ++m) { const f32x4 v0 = acc[ai][bj][m][0], v1 = acc[ai][bj][m][1];
                    u32x4 w; w.x = cvt_pk_bf16(v0[0], v0[1]); w.y = cvt_pk_bf16(v0[2], v0[3]); w.z = cvt_pk_bf16(v1[0], v1[1]); w.w = cvt_pk_bf16(v1[2], v1[3]);
                    *(u32x4*)(O + (size_t)(row0 + ai * HALF + m * 16) * ldc + col0 + bj * HALF) = w; } }
    }
};
struct EpiResF32 {
    float* C; const float* res; int ldc;
    struct Pre { __device__ __forceinline__ f32x4 init(int, int) const { return (f32x4){0.f, 0.f, 0.f, 0.f}; } };
    __device__ __forceinline__ Pre pre(const Unit&, int, int) const { return Pre{}; }
    __device__ __forceinline__ void operator()(const f32x4 (&acc)[2][2][4][2], const Unit& u, int wr, int wc, int fr, int fq, const Pre&) const {
        const int row0 = u.crow + wr * 64 + fr, col0 = u.ccol + wc * 32 + 8 * (((fq & 1) << 1) | (fq >> 1));
#pragma unroll
        for (int ai = 0; ai < 2; ++ai)
#pragma unroll
            for (int m = 0; m < 4; ++m) { const size_t off = (size_t)(row0 + ai * HALF + m * 16) * ldc + col0;
#pragma unroll
                for (int bj = 0; bj < 2; ++bj)
#pragma unroll
                    for (int n = 0; n < 2; ++n) { const f32x4 r = *(const f32x4*)(res + off + bj * HALF + n * 4); *(f32x4*)(C + off + bj * HALF + n * 4) = acc[ai][bj][m][n] + r; } }
    }
};
struct EpiSwiglu {
    bf16_t* O; const float* bias;
    __device__ __forceinline__ float act(float g, float up) const {
        g = fminf(g, 7.0f); up = fminf(fmaxf(up, -7.0f), 7.0f);
        const float sg = __builtin_amdgcn_rcpf(1.0f + __builtin_amdgcn_exp2f(-2.4554670416f * g));
        const float gs = g * sg; return __builtin_fmaf(gs, up, gs);
    }
    struct Pre { f32x4 b[2][2]; __device__ __forceinline__ f32x4 init(int bj, int n) const { return b[bj][n]; } };
    __device__ __forceinline__ Pre pre(const Unit& u, int wc, int fq) const { Pre p; const int col0 = u.ccol + wc * 32 + 8 * (((fq & 1) << 1) | (fq >> 1));
#pragma unroll
        for (int bj = 0; bj < 2; ++bj)
#pragma unroll
            for (int n = 0; n < 2; ++n) p.b[bj][n] = *(const f32x4*)(bias + (size_t)u.e * (2 * D_FF) + col0 + bj * HALF + 4 * n);
        return p; }
    __device__ __forceinline__ void operator()(const f32x4 (&acc)[2][2][4][2], const Unit& u, int wr, int wc, int fr, int fq, const Pre& pr) const {
        const int pf = ((fq & 1) << 1) | (fq >> 1);
        const int row0 = u.crow + wr * 64 + fr, col0 = u.ccol + wc * 32 + 8 * pf;
        const bool up = fq >= 2;
#pragma unroll
        for (int bj = 0; bj < 2; ++bj) {
#pragma unroll
            for (int ai = 0; ai < 2; ++ai) {
                u32x2 w[4];
#pragma unroll
                for (int m = 0; m < 4; ++m) { const f32x4 v0 = acc[ai][bj][m][0], v1 = acc[ai][bj][m][1];
                    w[m].x = cvt_pk_bf16(act(v0[0], v0[1]), act(v0[2], v0[3])); w[m].y = cvt_pk_bf16(act(v1[0], v1[1]), act(v1[2], v1[3])); }
#pragma unroll
                for (int mp = 0; mp < 2; ++mp) { unsigned ax = w[2 * mp].x, ay = w[2 * mp].y, bx = w[2 * mp + 1].x, by = w[2 * mp + 1].y;
                    asm volatile("s_nop 1\n\tv_permlane32_swap_b32 %0, %1" : "+v"(ax), "+v"(bx));
                    asm volatile("s_nop 1\n\tv_permlane32_swap_b32 %0, %1" : "+v"(ay), "+v"(by));
                    const int mrow = 2 * mp + (up ? 1 : 0), ccolact = ((col0 + bj * HALF) >> 1) - (up ? 4 : 0);
                    u32x4 o; o.x = ax; o.y = ay; o.z = bx; o.w = by;
                    *(u32x4*)(O + (size_t)(row0 + ai * HALF + mrow * 16) * D_FF + ccolact) = o; }
            }
        }
    }
};


template <class Epi, class Sched>
__device__ __forceinline__ void gemm_phase(LAS unsigned char* lds, const Sched& S, const Epi& E, int wave) {
    const int wid = wave, lane = lane_now(), tid = wid * 64 + lane, wr = wid >> 2, wc = wid & 3;
    constexpr int K = KDIM, nt = K / BK;
    unsigned voffA[2];
#pragma unroll
    for (int i = 0; i < 2; ++i) { int R, C; stage_rc(tid * 16 + i * 8192, R, C); voffA[i] = (unsigned)(R * K + C) * 2u; }
    unsigned goff[2][2];
#define G8_GOFF(h, unit_idx) do { const int _t = wid * 64 + lane_now(); const LAS unsigned short* _g = (const LAS unsigned short*)(lds + L_GTAB) + ((unit_idx) & 15) * 256 + 128 * (h); \
        _Pragma("unroll") for (int i = 0; i < 2; ++i) { int R, C; stage_rc(_t * 16 + i * 8192, R, C); goff[h][i] = (unsigned)_g[R] * (unsigned)(K * 2) + (unsigned)C * 2u; } } while (0)
    const int ldb = S.ldb;
    constexpr size_t kstep = (size_t)(BK * 2);
    constexpr size_t hstep = (size_t)HALF * K * 2;
    const size_t kstepB = (size_t)BK * ldb * 4;
    constexpr size_t hstepB = 512;
    const size_t jstepB = (size_t)16 * ldb * 4;
    const unsigned bvoff = (unsigned)((tid >> 5) * ldb * 4 + (tid & 31) * 16);
    const unsigned ldsbase = (unsigned)(size_t)lds;
    unsigned wbase;
    { const int k0 = tid >> 5, q = tid & 31, f = 2 * ((k0 & 3) + 4 * ((k0 >> 3) & 1)); wbase = ldsbase + (unsigned)(k0 * 256 + (((q >> 1) ^ f) * 16) + (q & 1) * 8); }
    const unsigned ldsw = (unsigned)wid * 1024u;
    const unsigned la0 = __builtin_amdgcn_readfirstlane(ldsbase + ldsw);
    const int fr = lane & 15, fq = lane >> 4;
    const int aoff = lds_byte(wr * 64 + fr, fq * 8);
    int bb[2];
    { const int q = (lane & 15) >> 2, p = lane & 3, f = 2 * (q + 4 * (fq & 1));
#pragma unroll
      for (int nf = 0; nf < 2; ++nf) { const int ch = 4 * wc + (((p & 1) << 1) | (p >> 1)); bb[nf] = (8 * fq + q) * 256 + ((ch ^ f) * 16) + nf * 8; } }
#define G8_SA(b, h) (((b) * 2 + (h)) * HTB)
#define G8_SB(b, h) ((4 + (b) * 2 + (h)) * HTB)
#define G8_GLDS(ldsaddr, voff, gbase) asm volatile("s_mov_b32 m0, %0\n\ts_nop 0\n\tglobal_load_lds_dwordx4 %1, %2" :: "s"(ldsaddr), "v"(voff), "s"(gbase) : "memory")
#define G8_STAGE_A(bufoff, gbase, h) do { const unsigned _la = la0 + (unsigned)(bufoff); if (Sched::GATHER) { \
        G8_GLDS(_la, goff[h][0], (const char*)(gbase)); G8_GLDS(_la + 8192u, goff[h][1], (const char*)(gbase)); } else { const char* _gb = (const char*)(gbase) + (h) * hstep; \
        G8_GLDS(_la, voffA[0], _gb); G8_GLDS(_la + 8192u, voffA[1], _gb); } } while (0)
#define G8_LOADB(R, ptr) do { const char* _p = (const char*)(ptr); \
        asm volatile("global_load_dwordx4 %0, %1, %2" : "=&v"(R##0) : "v"(bvoff), "s"(_p) : "memory"); _p += jstepB; \
        asm volatile("global_load_dwordx4 %0, %1, %2" : "=&v"(R##1) : "v"(bvoff), "s"(_p) : "memory"); _p += jstepB; \
        asm volatile("global_load_dwordx4 %0, %1, %2" : "=&v"(R##2) : "v"(bvoff), "s"(_p) : "memory"); _p += jstepB; \
        asm volatile("global_load_dwordx4 %0, %1, %2" : "=&v"(R##3) : "v"(bvoff), "s"(_p) : "memory"); } while (0)
#define G8_CVT2(R) do { R[0] = __builtin_bit_cast(float, cvt_pk_bf16(R[0], R[1])); R[1] = __builtin_bit_cast(float, cvt_pk_bf16(R[2], R[3])); } while (0)
#define G8_LO2(R) __builtin_shufflevector(R, R, 0, 1)
#define G8_CVTW(R, bufoff, N) do { asm volatile("s_waitcnt vmcnt(" #N ")" : "+v"(R##0), "+v"(R##1), "+v"(R##2), "+v"(R##3) :: "memory"); __builtin_amdgcn_sched_barrier(0); \
        const unsigned _wa = wbase + (unsigned)(bufoff); G8_CVT2(R##0); G8_CVT2(R##1); G8_CVT2(R##2); G8_CVT2(R##3); \
        asm volatile("ds_write_b64 %0, %1\n\tds_write_b64 %0, %2 offset:4096\n\tds_write_b64 %0, %3 offset:8192\n\tds_write_b64 %0, %4 offset:12288" :: "v"(_wa), "v"(G8_LO2(R##0)), "v"(G8_LO2(R##1)), "v"(G8_LO2(R##2)), "v"(G8_LO2(R##3)) : "memory"); } while (0)
#define G8_LDA(dst, b, h) do { _Pragma("unroll") for (int m = 0; m < 4; ++m) _Pragma("unroll") for (int k = 0; k < 2; ++k) dst[m][k] = *(const LAS bf16x8*)(lds + G8_SA(b, h) + aoff + m * 2048 + k * 1024); } while (0)
#define G8_TR(dst, addr, off) asm volatile("ds_read_b64_tr_b16 %0, %1 offset:%2" : "=v"(dst) : "v"(addr), "i"(off) : "memory")
#define G8_LDB(lo, hi, b, h) do { _Pragma("unroll") for (int n = 0; n < 2; ++n) { const unsigned _ad = ldsbase + (unsigned)(G8_SB(b, h)) + (unsigned)bb[n]; \
        G8_TR(lo[n][0], _ad, 0); G8_TR(hi[n][0], _ad, 1024); G8_TR(lo[n][1], _ad, 8192); G8_TR(hi[n][1], _ad, 9216); } } while (0)
#define G8_BF(lo, hi, n, k) __builtin_shufflevector(lo[n][k], hi[n][k], 0, 1, 2, 3, 4, 5, 6, 7)
#define G8_MMA(ai, bj, At, Bl, Bh) do { __builtin_amdgcn_s_setprio(1); _Pragma("unroll") for (int m = 0; m < 4; ++m) _Pragma("unroll") for (int n = 0; n < 2; ++n) _Pragma("unroll") for (int k = 0; k < 2; ++k) \
        acc[ai][bj][m][n] = __builtin_amdgcn_mfma_f32_16x16x32_bf16(G8_BF(Bl, Bh, n, k), At[m][k], acc[ai][bj][m][n], 0, 0, 0); __builtin_amdgcn_s_setprio(0); } while (0)
#define G8_WAIT_V(n) asm volatile("s_waitcnt vmcnt(" #n ")" ::: "memory")
#define G8_WAIT_L(n) do { asm volatile("s_waitcnt lgkmcnt(" #n ")" ::: "memory"); __builtin_amdgcn_sched_barrier(0); } while (0)
#define G8_BAR __builtin_amdgcn_s_barrier()
#define G8_SCHED __builtin_amdgcn_sched_barrier(0)
    Unit cur, nxt; int ui = 0;
    if (!S.next(0, cur)) return;
    f32x4 acc[2][2][4][2];
    { const typename Epi::Pre p0 = E.pre(cur, wc, lane_now() >> 4);
#pragma unroll
    for (int a = 0; a < 2; ++a)
#pragma unroll
        for (int b = 0; b < 2; ++b)
#pragma unroll
            for (int m = 0; m < 4; ++m)
#pragma unroll
                for (int n = 0; n < 2; ++n) acc[a][b][m][n] = p0.init(b, n); }
    bf16x8 At[4][2]; s16x4 B0l[2][2], B0h[2][2], B1l[2][2], B1h[2][2];
    f32x4 RA0, RA1, RA2, RA3, RB0, RB1, RB2, RB3;
    const char* cA = cur.a; const char* cB = cur.b;
    if (Sched::GATHER) { G8_GOFF(0, 0); G8_GOFF(1, 0); }
    G8_STAGE_A(G8_SA(0, 0), cA, 0); G8_STAGE_A(G8_SA(0, 1), cA, 1);
    G8_LOADB(RA, cB); G8_LOADB(RB, cB + hstepB);
    G8_CVTW(RA, G8_SB(0, 0), 4); G8_LOADB(RA, cB + kstepB);
    G8_CVTW(RB, G8_SB(0, 1), 4); G8_LOADB(RB, cB + kstepB + hstepB);
    G8_CVTW(RA, G8_SB(1, 0), 4); G8_LOADB(RA, cB + 2 * kstepB);
    G8_STAGE_A(G8_SA(1, 0), cA + kstep, 0);
    G8_CVTW(RB, G8_SB(1, 1), 6); G8_LOADB(RB, cB + 2 * kstepB + hstepB);
    G8_WAIT_L(0);
    if (wr == 1) G8_BAR;
    G8_BAR;
    const char* aq = cA + kstep; const char* bq = cB + 3 * kstepB;
    for (;;) {
        const bool has_next = S.next(ui + 1, nxt);
        const char* nA = has_next ? nxt.a : cA; const char* nB = has_next ? nxt.b : cB;
        for (int t = 0; t < nt; t += 2) {
            if (Sched::GATHER && t == nt - 2 && has_next) G8_GOFF(0, ui + 1);
            G8_LDB(B0l, B0h, 0, 0); G8_SCHED; G8_LDA(At, 0, 0); G8_STAGE_A(G8_SA(1, 1), aq, 1); aq = (t == nt - 2) ? nA : aq + kstep;
            G8_WAIT_L(8); G8_BAR; G8_WAIT_L(0); G8_MMA(0, 0, At, B0l, B0h); G8_BAR; G8_SCHED;
            if (Sched::GATHER && t == nt - 2 && has_next) G8_GOFF(1, ui + 1);
            G8_LDB(B1l, B1h, 0, 1); G8_CVTW(RA, G8_SB(0, 0), 8); G8_LOADB(RA, bq);
            G8_BAR; G8_WAIT_L(0); G8_MMA(0, 1, At, B1l, B1h); G8_BAR; G8_SCHED;
            G8_LDA(At, 0, 1); G8_STAGE_A(G8_SA(0, 0), aq, 0);
            G8_BAR; G8_WAIT_L(0); G8_MMA(1, 0, At, B0l, B0h); G8_BAR; G8_SCHED;
            G8_CVTW(RB, G8_SB(0, 1), 6); G8_LOADB(RB, bq + hstepB); bq = (t == nt - 4) ? nB : bq + kstepB;
            G8_BAR; G8_WAIT_L(0); G8_MMA(1, 1, At, B1l, B1h); G8_BAR; G8_SCHED;
            G8_LDB(B0l, B0h, 1, 0); G8_SCHED; G8_LDA(At, 1, 0); G8_STAGE_A(G8_SA(0, 1), aq, 1); aq += kstep;
            G8_WAIT_L(8); G8_BAR; G8_WAIT_L(0); G8_MMA(0, 0, At, B0l, B0h); G8_BAR; G8_SCHED;
            G8_LDB(B1l, B1h, 1, 1); G8_CVTW(RA, G8_SB(1, 0), 8); G8_LOADB(RA, bq);
            G8_BAR; G8_WAIT_L(0); G8_MMA(0, 1, At, B1l, B1h); G8_BAR; G8_SCHED;
            G8_LDA(At, 1, 1); G8_STAGE_A(G8_SA(1, 0), aq, 0);
            G8_BAR; G8_WAIT_L(0); G8_MMA(1, 0, At, B0l, B0h); G8_BAR; G8_SCHED;
            G8_CVTW(RB, G8_SB(1, 1), 6); G8_LOADB(RB, bq + hstepB); bq += kstepB;
            G8_BAR; G8_WAIT_L(0); G8_MMA(1, 1, At, B1l, B1h); G8_BAR; G8_SCHED;
        }
        const typename Epi::Pre epre = E.pre(has_next ? nxt : cur, wc, lane_now() >> 4);
        asm volatile("s_waitcnt vmcnt(0)" : "+v"(RA0), "+v"(RA1), "+v"(RA2), "+v"(RA3), "+v"(RB0), "+v"(RB1), "+v"(RB2), "+v"(RB3) :: "memory"); __builtin_amdgcn_sched_barrier(0);
        { const int le = lane_now(); E(acc, cur, wr, wc, le & 15, le >> 4, epre); }
        if (!has_next) break;
#pragma unroll
        for (int a = 0; a < 2; ++a)
#pragma unroll
            for (int b = 0; b < 2; ++b)
#pragma unroll
                for (int m = 0; m < 4; ++m)
#pragma unroll
                    for (int n = 0; n < 2; ++n) acc[a][b][m][n] = epre.init(b, n);
        cur = nxt; cA = nA; cB = nB; ++ui;
    }
    G8_WAIT_V(0);
    asm volatile("" :: "v"(RA0), "v"(RA1), "v"(RA2), "v"(RA3), "v"(RB0), "v"(RB1), "v"(RB2), "v"(RB3));
    if (wr == 0) G8_BAR;
    G8_BAR;
#undef G8_SA
#undef G8_SB
#undef G8_STAGE_A
#undef G8_GLDS
#undef G8_GOFF
#undef G8_LOADB
#undef G8_CVTW
#undef G8_CVT2
#undef G8_LO2
#undef G8_LDA
#undef G8_TR
#undef G8_LDB
#undef G8_BF
#undef G8_MMA
#undef G8_WAIT_V
#undef G8_WAIT_L
#undef G8_BAR
#undef G8_SCHED
}
}

struct Frame {
    LAS unsigned char* lds;
    unsigned* ctl; unsigned char* ws;
    int wave, vcu, G, gw, NGW;
    __device__ __forceinline__ int lane_() const { return lane_now(); }
    __device__ __forceinline__ int tid_() const { return wave * 64 + lane_now(); }
};
struct Args { const float* in[21]; float* out; unsigned char* ws; int ph_lo, ph_hi; };
template <int OFF> __device__ __forceinline__ unsigned long long karg_u64() { const auto kp = __builtin_amdgcn_kernarg_segment_ptr(); unsigned long long v;
    asm volatile("s_load_dwordx2 %0, %1, %2\n\ts_waitcnt lgkmcnt(0)" : "=s"(v) : "s"(kp), "i"(OFF)); return v; }
typedef const float __attribute__((address_space(1)))* gcf_ptr; typedef float __attribute__((address_space(1)))* gf_ptr;
template <int I> __device__ __forceinline__ const float* karg_in() { return (const float*)(gcf_ptr)karg_u64<8 * I>(); }
__device__ __forceinline__ float* karg_out() { return (float*)(gf_ptr)karg_u64<8 * 21>(); }


constexpr long CV_IN = (long)KDIM * IN_COLS / 512, CV_OUT = (long)KDIM * D_MODEL / 512, CV_GU = (long)N_EXP * KDIM * 4096 / 512, CV_DN = (long)N_EXP * KDIM * D_MODEL / 512;
__device__ __forceinline__ void conv_chunks(const float* __restrict__ src, bf16_t* __restrict__ dst, long c0, long c1, int gw, int NGW, int lane) {
    long c = c0 + gw;
    for (; c + 7L * NGW < c1; c += 8L * NGW) {
        f32x4 a[8], b[8];
#pragma unroll
        for (int i = 0; i < 8; ++i) { const f32x4* p = (const f32x4*)(src + (c + (long)i * NGW) * 512 + lane * 8); a[i] = __builtin_nontemporal_load(p); b[i] = __builtin_nontemporal_load(p + 1); }
#pragma unroll
        for (int i = 0; i < 8; ++i) { u32x4 w; w.x = pk2(a[i][0], a[i][1]); w.y = pk2(a[i][2], a[i][3]); w.z = pk2(b[i][0], b[i][1]); w.w = pk2(b[i][2], b[i][3]);
            __builtin_nontemporal_store(w, (u32x4*)(dst + (c + (long)i * NGW) * 512 + lane * 8)); }
    }
    for (; c < c1; c += NGW) { const f32x4* p = (const f32x4*)(src + c * 512 + lane * 8); const f32x4 a = __builtin_nontemporal_load(p), b = __builtin_nontemporal_load(p + 1);
        u32x4 w; w.x = pk2(a[0], a[1]); w.y = pk2(a[2], a[3]); w.z = pk2(b[0], b[1]); w.w = pk2(b[2], b[3]); __builtin_nontemporal_store(w, (u32x4*)(dst + c * 512 + lane * 8)); }
}
__device__ __forceinline__ void rms_row_bf16(const float* xrow, const float* g, bf16_t* orow, int lane) {
    const f32x4* xr = (const f32x4*)xrow + lane; const f32x4* gr = (const f32x4*)g + lane;
    f32x4 v[8]; float s = 0.f;
#pragma unroll
    for (int j = 0; j < 8; ++j) { v[j] = xr[64 * j]; s += (v[j][0] * v[j][0] + v[j][1] * v[j][1]) + (v[j][2] * v[j][2] + v[j][3] * v[j][3]); }
    const float rs = rsqrtf(wave_sum(s) * (1.0f / 2048.0f) + EPS);
    u32x2* o = (u32x2*)orow + lane;
#pragma unroll
    for (int j = 0; j < 8; ++j) { const f32x4 gg = gr[64 * j]; u32x2 w; w.x = pk2(v[j][0] * rs * gg[0], v[j][1] * rs * gg[1]); w.y = pk2(v[j][2] * rs * gg[2], v[j][3] * rs * gg[3]); o[64 * j] = w; }
}
__device__ __forceinline__ void p0_prologue(const Frame& F, const Args& a) {
    const int LANE = lane_now(), TID = F.wave * 64 + LANE; (void)TID;
    bf16_t* HN = (bf16_t*)(F.ws + WS_HN);
    const float* xin = karg_in<0>(); const float* nw = karg_in<1>();
    for (int m = F.gw; m < NTOK; m += F.NGW) rms_row_bf16(xin + (size_t)m * D_MODEL, nw, HN + (size_t)m * D_MODEL, LANE);
}

__device__ __forceinline__ float gelu_tanh(float x) { const float u = 0.7978845608028654f * (x + 0.044715f * x * x * x); return x * __builtin_amdgcn_rcpf(1.0f + __expf(-2.0f * u)); }
__device__ __forceinline__ float sigmoidf_(float x) { return __builtin_amdgcn_rcpf(1.0f + __expf(-x)); }
__device__ __forceinline__ void lru_unit(const Frame& F, const Args& a, int unit) {
    const int lane = lane_now();
    const int b = unit >> 9, k = (unit >> 4) & 31, blk = unit & 15;
    const bf16_t* proj = (const bf16_t*)(F.ws + WS_PROJ);
    LAS float* xs = (LAS float*)(F.lds + F.wave * 16384);
    const int ch = blk * 64 + lane;
    const float* cwp = karg_in<3>();
    const float cw0 = cwp[0 * LRU_W + ch], cw1 = cwp[1 * LRU_W + ch], cw2 = cwp[2 * LRU_W + ch], cw3 = cwp[3 * LRU_W + ch], cb = karg_in<4>()[ch];
    const int t0 = k * 64; const size_t row0 = (size_t)b * SEQ + t0;
    const bf16_t* xp = proj + row0 * IN_COLS + 3 * ATTN_W + ch;
    float xv[67];
#pragma unroll
    for (int i = 0; i < 67; ++i) xv[i] = (i >= 3 || t0 > 0) ? bf2f(xp[(i - 3) * IN_COLS]) : 0.f;
#define XS(t, c) ((t) * 64 + (((((c) >> 2) ^ ((t) & 15)) << 2) | ((c) & 3)))
#pragma unroll
    for (int t = 0; t < 64; ++t) xs[XS(t, lane)] = cb + cw0 * xv[t] + cw1 * xv[t + 1] + cw2 * xv[t + 2] + cw3 * xv[t + 3];
    const int c32 = lane & 31, hh = lane >> 5, xaddr = (lane ^ 32) << 2;
    bf16x8 wf[2][2][4];
#pragma unroll
    for (int g = 0; g < 2; ++g) { const float* wp = (g == 0 ? karg_in<5>() : karg_in<7>()) + (size_t)blk * 4096 + c32 + 512 * hh;
#pragma unroll
        for (int j = 0; j < 2; ++j)
#pragma unroll
            for (int s4 = 0; s4 < 4; ++s4) { const float* p = wp + 1024 * s4 + 32 * j; union { bf16x8 v; unsigned u[4]; } pk;
#pragma unroll
                for (int e = 0; e < 4; ++e) pk.u[e] = g8::cvt_pk_bf16(p[128 * e], p[128 * e + 64]);
                wf[g][j][s4] = pk.v; } }
    const float ba = karg_in<6>()[ch], bx = karg_in<8>()[ch];
    const float sp = log1pf(__expf(-karg_in<9>()[ch])); const float csp = -8.0f * 1.4426950408889634f * sp;
    bf16_t* hl = (bf16_t*)(F.ws + WS_HL) + row0 * LRU_W + ch; bf16_t* pc = (bf16_t*)(F.ws + WS_PC) + row0 * LRU_W + ch;
    LDS_WAIT();
    float h = 0.f, P = 1.f;
#pragma unroll 1
    for (int mt = 0; mt < 2; ++mt) {
        f32x16 acc[2][2];
#pragma unroll
        for (int g = 0; g < 2; ++g)
#pragma unroll
            for (int j = 0; j < 2; ++j)
#pragma unroll
                for (int i = 0; i < 16; ++i) acc[g][j][i] = 0.f;
        { const int tr = 32 * mt + c32;
#pragma unroll
          for (int s4 = 0; s4 < 4; ++s4) { const int g0 = 4 * s4 + 2 * hh;
              const f32x4 x0 = *(const LAS f32x4*)(xs + tr * 64 + ((g0 ^ (tr & 15)) << 2)), x1 = *(const LAS f32x4*)(xs + tr * 64 + (((g0 + 1) ^ (tr & 15)) << 2));
              union { bf16x8 v; unsigned u[4]; } pk; pk.u[0] = g8::cvt_pk_bf16(x0[0], x0[1]); pk.u[1] = g8::cvt_pk_bf16(x0[2], x0[3]); pk.u[2] = g8::cvt_pk_bf16(x1[0], x1[1]); pk.u[3] = g8::cvt_pk_bf16(x1[2], x1[3]);
#pragma unroll
              for (int g = 0; g < 2; ++g)
#pragma unroll
                  for (int j = 0; j < 2; ++j) acc[g][j] = __builtin_amdgcn_mfma_f32_32x32x16_bf16(pk.v, wf[g][j][s4], acc[g][j], 0, 0, 0); } }
        __builtin_amdgcn_sched_barrier(0); asm volatile("s_nop 15\n\ts_nop 15" ::: "memory"); __builtin_amdgcn_sched_barrier(0);
        float own[2][16], rcv[2][16];
#pragma unroll
        for (int g = 0; g < 2; ++g)
#pragma unroll
            for (int i = 0; i < 16; ++i) { float a0 = acc[g][0][i], a1 = acc[g][1][i];
                asm volatile("s_nop 1\n\tv_permlane32_swap_b32 %0, %1" : "+v"(a0), "+v"(a1));
                own[g][i] = hh ? a1 : a0; rcv[g][i] = hh ? a0 : a1; }
#pragma unroll 1
        for (int q = 0; q < 4; ++q) {
#pragma unroll
            for (int t8 = 0; t8 < 8; ++t8) { const int idx = t8 & 3, t = 32 * mt + 8 * q + t8; const bool mine = (((t8 >> 2) & 1) != 0) == (hh != 0);
                float r = (mine ? own[0][idx] : rcv[0][idx]) + ba, ii = (mine ? own[1][idx] : rcv[1][idx]) + bx;
                r = sigmoidf_(r); ii = sigmoidf_(ii);
                const float av = __builtin_amdgcn_exp2f(r * csp);
                const float bv = __builtin_amdgcn_sqrtf(fmaf(-av, av, 1.0f)) * (ii * xs[XS(t, lane)]);
                h = av * h + bv; P *= av;
                { const unsigned hp = pk2(h, P); hl[(size_t)t * LRU_W] = (bf16_t)(hp & 0xffffu); pc[(size_t)t * LRU_W] = (bf16_t)(hp >> 16); } }
#pragma unroll
            for (int g = 0; g < 2; ++g)
#pragma unroll
                for (int i = 0; i < 12; ++i) { own[g][i] = own[g][i + 4]; rcv[g][i] = rcv[g][i + 4]; }
        }
    }
#undef XS
    float* ae = (float*)(F.ws + WS_LRUE); float* he = ae + 4 * 32 * 1024;
    ae[(size_t)(b * 32 + k) * 1024 + ch] = P; he[(size_t)(b * 32 + k) * 1024 + ch] = h;
    LDS_WAIT();
}
constexpr int VP = 192;
constexpr int KP = 144;
__device__ __forceinline__ void attn_unit(const Frame& F, const Args& a, int u) {
    const int lane = lane_now();
    const int c = lane & 31, hh = lane >> 5, xaddr = (lane ^ 32) << 2;
    const int br = u >> 12, rem = u & 4095, bh = rem >> 6, qt = rem & 63;
    const int b = bh >> 4, h = bh & 15;
    const int dsh = br * 2, d = 1 << dsh;
    const int r = qt & (d - 1), ltile = qt >> dsh, l0 = ltile * 32;
    const bf16_t* proj = (const bf16_t*)(F.ws + WS_PROJ) + (size_t)b * SEQ * IN_COLS + h * 64;
    LAS unsigned char* vl = F.lds + F.wave * 16384;
    bf16x8 qf[4];
    {
      const int qrow_ = lane >> 3, qch = lane & 7; const char* qb = (const char*)proj + (size_t)(l0 * d + r) * (size_t)(IN_COLS * 2) + (size_t)qrow_ * ((size_t)d * (IN_COLS * 2)) + qch * 16;
      u32x4 qr[4];
#pragma unroll
      for (int i = 0; i < 4; ++i) qr[i] = *(const u32x4*)(qb + (size_t)(8 * i) * ((size_t)d * (IN_COLS * 2)));
#pragma unroll
      for (int i = 0; i < 4; ++i) *(LAS u32x4*)(vl + 32 * VP + (qrow_ + 8 * i) * KP + qch * 16) = qr[i];
#pragma unroll
      for (int s = 0; s < 4; ++s) qf[s] = *(const LAS bf16x8*)(vl + 32 * VP + c * KP + 16 * hh + 32 * s); }
    constexpr float LOG2E = 1.4426950408889634f;
    const float slope2 = exp2f(-0.5f * (float)(h + 1)) * LOG2E * (float)d;
    const float sc2 = 0.125f * LOG2E;
    float m = -INFINITY, lsum = 0.f;
    float kb[16];
#pragma unroll
    for (int i = 0; i < 16; ++i) { kb[i] = slope2 * (float)((i & 3) + 8 * (i >> 2) + 4 * hh); asm volatile("" : "+v"(kb[i])); }
    f32x16 o0, o1;
#pragma unroll
    for (int i = 0; i < 16; ++i) { o0[i] = 0.f; o1[i] = 0.f; }
    const int jfirst = ltile >= 4 ? 0 : 4 - ltile;
    u32x4 kr[3][4]; u32x4 vr[3][4];
    const int vrow = lane >> 3, vch = lane & 7;
    const unsigned rowb = (unsigned)d * (unsigned)(IN_COLS * 2);
    const unsigned kvo = (unsigned)vrow * rowb + (unsigned)((ATTN_W + vch * 8) * 2);
    const unsigned vvo = (unsigned)vrow * rowb + (unsigned)((2 * ATTN_W + vch * 8) * 2);
#define ATT_LOAD(j) do { const char* tb = (const char*)proj + (size_t)((l0 - 128 + 32 * (j)) * d + r) * (size_t)(IN_COLS * 2);     \
        _Pragma("unroll") for (int i = 0; i < 4; ++i) kr[(j) % 3][i] = *(const u32x4*)(tb + (size_t)(8 * i) * rowb + kvo); \
        _Pragma("unroll") for (int i = 0; i < 4; ++i) vr[(j) % 3][i] = *(const u32x4*)(tb + (size_t)(8 * i) * rowb + vvo); } while (0)
#pragma unroll
    for (int o = 0; o < 3; ++o) if (4 - o >= jfirst) ATT_LOAD(4 - o);
    const LAS unsigned char* vtr_base = vl + (4 * hh + ((lane & 15) >> 2)) * VP + (16 * ((lane >> 4) & 1) + 4 * (lane & 3)) * 2;
#pragma unroll
    for (int o = 0; o < 5; ++o) { constexpr int dummy = 0; (void)dummy; const int j = 4 - o; if (j >= jfirst) {
#pragma unroll
        for (int i = 0; i < 4; ++i) *(LAS u32x4*)(vl + (vrow + 8 * i) * VP + vch * 16) = vr[j % 3][i];
#pragma unroll
        for (int i = 0; i < 4; ++i) *(LAS u32x4*)(vl + 32 * VP + (vrow + 8 * i) * KP + vch * 16) = kr[j % 3][i];
        bf16x8 kf[4];
#pragma unroll
        for (int s = 0; s < 4; ++s) kf[s] = *(const LAS bf16x8*)(vl + 32 * VP + c * KP + 16 * hh + 32 * s);
        f32x16 sa;
#pragma unroll
        for (int i = 0; i < 16; ++i) sa[i] = 0.f;
#pragma unroll
        for (int s = 0; s < 4; ++s) sa = __builtin_amdgcn_mfma_f32_32x32x16_bf16(kf[s], qf[s], sa, 0, 0, 0);
        const float base = -slope2 * (float)(c + 128 - 32 * j);
        float mx = -INFINITY;
#pragma unroll
        for (int i = 0; i < 16; ++i) { const int ki = (i & 3) + 8 * (i >> 2) + 4 * hh;
            float v = __builtin_fmaf(sa[i], sc2, kb[i]);
            const bool valid = (j == 0) ? (ki >= c) : ((j == 4) ? (ki <= c) : true);
            v = valid ? v : -INFINITY; sa[i] = v; mx = fmaxf(mx, v); }
        mx += base;
        mx = fmaxf(mx, __builtin_bit_cast(float, __builtin_amdgcn_ds_bpermute(xaddr, __builtin_bit_cast(int, mx))));
        const float mnew = fmaxf(m, mx);
        const float alpha = __builtin_amdgcn_exp2f(m - mnew);
        const float msh = mnew - base;
        float ps = 0.f;
#pragma unroll
        for (int i = 0; i < 16; ++i) { const float p = __builtin_amdgcn_exp2f(sa[i] - msh); sa[i] = p; ps += p; }
        lsum = lsum * alpha + ps;
        if (o > 0 && __builtin_amdgcn_ballot_w64(mnew > m) != 0ull) {
#pragma unroll
            for (int i = 0; i < 16; ++i) { o0[i] *= alpha; o1[i] *= alpha; } }
        m = mnew;
        bf16x8 pf[2];
#pragma unroll
        for (int s = 0; s < 2; ++s) { u32x4 w; w.x = g8::cvt_pk_bf16(sa[8 * s + 0], sa[8 * s + 1]); w.y = g8::cvt_pk_bf16(sa[8 * s + 2], sa[8 * s + 3]); w.z = g8::cvt_pk_bf16(sa[8 * s + 4], sa[8 * s + 5]); w.w = g8::cvt_pk_bf16(sa[8 * s + 6], sa[8 * s + 7]);
            pf[s] = __builtin_bit_cast(bf16x8, w); }
#pragma unroll
        for (int s = 0; s < 2; ++s) {
#pragma unroll
            for (int nt = 0; nt < 2; ++nt) {
                const s16x4 lo = vtr(vtr_base + (16 * s) * VP + nt * 64), hi = vtr(vtr_base + (16 * s + 8) * VP + nt * 64);
                const bf16x8 af = __builtin_shufflevector(lo, hi, 0, 1, 2, 3, 4, 5, 6, 7);
                if (nt == 0) o0 = __builtin_amdgcn_mfma_f32_32x32x16_bf16(af, pf[s], o0, 0, 0, 0); else o1 = __builtin_amdgcn_mfma_f32_32x32x16_bf16(af, pf[s], o1, 0, 0, 0);
            }
        }
        }
        if (o + 3 <= 4 && 4 - (o + 3) >= jfirst) ATT_LOAD(4 - (o + 3));
    }
#undef ATT_LOAD
    lsum += __builtin_bit_cast(float, __builtin_amdgcn_ds_bpermute(xaddr, __builtin_bit_cast(int, lsum)));
    const float inv = __builtin_amdgcn_rcpf(lsum);
    const size_t tok = (size_t)b * SEQ + (size_t)((l0 + c) * d + r);
    { LAS unsigned char* ob = vl + 32 * VP + c * KP + 8 * hh;
#pragma unroll
      for (int g = 0; g < 4; ++g) {
        u32x2 w0, w1;
        w0.x = g8::cvt_pk_bf16(o0[4 * g] * inv, o0[4 * g + 1] * inv); w0.y = g8::cvt_pk_bf16(o0[4 * g + 2] * inv, o0[4 * g + 3] * inv);
        w1.x = g8::cvt_pk_bf16(o1[4 * g] * inv, o1[4 * g + 1] * inv); w1.y = g8::cvt_pk_bf16(o1[4 * g + 2] * inv, o1[4 * g + 3] * inv);
        *(LAS u32x2*)(ob + 16 * g) = w0; *(LAS u32x2*)(ob + 64 + 16 * g) = w1; }
      const int orow_ = lane >> 3, och = lane & 7;
#pragma unroll
      for (int i = 0; i < 4; ++i) { const u32x4 w = *(const LAS u32x4*)(vl + 32 * VP + (orow_ + 8 * i) * KP + och * 16);
        const size_t tk = (size_t)b * SEQ + (size_t)((l0 + orow_ + 8 * i) * d + r);
        *(u32x4*)((bf16_t*)(F.ws + WS_ATT) + ((size_t)br * NTOK + tk) * ATTN_W + h * 64 + och * 8) = w; } }
    if (hh == 0) ((float*)(F.ws + WS_LSE))[((size_t)br * NTOK + tok) * 16 + h] = 0.6931471805599453f * (m + __builtin_amdgcn_logf(lsum));
}
#ifndef PROBE_P2
#define PROBE_P2 0
#endif
__device__ __forceinline__ void p2_mixers(const Frame& F, const Args& a) {
    for (int u = F.gw; u < 2048; u += F.NGW) lru_unit(F, a, u);
    const bool split = F.G == 256, late = split && blockIdx.x < 128;
    const int bx = blockIdx.x, sub = split ? ((bx & 7) * 16 + ((bx >> 3) & 15)) * NWAVES + F.wave : F.gw;
    const int ustart = split ? (late ? 9216 + sub : sub) : F.gw, ustride = split ? 1024 : F.NGW, uend = split ? (late ? 12288 : 9216) : 3 * 4096;
#pragma nounroll
    for (int u = ustart; u < uend; u += ustride) { asm volatile("" ::: "memory"); const int u0 = __builtin_amdgcn_readfirstlane(u), pass = (u0 - ustart) / ustride;
        const int uu = (u0 & ~63) | ((u0 + 21 * pass) & 63);
        attn_unit(F, a, uu); }
}

__device__ __forceinline__ void p3_mix(const Frame& F, const Args& a) {
    const int LANE = lane_now(), TID = F.wave * 64 + LANE; (void)TID;
    LAS float* Hin = (LAS float*)F.lds;
    const float* ae = (const float*)(F.ws + WS_LRUE); const float* he = ae + 4 * 32 * 1024;
    const bf16_t* proj = (const bf16_t*)(F.ws + WS_PROJ);
    bf16_t* mixed = (bf16_t*)(F.ws + WS_MIXED);
    const f32x4* gr_att = (const f32x4*)karg_in<10>() + 2 * LANE; const f32x4* gr_rec = (const f32x4*)karg_in<11>() + 2 * LANE;
    for (int grp = F.vcu; grp < NTOK / 32; grp += F.G) {
        const int tok0 = grp * 32, b = tok0 / SEQ, k = (tok0 % SEQ) / 64;
        __syncthreads();
        for (int d = TID; d < LRU_W; d += NTHR) { float H = 0.f;
            for (int j0 = 0; j0 < k; j0 += 8) { float av[8], hv[8];
#pragma unroll
                for (int jj = 0; jj < 8; ++jj) { const bool ok = (j0 + jj) < k; const size_t o = (size_t)(b * 32 + (ok ? j0 + jj : 0)) * 1024 + d; const float a1 = ae[o], h1 = he[o]; av[jj] = ok ? a1 : 1.0f; hv[jj] = ok ? h1 : 0.0f; }
#pragma unroll
                for (int jj = 0; jj < 8; ++jj) H = av[jj] * H + hv[jj]; }
            Hin[d] = H; }
        __syncthreads();
        for (int tt = F.wave; tt < 32; tt += NWAVES) {
            const size_t tok = (size_t)tok0 + tt;
            { const bf16_t* ao = (const bf16_t*)(F.ws + WS_ATT); const float* lse = (const float*)(F.ws + WS_LSE); const f32x4* gr = gr_att;
              float v[2][8]; float s = 0.f;
#pragma unroll
              for (int j = 0; j < 2; ++j) { const int hd = (LANE >> 3) + 8 * j;
                  const float l0 = lse[(0 * (size_t)NTOK + tok) * 16 + hd], l1 = lse[(1 * (size_t)NTOK + tok) * 16 + hd], l2 = lse[(2 * (size_t)NTOK + tok) * 16 + hd];
                  const float M = fmaxf(l0, fmaxf(l1, l2)); float w0 = __expf(l0 - M), w1 = __expf(l1 - M), w2 = __expf(l2 - M); const float iw = __builtin_amdgcn_rcpf(w0 + w1 + w2); w0 *= iw; w1 *= iw; w2 *= iw;
                  const u32x4 a0 = *((const u32x4*)(ao + (0 * (size_t)NTOK + tok) * ATTN_W) + LANE + 64 * j), a1 = *((const u32x4*)(ao + (1 * (size_t)NTOK + tok) * ATTN_W) + LANE + 64 * j), a2 = *((const u32x4*)(ao + (2 * (size_t)NTOK + tok) * ATTN_W) + LANE + 64 * j);
#pragma unroll
                  for (int e = 0; e < 4; ++e) { v[j][2 * e] = w0 * bflo(a0[e]) + w1 * bflo(a1[e]) + w2 * bflo(a2[e]); v[j][2 * e + 1] = w0 * bfhi(a0[e]) + w1 * bfhi(a1[e]) + w2 * bfhi(a2[e]);
                      s += v[j][2 * e] * v[j][2 * e] + v[j][2 * e + 1] * v[j][2 * e + 1]; } }
              const float rs = rsqrtf(wave_sum(s) * (1.0f / 1024.0f) + EPS);
              u32x4* o = (u32x4*)(mixed + tok * D_MODEL) + LANE;
#pragma unroll
              for (int j = 0; j < 2; ++j) { const f32x4 g0 = gr[128 * j], g1 = gr[128 * j + 1]; u32x4 w;
                  w.x = pk2(v[j][0] * rs * g0[0], v[j][1] * rs * g0[1]); w.y = pk2(v[j][2] * rs * g0[2], v[j][3] * rs * g0[3]); w.z = pk2(v[j][4] * rs * g1[0], v[j][5] * rs * g1[1]); w.w = pk2(v[j][6] * rs * g1[2], v[j][7] * rs * g1[3]); o[64 * j] = w; } }
            { const u32x4* hr = (const u32x4*)((const bf16_t*)(F.ws + WS_HL) + tok * LRU_W) + LANE; const u32x4* pr = (const u32x4*)((const bf16_t*)(F.ws + WS_PC) + tok * LRU_W) + LANE;
              const u32x4* gp = (const u32x4*)(proj + tok * IN_COLS + 3 * ATTN_W + LRU_W) + LANE; const f32x4* gr = gr_rec;
              float v[2][8]; float s = 0.f;
#pragma unroll
              for (int j = 0; j < 2; ++j) { const u32x4 hw = hr[64 * j], pw = pr[64 * j], gw = gp[64 * j];
                  const f32x4 hi0 = *(const LAS f32x4*)(Hin + (LANE + 64 * j) * 8), hi1 = *(const LAS f32x4*)(Hin + (LANE + 64 * j) * 8 + 4);
#pragma unroll
                  for (int e = 0; e < 4; ++e) { const float ha = (e < 2) ? hi0[2 * e] : hi1[2 * e - 4], hb = (e < 2) ? hi0[2 * e + 1] : hi1[2 * e - 3];
                      v[j][2 * e] = (bflo(hw[e]) + bflo(pw[e]) * ha) * gelu_tanh(bflo(gw[e])); v[j][2 * e + 1] = (bfhi(hw[e]) + bfhi(pw[e]) * hb) * gelu_tanh(bfhi(gw[e]));
                      s += v[j][2 * e] * v[j][2 * e] + v[j][2 * e + 1] * v[j][2 * e + 1]; } }
              const float rs = rsqrtf(wave_sum(s) * (1.0f / 1024.0f) + EPS);
              u32x4* o = (u32x4*)(mixed + tok * D_MODEL + ATTN_W) + LANE;
#pragma unroll
              for (int j = 0; j < 2; ++j) { const f32x4 g0 = gr[128 * j], g1 = gr[128 * j + 1]; u32x4 w;
                  w.x = pk2(v[j][0] * rs * g0[0], v[j][1] * rs * g0[1]); w.y = pk2(v[j][2] * rs * g0[2], v[j][3] * rs * g0[3]); w.z = pk2(v[j][4] * rs * g1[0], v[j][5] * rs * g1[1]); w.w = pk2(v[j][6] * rs * g1[2], v[j][7] * rs * g1[3]); o[64 * j] = w; } }
        }
    }
    __syncthreads();
}

__device__ __forceinline__ void p5_router(const Frame& F, const Args& a) {
    const int LANE = lane_now(), TID = F.wave * 64 + LANE; (void)TID;
    const float* x1 = (const float*)(F.ws + WS_X1); bf16_t* hn2 = (bf16_t*)(F.ws + WS_HN2S); int* ridx = (int*)(F.ws + WS_RIDX);
    const float* g = karg_in<13>(); const float* wr = karg_in<14>(); const float* br = karg_in<15>();
    int* cnt = (int*)(F.ctl + CW_CNT);
    int* sel_e = (int*)(F.ws + WS_SEL); int* sel_pos = sel_e + NSLOT; float* sel_g = (float*)(sel_pos + NSLOT);
    LAS float* PART = (LAS float*)F.lds;
    LAS float* SSQ = PART + 8 * 1024;
    LAS float* RS = SSQ + 256;
    LAS float* LG = RS + 32;
    LAS int* lcnt = (LAS int*)(LG + 1024);
    LAS int* gbase = lcnt + 32;
    LAS int* ent_e = gbase + 32;
    LAS int* ent_r = ent_e + 128;
    LAS float* ent_g = (LAS float*)(ent_r + 128);
    const int lane = LANE, r16 = lane & 15, kq = lane >> 4;
    for (int grp = F.vcu; grp < NTOK / 32; grp += F.G) {
        const int tok0 = grp * 32;
        __syncthreads();
        if (TID < 32) lcnt[TID] = 0;
        f32x4 acc00 = {0.f, 0.f, 0.f, 0.f}, acc01 = acc00, acc10 = acc00, acc11 = acc00; float ss0 = 0.f, ss1 = 0.f;
        const float* xa = x1 + (size_t)(tok0 + r16) * D_MODEL + F.wave * 256 + 4 * kq;
        const float* gp = g + F.wave * 256 + 4 * kq;
        const float* wp = wr + (size_t)(F.wave * 256 + 4 * kq) * N_EXP + r16;
#pragma unroll 8
        for (int S = 0; S < 16; ++S) {
            const f32x4 xv0 = *(const f32x4*)(xa + 16 * S), xv1 = *(const f32x4*)(xa + 16 * S + (size_t)16 * D_MODEL), gv = *(const f32x4*)(gp + 16 * S);
            float b0[4], b1[4];
#pragma unroll
            for (int q = 0; q < 4; ++q) { b0[q] = wp[(size_t)(16 * S + q) * N_EXP]; b1[q] = wp[(size_t)(16 * S + q) * N_EXP + 16]; }
            ss0 += (xv0[0] * xv0[0] + xv0[1] * xv0[1]) + (xv0[2] * xv0[2] + xv0[3] * xv0[3]);
            ss1 += (xv1[0] * xv1[0] + xv1[1] * xv1[1]) + (xv1[2] * xv1[2] + xv1[3] * xv1[3]);
#pragma unroll
            for (int q = 0; q < 4; ++q) { const float a0 = xv0[q] * gv[q], a1 = xv1[q] * gv[q];
                acc00 = __builtin_amdgcn_mfma_f32_16x16x4f32(a0, b0[q], acc00, 0, 0, 0); acc01 = __builtin_amdgcn_mfma_f32_16x16x4f32(a0, b1[q], acc01, 0, 0, 0);
                acc10 = __builtin_amdgcn_mfma_f32_16x16x4f32(a1, b0[q], acc10, 0, 0, 0); acc11 = __builtin_amdgcn_mfma_f32_16x16x4f32(a1, b1[q], acc11, 0, 0, 0); }
        }
        { LAS float* pw = PART + F.wave * 1024;
#pragma unroll
          for (int q = 0; q < 4; ++q) { const int tr = 4 * kq + q;
              pw[tr * 32 + r16] = acc00[q]; pw[tr * 32 + 16 + r16] = acc01[q]; pw[(16 + tr) * 32 + r16] = acc10[q]; pw[(16 + tr) * 32 + 16 + r16] = acc11[q]; }
          ss0 += __shfl_xor(ss0, 16); ss0 += __shfl_xor(ss0, 32); ss1 += __shfl_xor(ss1, 16); ss1 += __shfl_xor(ss1, 32);
          if (kq == 0) { SSQ[F.wave * 32 + r16] = ss0; SSQ[F.wave * 32 + 16 + r16] = ss1; } }
        __syncthreads();
        if (TID < 32) { float t = 0.f;
#pragma unroll
            for (int w = 0; w < 8; ++w) t += SSQ[w * 32 + TID];
            RS[TID] = rsqrtf(t * (1.0f / 2048.0f) + EPS); }
        __syncthreads();
        { const int tt = TID >> 4, eg = TID & 15; float s0 = 0.f, s1 = 0.f;
#pragma unroll
          for (int w = 0; w < 8; ++w) { const f32x2 v = *(const LAS f32x2*)(PART + w * 1024 + tt * 32 + 2 * eg); s0 += v[0]; s1 += v[1]; }
          const float rs = RS[tt];
          LG[tt * 32 + 2 * eg] = s0 * rs + br[2 * eg]; LG[tt * 32 + 2 * eg + 1] = s1 * rs + br[2 * eg + 1]; }
        __syncthreads();
        for (int t4 = 0; t4 < 4; ++t4) {
            const int tk = F.wave * 4 + t4;
            float cur = (lane < 32) ? LG[tk * 32 + lane] : -INFINITY;
            int i0 = 0, i1 = 0, i2 = 0, i3 = 0; float v0 = 0.f, v1 = 0.f, v2 = 0.f, v3 = 0.f;
#pragma unroll
            for (int k = 0; k < 4; ++k) {
                const float mx = wave_max(cur);
                const unsigned long long bal = __ballot(cur == mx);
                const int bi = __ffsll((long long)bal) - 1;
                if (k == 0) { i0 = bi; v0 = mx; } else if (k == 1) { i1 = bi; v1 = mx; } else if (k == 2) { i2 = bi; v2 = mx; } else { i3 = bi; v3 = mx; }
                if (lane == bi) cur = -INFINITY;
            }
            if (lane == 0) {
                const float e1 = __expf(v1 - v0), e2 = __expf(v2 - v0), e3 = __expf(v3 - v0); const float inv = 1.0f / (1.0f + e1 + e2 + e3);
                const int base = tk * 4;
                ent_e[base + 0] = i0; ent_r[base + 0] = __hip_atomic_fetch_add(&lcnt[i0], 1, __ATOMIC_RELAXED, __HIP_MEMORY_SCOPE_WORKGROUP); ent_g[base + 0] = inv;
                ent_e[base + 1] = i1; ent_r[base + 1] = __hip_atomic_fetch_add(&lcnt[i1], 1, __ATOMIC_RELAXED, __HIP_MEMORY_SCOPE_WORKGROUP); ent_g[base + 1] = e1 * inv;
                ent_e[base + 2] = i2; ent_r[base + 2] = __hip_atomic_fetch_add(&lcnt[i2], 1, __ATOMIC_RELAXED, __HIP_MEMORY_SCOPE_WORKGROUP); ent_g[base + 2] = e2 * inv;
                ent_e[base + 3] = i3; ent_r[base + 3] = __hip_atomic_fetch_add(&lcnt[i3], 1, __ATOMIC_RELAXED, __HIP_MEMORY_SCOPE_WORKGROUP); ent_g[base + 3] = e3 * inv;
            }
        }
        __syncthreads();
        if (TID < 32) { const int n = lcnt[TID]; gbase[TID] = n > 0 ? atomicAdd(&cnt[TID], n) : 0; }
        __syncthreads();
        if (TID < 128) { const int e = ent_e[TID], pos = gbase[e] + ent_r[TID], tok = tok0 + (TID >> 2);
            sel_e[tok * 4 + (TID & 3)] = e; sel_pos[tok * 4 + (TID & 3)] = pos; sel_g[tok * 4 + (TID & 3)] = ent_g[TID]; ridx[e * NTOK + pos] = tok; }
        for (int t4 = 0; t4 < 4; ++t4) { const int tk = F.wave * 4 + t4; const float rs = RS[tk];
            const f32x4* xr = (const f32x4*)(x1 + (size_t)(tok0 + tk) * D_MODEL) + lane; const f32x4* gr = (const f32x4*)g + lane; u32x2 w[8];
#pragma unroll
            for (int j = 0; j < 8; ++j) { const f32x4 v = xr[64 * j], gg = gr[64 * j]; w[j].x = pk2(v[0] * rs * gg[0], v[1] * rs * gg[1]); w[j].y = pk2(v[2] * rs * gg[2], v[3] * rs * gg[3]); }
            { u32x2* o = (u32x2*)(hn2 + (size_t)(tok0 + tk) * D_MODEL) + lane;
#pragma unroll
              for (int j = 0; j < 8; ++j) o[64 * j] = w[j]; } }
    }
    __syncthreads();
}

__device__ __forceinline__ void build_tpre(const Frame& F, int nhb) {
    const int TID = F.tid_();
    LAS int* tpre = (LAS int*)(F.lds + L_TPRE); LAS int* bid = (LAS int*)(F.lds + L_BLKID); LAS int* bpre = (LAS int*)(F.lds + L_BLKPRE); LAS int* bsz = (LAS int*)(F.lds + L_BLKPRE + 512);
    __syncthreads();
    if (TID == 0) { const int* cnt = (const int*)(F.ctl + CW_CNT); int acc = 0; for (int e = 0; e < N_EXP; ++e) { tpre[e] = acc; acc += (cnt[e] + 255) >> 8; tpre[64 + e] = cnt[e]; } tpre[N_EXP] = acc; }
    __syncthreads();
    if (nhb) {
        const int nb = N_EXP * nhb;
        if (TID < nb) {
            const int e = TID / nhb, nm = tpre[e + 1] - tpre[e]; int r = 0;
            for (int b = 0; b < nb; ++b) { const int eb = b / nhb, nmb = tpre[eb + 1] - tpre[eb]; r += (nmb > nm || (nmb == nm && b < TID)) ? 1 : 0; }
            bid[(r & 7) * 8 + (r >> 3)] = TID; bsz[(r & 7) * 8 + (r >> 3)] = nm * 8;
        }
        __syncthreads();
        if (TID < 8) { int acc = 0; bpre[TID * 9] = 0; for (int k = 0; k < 4 * nhb; ++k) { acc += bsz[TID * 8 + k]; bpre[TID * 9 + k + 1] = acc; } }
        __syncthreads();
    }
}

__device__ __forceinline__ void p8_final(const Frame& F, const Args& a) {
    const int LANE = lane_now(), TID = F.wave * 64 + LANE; (void)TID;
    const LAS int* tpre = (const LAS int*)(F.lds + L_TPRE);
    const float* x1 = (const float*)(F.ws + WS_X1); const bf16_t* Y = (const bf16_t*)(F.ws + WS_Y);
    const int* sel_e = (const int*)(F.ws + WS_SEL); const int* sel_pos = sel_e + NSLOT; const float* sel_g = (const float*)(sel_pos + NSLOT);
    const f32x4* gr = (const f32x4*)karg_in<20>() + LANE; float* outp = karg_out();
    for (int tok = F.gw; tok < NTOK; tok += F.NGW) {
        const f32x4* xr = (const f32x4*)(x1 + (size_t)tok * D_MODEL) + LANE;
        f32x4 v[8];
#pragma unroll
        for (int j = 0; j < 8; ++j) v[j] = xr[64 * j];
#pragma unroll
        for (int k = 0; k < 4; ++k) {
            const int e = sel_e[tok * 4 + k]; const size_t row = (size_t)tpre[e] * 256 + sel_pos[tok * 4 + k]; const float gk = sel_g[tok * 4 + k];
            const u32x2* yp = (const u32x2*)(Y + row * D_MODEL) + LANE;
#pragma unroll
            for (int j = 0; j < 8; ++j) { const u32x2 w = yp[64 * j]; v[j][0] += gk * bflo(w.x); v[j][1] += gk * bfhi(w.x); v[j][2] += gk * bflo(w.y); v[j][3] += gk * bfhi(w.y); }
        }
        float s = 0.f;
#pragma unroll
        for (int j = 0; j < 8; ++j) s += (v[j][0] * v[j][0] + v[j][1] * v[j][1]) + (v[j][2] * v[j][2] + v[j][3] * v[j][3]);
        const float rs = rsqrtf(wave_sum(s) * (1.0f / 2048.0f) + EPS);
        f32x4* o = (f32x4*)(outp + (size_t)tok * D_MODEL) + LANE;
#pragma unroll
        for (int j = 0; j < 8; ++j) { const f32x4 g = gr[64 * j]; o[64 * j] = (f32x4){v[j][0] * rs * g[0], v[j][1] * rs * g[1], v[j][2] * rs * g[2], v[j][3] * rs * g[3]}; }
    }
}

__device__ __forceinline__ void ph1_inproj(const Frame& F, const Args& args) {
    unsigned char* ws = F.ws;
    const int ncol = (F.G == 256) ? 4096 / 256 : IN_COLS / 256;
    g8::DenseOrder S{(const char*)(ws + WS_HN), (const char*)karg_in<2>(), NTOK / 256, ncol, (NTOK / 256) * ncol, F.G, (int)blockIdx.x, IN_COLS};
    g8::EpiBf16 E{(bf16_t*)(ws + WS_PROJ), IN_COLS, nullptr, 0};
    g8::gemm_phase<g8::EpiBf16, g8::DenseOrder>(F.lds, S, E, F.wave);
}
__device__ __forceinline__ void ph1_gate(const Frame& F, const Args& args) {
    unsigned char* ws = F.ws;
    g8::DenseOrder S{(const char*)(ws + WS_HN), (const char*)(karg_in<2>() + 4096), NTOK / 256, 4, (NTOK / 256) * 4, F.G, (int)blockIdx.x, IN_COLS};
    g8::EpiBf16 E{(bf16_t*)(ws + WS_PROJ) + 4096, IN_COLS, nullptr, 0};
    g8::gemm_phase<g8::EpiBf16, g8::DenseOrder>(F.lds, S, E, F.wave);
}
__device__ __forceinline__ void ph4_outproj(const Frame& F, const Args& args) {
    unsigned char* ws = F.ws;
    g8::DenseOrder S{(const char*)(ws + WS_MIXED), (const char*)karg_in<12>(), NTOK / 256, D_MODEL / 256, (NTOK / 256) * (D_MODEL / 256), F.G, (int)blockIdx.x, D_MODEL};
    g8::EpiResF32 E{(float*)(ws + WS_X1), karg_in<0>(), D_MODEL};
    g8::gemm_phase<g8::EpiResF32, g8::DenseOrder>(F.lds, S, E, F.wave);
}
__device__ __forceinline__ void ph6_gateup(const Frame& F, const Args& args) {
    unsigned char* ws = F.ws;
    build_tpre(F, 2);
    g8::GroupedOrderT<true> S{(const char*)(ws + WS_HN2S), (const char*)karg_in<16>(), (const LAS int*)(F.lds + L_TPRE), (const LAS int*)(F.lds + L_BLKID), (const LAS int*)(F.lds + L_BLKPRE), 2, F.G, (int)blockIdx.x, (size_t)4096 * KDIM * 4, true, 4096};
    g8::EpiSwiglu E{(bf16_t*)(ws + WS_ACT), karg_in<17>()};
    {
        LAS unsigned short* gt = (LAS unsigned short*)(F.lds + L_GTAB); const int* ridx = (const int*)(ws + WS_RIDX); const LAS int* tp = (const LAS int*)(F.lds + L_TPRE);
        const int TID = F.tid_(); int val[8];
#pragma unroll
        for (int j = 0; j < 8; ++j) { const int idx = TID + 512 * j, i = idx >> 8, r = idx & 255; g8::Unit u; val[j] = 0;
            if (S.next(i, u)) { const int pos = u.gi + r, cn = tp[64 + u.e]; val[j] = ridx[u.e * NTOK + (pos < cn ? pos : u.gi)]; } }
#pragma unroll
        for (int j = 0; j < 8; ++j) gt[TID + 512 * j] = (unsigned short)val[j];
        __syncthreads();
    }
    g8::gemm_phase<g8::EpiSwiglu, g8::GroupedOrderT<true>>(F.lds, S, E, F.wave);
}
__device__ __forceinline__ void ph7_down(const Frame& F, const Args& args) {
    unsigned char* ws = F.ws;
    build_tpre(F, 1);
    g8::GroupedOrderT<false> S{(const char*)(ws + WS_ACT), (const char*)karg_in<18>(), (const LAS int*)(F.lds + L_TPRE), (const LAS int*)(F.lds + L_BLKID), (const LAS int*)(F.lds + L_BLKPRE), 1, F.G, (int)blockIdx.x, (size_t)D_MODEL * KDIM * 4, false, D_MODEL};
    g8::EpiBf16 E{(bf16_t*)(ws + WS_Y), D_MODEL, karg_in<19>(), D_MODEL};
    g8::gemm_phase<g8::EpiBf16, g8::GroupedOrderT<false>>(F.lds, S, E, F.wave);
}

constexpr int N_PHASES = 9;
__global__ void __launch_bounds__(NTHR, 2) mk_fwd(Args args) {
    extern __shared__ __attribute__((aligned(16))) unsigned char lds_raw[];
    Frame F;
    F.lds = (LAS unsigned char*)lds_raw;
    F.wave = __builtin_amdgcn_readfirstlane((int)threadIdx.x >> 6);
    F.G = gridDim.x; { const int bx = blockIdx.x; F.vcu = (F.G % 8 == 0) ? (bx % 8) * (F.G / 8) + bx / 8 : bx; }
    F.gw = F.vcu * NWAVES + F.wave; F.NGW = F.G * NWAVES;
    F.ws = (unsigned char*)(unsigned char __attribute__((address_space(1)))*)args.ws; F.ctl = (unsigned*)(F.ws + WS_CTL);
    for (int u = F.tid_(); u < (LDS_BYTES - LDSCTL_OFF) / 4; u += NTHR) ((LAS unsigned*)(F.lds + LDSCTL_OFF))[u] = 0u;
    __syncthreads();
    const int lo = args.ph_lo, hi = args.ph_hi;
    unsigned bar_x = 0;
    if (hi - lo > 1) bar_x = __builtin_amdgcn_readfirstlane(xcd_barrier_post(F.ctl + CW_BAR, (volatile LAS unsigned*)(F.lds + L_MISC) + 8, F.tid_()).x);
#define IN(k) (lo <= (k) && (k) < hi)
#define XBAR() do { unsigned* _bp = F.ctl + CW_BAR; asm volatile("" : "+s"(_bp)); XcdBarrier _b; _b.bar = _bp; _b.x = bar_x; _b.st = (volatile LAS unsigned*)(F.lds + L_MISC) + 8; xcd_barrier(_b, F.tid_()); } while (0)
#define SEAM(k) do { if (IN(k) && IN((k) + 1)) XBAR(); } while (0)

#define PHASE(k, call) do { if (IN(k)) { call; } if ((PROBE_MASK >> (k)) & 1) { XBAR(); if (IN(k)) { call; } } } while (0)
    PHASE(0, p0_prologue(F, args)); SEAM(0);
    PHASE(1, ph1_inproj(F, args)); SEAM(1);
    if (IN(2)) { if (F.G == 256 && blockIdx.x < 128) ph1_gate(F, args); p2_mixers(F, args); } SEAM(2);
    PHASE(3, p3_mix(F, args)); SEAM(3);
    PHASE(4, ph4_outproj(F, args)); SEAM(4);
    if (IN(5)) { p5_router(F, args); } SEAM(5);
    PHASE(6, ph6_gateup(F, args)); SEAM(6);
    PHASE(7, ph7_down(F, args)); SEAM(7);
    if (IN(8)) { build_tpre(F, 0); p8_final(F, args); }
#undef IN
#undef SEAM
}

extern "C" void kernel_launch(void* const* d_in, const int* in_sizes, int n_in, void* d_out, int out_size, void* d_ws, size_t ws_size, hipStream_t stream) {
    static int grid = 0;
    if (grid == 0) {
        if (n_in != 21 || out_size != NTOK * D_MODEL || ws_size < WS_END) { fprintf(stderr, "kernel_launch: unexpected problem (n_in %d out %d ws %zu)\n", n_in, out_size, ws_size); grid = -1; return; }
        int dev = 0, cus = 0, per_cu = 0;
        if (hipGetDevice(&dev) != hipSuccess || hipDeviceGetAttribute(&cus, hipDeviceAttributeMultiprocessorCount, dev) != hipSuccess) { grid = -1; return; }
        if (hipFuncSetAttribute((const void*)mk_fwd, hipFuncAttributeMaxDynamicSharedMemorySize, LDS_BYTES) != hipSuccess) { fprintf(stderr, "kernel_launch: hipFuncSetAttribute failed\n"); grid = -1; return; }
        if (hipOccupancyMaxActiveBlocksPerMultiprocessor(&per_cu, (const void*)mk_fwd, NTHR, LDS_BYTES) != hipSuccess || per_cu < 1) { fprintf(stderr, "kernel_launch: occupancy query says %d\n", per_cu); }
        (void)hipGetLastError();
        grid = cus;
    }
    if (grid < 0) return;
    if (hipMemsetAsync((char*)d_ws + WS_CTL, 0, CTL_ZERO_BYTES, stream) != hipSuccess) return;
    Args a{};
    for (int i = 0; i < 21; ++i) a.in[i] = (const float*)d_in[i];
    a.out = (float*)d_out; a.ws = (unsigned char*)d_ws;
#if MK_N_LAUNCHES == 1
    a.ph_lo = 0; a.ph_hi = N_PHASES;
    hipLaunchKernelGGL(mk_fwd, dim3(grid), dim3(NTHR), LDS_BYTES, stream, a);
#else
    for (int p = 0; p < N_PHASES; ++p) { a.ph_lo = p; a.ph_hi = p + 1; hipLaunchKernelGGL(mk_fwd, dim3(grid), dim3(NTHR), LDS_BYTES, stream, a); }
#endif
}
```
